# Optimizing an MI355X kernel written in HIP

```python
import jax, jax.numpy as jnp
from jax import lax
import numpy as np

D_MODEL = 1024
BATCH = 8
SEQ = 4096
DEPTH = 2

N_A_LAYERS = DEPTH // 2
N_B_LAYERS = DEPTH - N_A_LAYERS

RWKV_HEAD_SIZE = 64
RWKV_HEADS = D_MODEL // RWKV_HEAD_SIZE
DECAY_LORA = 64
AAA_LORA = 64
GATE_LORA = 128
GN_EPS = 64e-5

MLA_HEADS = 8
QK_NOPE_DIM = 128
QK_ROPE_DIM = 64
V_HEAD_DIM = 128
Q_LORA_RANK = 512
KV_LORA_RANK = 256
ROPE_THETA = 10000.0
Q_BLOCK = 128
MAX_POS_OFFSET = 2048

D_FF = 2816
RMS_EPS = 1e-6

kernel_name = "hybrid_rwkv7_mla_yoco_macaron"


def rmsnorm(x, g):
    xf = x.astype(jnp.float32)
    y = xf * lax.rsqrt(jnp.mean(xf * xf, axis=-1, keepdims=True) + RMS_EPS)
    return (y * g.astype(jnp.float32)).astype(x.dtype)


def swiglu(x, w_gate, w_up, w_down):
    return (jax.nn.silu(x @ w_gate) * (x @ w_up)) @ w_down


def rope_tables(positions):
    inv_freq = ROPE_THETA ** (-jnp.arange(0, QK_ROPE_DIM, 2, dtype=jnp.float32) / QK_ROPE_DIM)
    ang = positions.astype(jnp.float32)[..., None] * inv_freq
    return jnp.cos(ang), jnp.sin(ang)


def apply_rope(x, cos, sin):
    half = x.shape[-1] // 2
    xf = x.astype(jnp.float32)
    x1, x2 = xf[..., :half], xf[..., half:]
    return jnp.concatenate([x1 * cos - x2 * sin, x2 * cos + x1 * sin], axis=-1).astype(x.dtype)


def wkv7_scan(r, decay, k, v, kk, a):
    B, S, H, N = r.shape

    def step(state, inp):
        r_t, w_t, k_t, v_t, kk_t, a_t = inp
        sa = jnp.einsum("bhvk,bhk->bhv", state, kk_t)
        state = (state * w_t[:, :, None, :]
                 - sa[..., None] * (kk_t * a_t)[:, :, None, :]
                 + v_t[..., None] * k_t[:, :, None, :])
        y_t = jnp.einsum("bhvk,bhk->bhv", state, r_t)
        return state, y_t

    xs = tuple(jnp.moveaxis(t, 1, 0) for t in (r, decay, k, v, kk, a))
    state0 = jnp.zeros((B, H, N, N), jnp.float32)
    _, ys = lax.scan(step, state0, xs)
    return jnp.moveaxis(ys, 0, 1)


def rwkv7_time_mix(x, mix, w_r, w_k, w_v, w_o, w0, w1, w2, a0, a1, a2, g1, g2, k_k, k_a, r_k, gn_w, gn_b):
    B, S, D = x.shape
    H, N = RWKV_HEADS, RWKV_HEAD_SIZE
    f32 = jnp.float32
    xx = jnp.pad(x, ((0, 0), (1, 0), (0, 0)))[:, :-1] - x
    xr, xw, xk, xv, xa, xg = (x + xx * mix[i] for i in range(6))
    r = xr @ w_r
    k = xk @ w_k
    v = xv @ w_v
    w_log = -jax.nn.softplus(-(w0 + jnp.tanh(xw @ w1) @ w2).astype(f32)) - 0.5
    decay = jnp.exp(-jnp.exp(w_log))
    a = jax.nn.sigmoid((a0 + (xa @ a1) @ a2).astype(f32))
    g = jax.nn.sigmoid(xg @ g1) @ g2
    kk = (k * k_k).astype(f32).reshape(B, S, H, N)
    kk = kk * lax.rsqrt(jnp.maximum(jnp.sum(kk * kk, axis=-1, keepdims=True), 1e-24))
    k = k.astype(f32) * (1.0 + (a - 1.0) * k_a.astype(f32))
    heads = lambda t: t.astype(f32).reshape(B, S, H, N)
    rh, kh, vh = heads(r), heads(k), heads(v)
    y = wkv7_scan(rh, heads(decay), kh, vh, kk, heads(a))
    mu = jnp.mean(y, axis=-1, keepdims=True)
    var = jnp.mean(jnp.square(y - mu), axis=-1, keepdims=True)
    yn = ((y - mu) * lax.rsqrt(var + GN_EPS)).reshape(B, S, D) * gn_w.astype(f32) + gn_b.astype(f32)
    bonus = jnp.sum(rh * kh * r_k.astype(f32), axis=-1, keepdims=True) * vh
    out = (yn + bonus.reshape(B, S, D)).astype(x.dtype) * g
    return out @ w_o


def mla_shared_kv(h, kv_norm_g, w_dkv, kv_latent_g, w_ukv, cos, sin):
    B, S, _ = h.shape
    ckv = rmsnorm(h, kv_norm_g) @ w_dkv
    c, k_rope = ckv[..., :KV_LORA_RANK], ckv[..., KV_LORA_RANK:]
    c = rmsnorm(c, kv_latent_g)
    kv = (c @ w_ukv).reshape(B, S, MLA_HEADS, QK_NOPE_DIM + V_HEAD_DIM)
    k_nope, v = kv[..., :QK_NOPE_DIM], kv[..., QK_NOPE_DIM:]
    k_rope = apply_rope(k_rope, cos, sin)
    return k_nope, k_rope, v


def mla_attention(x, w_dq, q_latent_g, w_uq, w_o, k_nope, k_rope, v, cos, sin):
    B, S, _ = x.shape
    q = (rmsnorm(x @ w_dq, q_latent_g) @ w_uq).reshape(B, S, MLA_HEADS, QK_NOPE_DIM + QK_ROPE_DIM)
    q_nope = q[..., :QK_NOPE_DIM]
    q_rope = apply_rope(q[..., QK_NOPE_DIM:], cos[:, :, None, :], sin[:, :, None, :])
    scale = (QK_NOPE_DIM + QK_ROPE_DIM) ** -0.5
    outs = []
    for start in range(0, S, Q_BLOCK):
        end = start + Q_BLOCK
        s = (jnp.einsum("bqhd,bkhd->bhqk", q_nope[:, start:end], k_nope[:, :end])
             + jnp.einsum("bqhd,bkd->bhqk", q_rope[:, start:end], k_rope[:, :end]))
        s = s.astype(jnp.float32) * scale
        mask = (start + jnp.arange(Q_BLOCK))[:, None] >= jnp.arange(end)[None, :]
        p = jax.nn.softmax(jnp.where(mask, s, -1e30), axis=-1).astype(v.dtype)
        outs.append(jnp.einsum("bhqk,bkhd->bqhd", p, v[:, :end]))
    o = jnp.concatenate(outs, axis=1).reshape(B, S, MLA_HEADS * V_HEAD_DIM)
    return o @ w_o


def setup_inputs(seed: int = 0) -> dict:
    key = jax.random.key(seed)
    k = jax.random.split(key, 40)
    f32 = jnp.float32
    D, H, N = D_MODEL, RWKV_HEADS, RWKV_HEAD_SIZE
    na, nb = N_A_LAYERS, N_B_LAYERS
    nrm = lambda i, shape, scale: jax.random.normal(k[i], shape, f32) * scale
    x = nrm(0, (BATCH, SEQ, D), 1.0)
    positions = (jnp.arange(SEQ, dtype=jnp.int32)[None, :]
                 + jax.random.randint(k[1], (BATCH, 1), 0, MAX_POS_OFFSET, dtype=jnp.int32))
    return {
        "x": x,
        "positions": positions,
        "norm_g": 1.0 + nrm(2, (DEPTH, 3, D), 0.02),
        "ffn_w_gate": nrm(3, (DEPTH, 2, D, D_FF), D ** -0.5),
        "ffn_w_up": nrm(4, (DEPTH, 2, D, D_FF), D ** -0.5),
        "ffn_w_down": nrm(5, (DEPTH, 2, D_FF, D), D_FF ** -0.5),
        "rwkv_mix": jax.random.uniform(k[6], (na, 6, D), f32),
        "rwkv_w_r": nrm(7, (na, D, D), D ** -0.5),
        "rwkv_w_k": nrm(8, (na, D, D), D ** -0.5),
        "rwkv_w_v": nrm(9, (na, D, D), D ** -0.5),
        "rwkv_w_o": nrm(10, (na, D, D), D ** -0.5),
        "rwkv_w0": jax.random.uniform(k[11], (na, D), f32, -3.0, 0.5),
        "rwkv_w1": nrm(12, (na, D, DECAY_LORA), D ** -0.5),
        "rwkv_w2": nrm(13, (na, DECAY_LORA, D), 0.1 * DECAY_LORA ** -0.5),
        "rwkv_a0": nrm(14, (na, D), 0.1),
        "rwkv_a1": nrm(15, (na, D, AAA_LORA), D ** -0.5),
        "rwkv_a2": nrm(16, (na, AAA_LORA, D), 0.1 * AAA_LORA ** -0.5),
        "rwkv_g1": nrm(17, (na, D, GATE_LORA), D ** -0.5),
        "rwkv_g2": nrm(18, (na, GATE_LORA, D), GATE_LORA ** -0.5),
        "rwkv_k_k": 0.85 + nrm(19, (na, D), 0.05),
        "rwkv_k_a": 1.0 + nrm(20, (na, D), 0.05),
        "rwkv_r_k": nrm(21, (na, H, N), 0.1),
        "rwkv_gn_w": 1.0 + nrm(22, (na, D), 0.02),
        "rwkv_gn_b": nrm(23, (na, D), 0.02),
        "kv_norm_g": 1.0 + nrm(24, (D,), 0.02),
        "mla_w_dkv": nrm(25, (D, KV_LORA_RANK + QK_ROPE_DIM), D ** -0.5),
        "mla_kv_latent_g": 1.0 + nrm(26, (KV_LORA_RANK,), 0.02),
        "mla_w_ukv": nrm(27, (KV_LORA_RANK, MLA_HEADS * (QK_NOPE_DIM + V_HEAD_DIM)), KV_LORA_RANK ** -0.5),
        "mla_w_dq": nrm(28, (nb, D, Q_LORA_RANK), D ** -0.5),
        "mla_q_latent_g": 1.0 + nrm(29, (nb, Q_LORA_RANK), 0.02),
        "mla_w_uq": nrm(30, (nb, Q_LORA_RANK, MLA_HEADS * (QK_NOPE_DIM + QK_ROPE_DIM)), Q_LORA_RANK ** -0.5),
        "mla_w_o": nrm(31, (nb, MLA_HEADS * V_HEAD_DIM, D), (MLA_HEADS * V_HEAD_DIM) ** -0.5),
        "final_norm_g": 1.0 + nrm(32, (D,), 0.02),
    }


def reference(x, positions, norm_g, ffn_w_gate, ffn_w_up, ffn_w_down,
              rwkv_mix, rwkv_w_r, rwkv_w_k, rwkv_w_v, rwkv_w_o, rwkv_w0, rwkv_w1, rwkv_w2,
              rwkv_a0, rwkv_a1, rwkv_a2, rwkv_g1, rwkv_g2, rwkv_k_k, rwkv_k_a, rwkv_r_k,
              rwkv_gn_w, rwkv_gn_b, kv_norm_g, mla_w_dkv, mla_kv_latent_g, mla_w_ukv,
              mla_w_dq, mla_q_latent_g, mla_w_uq, mla_w_o, final_norm_g):
    cos, sin = rope_tables(positions)
    h = x
    shared_kv = None
    for layer in range(DEPTH):
        if layer == N_A_LAYERS:
            shared_kv = mla_shared_kv(h, kv_norm_g, mla_w_dkv, mla_kv_latent_g, mla_w_ukv, cos, sin)
        h = h + 0.5 * swiglu(rmsnorm(h, norm_g[layer, 0]),
                             ffn_w_gate[layer, 0], ffn_w_up[layer, 0], ffn_w_down[layer, 0])
        hn = rmsnorm(h, norm_g[layer, 1])
        if layer < N_A_LAYERS:
            i = layer
            h = h + rwkv7_time_mix(hn, rwkv_mix[i], rwkv_w_r[i], rwkv_w_k[i], rwkv_w_v[i], rwkv_w_o[i],
                                   rwkv_w0[i], rwkv_w1[i], rwkv_w2[i], rwkv_a0[i], rwkv_a1[i], rwkv_a2[i],
                                   rwkv_g1[i], rwkv_g2[i], rwkv_k_k[i], rwkv_k_a[i], rwkv_r_k[i],
                                   rwkv_gn_w[i], rwkv_gn_b[i])
        else:
            j = layer - N_A_LAYERS
            k_nope, k_rope, v = shared_kv
            h = h + mla_attention(hn, mla_w_dq[j], mla_q_latent_g[j], mla_w_uq[j], mla_w_o[j],
                                  k_nope, k_rope, v, cos, sin)
        h = h + 0.5 * swiglu(rmsnorm(h, norm_g[layer, 2]),
                             ffn_w_gate[layer, 1], ffn_w_up[layer, 1], ffn_w_down[layer, 1])
    return rmsnorm(h, final_norm_g)
```

```cpp
#include <hip/hip_runtime.h>
#include <hip/hip_cooperative_groups.h>
#include <cstdio>
#include <cstdint>
namespace cg = cooperative_groups;

#define LAS __attribute__((address_space(3)))
typedef unsigned short bf16_t;
typedef short bf16x8 __attribute__((ext_vector_type(8)));
typedef float f32x4 __attribute__((ext_vector_type(4)));
typedef float f32x16 __attribute__((ext_vector_type(16)));
typedef unsigned u32x4 __attribute__((ext_vector_type(4)));
typedef unsigned u32x2 __attribute__((ext_vector_type(2)));

constexpr int T = 32768, D = 1024, FF = 2816, SEQ = 4096, NB = 8;
constexpr float RMS_EPS = 1e-6f, GN_EPS = 64e-5f;
constexpr float LOG2E = 1.4426950408889634f;
constexpr float QSCALE = 0.07216878364870322f * 1.4426950408889634f;

constexpr size_t MiB = 1u << 20;
constexpr size_t WS_SLOTH = MiB / 2;
constexpr size_t WS_SLOTC = WS_SLOTH + 2 * MiB;
constexpr size_t WS_SLOTQ = WS_SLOTC + MiB / 2;
constexpr size_t WS_W = 4 * MiB;
constexpr size_t W_UG = WS_W;
constexpr size_t W_DN = W_UG + 48 * MiB;
constexpr size_t W_R = W_DN + 22 * MiB;
constexpr size_t W_K = W_R + 2 * MiB;
constexpr size_t W_V = W_K + 2 * MiB;
constexpr size_t W_O = W_V + 2 * MiB;
constexpr size_t W_LD = W_O + 2 * MiB;
constexpr size_t W_LU = W_LD + 1 * MiB;
constexpr size_t W_KN = W_LU + 2 * MiB;
constexpr size_t W_VT = W_KN + MiB / 2;
constexpr size_t W_DQ = W_VT + MiB / 2;
constexpr size_t W_UQ = W_DQ + 1 * MiB;
constexpr size_t W_MO = W_UQ + 2 * MiB;
constexpr size_t W_END = W_MO + 2 * MiB;
constexpr size_t WS_A = 92 * MiB;
static_assert(W_END <= WS_A, "weights region");
constexpr size_t A_HB = WS_A + 0;
constexpr size_t A_MID = WS_A + 64 * MiB;
constexpr size_t A_C = WS_A + 240 * MiB;
constexpr size_t A_KR = WS_A + 256 * MiB;
constexpr size_t A_KN = WS_A + 260 * MiB;
constexpr size_t A_VT = WS_A + 324 * MiB;
constexpr size_t A_QLAT = A_MID;
constexpr size_t A_QN = A_MID + 32 * MiB;
constexpr size_t A_QR = A_MID + 96 * MiB;
constexpr size_t A_X1 = WS_A + 0;
constexpr size_t A_XK = WS_A + 128 * MiB;
constexpr size_t A_XV = WS_A + 192 * MiB;
constexpr size_t A_R = WS_A + 256 * MiB;
constexpr size_t A_LM = WS_A + 320 * MiB;
constexpr size_t A_KK = WS_A + 0;
constexpr size_t A_VV = WS_A + 64 * MiB;
constexpr size_t A_E = WS_A + 128 * MiB;
constexpr size_t A_AA = WS_A + 192 * MiB;
constexpr size_t A_G = WS_A + 336 * MiB;
constexpr size_t A_COS = WS_A + 404 * MiB;
constexpr size_t A_SIN = WS_A + 408 * MiB;
constexpr size_t W_RL = WS_A + 412 * MiB;
constexpr size_t WS_NEED = 512 * MiB;

constexpr int LDS_BYTES = 147456;
constexpr int NPHASES = 24;
#ifndef N_LAUNCHES
#define N_LAUNCHES 1
#endif

__device__ __forceinline__ unsigned cvt_pk_bf16(float lo, float hi) { unsigned r; asm volatile("v_cvt_pk_bf16_f32 %0, %1, %2" : "=v"(r) : "v"(lo), "v"(hi)); return r; }
__device__ __forceinline__ float fsigmoid(float x) { return __builtin_amdgcn_rcpf(1.0f + __builtin_amdgcn_exp2f(-x * LOG2E)); }
__device__ __forceinline__ float ftanh(float x) { return 1.0f - 2.0f * __builtin_amdgcn_rcpf(1.0f + __builtin_amdgcn_exp2f(2.0f * LOG2E * x)); }
__device__ __forceinline__ float wave_sum(float v) {
#pragma unroll
    for (int o = 1; o < 64; o <<= 1) v += __shfl_xor(v, o);
    return v;
}
template <int CTRL> __device__ __forceinline__ float dpp_mov(float x) { return __builtin_bit_cast(float, __builtin_amdgcn_update_dpp(0, __builtin_bit_cast(int, x), CTRL, 0xf, 0xf, true)); }
__device__ __forceinline__ float red8(float x) { x += dpp_mov<0xB1>(x); x += dpp_mov<0x4E>(x); x += dpp_mov<0x141>(x); return x; }
__device__ __forceinline__ float red16(float x) { x = red8(x); x += dpp_mov<0x140>(x); return x; }
__device__ __forceinline__ float sum4(f32x4 v) { return (v[0] + v[1]) + (v[2] + v[3]); }
__device__ __forceinline__ float rstd_slots16(const float* s, int row) {
    const f32x4* p = (const f32x4*)(s + (size_t)row * 16);
    const f32x4 a = p[0], b = p[1], c = p[2], d = p[3];
    return __builtin_amdgcn_rsqf((sum4(a) + sum4(b) + sum4(c) + sum4(d)) * (1.0f / 1024.0f) + RMS_EPS);
}
__device__ __forceinline__ f32x4 unpack4(u32x2 p) { f32x4 r; r[0] = __uint_as_float(p.x << 16); r[1] = __uint_as_float(p.x & 0xffff0000u); r[2] = __uint_as_float(p.y << 16); r[3] = __uint_as_float(p.y & 0xffff0000u); return r; }

__device__ __forceinline__ int fresh_tid(int wave_s) { int l; asm volatile("v_mbcnt_lo_u32_b32 %0, -1, 0\n\tv_mbcnt_hi_u32_b32 %0, -1, %0" : "=v"(l)); return wave_s * 64 + l; }

namespace pg8 {
constexpr int BM = 256, BK = 64, HALF = 128, HTB = HALF * BK * 2, STAGE_BYTES = 8 * HTB, NXCD = 8, WGM = 8;
__device__ __forceinline__ int lds_byte(int r, int c) { const int st = (r >> 4) * 2 + (c >> 5), rr = r & 15, cc = c & 31, ob = rr * 64 + cc * 2; return st * 1024 + (ob ^ (((ob >> 9) & 1) << 5)); }
__device__ __forceinline__ void stage_rc(int b, int& R, int& C) { const int st = b / 1024, sb = b % 1024, swz = sb ^ (((sb >> 9) & 1) << 5); R = (st >> 1) * 16 + swz / 64; C = (st & 1) * 32 + (swz % 64) / 2; }
__device__ __forceinline__ int perm32(int rho) { const int n = rho >> 4, i = rho & 15; return 8 * (i >> 2) + 4 * n + (i & 3); }
struct Unit { int pm, pn; };
struct Gemm { const bf16_t* A; int lda; const bf16_t* Bt; int ldb; int M, N, K; };
struct StaticOrder {
    int nM, nN, nwg, G, c;
    __device__ void init(int M, int N, int G_, int c_) { nM = M / BM; nN = N / BM; nwg = nM * nN; G = G_; c = c_; }
    __device__ bool next(int i, Unit& u) const {
        const long L = (long)i * G + c; if (L >= nwg) return false;
        int wgid = (int)L; { const int q = nwg / NXCD, r = nwg % NXCD, xcd = wgid % NXCD, off = wgid / NXCD; wgid = (xcd < r ? xcd * (q + 1) : r * (q + 1) + (xcd - r) * q) + off; }
        const int nig = WGM * nN, gid = wgid / nig, fm = gid * WGM, gsz = (nM - fm) < WGM ? (nM - fm) : WGM;
        u.pm = fm + ((wgid % nig) % gsz); u.pn = (wgid % nig) / gsz; return true;
    }
};

template <class Epi>
__device__ __forceinline__ void gemm_phase(LAS unsigned char* lds, const Gemm g, const StaticOrder& S, const Epi& E, int wave_s) {
    const int tid = fresh_tid(wave_s), wid = __builtin_amdgcn_readfirstlane(tid >> 6), lane = tid & 63, wr = wid >> 2, wc = wid & 3, fr = lane & 15, fq = lane >> 4;
    const int K = g.K, nt = K / BK;
    unsigned voffA[2], voffB[2];
#pragma unroll
    for (int i = 0; i < 2; ++i) { int R, C; stage_rc(tid * 16 + i * 8192, R, C); const int Rb = Epi::PERM ? ((R & ~31) + perm32(R & 31)) : R;
        voffA[i] = (unsigned)(R * g.lda + C) * 2u; voffB[i] = (unsigned)(Rb * g.ldb + C) * 2u; }
    const size_t kstep = (size_t)(BK * 2);
    const size_t hstepA = (size_t)HALF * g.lda * 2, hstepB = (size_t)HALF * g.ldb * 2;
    const size_t tstepA = 2 * hstepA, tstepB = 2 * hstepB;
    const unsigned ldsw = (unsigned)wid * 1024u;
    const int aoff = lds_byte(wr * 64 + fr, fq * 8), boff = lds_byte(wc * 32 + fr, fq * 8);
#define PG8_SA(b, h) ((b) * 65536 + (h) * HTB)
#define PG8_SB(b, h) ((b) * 65536 + (2 + (h)) * HTB)
#define PG8_STAGE(bufoff, gbase, voff) do { _Pragma("unroll") for (int _i = 0; _i < 2; ++_i) \
        __builtin_amdgcn_global_load_lds((const unsigned*)((const char*)(gbase) + (voff)[_i]), (LAS unsigned*)(lds + (bufoff) + ldsw + _i * 8192), 16, 0, 0); } while (0)
#define PG8_LDA(dst, b, h) do { _Pragma("unroll") for (int m = 0; m < 4; ++m) _Pragma("unroll") for (int k = 0; k < 2; ++k) dst[m][k] = *(const LAS bf16x8*)(lds + PG8_SA(b, h) + aoff + m * 2048 + k * 1024); } while (0)
#define PG8_LDB(dst, b, h) do { _Pragma("unroll") for (int n = 0; n < 2; ++n) _Pragma("unroll") for (int k = 0; k < 2; ++k) dst[n][k] = *(const LAS bf16x8*)(lds + PG8_SB(b, h) + boff + n * 2048 + k * 1024); } while (0)
#define PG8_MMA(ai, bj, At, Bt) do { _Pragma("unroll") for (int m = 0; m < 4; ++m) _Pragma("unroll") for (int n = 0; n < 2; ++n) _Pragma("unroll") for (int k = 0; k < 2; ++k) \
        acc[ai][bj][m][n] = __builtin_amdgcn_mfma_f32_16x16x32_bf16(Bt[n][k], At[m][k], acc[ai][bj][m][n], 0, 0, 0); } while (0)
#define PG8_WAIT_V(n) asm volatile("s_waitcnt vmcnt(" #n ")" ::: "memory")
#define PG8_WAIT_L(n) asm volatile("s_waitcnt lgkmcnt(" #n ")" ::: "memory")
#define PG8_BAR __builtin_amdgcn_s_barrier()
#define PG8_SCHED __builtin_amdgcn_sched_barrier(0)
    Unit cur, nxt; int ui = 0;
    if (!S.next(0, cur)) return;
    f32x4 acc[2][2][4][2];
#pragma unroll
    for (int a = 0; a < 2; ++a)
#pragma unroll
        for (int b = 0; b < 2; ++b)
#pragma unroll
            for (int m = 0; m < 4; ++m)
#pragma unroll
                for (int n = 0; n < 2; ++n) acc[a][b][m][n] = (f32x4){0.f, 0.f, 0.f, 0.f};
    bf16x8 At[4][2], B0[2][2], B1[2][2];
    const char* cA = (const char*)g.A + (size_t)cur.pm * tstepA; const char* cB = (const char*)g.Bt + (size_t)cur.pn * tstepB;
    PG8_STAGE(PG8_SB(0, 0), cB, voffB); PG8_STAGE(PG8_SB(0, 1), cB + hstepB, voffB); PG8_STAGE(PG8_SA(0, 0), cA, voffA); PG8_STAGE(PG8_SA(0, 1), cA + hstepA, voffA);
    PG8_WAIT_V(0); PG8_BAR;
    for (;;) {
        const bool has_next = S.next(ui + 1, nxt);
        const char* nA = has_next ? (const char*)g.A + (size_t)nxt.pm * tstepA : cA; const char* nB = has_next ? (const char*)g.Bt + (size_t)nxt.pn * tstepB : cB;
        for (int t = 0; t < nt; t += 2) {
            const bool last = (t == nt - 2);
            {
                const char* pa = cA + (size_t)(t + 1) * kstep; const char* pb = cB + (size_t)(t + 1) * kstep;
                PG8_LDB(B0, 0, 0); PG8_LDB(B1, 0, 1); PG8_LDA(At, 0, 0);
                PG8_STAGE(PG8_SB(1, 0), pb, voffB); PG8_STAGE(PG8_SB(1, 1), pb + hstepB, voffB); PG8_STAGE(PG8_SA(1, 0), pa, voffA); PG8_STAGE(PG8_SA(1, 1), pa + hstepA, voffA);
                PG8_MMA(0, 0, At, B0); PG8_MMA(0, 1, At, B1);
                PG8_LDA(At, 0, 1); PG8_MMA(1, 0, At, B0); PG8_MMA(1, 1, At, B1);
                PG8_WAIT_V(0); PG8_WAIT_L(0); PG8_BAR;
            }
            {
                const char* pa = last ? nA : cA + (size_t)(t + 2) * kstep; const char* pb = last ? nB : cB + (size_t)(t + 2) * kstep;
                PG8_LDB(B0, 1, 0); PG8_LDB(B1, 1, 1); PG8_LDA(At, 1, 0);
                if (!last || has_next) { PG8_STAGE(PG8_SB(0, 0), pb, voffB); PG8_STAGE(PG8_SB(0, 1), pb + hstepB, voffB); PG8_STAGE(PG8_SA(0, 0), pa, voffA); PG8_STAGE(PG8_SA(0, 1), pa + hstepA, voffA); }
                PG8_MMA(0, 0, At, B0); PG8_MMA(0, 1, At, B1);
                PG8_LDA(At, 1, 1); PG8_MMA(1, 0, At, B0); PG8_MMA(1, 1, At, B1);
                PG8_WAIT_V(0); PG8_WAIT_L(0); PG8_BAR;
            }
        }
        E(acc, cur, wr, wc, fr, fq);
        if (!has_next) break;
#pragma unroll
        for (int a = 0; a < 2; ++a)
#pragma unroll
            for (int b = 0; b < 2; ++b)
#pragma unroll
                for (int m = 0; m < 4; ++m)
#pragma unroll
                    for (int n = 0; n < 2; ++n) acc[a][b][m][n] = (f32x4){0.f, 0.f, 0.f, 0.f};
        cur = nxt; cA = nA; cB = nB; ++ui;
    }
    PG8_WAIT_V(0);
    PG8_BAR;
#undef PG8_SA
#undef PG8_SB
#undef PG8_STAGE
#undef PG8_LDA
#undef PG8_LDB
#undef PG8_MMA
#undef PG8_WAIT_V
#undef PG8_WAIT_L
#undef PG8_BAR
#undef PG8_SCHED
}
}
using pg8::Unit;
typedef f32x4 AccT[2][2][4][2];

__device__ __forceinline__ u32x4 pack8(f32x4 a, f32x4 b) { u32x4 w; w.x = cvt_pk_bf16(a[0], a[1]); w.y = cvt_pk_bf16(a[2], a[3]); w.z = cvt_pk_bf16(b[0], b[1]); w.w = cvt_pk_bf16(b[2], b[3]); return w; }

struct EpiSwiglu {
    static constexpr bool PERM = true;
    bf16_t* mid; const float* slotsH; bf16_t* cbuf; float* slotsC; bf16_t* krope; const float* cosT; const float* sinT;
    __device__ __forceinline__ void operator()(const AccT& acc, const Unit& u, int wr, int wc, int fr, int fq) const {
        const int row0 = u.pm * 256 + wr * 64 + fr;
        if (u.pn < 22) {
#pragma unroll
            for (int ai = 0; ai < 2; ++ai)
#pragma unroll
                for (int m = 0; m < 4; ++m) {
                    const int row = row0 + ai * 128 + m * 16; const float rs = rstd_slots16(slotsH, row);
                    f32x4 o[2];
#pragma unroll
                    for (int n = 0; n < 2; ++n)
#pragma unroll
                        for (int i = 0; i < 4; ++i) { const float gt = acc[ai][0][m][n][i] * rs, up = acc[ai][1][m][n][i] * rs; o[n][i] = gt * fsigmoid(gt) * up; }
                    *(u32x4*)(mid + (size_t)row * FF + u.pn * 128 + wc * 32 + fq * 8) = pack8(o[0], o[1]);
                }
        } else if (u.pn == 22) {
#pragma unroll
            for (int ai = 0; ai < 2; ++ai)
#pragma unroll
                for (int m = 0; m < 4; ++m) {
                    const int row = row0 + ai * 128 + m * 16; const float rs = rstd_slots16(slotsH, row);
                    float ss = 0.f;
#pragma unroll
                    for (int bj = 0; bj < 2; ++bj) { const f32x4 a = acc[ai][bj][m][0] * rs, b = acc[ai][bj][m][1] * rs;
                        ss += (a[0] * a[0] + a[1] * a[1]) + (a[2] * a[2] + a[3] * a[3]) + (b[0] * b[0] + b[1] * b[1]) + (b[2] * b[2] + b[3] * b[3]);
                        *(u32x4*)(cbuf + (size_t)row * 256 + bj * 128 + wc * 32 + fq * 8) = pack8(a, b); }
                    ss += __shfl_xor(ss, 16); ss += __shfl_xor(ss, 32);
                    if (fq == 0) slotsC[(size_t)row * 4 + wc] = ss;
                }
        } else if (wc == 0) {
#pragma unroll
            for (int ai = 0; ai < 2; ++ai)
#pragma unroll
                for (int m = 0; m < 4; ++m) {
                    const int row = row0 + ai * 128 + m * 16; const float rs = rstd_slots16(slotsH, row);
                    f32x4 o1[2], o2[2];
#pragma unroll
                    for (int n = 0; n < 2; ++n) { const f32x4 c = *(const f32x4*)(cosT + (size_t)row * 32 + fq * 8 + n * 4), s = *(const f32x4*)(sinT + (size_t)row * 32 + fq * 8 + n * 4);
                        const f32x4 x1 = acc[ai][0][m][n] * rs, x2 = acc[ai][1][m][n] * rs; o1[n] = x1 * c - x2 * s; o2[n] = x2 * c + x1 * s; }
                    *(u32x4*)(krope + (size_t)row * 64 + fq * 8) = pack8(o1[0], o1[1]);
                    *(u32x4*)(krope + (size_t)row * 64 + 32 + fq * 8) = pack8(o2[0], o2[1]);
                }
        }
    }
};
struct EpiResid {
    static constexpr bool PERM = false;
    const float* hin; float* hout; bf16_t* hb; float* slots; float alpha;
    __device__ __forceinline__ void operator()(const AccT& acc, const Unit& u, int wr, int wc, int fr, int fq) const {
        const int row0 = u.pm * 256 + wr * 64 + fr, col0 = u.pn * 256 + wc * 32 + 4 * fq;
#pragma unroll
        for (int ai = 0; ai < 2; ++ai)
#pragma unroll
            for (int m = 0; m < 4; ++m) {
                const int row = row0 + ai * 128 + m * 16; const size_t off = (size_t)row * D + col0; float ss = 0.f;
#pragma unroll
                for (int bj = 0; bj < 2; ++bj)
#pragma unroll
                    for (int n = 0; n < 2; ++n) { const size_t o2 = off + bj * 128 + n * 16; const f32x4 b = *(const f32x4*)(hin + o2); const f32x4 o = b + acc[ai][bj][m][n] * alpha;
                        *(f32x4*)(hout + o2) = o; ss += (o[0] * o[0] + o[1] * o[1]) + (o[2] * o[2] + o[3] * o[3]);
                        if (hb) { u32x2 w; w.x = cvt_pk_bf16(o[0], o[1]); w.y = cvt_pk_bf16(o[2], o[3]); *(u32x2*)(hb + o2) = w; } }
                if (slots) { ss += __shfl_xor(ss, 16); ss += __shfl_xor(ss, 32); if (fq == 0) slots[(size_t)row * 16 + u.pn * 4 + wc] = ss; }
                if (m & 1) asm volatile("" ::: "memory");
            }
    }
};
struct EpiBf16 {
    static constexpr bool PERM = true;
    bf16_t* O; int ldc;
    __device__ __forceinline__ void operator()(const AccT& acc, const Unit& u, int wr, int wc, int fr, int fq) const {
        const int row0 = u.pm * 256 + wr * 64 + fr, col0 = u.pn * 256 + wc * 32 + 8 * fq;
#pragma unroll
        for (int ai = 0; ai < 2; ++ai)
#pragma unroll
            for (int m = 0; m < 4; ++m) { bf16_t* rp = O + (size_t)(row0 + ai * 128 + m * 16) * ldc + col0;
#pragma unroll
                for (int bj = 0; bj < 2; ++bj) *(u32x4*)(rp + bj * 128) = pack8(acc[ai][bj][m][0], acc[ai][bj][m][1]); }
    }
};
struct EpiLoraDown {
    static constexpr bool PERM = true;
    bf16_t* O;
    __device__ __forceinline__ void operator()(const AccT& acc, const Unit& u, int wr, int wc, int fr, int fq) const {
        const int row0 = u.pm * 256 + wr * 64 + fr, col0 = wc * 32 + 8 * fq;
#pragma unroll
        for (int ai = 0; ai < 2; ++ai)
#pragma unroll
            for (int m = 0; m < 4; ++m) { bf16_t* rp = O + (size_t)(row0 + ai * 128 + m * 16) * 256 + col0;
                f32x4 a = acc[ai][0][m][0], b = acc[ai][0][m][1];
                if (wc < 2) {
#pragma unroll
                    for (int i = 0; i < 4; ++i) { a[i] = ftanh(a[i]); b[i] = ftanh(b[i]); } }
                *(u32x4*)(rp) = pack8(a, b);
                a = acc[ai][1][m][0]; b = acc[ai][1][m][1];
#pragma unroll
                for (int i = 0; i < 4; ++i) { a[i] = fsigmoid(a[i]); b[i] = fsigmoid(b[i]); }
                *(u32x4*)(rp + 128) = pack8(a, b); }
    }
};
struct EpiRL {
    static constexpr bool PERM = true;
    bf16_t* R; bf16_t* O;
    __device__ __forceinline__ void operator()(const AccT& acc, const Unit& u, int wr, int wc, int fr, int fq) const {
        const int row0 = u.pm * 256 + wr * 64 + fr;
        if (u.pn < 4) {
            const int col0 = u.pn * 256 + wc * 32 + 8 * fq;
#pragma unroll
            for (int ai = 0; ai < 2; ++ai)
#pragma unroll
                for (int m = 0; m < 4; ++m) { bf16_t* rp = R + (size_t)(row0 + ai * 128 + m * 16) * D + col0;
#pragma unroll
                    for (int bj = 0; bj < 2; ++bj) *(u32x4*)(rp + bj * 128) = pack8(acc[ai][bj][m][0], acc[ai][bj][m][1]); }
        } else {
            const int col0 = wc * 32 + 8 * fq;
#pragma unroll
            for (int ai = 0; ai < 2; ++ai)
#pragma unroll
                for (int m = 0; m < 4; ++m) { bf16_t* rp = O + (size_t)(row0 + ai * 128 + m * 16) * 256 + col0;
                    f32x4 a = acc[ai][0][m][0], b = acc[ai][0][m][1];
                    if (wc < 2) {
#pragma unroll
                        for (int i = 0; i < 4; ++i) { a[i] = ftanh(a[i]); b[i] = ftanh(b[i]); } }
                    *(u32x4*)(rp) = pack8(a, b);
                    a = acc[ai][1][m][0]; b = acc[ai][1][m][1];
#pragma unroll
                    for (int i = 0; i < 4; ++i) { a[i] = fsigmoid(a[i]); b[i] = fsigmoid(b[i]); }
                    *(u32x4*)(rp + 128) = pack8(a, b); }
        }
    }
};
struct EpiLoraUp {
    static constexpr bool PERM = true;
    unsigned char* wsb; const float* w0; const float* a0;
    __device__ __forceinline__ void operator()(const AccT& acc, const Unit& u, int wr, int wc, int fr, int fq) const {
        const int grp = u.pn >> 2, colt = (u.pn & 3) * 256;
        const int row0 = u.pm * 256 + wr * 64 + fr, col0 = colt + wc * 32 + 8 * fq;
        size_t ooff = A_G; if (grp == 0) ooff = A_E; if (grp == 1) ooff = A_AA;
        bf16_t* O = (bf16_t*)(wsb + ooff); const float* bias = grp == 0 ? w0 : a0;
#pragma unroll
        for (int ai = 0; ai < 2; ++ai)
#pragma unroll
            for (int m = 0; m < 4; ++m) { bf16_t* rp = O + (size_t)(row0 + ai * 128 + m * 16) * D + col0;
#pragma unroll
                for (int bj = 0; bj < 2; ++bj) { f32x4 a = acc[ai][bj][m][0], b = acc[ai][bj][m][1];
                    if (grp < 2) { const float sc = grp == 0 ? 0.6065306597126334f : 1.0f;
                        const f32x4 b0 = *(const f32x4*)(bias + col0 + bj * 128), b1 = *(const f32x4*)(bias + col0 + bj * 128 + 4);
                        a = a + b0; b = b + b1;
#pragma unroll
                        for (int i = 0; i < 4; ++i) { a[i] = sc * fsigmoid(a[i]); b[i] = sc * fsigmoid(b[i]); } }
                    *(u32x4*)(rp + bj * 128) = pack8(a, b); }
                asm volatile("" ::: "memory"); }
    }
};
struct EpiQlat {
    static constexpr bool PERM = true;
    bf16_t* O; const float* slotsH; float* slotsQ;
    __device__ __forceinline__ void operator()(const AccT& acc, const Unit& u, int wr, int wc, int fr, int fq) const {
        const int row0 = u.pm * 256 + wr * 64 + fr, col0 = u.pn * 256 + wc * 32 + 8 * fq;
#pragma unroll
        for (int ai = 0; ai < 2; ++ai)
#pragma unroll
            for (int m = 0; m < 4; ++m) { const int row = row0 + ai * 128 + m * 16; const float rs = rstd_slots16(slotsH, row); float ss = 0.f;
#pragma unroll
                for (int bj = 0; bj < 2; ++bj) { const f32x4 a = acc[ai][bj][m][0] * rs, b = acc[ai][bj][m][1] * rs;
                    ss += (a[0] * a[0] + a[1] * a[1]) + (a[2] * a[2] + a[3] * a[3]) + (b[0] * b[0] + b[1] * b[1]) + (b[2] * b[2] + b[3] * b[3]);
                    *(u32x4*)(O + (size_t)row * 512 + col0 + bj * 128) = pack8(a, b); }
                ss += __shfl_xor(ss, 16); ss += __shfl_xor(ss, 32);
                if (fq == 0) slotsQ[(size_t)row * 8 + u.pn * 4 + wc] = ss; }
    }
};
struct EpiQ {
    static constexpr bool PERM = true;
    bf16_t* qn; bf16_t* qr; const float* slotsQ; const float* cosT; const float* sinT;
    __device__ __forceinline__ void operator()(const AccT& acc, const Unit& u, int wr, int wc, int fr, int fq) const {
        const int row0 = u.pm * 256 + wr * 64 + fr;
#pragma unroll
        for (int ai = 0; ai < 2; ++ai)
#pragma unroll
            for (int m = 0; m < 4; ++m) { const int row = row0 + ai * 128 + m * 16;
                const f32x4 s0 = *(const f32x4*)(slotsQ + (size_t)row * 8), s1 = *(const f32x4*)(slotsQ + (size_t)row * 8 + 4);
                const float rs = __builtin_amdgcn_rsqf((sum4(s0) + sum4(s1)) * (1.0f / 512.0f) + RMS_EPS) * QSCALE;
                if (u.pn < 4) {
#pragma unroll
                    for (int bj = 0; bj < 2; ++bj) *(u32x4*)(qn + (size_t)row * D + u.pn * 256 + bj * 128 + wc * 32 + fq * 8) = pack8(acc[ai][bj][m][0] * rs, acc[ai][bj][m][1] * rs);
                } else {
                    const int head = 4 * (u.pn - 4) + wc; f32x4 o1[2], o2[2];
#pragma unroll
                    for (int n = 0; n < 2; ++n) { const f32x4 c = *(const f32x4*)(cosT + (size_t)row * 32 + fq * 8 + n * 4), s = *(const f32x4*)(sinT + (size_t)row * 32 + fq * 8 + n * 4);
                        const f32x4 x1 = acc[ai][0][m][n] * rs, x2 = acc[ai][1][m][n] * rs; o1[n] = x1 * c - x2 * s; o2[n] = x2 * c + x1 * s; }
                    *(u32x4*)(qr + (size_t)row * 512 + head * 64 + fq * 8) = pack8(o1[0], o1[1]);
                    *(u32x4*)(qr + (size_t)row * 512 + head * 64 + 32 + fq * 8) = pack8(o2[0], o2[1]);
                } }
    }
};
struct EpiKnope {
    static constexpr bool PERM = true;
    bf16_t* O; const float* slotsC;
    __device__ __forceinline__ void operator()(const AccT& acc, const Unit& u, int wr, int wc, int fr, int fq) const {
        const int row0 = u.pm * 256 + wr * 64 + fr, col0 = u.pn * 256 + wc * 32 + 8 * fq;
#pragma unroll
        for (int ai = 0; ai < 2; ++ai)
#pragma unroll
            for (int m = 0; m < 4; ++m) { const int row = row0 + ai * 128 + m * 16; const f32x4 s = *(const f32x4*)(slotsC + (size_t)row * 4);
                const float rs = __builtin_amdgcn_rsqf(sum4(s) * (1.0f / 256.0f) + RMS_EPS);
#pragma unroll
                for (int bj = 0; bj < 2; ++bj) *(u32x4*)(O + (size_t)row * D + col0 + bj * 128) = pack8(acc[ai][bj][m][0] * rs, acc[ai][bj][m][1] * rs); }
    }
};
struct EpiVt {
    static constexpr bool PERM = true;
    bf16_t* O; const float* slotsC;
    __device__ __forceinline__ void operator()(const AccT& acc, const Unit& u, int wr, int wc, int fr, int fq) const {
        const int row0 = u.pm * 256 + wr * 64 + fr, col0 = u.pn * 256 + wc * 32 + 8 * fq;
        f32x4 rs[2][2];
#pragma unroll
        for (int bj = 0; bj < 2; ++bj)
#pragma unroll
            for (int n = 0; n < 2; ++n)
#pragma unroll
                for (int i = 0; i < 4; ++i) { const f32x4 s = *(const f32x4*)(slotsC + (size_t)(col0 + bj * 128 + n * 4 + i) * 4); rs[bj][n][i] = __builtin_amdgcn_rsqf(sum4(s) * (1.0f / 256.0f) + RMS_EPS); }
#pragma unroll
        for (int ai = 0; ai < 2; ++ai)
#pragma unroll
            for (int m = 0; m < 4; ++m) { const int row = row0 + ai * 128 + m * 16;
#pragma unroll
                for (int bj = 0; bj < 2; ++bj) *(u32x4*)(O + (size_t)row * T + col0 + bj * 128) = pack8(acc[ai][bj][m][0] * rs[bj][0], acc[ai][bj][m][1] * rs[bj][1]); }
    }
};

struct Args { const float* in[33]; const int* pos; float* out; unsigned char* ws; int ph_lo, ph_hi; };

struct Ctx { LAS unsigned char* lds; int vcu, G, wave; };

__device__ __forceinline__ void tr_item(const float* W, int ldw, int k0, int n0, const float* s1, const float* s2, int ks0, bf16_t* Bt, int ldb, int nd0, int kd0, LAS float* scr, int lane) {
#pragma unroll 8
    for (int i = 0; i < 32; ++i) { const int kk = 2 * i + (lane >> 5);
        float sc = s1 ? s1[ks0 + kk] : 1.0f; if (s2) sc -= s2[ks0 + kk];
        scr[kk * 33 + (lane & 31)] = sc * W[(size_t)(k0 + kk) * ldw + n0 + (lane & 31)]; }
    asm volatile("s_waitcnt lgkmcnt(0)" ::: "memory");
    const int c = lane & 7;
#pragma unroll
    for (int j = 0; j < 4; ++j) { const int n = (lane >> 3) + 8 * j; const LAS float* s = scr + (8 * c) * 33 + n;
        u32x4 o; o.x = cvt_pk_bf16(s[0 * 33], s[1 * 33]); o.y = cvt_pk_bf16(s[2 * 33], s[3 * 33]); o.z = cvt_pk_bf16(s[4 * 33], s[5 * 33]); o.w = cvt_pk_bf16(s[6 * 33], s[7 * 33]);
        *(u32x4*)(Bt + (size_t)(nd0 + n) * ldb + kd0 + 8 * c) = o; }
    asm volatile("s_waitcnt lgkmcnt(0)" ::: "memory");
}
__device__ __forceinline__ void zero_item(bf16_t* Bt, int ldb, int nd0, int kd0, int lane) {
    const int c = lane & 7;
#pragma unroll
    for (int j = 0; j < 4; ++j) { const int n = (lane >> 3) + 8 * j; *(u32x4*)(Bt + (size_t)(nd0 + n) * ldb + kd0 + 8 * c) = (u32x4){0u, 0u, 0u, 0u}; }
}

__device__ __forceinline__ void p0_prologue(const Ctx& F, const Args& a) {
    unsigned char* ws = a.ws;
    const int tid = fresh_tid(F.wave), lane = tid & 63, wave = __builtin_amdgcn_readfirstlane(tid >> 6);
    LAS float* scr = (LAS float*)(F.lds + wave * 16384);
    const int gw = F.vcu * 8 + wave, NGW = F.G * 8;
    const float* norm_g = a.in[2];
    constexpr int I_UG = 16 * 176, I_UGX = 16 * 16, I_DN = 44 * 32, I_SQ = 16 * 32, I_LD = 32 * 8, I_LU = 4 * 96, I_KN = 4 * 32, I_DQ = 16 * 16, I_UQ = 8 * 48;
    constexpr int NITEMS = 4 * I_UG + I_UGX + 4 * I_DN + 4 * I_SQ + I_LD + I_LU + 2 * I_KN + I_DQ + I_UQ + I_SQ;
    for (int it = gw; it < NITEMS; it += NGW) {
        int r = it;
        if (r < 4 * I_UG) { const int q = r / I_UG; r -= q * I_UG; const int l = q >> 1, s = q & 1; const int kb = r / 176, nb = r % 176, pn = nb >> 3, jb = nb & 7;
            const float* src = (jb < 4 ? a.in[3] : a.in[4]) + (size_t)q * D * FF;
            tr_item(src, FF, 64 * kb, 128 * pn + 32 * (jb & 3), norm_g + (l * 3 + (s ? 2 : 0)) * D, nullptr, 64 * kb, (bf16_t*)(ws + W_UG) + (size_t)q * 6144 * D, D, 32 * nb, 64 * kb, scr, lane); continue; }
        r -= 4 * I_UG;
        if (r < I_UGX) { const int kb = r / 16, nb = r % 16; bf16_t* Bt = (bf16_t*)(ws + W_UG) + (size_t)2 * 6144 * D;
            int sc = -1; if (nb < 8) sc = 32 * nb; else if (nb == 8) sc = 256; else if (nb == 12) sc = 288;
            if (sc >= 0) tr_item(a.in[25], 320, 64 * kb, sc, a.in[24], nullptr, 64 * kb, Bt, D, 5632 + 32 * nb, 64 * kb, scr, lane); else zero_item(Bt, D, 5632 + 32 * nb, 64 * kb, lane); continue; }
        r -= I_UGX;
        if (r < 4 * I_DN) { const int q = r / I_DN; r -= q * I_DN; const int kb = r / 32, nb = r % 32;
            tr_item(a.in[5] + (size_t)q * FF * D, D, 64 * kb, 32 * nb, nullptr, nullptr, 0, (bf16_t*)(ws + W_DN) + (size_t)q * D * FF, FF, 32 * nb, 64 * kb, scr, lane); continue; }
        r -= 4 * I_DN;
        if (r < 4 * I_SQ) { const int q = r / I_SQ; r -= q * I_SQ; const int kb = r / 32, nb = r % 32;
            if (q == 0) { tr_item(a.in[7], D, 64 * kb, 32 * nb, nullptr, nullptr, 0, (bf16_t*)(ws + W_RL), 2048, 32 * nb, 64 * kb, scr, lane); zero_item((bf16_t*)(ws + W_RL), 2048, 32 * nb, 1024 + 64 * kb, lane); }
            else tr_item(a.in[7 + q], D, 64 * kb, 32 * nb, nullptr, nullptr, 0, (bf16_t*)(ws + W_R + (size_t)q * 2 * MiB), D, 32 * nb, 64 * kb, scr, lane);
            continue; }
        r -= 4 * I_SQ;
        if (r < I_LD) { const int kb = r / 8, nb = r % 8; const int kk0 = 64 * (kb & 15); const bool second = kb >= 16;
            const float* src; int ldw, nc, mi; if (nb < 2) { src = a.in[12]; ldw = 64; nc = 32 * nb; mi = 1; } else if (nb < 4) { src = a.in[15]; ldw = 64; nc = 32 * (nb - 2); mi = 4; } else { src = a.in[17]; ldw = 128; nc = 32 * (nb - 4); mi = 5; }
            tr_item(src, ldw, kk0, nc, second ? a.in[6] + mi * D : nullptr, second ? a.in[6] : nullptr, kk0, (bf16_t*)(ws + W_RL), 2048, 1024 + 32 * nb, 64 * kb, scr, lane); continue; }
        r -= I_LD;
        if (r < I_LU) { const int kb = r / 96, nb = r % 96; const int grp = nb / 32, nc = 32 * (nb % 32); bf16_t* Bt = (bf16_t*)(ws + W_LU);
            if (grp == 0) { if (kb == 0) tr_item(a.in[13], D, 0, nc, nullptr, nullptr, 0, Bt, 256, 32 * nb, 0, scr, lane); else zero_item(Bt, 256, 32 * nb, 64 * kb, lane); }
            else if (grp == 1) { if (kb == 1) tr_item(a.in[16], D, 0, nc, nullptr, nullptr, 0, Bt, 256, 32 * nb, 64, scr, lane); else zero_item(Bt, 256, 32 * nb, 64 * kb, lane); }
            else { if (kb >= 2) tr_item(a.in[18], D, 64 * (kb - 2), nc, nullptr, nullptr, 0, Bt, 256, 32 * nb, 64 * kb, scr, lane); else zero_item(Bt, 256, 32 * nb, 64 * kb, lane); }
            continue; }
        r -= I_LU;
        if (r < 2 * I_KN) { const int q = r / I_KN; r -= q * I_KN; const int kb = r / 32, nb = r % 32;
            const int n0 = 32 * nb, sc = (n0 >> 7) * 256 + (n0 & 127) + q * 128;
            tr_item(a.in[27], 2048, 64 * kb, sc, a.in[26], nullptr, 64 * kb, (bf16_t*)(ws + (q ? W_VT : W_KN)), 256, n0, 64 * kb, scr, lane); continue; }
        r -= 2 * I_KN;
        if (r < I_DQ) { const int kb = r / 16, nb = r % 16;
            tr_item(a.in[28], 512, 64 * kb, 32 * nb, norm_g + (1 * 3 + 1) * D, nullptr, 64 * kb, (bf16_t*)(ws + W_DQ), D, 32 * nb, 64 * kb, scr, lane); continue; }
        r -= I_DQ;
        if (r < I_UQ) { const int kb = r / 48, nb = r % 48; int sc;
            if (nb < 32) { const int n0 = 32 * nb; sc = (n0 >> 7) * 192 + (n0 & 127); }
            else { const int t2 = (nb - 32) >> 3, jj = (nb - 32) & 7, half = jj >> 2, hh = jj & 3; sc = (4 * t2 + hh) * 192 + 128 + 32 * half; }
            tr_item(a.in[30], 1536, 64 * kb, sc, a.in[29], nullptr, 64 * kb, (bf16_t*)(ws + W_UQ), 512, 32 * nb, 64 * kb, scr, lane); continue; }
        r -= I_UQ;
        { const int kb = r / 32, nb = r % 32; tr_item(a.in[31], D, 64 * kb, 32 * nb, nullptr, nullptr, 0, (bf16_t*)(ws + W_MO), D, 32 * nb, 64 * kb, scr, lane); }
    }
    const float* x = a.in[0]; bf16_t* hb = (bf16_t*)(ws + A_HB); float* slotsH = (float*)(ws + WS_SLOTH);
    for (int m = gw; m < T; m += NGW) {
        const f32x4* xr = (const f32x4*)(x + (size_t)m * D) + lane; float ss = 0.f;
#pragma unroll
        for (int j = 0; j < 4; ++j) { const f32x4 v = xr[64 * j]; ss += (v[0] * v[0] + v[1] * v[1]) + (v[2] * v[2] + v[3] * v[3]);
            u32x2 w; w.x = cvt_pk_bf16(v[0], v[1]); w.y = cvt_pk_bf16(v[2], v[3]); *((u32x2*)(hb + (size_t)m * D) + lane + 64 * j) = w; }
        ss = wave_sum(ss);
        if (lane < 16) slotsH[(size_t)m * 16 + lane] = lane == 0 ? ss : 0.f;
    }
    float* cosT = (float*)(ws + A_COS); float* sinT = (float*)(ws + A_SIN);
    for (int i = (F.vcu * 512 + tid); i < T * 32; i += F.G * 512) {
        const int tok = i >> 5, j = i & 31;
        const float inv = exp2f(-(float)j * (13.287712379549449f / 32.0f));
        const float ang = (float)a.pos[tok] * inv;
        const double rev = (double)ang * 0.15915494309189535; const float fr = (float)(rev - floor(rev));
        cosT[i] = __builtin_amdgcn_cosf(fr); sinT[i] = __builtin_amdgcn_sinf(fr);
    }
}

__device__ __forceinline__ void p_premix(const Ctx& F, const Args& a) {
    const float* h = a.out; const float* g = a.in[2] + 1 * D; const float* mix = a.in[6];
    bf16_t* X1 = (bf16_t*)(a.ws + A_X1); bf16_t* XK = (bf16_t*)(a.ws + A_XK); bf16_t* XV = (bf16_t*)(a.ws + A_XV);
    const int tid = fresh_tid(F.wave), lane = tid & 63, wave = __builtin_amdgcn_readfirstlane(tid >> 6);
    const int gw = F.vcu * 8 + wave, NGW = F.G * 8;
    for (int ch = gw; ch < T / 16; ch += NGW) {
        const int t0 = ch * 16;
        f32x4 prev[4], gv[4];
#pragma unroll
        for (int j = 0; j < 4; ++j) gv[j] = *((const f32x4*)g + lane + 64 * j);
        if ((t0 & (SEQ - 1)) == 0) {
#pragma unroll
            for (int j = 0; j < 4; ++j) prev[j] = (f32x4){0.f, 0.f, 0.f, 0.f};
        } else {
            float ss = 0.f;
#pragma unroll
            for (int j = 0; j < 4; ++j) { prev[j] = *((const f32x4*)(h + (size_t)(t0 - 1) * D) + lane + 64 * j); ss += (prev[j][0] * prev[j][0] + prev[j][1] * prev[j][1]) + (prev[j][2] * prev[j][2] + prev[j][3] * prev[j][3]); }
            const float rs = __builtin_amdgcn_rsqf(wave_sum(ss) * (1.0f / 1024.0f) + RMS_EPS);
#pragma unroll
            for (int j = 0; j < 4; ++j) prev[j] = prev[j] * rs * gv[j];
        }
        for (int t = t0; t < t0 + 16; ++t) {
            f32x4 cur[4]; float ss = 0.f;
#pragma unroll
            for (int j = 0; j < 4; ++j) { cur[j] = *((const f32x4*)(h + (size_t)t * D) + lane + 64 * j); ss += (cur[j][0] * cur[j][0] + cur[j][1] * cur[j][1]) + (cur[j][2] * cur[j][2] + cur[j][3] * cur[j][3]); }
            const float rs = __builtin_amdgcn_rsqf(wave_sum(ss) * (1.0f / 1024.0f) + RMS_EPS);
#pragma unroll
            for (int j = 0; j < 4; ++j) {
                const f32x4 hn = cur[j] * rs * gv[j]; const f32x4 xx = prev[j] - hn; prev[j] = hn;
                const f32x4 mr = *((const f32x4*)(mix + 0 * D) + lane + 64 * j), mk = *((const f32x4*)(mix + 2 * D) + lane + 64 * j), mv = *((const f32x4*)(mix + 3 * D) + lane + 64 * j);
                const f32x4 xr = hn + xx * mr, xk = hn + xx * mk, xv = hn + xx * mv;
                u32x2 w;
                w.x = cvt_pk_bf16(xr[0], xr[1]); w.y = cvt_pk_bf16(xr[2], xr[3]); *((u32x2*)(X1 + (size_t)t * 2048) + lane + 64 * j) = w;
                w.x = cvt_pk_bf16(xx[0], xx[1]); w.y = cvt_pk_bf16(xx[2], xx[3]); *((u32x2*)(X1 + (size_t)t * 2048 + 1024) + lane + 64 * j) = w;
                w.x = cvt_pk_bf16(xk[0], xk[1]); w.y = cvt_pk_bf16(xk[2], xk[3]); *((u32x2*)(XK + (size_t)t * D) + lane + 64 * j) = w;
                w.x = cvt_pk_bf16(xv[0], xv[1]); w.y = cvt_pk_bf16(xv[2], xv[3]); *((u32x2*)(XV + (size_t)t * D) + lane + 64 * j) = w;
            }
        }
    }
}

constexpr int TC = 32;
__device__ __forceinline__ void p_scan(const Ctx& F, const Args& a) {
    const bf16_t* Rb = (const bf16_t*)(a.ws + A_R); const bf16_t* Kb = (const bf16_t*)(a.ws + A_KK); const bf16_t* Vb = (const bf16_t*)(a.ws + A_VV);
    const bf16_t* Eb = (const bf16_t*)(a.ws + A_E); const bf16_t* Ab = (const bf16_t*)(a.ws + A_AA); bf16_t* Gb = (bf16_t*)(a.ws + A_G);
    const float* k_k = a.in[19]; const float* k_a = a.in[20]; const float* r_k = a.in[21]; const float* gn_w = a.in[22]; const float* gn_b = a.in[23];
    LAS float* sR = (LAS float*)(F.lds); LAS float* sW = sR + TC * 64; LAS float* sK = sW + TC * 64; LAS float* sV = sK + TC * 64;
    LAS float* sKK = sV + TC * 64; LAS float* sKA = sKK + TC * 64; LAS float* sY = sKA + TC * 64; LAS float* sBo = sY + TC * 64;
    const int tid = fresh_tid(F.wave), lane = tid & 63, wave = __builtin_amdgcn_readfirstlane(tid >> 6);
    const int irow = wave * 8 + (lane >> 3), kseg = (lane & 7) * 8;
    const int ptt = tid >> 4, pc = (tid & 15) * 4;
    for (int unit0 = F.vcu; unit0 < 2 * NB * 16; unit0 += F.G) {
        const int unit = unit0 & 127; const bool shadow = unit0 >= 128;
        const int b = unit >> 4, hd = unit & 15; const int cbase = hd * 64;
        float S[8];
#pragma unroll
        for (int j = 0; j < 8; ++j) S[j] = 0.f;
        const f32x4 kkv = *(const f32x4*)(k_k + cbase + pc), kav = *(const f32x4*)(k_a + cbase + pc), rkv = *(const f32x4*)(r_k + cbase + pc);
        const f32x4 gw = *(const f32x4*)(gn_w + cbase + pc), gb = *(const f32x4*)(gn_b + cbase + pc);
        for (int c0 = 0; c0 < SEQ; c0 += TC) {
            const size_t gidx = (size_t)(b * SEQ + c0 + ptt) * D + cbase + pc;
            {
                const f32x4 r = unpack4(*(const u32x2*)(Rb + gidx)), k = unpack4(*(const u32x2*)(Kb + gidx)), v = unpack4(*(const u32x2*)(Vb + gidx));
                const f32x4 e = unpack4(*(const u32x2*)(Eb + gidx)), aa = unpack4(*(const u32x2*)(Ab + gidx));
                f32x4 kk = k * kkv; float ss = (kk[0] * kk[0] + kk[1] * kk[1]) + (kk[2] * kk[2] + kk[3] * kk[3]); ss = red16(ss);
                kk = kk * __builtin_amdgcn_rsqf(fmaxf(ss, 1e-24f));
                const f32x4 kp = k * (1.0f + (aa - 1.0f) * kav);
                const f32x4 rk = r * kp * rkv; const float bo = red16((rk[0] + rk[1]) + (rk[2] + rk[3]));
                f32x4 w;
#pragma unroll
                for (int i = 0; i < 4; ++i) w[i] = __builtin_amdgcn_exp2f(-e[i] * LOG2E);
                const int o = ptt * 64 + pc;
                *(LAS f32x4*)(sR + o) = r; *(LAS f32x4*)(sW + o) = w; *(LAS f32x4*)(sK + o) = kp; *(LAS f32x4*)(sV + o) = v; *(LAS f32x4*)(sKK + o) = kk; *(LAS f32x4*)(sKA + o) = kk * aa;
                if ((tid & 15) == 0) sBo[ptt] = bo;
            }
            __syncthreads();
#pragma unroll 2
            for (int t = 0; t < TC; ++t) {
                const int o = t * 64 + kseg;
                const f32x4 kk0 = *(const LAS f32x4*)(sKK + o), kk1 = *(const LAS f32x4*)(sKK + o + 4);
                const f32x4 w0 = *(const LAS f32x4*)(sW + o), w1 = *(const LAS f32x4*)(sW + o + 4);
                const f32x4 ka0 = *(const LAS f32x4*)(sKA + o), ka1 = *(const LAS f32x4*)(sKA + o + 4);
                const f32x4 kp0 = *(const LAS f32x4*)(sK + o), kp1 = *(const LAS f32x4*)(sK + o + 4);
                const f32x4 r0 = *(const LAS f32x4*)(sR + o), r1 = *(const LAS f32x4*)(sR + o + 4);
                const float vv = sV[t * 64 + irow];
                float sa = ((S[0] * kk0[0] + S[1] * kk0[1]) + (S[2] * kk0[2] + S[3] * kk0[3])) + ((S[4] * kk1[0] + S[5] * kk1[1]) + (S[6] * kk1[2] + S[7] * kk1[3]));
                sa = red8(sa);
#pragma unroll
                for (int j = 0; j < 4; ++j) { S[j] = S[j] * w0[j] + (vv * kp0[j] - sa * ka0[j]); S[4 + j] = S[4 + j] * w1[j] + (vv * kp1[j] - sa * ka1[j]); }
                float y = ((S[0] * r0[0] + S[1] * r0[1]) + (S[2] * r0[2] + S[3] * r0[3])) + ((S[4] * r1[0] + S[5] * r1[1]) + (S[6] * r1[2] + S[7] * r1[3]));
                y = red8(y);
                if ((lane & 7) == 0) sY[t * 64 + irow] = y;
            }
            __syncthreads();
            {
                const int o = ptt * 64 + pc;
                const f32x4 y = *(const LAS f32x4*)(sY + o), v = *(const LAS f32x4*)(sV + o);
                const float mu = red16((y[0] + y[1]) + (y[2] + y[3])) * (1.0f / 64.0f);
                const f32x4 d = y - mu; const float var = red16((d[0] * d[0] + d[1] * d[1]) + (d[2] * d[2] + d[3] * d[3])) * (1.0f / 64.0f);
                const float rs = __builtin_amdgcn_rsqf(var + GN_EPS); const float bo = sBo[ptt];
                const f32x4 gg = unpack4(*(const u32x2*)(Gb + gidx));
                const f32x4 ov = (d * rs * gw + gb + v * bo) * gg;
                u32x2 w; w.x = cvt_pk_bf16(ov[0], ov[1]); w.y = cvt_pk_bf16(ov[2], ov[3]); if (!shadow) *(u32x2*)(Gb + gidx) = w;
            }
            __syncthreads();
        }
    }
}

constexpr int KROW = 400, VROW = 144, KBUF = 64 * KROW, VBUF = 128 * VROW, ABUF = KBUF + VBUF;
__device__ __forceinline__ void attn_unit(LAS unsigned char* lds, const bf16_t* qn, const bf16_t* qr, const bf16_t* kn, const bf16_t* kr, const bf16_t* vt, bf16_t* o_out, int b, int h, int qb, int wave_s) {
    const int tid = fresh_tid(wave_s), lane = tid & 63, wid = __builtin_amdgcn_readfirstlane(tid >> 6), r32 = lane & 31, hi = lane >> 5;
    const int tok0 = b * SEQ, q0 = qb * 256 + wid * 32;
    bf16x8 qf[12];
    { const size_t tq = (size_t)(tok0 + q0 + r32);
#pragma unroll
      for (int d = 0; d < 8; ++d) qf[d] = *(const bf16x8*)(qn + tq * D + h * 128 + d * 16 + hi * 8);
#pragma unroll
      for (int d = 0; d < 4; ++d) qf[8 + d] = *(const bf16x8*)(qr + tq * 512 + h * 64 + d * 16 + hi * 8); }
    const int NT = (qb + 1) * 4;
    const int kkey0 = tid >> 4, kch0 = tid & 15;
    const int rkey = tid >> 3, rch = tid & 7;
    const int vrow0 = tid >> 3, vch = tid & 7;
    const bf16_t* gk0 = kn + (size_t)(tok0 + kkey0) * D + h * 128 + kch0 * 8;
    const bf16_t* gk1 = gk0 + (size_t)32 * D;
    const bf16_t* gr = kr + (size_t)(tok0 + rkey) * 64 + rch * 8;
    const bf16_t* gv0 = vt + (size_t)(h * 128 + vrow0) * T + tok0 + vch * 8;
    const bf16_t* gv1 = gv0 + (size_t)64 * T;
    const int lk0 = kkey0 * KROW + kch0 * 16, lk1 = lk0 + 32 * KROW, lr = rkey * KROW + 256 + rch * 16, lv0 = KBUF + vrow0 * VROW + vch * 16, lv1 = lv0 + 64 * VROW;
    const int pr = (r32 & 0x13) | ((r32 & 4) << 1) | ((r32 & 8) >> 1);
    const int kfo = pr * KROW + hi * 16, vfo = KBUF + r32 * VROW + hi * 16;
    u32x4 ld0, ld1, ld2, ld3, ld4;
    ld0 = *(const u32x4*)gk0; ld1 = *(const u32x4*)gk1; ld2 = *(const u32x4*)gr; ld3 = *(const u32x4*)gv0; ld4 = *(const u32x4*)gv1;
    __syncthreads();
    *(LAS u32x4*)(lds + lk0) = ld0; *(LAS u32x4*)(lds + lk1) = ld1; *(LAS u32x4*)(lds + lr) = ld2; *(LAS u32x4*)(lds + lv0) = ld3; *(LAS u32x4*)(lds + lv1) = ld4;
    __syncthreads();
    float mrun = -1e30f, lrun = 0.f;
    f32x16 o[4];
#pragma unroll
    for (int d = 0; d < 4; ++d) o[d] = f32x16{};
    for (int t = 0; t < NT; ++t) {
        const int cb = (t & 1) * ABUF, nb = ((t + 1) & 1) * ABUF;
        const bool more = (t + 1 < NT);
        if (more) { const size_t ko = (size_t)(t + 1) * 64 * D, ro = (size_t)(t + 1) * 64 * 64, vo = (size_t)(t + 1) * 64;
            ld0 = *(const u32x4*)(gk0 + ko); ld1 = *(const u32x4*)(gk1 + ko); ld2 = *(const u32x4*)(gr + ro); ld3 = *(const u32x4*)(gv0 + vo); ld4 = *(const u32x4*)(gv1 + vo); }
        if (64 * t <= q0 + 31) {
            f32x16 s0 = f32x16{}, s1 = f32x16{};
#pragma unroll
            for (int d = 0; d < 12; ++d) {
                const bf16x8 k0 = *(const LAS bf16x8*)(lds + cb + kfo + d * 32), k1 = *(const LAS bf16x8*)(lds + cb + kfo + 32 * KROW + d * 32);
                s0 = __builtin_amdgcn_mfma_f32_32x32x16_bf16(k0, qf[d], s0, 0, 0, 0);
                s1 = __builtin_amdgcn_mfma_f32_32x32x16_bf16(k1, qf[d], s1, 0, 0, 0);
            }
            if (64 * t + 63 > q0) {
                const int qi = q0 + r32, kb0 = 64 * t + 8 * hi;
#pragma unroll
                for (int r = 0; r < 16; ++r) { const int key = kb0 + 16 * (r >> 3) + (r & 7); if (key > qi) s0[r] = -1e30f; if (key + 32 > qi) s1[r] = -1e30f; }
            }
            float mx = fmaxf(s0[0], s1[0]);
#pragma unroll
            for (int r = 1; r < 16; ++r) mx = fmaxf(mx, fmaxf(s0[r], s1[r]));
            mx = fmaxf(mx, __shfl_xor(mx, 32));
            const float mnew = fmaxf(mrun, mx); const float alpha = __builtin_amdgcn_exp2f(mrun - mnew); mrun = mnew;
            float ps = 0.f;
#pragma unroll
            for (int r = 0; r < 16; ++r) { s0[r] = __builtin_amdgcn_exp2f(s0[r] - mnew); s1[r] = __builtin_amdgcn_exp2f(s1[r] - mnew); ps += s0[r] + s1[r]; }
            lrun = lrun * alpha + ps;
#pragma unroll
            for (int d = 0; d < 4; ++d) o[d] = o[d] * alpha;
            bf16x8 pf[4];
            { u32x4 w;
              w.x = cvt_pk_bf16(s0[0], s0[1]); w.y = cvt_pk_bf16(s0[2], s0[3]); w.z = cvt_pk_bf16(s0[4], s0[5]); w.w = cvt_pk_bf16(s0[6], s0[7]); pf[0] = __builtin_bit_cast(bf16x8, w);
              w.x = cvt_pk_bf16(s0[8], s0[9]); w.y = cvt_pk_bf16(s0[10], s0[11]); w.z = cvt_pk_bf16(s0[12], s0[13]); w.w = cvt_pk_bf16(s0[14], s0[15]); pf[1] = __builtin_bit_cast(bf16x8, w);
              w.x = cvt_pk_bf16(s1[0], s1[1]); w.y = cvt_pk_bf16(s1[2], s1[3]); w.z = cvt_pk_bf16(s1[4], s1[5]); w.w = cvt_pk_bf16(s1[6], s1[7]); pf[2] = __builtin_bit_cast(bf16x8, w);
              w.x = cvt_pk_bf16(s1[8], s1[9]); w.y = cvt_pk_bf16(s1[10], s1[11]); w.z = cvt_pk_bf16(s1[12], s1[13]); w.w = cvt_pk_bf16(s1[14], s1[15]); pf[3] = __builtin_bit_cast(bf16x8, w); }
#pragma unroll
            for (int d = 0; d < 4; ++d)
#pragma unroll
                for (int ks = 0; ks < 4; ++ks) {
                    const bf16x8 vf = *(const LAS bf16x8*)(lds + cb + vfo + d * 32 * VROW + ks * 32);
                    o[d] = __builtin_amdgcn_mfma_f32_32x32x16_bf16(vf, pf[ks], o[d], 0, 0, 0);
                }
        }
        if (more) { *(LAS u32x4*)(lds + nb + lk0) = ld0; *(LAS u32x4*)(lds + nb + lk1) = ld1; *(LAS u32x4*)(lds + nb + lr) = ld2; *(LAS u32x4*)(lds + nb + lv0) = ld3; *(LAS u32x4*)(lds + nb + lv1) = ld4; }
        __syncthreads();
    }
    lrun += __shfl_xor(lrun, 32);
    const float rl = __builtin_amdgcn_rcpf(lrun);
    bf16_t* op = o_out + (size_t)(tok0 + q0 + r32) * D + h * 128 + 4 * hi;
#pragma unroll
    for (int d = 0; d < 4; ++d)
#pragma unroll
        for (int r4 = 0; r4 < 4; ++r4) { u32x2 w; w.x = cvt_pk_bf16(o[d][4 * r4] * rl, o[d][4 * r4 + 1] * rl); w.y = cvt_pk_bf16(o[d][4 * r4 + 2] * rl, o[d][4 * r4 + 3] * rl);
            *(u32x2*)(op + 32 * d + 8 * r4) = w; }
}
__device__ __forceinline__ void p_attn(const Ctx& F, const Args& a) {
    const bf16_t* qn = (const bf16_t*)(a.ws + A_QN); const bf16_t* qr = (const bf16_t*)(a.ws + A_QR);
    const bf16_t* kn = (const bf16_t*)(a.ws + A_KN); const bf16_t* kr = (const bf16_t*)(a.ws + A_KR); const bf16_t* vt = (const bf16_t*)(a.ws + A_VT);
    bf16_t* oo = (bf16_t*)(a.ws + A_QN);
    for (int p = F.vcu; p < 512; p += F.G) {
        const int bh = p >> 3, s = p & 7;
        attn_unit(F.lds, qn, qr, kn, kr, vt, oo, bh >> 3, bh & 7, 15 - s, F.wave);
        attn_unit(F.lds, qn, qr, kn, kr, vt, oo, bh >> 3, bh & 7, s, F.wave);
    }
}

__device__ __forceinline__ void p_final(const Ctx& F, const Args& a) {
    float* h = a.out; const float* g = a.in[32];
    const int tid = fresh_tid(F.wave), lane = tid & 63, wave = __builtin_amdgcn_readfirstlane(tid >> 6);
    const int gw = F.vcu * 8 + wave, NGW = F.G * 8;
    f32x4 gv[4];
#pragma unroll
    for (int j = 0; j < 4; ++j) gv[j] = *((const f32x4*)g + lane + 64 * j);
    for (int m = gw; m < T; m += NGW) {
        f32x4 v[4]; float ss = 0.f;
#pragma unroll
        for (int j = 0; j < 4; ++j) { v[j] = *((const f32x4*)(h + (size_t)m * D) + lane + 64 * j); ss += (v[j][0] * v[j][0] + v[j][1] * v[j][1]) + (v[j][2] * v[j][2] + v[j][3] * v[j][3]); }
        const float rs = __builtin_amdgcn_rsqf(wave_sum(ss) * (1.0f / 1024.0f) + RMS_EPS);
#pragma unroll
        for (int j = 0; j < 4; ++j) *((f32x4*)(h + (size_t)m * D) + lane + 64 * j) = v[j] * rs * gv[j];
    }
}

__device__ __forceinline__ void my_grid_sync(unsigned* cnt, unsigned G, int wave_s) {
    __builtin_amdgcn_fence(__ATOMIC_RELEASE, "agent");
    asm volatile("s_waitcnt vmcnt(0) lgkmcnt(0)" ::: "memory");
    __syncthreads();
    if (fresh_tid(wave_s) == 0) {
        __hip_atomic_fetch_add(cnt, 1u, __ATOMIC_RELAXED, __HIP_MEMORY_SCOPE_AGENT);
        while (__hip_atomic_load(cnt, __ATOMIC_RELAXED, __HIP_MEMORY_SCOPE_AGENT) < G) __builtin_amdgcn_s_sleep(2);
    }
    __syncthreads();
    __builtin_amdgcn_fence(__ATOMIC_ACQUIRE, "agent");
    asm volatile("s_waitcnt vmcnt(0)" ::: "memory");
}
#define GSYNC() do { my_grid_sync(bar_words + 64 * bar_idx, (unsigned)F.G, F.wave); ++bar_idx; } while (0)
#define RUN_GEMM(EPI_T, epi, Aptr, lda_, Bptr, ldb_, M_, N_, K_) do { pg8::Gemm g_{(const bf16_t*)(Aptr), (lda_), (const bf16_t*)(Bptr), (ldb_), (M_), (N_), (K_)}; \
    pg8::StaticOrder S_; S_.init((M_), (N_), F.G, (int)blockIdx.x); pg8::gemm_phase<EPI_T>(F.lds, g_, S_, (epi), F.wave); } while (0)

__global__ void __launch_bounds__(512, 2) fwd_mega(Args a) {
    extern __shared__ __attribute__((aligned(16))) unsigned char lds_raw[];
    cg::grid_group grid = cg::this_grid();
    Ctx F; F.lds = (LAS unsigned char*)lds_raw; F.wave = __builtin_amdgcn_readfirstlane((int)threadIdx.x >> 6);
    F.G = gridDim.x; { const int bx = blockIdx.x; F.vcu = (F.G % 8 == 0) ? (bx % 8) * (F.G / 8) + bx / 8 : bx; }
    unsigned char* ws = a.ws;
    float* slotsH = (float*)(ws + WS_SLOTH); float* slotsC = (float*)(ws + WS_SLOTC); float* slotsQ = (float*)(ws + WS_SLOTQ);
    bf16_t* HB = (bf16_t*)(ws + A_HB); bf16_t* MID = (bf16_t*)(ws + A_MID);
    const float* cosT = (const float*)(ws + A_COS); const float* sinT = (const float*)(ws + A_SIN);
    bf16_t* WUG = (bf16_t*)(ws + W_UG); bf16_t* WDN = (bf16_t*)(ws + W_DN);

    unsigned* bar_words = (unsigned*)ws; int bar_idx = 0;
    if (a.ph_hi - a.ph_lo > 1) grid.sync();
    if (a.ph_lo <= 0 && 0 < a.ph_hi) {
    p0_prologue(F, a);
    }
    if (a.ph_lo <= 0 && 1 < a.ph_hi) GSYNC();
    if (a.ph_lo <= 1 && 1 < a.ph_hi) {
    { EpiSwiglu E{MID, slotsH, nullptr, nullptr, nullptr, nullptr, nullptr}; RUN_GEMM(EpiSwiglu, E, HB, D, WUG, D, T, 5632, D); }
    }
    if (a.ph_lo <= 1 && 2 < a.ph_hi) GSYNC();
    if (a.ph_lo <= 2 && 2 < a.ph_hi) {
    { EpiResid E{a.in[0], a.out, nullptr, nullptr, 0.5f}; RUN_GEMM(EpiResid, E, MID, FF, WDN, FF, T, D, FF); }
    }
    if (a.ph_lo <= 2 && 3 < a.ph_hi) GSYNC();
    if (a.ph_lo <= 3 && 3 < a.ph_hi) {
    p_premix(F, a);
    }
    if (a.ph_lo <= 3 && 4 < a.ph_hi) GSYNC();
    if (a.ph_lo <= 4 && 4 < a.ph_hi) {
    { EpiRL E{(bf16_t*)(ws + A_R), (bf16_t*)(ws + A_LM)}; RUN_GEMM(EpiRL, E, ws + A_X1, 2048, ws + W_RL, 2048, T, 1280, 2048); }
    }
    if (a.ph_lo <= 4 && 5 < a.ph_hi) GSYNC();
    if (a.ph_lo <= 5 && 5 < a.ph_hi) {
    }
    if (a.ph_lo <= 5 && 6 < a.ph_hi) GSYNC();
    if (a.ph_lo <= 6 && 6 < a.ph_hi) {
    { EpiBf16 E{(bf16_t*)(ws + A_KK), D}; RUN_GEMM(EpiBf16, E, ws + A_XK, D, ws + W_K, D, T, D, D); }
    }
    if (a.ph_lo <= 6 && 7 < a.ph_hi) GSYNC();
    if (a.ph_lo <= 7 && 7 < a.ph_hi) {
    { EpiBf16 E{(bf16_t*)(ws + A_VV), D}; RUN_GEMM(EpiBf16, E, ws + A_XV, D, ws + W_V, D, T, D, D); }
    }
    if (a.ph_lo <= 7 && 8 < a.ph_hi) GSYNC();
    if (a.ph_lo <= 8 && 8 < a.ph_hi) {
    { EpiLoraUp E{ws, a.in[11], a.in[14]}; RUN_GEMM(EpiLoraUp, E, ws + A_LM, 256, ws + W_LU, 256, T, 3072, 256); }
    }
    if (a.ph_lo <= 8 && 9 < a.ph_hi) GSYNC();
    if (a.ph_lo <= 9 && 9 < a.ph_hi) {
    p_scan(F, a);
    }
    if (a.ph_lo <= 9 && 10 < a.ph_hi) GSYNC();
    if (a.ph_lo <= 10 && 10 < a.ph_hi) {
    { EpiResid E{a.out, a.out, HB, slotsH, 1.0f}; RUN_GEMM(EpiResid, E, ws + A_G, D, ws + W_O, D, T, D, D); }
    }
    if (a.ph_lo <= 10 && 11 < a.ph_hi) GSYNC();
    if (a.ph_lo <= 11 && 11 < a.ph_hi) {
    { EpiSwiglu E{MID, slotsH, nullptr, nullptr, nullptr, nullptr, nullptr}; RUN_GEMM(EpiSwiglu, E, HB, D, WUG + (size_t)1 * 6144 * D, D, T, 5632, D); }
    }
    if (a.ph_lo <= 11 && 12 < a.ph_hi) GSYNC();
    if (a.ph_lo <= 12 && 12 < a.ph_hi) {
    { EpiResid E{a.out, a.out, HB, slotsH, 0.5f}; RUN_GEMM(EpiResid, E, MID, FF, WDN + (size_t)1 * D * FF, FF, T, D, FF); }
    }
    if (a.ph_lo <= 12 && 13 < a.ph_hi) GSYNC();
    if (a.ph_lo <= 13 && 13 < a.ph_hi) {
    { EpiSwiglu E{MID, slotsH, (bf16_t*)(ws + A_C), slotsC, (bf16_t*)(ws + A_KR), cosT, sinT}; RUN_GEMM(EpiSwiglu, E, HB, D, WUG + (size_t)2 * 6144 * D, D, T, 6144, D); }
    }
    if (a.ph_lo <= 13 && 14 < a.ph_hi) GSYNC();
    if (a.ph_lo <= 14 && 14 < a.ph_hi) {
    { EpiResid E{a.out, a.out, HB, slotsH, 0.5f}; RUN_GEMM(EpiResid, E, MID, FF, WDN + (size_t)2 * D * FF, FF, T, D, FF); }
    }
    if (a.ph_lo <= 14 && 15 < a.ph_hi) GSYNC();
    if (a.ph_lo <= 15 && 15 < a.ph_hi) {
    { EpiKnope E{(bf16_t*)(ws + A_KN), slotsC}; RUN_GEMM(EpiKnope, E, ws + A_C, 256, ws + W_KN, 256, T, D, 256); }
    }
    if (a.ph_lo <= 15 && 16 < a.ph_hi) GSYNC();
    if (a.ph_lo <= 16 && 16 < a.ph_hi) {
    { EpiVt E{(bf16_t*)(ws + A_VT), slotsC}; RUN_GEMM(EpiVt, E, ws + W_VT, 256, ws + A_C, 256, D, T, 256); }
    }
    if (a.ph_lo <= 16 && 17 < a.ph_hi) GSYNC();
    if (a.ph_lo <= 17 && 17 < a.ph_hi) {
    { EpiQlat E{(bf16_t*)(ws + A_QLAT), slotsH, slotsQ}; RUN_GEMM(EpiQlat, E, HB, D, ws + W_DQ, D, T, 512, D); }
    }
    if (a.ph_lo <= 17 && 18 < a.ph_hi) GSYNC();
    if (a.ph_lo <= 18 && 18 < a.ph_hi) {
    { EpiQ E{(bf16_t*)(ws + A_QN), (bf16_t*)(ws + A_QR), slotsQ, cosT, sinT}; RUN_GEMM(EpiQ, E, ws + A_QLAT, 512, ws + W_UQ, 512, T, 1536, 512); }
    }
    if (a.ph_lo <= 18 && 19 < a.ph_hi) GSYNC();
    if (a.ph_lo <= 19 && 19 < a.ph_hi) {
    p_attn(F, a);
    }
    if (a.ph_lo <= 19 && 20 < a.ph_hi) GSYNC();
    if (a.ph_lo <= 20 && 20 < a.ph_hi) {
    { EpiResid E{a.out, a.out, HB, slotsH, 1.0f}; RUN_GEMM(EpiResid, E, ws + A_QN, D, ws + W_MO, D, T, D, D); }
    }
    if (a.ph_lo <= 20 && 21 < a.ph_hi) GSYNC();
    if (a.ph_lo <= 21 && 21 < a.ph_hi) {
    { EpiSwiglu E{MID, slotsH, nullptr, nullptr, nullptr, nullptr, nullptr}; RUN_GEMM(EpiSwiglu, E, HB, D, WUG + (size_t)3 * 6144 * D, D, T, 5632, D); }
    }
    if (a.ph_lo <= 21 && 22 < a.ph_hi) GSYNC();
    if (a.ph_lo <= 22 && 22 < a.ph_hi) {
    { EpiResid E{a.out, a.out, nullptr, nullptr, 0.5f}; RUN_GEMM(EpiResid, E, MID, FF, WDN + (size_t)3 * D * FF, FF, T, D, FF); }
    }
    if (a.ph_lo <= 22 && 23 < a.ph_hi) GSYNC();
    if (a.ph_lo <= 23 && 23 < a.ph_hi) {
    p_final(F, a);
    }
}

extern "C" void kernel_launch(void* const* d_in, const int* in_sizes, int n_in, void* d_out, int out_size, void* d_ws, size_t ws_size, hipStream_t stream) {
    static int grid = 0;
    if (grid == 0) {
        if (n_in != 33 || out_size != T * D || ws_size < WS_NEED) { fprintf(stderr, "kernel_launch: unexpected shapes: n_in %d out %d ws %zu (need %zu)\n", n_in, out_size, ws_size, (size_t)WS_NEED); grid = -1; return; }
        int dev = 0, cus = 0, per_cu = 0;
        (void)hipGetDevice(&dev); (void)hipDeviceGetAttribute(&cus, hipDeviceAttributeMultiprocessorCount, dev);
        (void)hipFuncSetAttribute((const void*)fwd_mega, hipFuncAttributeMaxDynamicSharedMemorySize, LDS_BYTES);
        (void)hipOccupancyMaxActiveBlocksPerMultiprocessor(&per_cu, (const void*)fwd_mega, 512, LDS_BYTES);
        (void)hipGetLastError();
        grid = cus > 0 ? cus : 256;
        if (grid > 256) grid = 256;
    }
    if (grid < 0) return;
    (void)hipMemsetAsync(d_ws, 0, 65536, stream);
    Args a{};
    for (int i = 0; i < 33; ++i) a.in[i] = (const float*)d_in[i];
    a.pos = (const int*)d_in[1]; a.out = (float*)d_out; a.ws = (unsigned char*)d_ws;
    hipError_t e = hipSuccess;
#if N_LAUNCHES == 1
    a.ph_lo = 0; a.ph_hi = NPHASES;
    { void* args[] = {&a}; e = hipLaunchCooperativeKernel((void*)fwd_mega, dim3(grid), dim3(512), args, LDS_BYTES, stream); }
#else
    for (int p = 0; p < NPHASES; ++p) { a.ph_lo = p; a.ph_hi = p + 1; hipLaunchKernelGGL(fwd_mega, dim3(grid), dim3(512), LDS_BYTES, stream, a); }
    e = hipPeekAtLastError();
#endif
    if (e != hipSuccess) fprintf(stderr, "cooperative launch failed: %s (grid %d)\n", hipGetErrorString(e), grid);
}
```

```cpp
#include <hip/hip_runtime.h>
#include <hip/hip_cooperative_groups.h>
#include <cstdio>
#include <cstdint>
namespace cg = cooperative_groups;

#define LAS __attribute__((address_space(3)))
typedef unsigned short bf16_t;
typedef short bf16x8 __attribute__((ext_vector_type(8)));
typedef float f32x4 __attribute__((ext_vector_type(4)));
typedef float f32x16 __attribute__((ext_vector_type(16)));
typedef unsigned u32x4 __attribute__((ext_vector_type(4)));
typedef unsigned u32x2 __attribute__((ext_vector_type(2)));

constexpr int T = 32768, D = 1024, FF = 2816, SEQ = 4096, NB = 8;
constexpr float RMS_EPS = 1e-6f, GN_EPS = 64e-5f;
constexpr float LOG2E = 1.4426950408889634f;
constexpr float QSCALE = 0.07216878364870322f * 1.4426950408889634f;

constexpr size_t MiB = 1u << 20;
constexpr size_t WS_SLOTH = MiB / 2;
constexpr size_t WS_SLOTC = WS_SLOTH + 2 * MiB;
constexpr size_t WS_SLOTQ = WS_SLOTC + MiB / 2;
constexpr size_t WS_W = 4 * MiB;
constexpr size_t W_UG = WS_W;
constexpr size_t W_DN = W_UG + 48 * MiB;
constexpr size_t W_R = W_DN + 22 * MiB;
constexpr size_t W_K = W_R + 2 * MiB;
constexpr size_t W_V = W_K + 2 * MiB;
constexpr size_t W_O = W_V + 2 * MiB;
constexpr size_t W_LD = W_O + 2 * MiB;
constexpr size_t W_LU = W_LD + 1 * MiB;
constexpr size_t W_KN = W_LU + 2 * MiB;
constexpr size_t W_VT = W_KN + MiB / 2;
constexpr size_t W_DQ = W_VT + MiB / 2;
constexpr size_t W_UQ = W_DQ + 1 * MiB;
constexpr size_t W_MO = W_UQ + 2 * MiB;
constexpr size_t W_END = W_MO + 2 * MiB;
constexpr size_t WS_A = 92 * MiB;
static_assert(W_END <= WS_A, "weights region");
constexpr size_t A_HB = WS_A + 0;
constexpr size_t A_MID = WS_A + 64 * MiB;
constexpr size_t A_C = WS_A + 240 * MiB;
constexpr size_t A_KR = WS_A + 256 * MiB;
constexpr size_t A_KN = WS_A + 260 * MiB;
constexpr size_t A_VT = WS_A + 324 * MiB;
constexpr size_t A_QLAT = A_MID;
constexpr size_t A_QN = A_MID + 32 * MiB;
constexpr size_t A_QR = A_MID + 96 * MiB;
constexpr size_t A_X1 = WS_A + 0;
constexpr size_t A_XK = WS_A + 128 * MiB;
constexpr size_t A_XV = WS_A + 192 * MiB;
constexpr size_t A_R = WS_A + 256 * MiB;
constexpr size_t A_LM = WS_A + 320 * MiB;
constexpr size_t A_KK = WS_A + 0;
constexpr size_t A_VV = WS_A + 64 * MiB;
constexpr size_t A_E = WS_A + 128 * MiB;
constexpr size_t A_AA = WS_A + 192 * MiB;
constexpr size_t A_G = WS_A + 336 * MiB;
constexpr size_t A_COS = WS_A + 404 * MiB;
constexpr size_t A_SIN = WS_A + 408 * MiB;
constexpr size_t W_RL = WS_A + 412 * MiB;
constexpr size_t WS_NEED = 512 * MiB;

constexpr int LDS_BYTES = 147456;
constexpr int NPHASES = 24;
#ifndef N_LAUNCHES
#define N_LAUNCHES 1
#endif

__device__ __forceinline__ unsigned cvt_pk_bf16(float lo, float hi) { unsigned r; asm volatile("v_cvt_pk_bf16_f32 %0, %1, %2" : "=v"(r) : "v"(lo), "v"(hi)); return r; }
__device__ __forceinline__ float fsigmoid(float x) { return __builtin_amdgcn_rcpf(1.0f + __builtin_amdgcn_exp2f(-x * LOG2E)); }
__device__ __forceinline__ float ftanh(float x) { return 1.0f - 2.0f * __builtin_amdgcn_rcpf(1.0f + __builtin_amdgcn_exp2f(2.0f * LOG2E * x)); }
__device__ __forceinline__ float wave_sum(float v) {
#pragma unroll
    for (int o = 1; o < 64; o <<= 1) v += __shfl_xor(v, o);
    return v;
}
template <int CTRL> __device__ __forceinline__ float dpp_mov(float x) { return __builtin_bit_cast(float, __builtin_amdgcn_update_dpp(0, __builtin_bit_cast(int, x), CTRL, 0xf, 0xf, true)); }
__device__ __forceinline__ float red8(float x) { x += dpp_mov<0xB1>(x); x += dpp_mov<0x4E>(x); x += dpp_mov<0x141>(x); return x; }
__device__ __forceinline__ float red16(float x) { x = red8(x); x += dpp_mov<0x140>(x); return x; }
__device__ __forceinline__ float sum4(f32x4 v) { return (v[0] + v[1]) + (v[2] + v[3]); }
__device__ __forceinline__ float rstd_slots16(const float* s, int row) {
    const f32x4* p = (const f32x4*)(s + (size_t)row * 16);
    const f32x4 a = p[0], b = p[1], c = p[2], d = p[3];
    return __builtin_amdgcn_rsqf((sum4(a) + sum4(b) + sum4(c) + sum4(d)) * (1.0f / 1024.0f) + RMS_EPS);
}
__device__ __forceinline__ f32x4 unpack4(u32x2 p) { f32x4 r; r[0] = __uint_as_float(p.x << 16); r[1] = __uint_as_float(p.x & 0xffff0000u); r[2] = __uint_as_float(p.y << 16); r[3] = __uint_as_float(p.y & 0xffff0000u); return r; }

__device__ __forceinline__ int fresh_tid(int wave_s) { int l; asm volatile("v_mbcnt_lo_u32_b32 %0, -1, 0\n\tv_mbcnt_hi_u32_b32 %0, -1, %0" : "=v"(l)); return wave_s * 64 + l; }

namespace pg8 {
constexpr int BM = 256, BK = 64, HALF = 128, HTB = HALF * BK * 2, STAGE_BYTES = 8 * HTB, NXCD = 8, WGM = 8;
__device__ __forceinline__ int lds_byte(int r, int c) { const int st = (r >> 4) * 2 + (c >> 5), rr = r & 15, cc = c & 31, ob = rr * 64 + cc * 2; return st * 1024 + (ob ^ (((ob >> 9) & 1) << 5)); }
__device__ __forceinline__ void stage_rc(int b, int& R, int& C) { const int st = b / 1024, sb = b % 1024, swz = sb ^ (((sb >> 9) & 1) << 5); R = (st >> 1) * 16 + swz / 64; C = (st & 1) * 32 + (swz % 64) / 2; }
__device__ __forceinline__ int perm32(int rho) { const int n = rho >> 4, i = rho & 15; return 8 * (i >> 2) + 4 * n + (i & 3); }
struct Unit { int pm, pn; };
struct Gemm { const bf16_t* A; int lda; const bf16_t* Bt; int ldb; int M, N, K; };
struct StaticOrder {
    int nM, nN, nwg, G, c;
    __device__ void init(int M, int N, int G_, int c_) { nM = M / BM; nN = N / BM; nwg = nM * nN; G = G_; c = c_; }
    __device__ bool next(int i, Unit& u) const {
        const long L = (long)i * G + c; if (L >= nwg) return false;
        int wgid = (int)L; { const int q = nwg / NXCD, r = nwg % NXCD, xcd = wgid % NXCD, off = wgid / NXCD; wgid = (xcd < r ? xcd * (q + 1) : r * (q + 1) + (xcd - r) * q) + off; }
        const int nig = WGM * nN, gid = wgid / nig, fm = gid * WGM, gsz = (nM - fm) < WGM ? (nM - fm) : WGM;
        u.pm = fm + ((wgid % nig) % gsz); u.pn = (wgid % nig) / gsz; return true;
    }
};

template <class Epi>
__device__ __forceinline__ void gemm_phase(LAS unsigned char* lds, const Gemm g, const StaticOrder& S, const Epi& E, int wave_s) {
    const int tid = fresh_tid(wave_s), wid = __builtin_amdgcn_readfirstlane(tid >> 6), lane = tid & 63, wr = wid >> 2, wc = wid & 3, fr = lane & 15, fq = lane >> 4;
    const int K = g.K, nt = K / BK;
    unsigned voffA[2], voffB[2];
#pragma unroll
    for (int i = 0; i < 2; ++i) { int R, C; stage_rc(tid * 16 + i * 8192, R, C); const int Rb = Epi::PERM ? ((R & ~31) + perm32(R & 31)) : R;
        voffA[i] = (unsigned)(R * g.lda + C) * 2u; voffB[i] = (unsigned)(Rb * g.ldb + C) * 2u; }
    const size_t kstep = (size_t)(BK * 2);
    const size_t hstepA = (size_t)HALF * g.lda * 2, hstepB = (size_t)HALF * g.ldb * 2;
    const size_t tstepA = 2 * hstepA, tstepB = 2 * hstepB;
    const unsigned ldsw = (unsigned)wid * 1024u;
    const int aoff = lds_byte(wr * 64 + fr, fq * 8), boff = lds_byte(wc * 32 + fr, fq * 8);
#define PG8_SA(b, h) (((b) * 2 + (h)) * HTB)
#define PG8_SB(b, h) ((4 + (b) * 2 + (h)) * HTB)
#define PG8_STAGE(bufoff, gbase, voff) do { _Pragma("unroll") for (int _i = 0; _i < 2; ++_i) \
        __builtin_amdgcn_global_load_lds((const unsigned*)((const char*)(gbase) + (voff)[_i]), (LAS unsigned*)(lds + (bufoff) + ldsw + _i * 8192), 16, 0, 0); } while (0)
#define PG8_LDA(dst, b, h) do { _Pragma("unroll") for (int m = 0; m < 4; ++m) _Pragma("unroll") for (int k = 0; k < 2; ++k) dst[m][k] = *(const LAS bf16x8*)(lds + PG8_SA(b, h) + aoff + m * 2048 + k * 1024); } while (0)
#define PG8_LDB(dst, b, h) do { _Pragma("unroll") for (int n = 0; n < 2; ++n) _Pragma("unroll") for (int k = 0; k < 2; ++k) dst[n][k] = *(const LAS bf16x8*)(lds + PG8_SB(b, h) + boff + n * 2048 + k * 1024); } while (0)
#define PG8_MMA(ai, bj, At, Bt) do { __builtin_amdgcn_s_setprio(1); _Pragma("unroll") for (int m = 0; m < 4; ++m) _Pragma("unroll") for (int n = 0; n < 2; ++n) _Pragma("unroll") for (int k = 0; k < 2; ++k) \
        acc[ai][bj][m][n] = __builtin_amdgcn_mfma_f32_16x16x32_bf16(Bt[n][k], At[m][k], acc[ai][bj][m][n], 0, 0, 0); __builtin_amdgcn_s_setprio(0); } while (0)
#define PG8_WAIT_V(n) asm volatile("s_waitcnt vmcnt(" #n ")" ::: "memory")
#define PG8_WAIT_L(n) asm volatile("s_waitcnt lgkmcnt(" #n ")" ::: "memory")
#define PG8_BAR __builtin_amdgcn_s_barrier()
#define PG8_SCHED __builtin_amdgcn_sched_barrier(0)
    Unit cur, nxt; int ui = 0;
    if (!S.next(0, cur)) return;
    f32x4 acc[2][2][4][2];
#pragma unroll
    for (int a = 0; a < 2; ++a)
#pragma unroll
        for (int b = 0; b < 2; ++b)
#pragma unroll
            for (int m = 0; m < 4; ++m)
#pragma unroll
                for (int n = 0; n < 2; ++n) acc[a][b][m][n] = (f32x4){0.f, 0.f, 0.f, 0.f};
    bf16x8 At[4][2], B0[2][2], B1[2][2];
    const char* cA = (const char*)g.A + (size_t)cur.pm * tstepA; const char* cB = (const char*)g.Bt + (size_t)cur.pn * tstepB;
    PG8_STAGE(PG8_SB(0, 0), cB, voffB); PG8_STAGE(PG8_SB(0, 1), cB + hstepB, voffB); PG8_STAGE(PG8_SA(0, 0), cA, voffA); PG8_STAGE(PG8_SA(0, 1), cA + hstepA, voffA);
    if (wr == 1) PG8_BAR;
    PG8_WAIT_V(2); PG8_BAR;
    PG8_STAGE(PG8_SB(1, 0), cB + kstep, voffB); PG8_STAGE(PG8_SA(1, 0), cA + kstep, voffA); PG8_STAGE(PG8_SB(1, 1), cB + hstepB + kstep, voffB);
    PG8_WAIT_V(6); PG8_BAR;
    for (;;) {
        const bool has_next = S.next(ui + 1, nxt);
        const char* nA = has_next ? (const char*)g.A + (size_t)nxt.pm * tstepA : cA; const char* nB = has_next ? (const char*)g.Bt + (size_t)nxt.pn * tstepB : cB;
        for (int t = 0; t < nt; t += 2) {
            const bool last = (t == nt - 2);
            const char* a1 = cA + (size_t)(t + 1) * kstep;
            const char* a2 = last ? nA : cA + (size_t)(t + 2) * kstep; const char* b2 = last ? nB : cB + (size_t)(t + 2) * kstep;
            const char* a3 = a2 + kstep; const char* b3 = b2 + kstep;
            PG8_LDB(B0, 0, 0); PG8_LDB(B1, 0, 1); PG8_SCHED; PG8_LDA(At, 0, 0); PG8_STAGE(PG8_SA(1, 1), a1 + hstepA, voffA);
            PG8_WAIT_V(8); PG8_WAIT_L(0); PG8_BAR; PG8_MMA(0, 0, At, B0); PG8_MMA(0, 1, At, B1); PG8_BAR; PG8_SCHED;
            PG8_LDA(At, 0, 1); PG8_STAGE(PG8_SB(0, 0), b2, voffB); PG8_STAGE(PG8_SB(0, 1), b2 + hstepB, voffB); PG8_STAGE(PG8_SA(0, 0), a2, voffA);
            PG8_WAIT_V(8); PG8_WAIT_L(0); PG8_BAR; PG8_MMA(1, 0, At, B0); PG8_MMA(1, 1, At, B1); PG8_BAR; PG8_SCHED;
            PG8_LDB(B0, 1, 0); PG8_LDB(B1, 1, 1); PG8_SCHED; PG8_LDA(At, 1, 0); PG8_STAGE(PG8_SA(0, 1), a2 + hstepA, voffA);
            PG8_WAIT_V(8); PG8_WAIT_L(0); PG8_BAR; PG8_MMA(0, 0, At, B0); PG8_MMA(0, 1, At, B1); PG8_BAR; PG8_SCHED;
            PG8_LDA(At, 1, 1); PG8_STAGE(PG8_SB(1, 0), b3, voffB); PG8_STAGE(PG8_SB(1, 1), b3 + hstepB, voffB); PG8_STAGE(PG8_SA(1, 0), a3, voffA);
            PG8_WAIT_V(8); PG8_WAIT_L(0); PG8_BAR; PG8_MMA(1, 0, At, B0); PG8_MMA(1, 1, At, B1); PG8_BAR; PG8_SCHED;
        }
        if (wr == 0) PG8_BAR;
        E(acc, cur, wr, wc, fr, fq);
        if (!has_next) break;
#pragma unroll
        for (int a = 0; a < 2; ++a)
#pragma unroll
            for (int b = 0; b < 2; ++b)
#pragma unroll
                for (int m = 0; m < 4; ++m)
#pragma unroll
                    for (int n = 0; n < 2; ++n) acc[a][b][m][n] = (f32x4){0.f, 0.f, 0.f, 0.f};
        cur = nxt; cA = nA; cB = nB; ++ui;
        if (wr == 1) PG8_BAR;
    }
    PG8_WAIT_V(0);
    PG8_BAR;
#undef PG8_SA
#undef PG8_SB
#undef PG8_STAGE
#undef PG8_LDA
#undef PG8_LDB
#undef PG8_MMA
#undef PG8_WAIT_V
#undef PG8_WAIT_L
#undef PG8_BAR
#undef PG8_SCHED
}
}
using pg8::Unit;
typedef f32x4 AccT[2][2][4][2];

__device__ __forceinline__ u32x4 pack8(f32x4 a, f32x4 b) { u32x4 w; w.x = cvt_pk_bf16(a[0], a[1]); w.y = cvt_pk_bf16(a[2], a[3]); w.z = cvt_pk_bf16(b[0], b[1]); w.w = cvt_pk_bf16(b[2], b[3]); return w; }

struct EpiSwiglu {
    static constexpr bool PERM = true;
    bf16_t* mid; const float* slotsH; bf16_t* cbuf; float* slotsC; bf16_t* krope; const float* cosT; const float* sinT;
    __device__ __forceinline__ void operator()(const AccT& acc, const Unit& u, int wr, int wc, int fr, int fq) const {
        const int row0 = u.pm * 256 + wr * 64 + fr;
        if (u.pn < 22) {
#pragma unroll
            for (int ai = 0; ai < 2; ++ai)
#pragma unroll
                for (int m = 0; m < 4; ++m) {
                    const int row = row0 + ai * 128 + m * 16; const float rs = rstd_slots16(slotsH, row);
                    f32x4 o[2];
#pragma unroll
                    for (int n = 0; n < 2; ++n)
#pragma unroll
                        for (int i = 0; i < 4; ++i) { const float gt = acc[ai][0][m][n][i] * rs, up = acc[ai][1][m][n][i] * rs; o[n][i] = gt * fsigmoid(gt) * up; }
                    *(u32x4*)(mid + (size_t)row * FF + u.pn * 128 + wc * 32 + fq * 8) = pack8(o[0], o[1]);
                }
        } else if (u.pn == 22) {
#pragma unroll
            for (int ai = 0; ai < 2; ++ai)
#pragma unroll
                for (int m = 0; m < 4; ++m) {
                    const int row = row0 + ai * 128 + m * 16; const float rs = rstd_slots16(slotsH, row);
                    float ss = 0.f;
#pragma unroll
                    for (int bj = 0; bj < 2; ++bj) { const f32x4 a = acc[ai][bj][m][0] * rs, b = acc[ai][bj][m][1] * rs;
                        ss += (a[0] * a[0] + a[1] * a[1]) + (a[2] * a[2] + a[3] * a[3]) + (b[0] * b[0] + b[1] * b[1]) + (b[2] * b[2] + b[3] * b[3]);
                        *(u32x4*)(cbuf + (size_t)row * 256 + bj * 128 + wc * 32 + fq * 8) = pack8(a, b); }
                    ss += __shfl_xor(ss, 16); ss += __shfl_xor(ss, 32);
                    if (fq == 0) slotsC[(size_t)row * 4 + wc] = ss;
                }
        } else if (wc == 0) {
#pragma unroll
            for (int ai = 0; ai < 2; ++ai)
#pragma unroll
                for (int m = 0; m < 4; ++m) {
                    const int row = row0 + ai * 128 + m * 16; const float rs = rstd_slots16(slotsH, row);
                    f32x4 o1[2], o2[2];
#pragma unroll
                    for (int n = 0; n < 2; ++n) { const f32x4 c = *(const f32x4*)(cosT + (size_t)row * 32 + fq * 8 + n * 4), s = *(const f32x4*)(sinT + (size_t)row * 32 + fq * 8 + n * 4);
                        const f32x4 x1 = acc[ai][0][m][n] * rs, x2 = acc[ai][1][m][n] * rs; o1[n] = x1 * c - x2 * s; o2[n] = x2 * c + x1 * s; }
                    *(u32x4*)(krope + (size_t)row * 64 + fq * 8) = pack8(o1[0], o1[1]);
                    *(u32x4*)(krope + (size_t)row * 64 + 32 + fq * 8) = pack8(o2[0], o2[1]);
                }
        }
    }
};
struct EpiResid {
    static constexpr bool PERM = false;
    const float* hin; float* hout; bf16_t* hb; float* slots; float alpha;
    __device__ __forceinline__ void operator()(const AccT& acc, const Unit& u, int wr, int wc, int fr, int fq) const {
        const int row0 = u.pm * 256 + wr * 64 + fr, col0 = u.pn * 256 + wc * 32 + 4 * fq;
#pragma unroll
        for (int ai = 0; ai < 2; ++ai)
#pragma unroll
            for (int m = 0; m < 4; ++m) {
                const int row = row0 + ai * 128 + m * 16; const size_t off = (size_t)row * D + col0; float ss = 0.f;
#pragma unroll
                for (int bj = 0; bj < 2; ++bj)
#pragma unroll
                    for (int n = 0; n < 2; ++n) { const size_t o2 = off + bj * 128 + n * 16; const f32x4 b = *(const f32x4*)(hin + o2); const f32x4 o = b + acc[ai][bj][m][n] * alpha;
                        *(f32x4*)(hout + o2) = o; ss += (o[0] * o[0] + o[1] * o[1]) + (o[2] * o[2] + o[3] * o[3]);
                        if (hb) { u32x2 w; w.x = cvt_pk_bf16(o[0], o[1]); w.y = cvt_pk_bf16(o[2], o[3]); *(u32x2*)(hb + o2) = w; } }
                if (slots) { ss += __shfl_xor(ss, 16); ss += __shfl_xor(ss, 32); if (fq == 0) slots[(size_t)row * 16 + u.pn * 4 + wc] = ss; }
                if (m & 1) asm volatile("" ::: "memory");
            }
    }
};
struct EpiBf16 {
    static constexpr bool PERM = true;
    bf16_t* O; int ldc;
    __device__ __forceinline__ void operator()(const AccT& acc, const Unit& u, int wr, int wc, int fr, int fq) const {
        const int row0 = u.pm * 256 + wr * 64 + fr, col0 = u.pn * 256 + wc * 32 + 8 * fq;
#pragma unroll
        for (int ai = 0; ai < 2; ++ai)
#pragma unroll
            for (int m = 0; m < 4; ++m) { bf16_t* rp = O + (size_t)(row0 + ai * 128 + m * 16) * ldc + col0;
#pragma unroll
                for (int bj = 0; bj < 2; ++bj) *(u32x4*)(rp + bj * 128) = pack8(acc[ai][bj][m][0], acc[ai][bj][m][1]); }
    }
};
struct EpiLoraDown {
    static constexpr bool PERM = true;
    bf16_t* O;
    __device__ __forceinline__ void operator()(const AccT& acc, const Unit& u, int wr, int wc, int fr, int fq) const {
        const int row0 = u.pm * 256 + wr * 64 + fr, col0 = wc * 32 + 8 * fq;
#pragma unroll
        for (int ai = 0; ai < 2; ++ai)
#pragma unroll
            for (int m = 0; m < 4; ++m) { bf16_t* rp = O + (size_t)(row0 + ai * 128 + m * 16) * 256 + col0;
                f32x4 a = acc[ai][0][m][0], b = acc[ai][0][m][1];
                if (wc < 2) {
#pragma unroll
                    for (int i = 0; i < 4; ++i) { a[i] = ftanh(a[i]); b[i] = ftanh(b[i]); } }
                *(u32x4*)(rp) = pack8(a, b);
                a = acc[ai][1][m][0]; b = acc[ai][1][m][1];
#pragma unroll
                for (int i = 0; i < 4; ++i) { a[i] = fsigmoid(a[i]); b[i] = fsigmoid(b[i]); }
                *(u32x4*)(rp + 128) = pack8(a, b); }
    }
};
struct EpiRL {
    static constexpr bool PERM = true;
    bf16_t* R; bf16_t* O;
    __device__ __forceinline__ void operator()(const AccT& acc, const Unit& u, int wr, int wc, int fr, int fq) const {
        const int row0 = u.pm * 256 + wr * 64 + fr;
        if (u.pn < 4) {
            const int col0 = u.pn * 256 + wc * 32 + 8 * fq;
#pragma unroll
            for (int ai = 0; ai < 2; ++ai)
#pragma unroll
                for (int m = 0; m < 4; ++m) { bf16_t* rp = R + (size_t)(row0 + ai * 128 + m * 16) * D + col0;
#pragma unroll
                    for (int bj = 0; bj < 2; ++bj) *(u32x4*)(rp + bj * 128) = pack8(acc[ai][bj][m][0], acc[ai][bj][m][1]); }
        } else {
            const int col0 = wc * 32 + 8 * fq;
#pragma unroll
            for (int ai = 0; ai < 2; ++ai)
#pragma unroll
                for (int m = 0; m < 4; ++m) { bf16_t* rp = O + (size_t)(row0 + ai * 128 + m * 16) * 256 + col0;
                    f32x4 a = acc[ai][0][m][0], b = acc[ai][0][m][1];
                    if (wc < 2) {
#pragma unroll
                        for (int i = 0; i < 4; ++i) { a[i] = ftanh(a[i]); b[i] = ftanh(b[i]); } }
                    *(u32x4*)(rp) = pack8(a, b);
                    a = acc[ai][1][m][0]; b = acc[ai][1][m][1];
#pragma unroll
                    for (int i = 0; i < 4; ++i) { a[i] = fsigmoid(a[i]); b[i] = fsigmoid(b[i]); }
                    *(u32x4*)(rp + 128) = pack8(a, b); }
        }
    }
};
struct EpiLoraUp {
    static constexpr bool PERM = true;
    unsigned char* wsb; const float* w0; const float* a0;
    __device__ __forceinline__ void operator()(const AccT& acc, const Unit& u, int wr, int wc, int fr, int fq) const {
        const int grp = u.pn >> 2, colt = (u.pn & 3) * 256;
        const int row0 = u.pm * 256 + wr * 64 + fr, col0 = colt + wc * 32 + 8 * fq;
        size_t ooff = A_G; if (grp == 0) ooff = A_E; if (grp == 1) ooff = A_AA;
        bf16_t* O = (bf16_t*)(wsb + ooff); const float* bias = grp == 0 ? w0 : a0;
#pragma unroll
        for (int ai = 0; ai < 2; ++ai)
#pragma unroll
            for (int m = 0; m < 4; ++m) { bf16_t* rp = O + (size_t)(row0 + ai * 128 + m * 16) * D + col0;
#pragma unroll
                for (int bj = 0; bj < 2; ++bj) { f32x4 a = acc[ai][bj][m][0], b = acc[ai][bj][m][1];
                    if (grp < 2) { const float sc = grp == 0 ? 0.6065306597126334f : 1.0f;
                        const f32x4 b0 = *(const f32x4*)(bias + col0 + bj * 128), b1 = *(const f32x4*)(bias + col0 + bj * 128 + 4);
                        a = a + b0; b = b + b1;
#pragma unroll
                        for (int i = 0; i < 4; ++i) { a[i] = sc * fsigmoid(a[i]); b[i] = sc * fsigmoid(b[i]); } }
                    *(u32x4*)(rp + bj * 128) = pack8(a, b); }
                asm volatile("" ::: "memory"); }
    }
};
struct EpiQlat {
    static constexpr bool PERM = true;
    bf16_t* O; const float* slotsH; float* slotsQ;
    __device__ __forceinline__ void operator()(const AccT& acc, const Unit& u, int wr, int wc, int fr, int fq) const {
        const int row0 = u.pm * 256 + wr * 64 + fr, col0 = u.pn * 256 + wc * 32 + 8 * fq;
#pragma unroll
        for (int ai = 0; ai < 2; ++ai)
#pragma unroll
            for (int m = 0; m < 4; ++m) { const int row = row0 + ai * 128 + m * 16; const float rs = rstd_slots16(slotsH, row); float ss = 0.f;
#pragma unroll
                for (int bj = 0; bj < 2; ++bj) { const f32x4 a = acc[ai][bj][m][0] * rs, b = acc[ai][bj][m][1] * rs;
                    ss += (a[0] * a[0] + a[1] * a[1]) + (a[2] * a[2] + a[3] * a[3]) + (b[0] * b[0] + b[1] * b[1]) + (b[2] * b[2] + b[3] * b[3]);
                    *(u32x4*)(O + (size_t)row * 512 + col0 + bj * 128) = pack8(a, b); }
                ss += __shfl_xor(ss, 16); ss += __shfl_xor(ss, 32);
                if (fq == 0) slotsQ[(size_t)row * 8 + u.pn * 4 + wc] = ss; }
    }
};
struct EpiQ {
    static constexpr bool PERM = true;
    bf16_t* qn; bf16_t* qr; const float* slotsQ; const float* cosT; const float* sinT;
    __device__ __forceinline__ void operator()(const AccT& acc, const Unit& u, int wr, int wc, int fr, int fq) const {
        const int row0 = u.pm * 256 + wr * 64 + fr;
#pragma unroll
        for (int ai = 0; ai < 2; ++ai)
#pragma unroll
            for (int m = 0; m < 4; ++m) { const int row = row0 + ai * 128 + m * 16;
                const f32x4 s0 = *(const f32x4*)(slotsQ + (size_t)row * 8), s1 = *(const f32x4*)(slotsQ + (size_t)row * 8 + 4);
                const float rs = __builtin_amdgcn_rsqf((sum4(s0) + sum4(s1)) * (1.0f / 512.0f) + RMS_EPS) * QSCALE;
                if (u.pn < 4) {
#pragma unroll
                    for (int bj = 0; bj < 2; ++bj) *(u32x4*)(qn + (size_t)row * D + u.pn * 256 + bj * 128 + wc * 32 + fq * 8) = pack8(acc[ai][bj][m][0] * rs, acc[ai][bj][m][1] * rs);
                } else {
                    const int head = 4 * (u.pn - 4) + wc; f32x4 o1[2], o2[2];
#pragma unroll
                    for (int n = 0; n < 2; ++n) { const f32x4 c = *(const f32x4*)(cosT + (size_t)row * 32 + fq * 8 + n * 4), s = *(const f32x4*)(sinT + (size_t)row * 32 + fq * 8 + n * 4);
                        const f32x4 x1 = acc[ai][0][m][n] * rs, x2 = acc[ai][1][m][n] * rs; o1[n] = x1 * c - x2 * s; o2[n] = x2 * c + x1 * s; }
                    *(u32x4*)(qr + (size_t)row * 512 + head * 64 + fq * 8) = pack8(o1[0], o1[1]);
                    *(u32x4*)(qr + (size_t)row * 512 + head * 64 + 32 + fq * 8) = pack8(o2[0], o2[1]);
                } }
    }
};
struct EpiKnope {
    static constexpr bool PERM = true;
    bf16_t* O; const float* slotsC;
    __device__ __forceinline__ void operator()(const AccT& acc, const Unit& u, int wr, int wc, int fr, int fq) const {
        const int row0 = u.pm * 256 + wr * 64 + fr, col0 = u.pn * 256 + wc * 32 + 8 * fq;
#pragma unroll
        for (int ai = 0; ai < 2; ++ai)
#pragma unroll
            for (int m = 0; m < 4; ++m) { const int row = row0 + ai * 128 + m * 16; const f32x4 s = *(const f32x4*)(slotsC + (size_t)row * 4);
                const float rs = __builtin_amdgcn_rsqf(sum4(s) * (1.0f / 256.0f) + RMS_EPS);
#pragma unroll
                for (int bj = 0; bj < 2; ++bj) *(u32x4*)(O + (size_t)row * D + col0 + bj * 128) = pack8(acc[ai][bj][m][0] * rs, acc[ai][bj][m][1] * rs); }
    }
};
struct EpiVt {
    static constexpr bool PERM = true;
    bf16_t* O; const float* slotsC;
    __device__ __forceinline__ void operator()(const AccT& acc, const Unit& u, int wr, int wc, int fr, int fq) const {
        const int row0 = u.pm * 256 + wr * 64 + fr, col0 = u.pn * 256 + wc * 32 + 8 * fq;
        f32x4 rs[2][2];
#pragma unroll
        for (int bj = 0; bj < 2; ++bj)
#pragma unroll
            for (int n = 0; n < 2; ++n)
#pragma unroll
                for (int i = 0; i < 4; ++i) { const f32x4 s = *(const f32x4*)(slotsC + (size_t)(col0 + bj * 128 + n * 4 + i) * 4); rs[bj][n][i] = __builtin_amdgcn_rsqf(sum4(s) * (1.0f / 256.0f) + RMS_EPS); }
#pragma unroll
        for (int ai = 0; ai < 2; ++ai)
#pragma unroll
            for (int m = 0; m < 4; ++m) { const int row = row0 + ai * 128 + m * 16;
#pragma unroll
                for (int bj = 0; bj < 2; ++bj) *(u32x4*)(O + (size_t)row * T + col0 + bj * 128) = pack8(acc[ai][bj][m][0] * rs[bj][0], acc[ai][bj][m][1] * rs[bj][1]); }
    }
};

struct Args { const float* in[33]; const int* pos; float* out; unsigned char* ws; int ph_lo, ph_hi; };

struct Ctx { LAS unsigned char* lds; int vcu, G, wave; };

__device__ __forceinline__ void tr_item(const float* W, int ldw, int k0, int n0, const float* s1, const float* s2, int ks0, bf16_t* Bt, int ldb, int nd0, int kd0, LAS float* scr, int lane) {
#pragma unroll 8
    for (int i = 0; i < 32; ++i) { const int kk = 2 * i + (lane >> 5);
        float sc = s1 ? s1[ks0 + kk] : 1.0f; if (s2) sc -= s2[ks0 + kk];
        scr[kk * 33 + (lane & 31)] = sc * W[(size_t)(k0 + kk) * ldw + n0 + (lane & 31)]; }
    asm volatile("s_waitcnt lgkmcnt(0)" ::: "memory");
    const int c = lane & 7;
#pragma unroll
    for (int j = 0; j < 4; ++j) { const int n = (lane >> 3) + 8 * j; const LAS float* s = scr + (8 * c) * 33 + n;
        u32x4 o; o.x = cvt_pk_bf16(s[0 * 33], s[1 * 33]); o.y = cvt_pk_bf16(s[2 * 33], s[3 * 33]); o.z = cvt_pk_bf16(s[4 * 33], s[5 * 33]); o.w = cvt_pk_bf16(s[6 * 33], s[7 * 33]);
        *(u32x4*)(Bt + (size_t)(nd0 + n) * ldb + kd0 + 8 * c) = o; }
    asm volatile("s_waitcnt lgkmcnt(0)" ::: "memory");
}
__device__ __forceinline__ void zero_item(bf16_t* Bt, int ldb, int nd0, int kd0, int lane) {
    const int c = lane & 7;
#pragma unroll
    for (int j = 0; j < 4; ++j) { const int n = (lane >> 3) + 8 * j; *(u32x4*)(Bt + (size_t)(nd0 + n) * ldb + kd0 + 8 * c) = (u32x4){0u, 0u, 0u, 0u}; }
}

__device__ __forceinline__ void p0_prologue(const Ctx& F, const Args& a) {
    unsigned char* ws = a.ws;
    const int tid = fresh_tid(F.wave), lane = tid & 63, wave = __builtin_amdgcn_readfirstlane(tid >> 6);
    LAS float* scr = (LAS float*)(F.lds + wave * 16384);
    const int gw = F.vcu * 8 + wave, NGW = F.G * 8;
    const float* norm_g = a.in[2];
    constexpr int I_UG = 16 * 176, I_UGX = 16 * 16, I_DN = 44 * 32, I_SQ = 16 * 32, I_LD = 32 * 8, I_LU = 4 * 96, I_KN = 4 * 32, I_DQ = 16 * 16, I_UQ = 8 * 48;
    constexpr int NITEMS = 4 * I_UG + I_UGX + 4 * I_DN + 4 * I_SQ + I_LD + I_LU + 2 * I_KN + I_DQ + I_UQ + I_SQ;
    for (int it = gw; it < NITEMS; it += NGW) {
        int r = it;
        if (r < 4 * I_UG) { const int q = r / I_UG; r -= q * I_UG; const int l = q >> 1, s = q & 1; const int kb = r / 176, nb = r % 176, pn = nb >> 3, jb = nb & 7;
            const float* src = (jb < 4 ? a.in[3] : a.in[4]) + (size_t)q * D * FF;
            tr_item(src, FF, 64 * kb, 128 * pn + 32 * (jb & 3), norm_g + (l * 3 + (s ? 2 : 0)) * D, nullptr, 64 * kb, (bf16_t*)(ws + W_UG) + (size_t)q * 6144 * D, D, 32 * nb, 64 * kb, scr, lane); continue; }
        r -= 4 * I_UG;
        if (r < I_UGX) { const int kb = r / 16, nb = r % 16; bf16_t* Bt = (bf16_t*)(ws + W_UG) + (size_t)2 * 6144 * D;
            int sc = -1; if (nb < 8) sc = 32 * nb; else if (nb == 8) sc = 256; else if (nb == 12) sc = 288;
            if (sc >= 0) tr_item(a.in[25], 320, 64 * kb, sc, a.in[24], nullptr, 64 * kb, Bt, D, 5632 + 32 * nb, 64 * kb, scr, lane); else zero_item(Bt, D, 5632 + 32 * nb, 64 * kb, lane); continue; }
        r -= I_UGX;
        if (r < 4 * I_DN) { const int q = r / I_DN; r -= q * I_DN; const int kb = r / 32, nb = r % 32;
            tr_item(a.in[5] + (size_t)q * FF * D, D, 64 * kb, 32 * nb, nullptr, nullptr, 0, (bf16_t*)(ws + W_DN) + (size_t)q * D * FF, FF, 32 * nb, 64 * kb, scr, lane); continue; }
        r -= 4 * I_DN;
        if (r < 4 * I_SQ) { const int q = r / I_SQ; r -= q * I_SQ; const int kb = r / 32, nb = r % 32;
            if (q == 0) { tr_item(a.in[7], D, 64 * kb, 32 * nb, nullptr, nullptr, 0, (bf16_t*)(ws + W_RL), 2048, 32 * nb, 64 * kb, scr, lane); zero_item((bf16_t*)(ws + W_RL), 2048, 32 * nb, 1024 + 64 * kb, lane); }
            else tr_item(a.in[7 + q], D, 64 * kb, 32 * nb, nullptr, nullptr, 0, (bf16_t*)(ws + W_R + (size_t)q * 2 * MiB), D, 32 * nb, 64 * kb, scr, lane);
            continue; }
        r -= 4 * I_SQ;
        if (r < I_LD) { const int kb = r / 8, nb = r % 8; const int kk0 = 64 * (kb & 15); const bool second = kb >= 16;
            const float* src; int ldw, nc, mi; if (nb < 2) { src = a.in[12]; ldw = 64; nc = 32 * nb; mi = 1; } else if (nb < 4) { src = a.in[15]; ldw = 64; nc = 32 * (nb - 2); mi = 4; } else { src = a.in[17]; ldw = 128; nc = 32 * (nb - 4); mi = 5; }
            tr_item(src, ldw, kk0, nc, second ? a.in[6] + mi * D : nullptr, second ? a.in[6] : nullptr, kk0, (bf16_t*)(ws + W_RL), 2048, 1024 + 32 * nb, 64 * kb, scr, lane); continue; }
        r -= I_LD;
        if (r < I_LU) { const int kb = r / 96, nb = r % 96; const int grp = nb / 32, nc = 32 * (nb % 32); bf16_t* Bt = (bf16_t*)(ws + W_LU);
            if (grp == 0) { if (kb == 0) tr_item(a.in[13], D, 0, nc, nullptr, nullptr, 0, Bt, 256, 32 * nb, 0, scr, lane); else zero_item(Bt, 256, 32 * nb, 64 * kb, lane); }
            else if (grp == 1) { if (kb == 1) tr_item(a.in[16], D, 0, nc, nullptr, nullptr, 0, Bt, 256, 32 * nb, 64, scr, lane); else zero_item(Bt, 256, 32 * nb, 64 * kb, lane); }
            else { if (kb >= 2) tr_item(a.in[18], D, 64 * (kb - 2), nc, nullptr, nullptr, 0, Bt, 256, 32 * nb, 64 * kb, scr, lane); else zero_item(Bt, 256, 32 * nb, 64 * kb, lane); }
            continue; }
        r -= I_LU;
        if (r < 2 * I_KN) { const int q = r / I_KN; r -= q * I_KN; const int kb = r / 32, nb = r % 32;
            const int n0 = 32 * nb, sc = (n0 >> 7) * 256 + (n0 & 127) + q * 128;
            tr_item(a.in[27], 2048, 64 * kb, sc, a.in[26], nullptr, 64 * kb, (bf16_t*)(ws + (q ? W_VT : W_KN)), 256, n0, 64 * kb, scr, lane); continue; }
        r -= 2 * I_KN;
        if (r < I_DQ) { const int kb = r / 16, nb = r % 16;
            tr_item(a.in[28], 512, 64 * kb, 32 * nb, norm_g + (1 * 3 + 1) * D, nullptr, 64 * kb, (bf16_t*)(ws + W_DQ), D, 32 * nb, 64 * kb, scr, lane); continue; }
        r -= I_DQ;
        if (r < I_UQ) { const int kb = r / 48, nb = r % 48; int sc;
            if (nb < 32) { const int n0 = 32 * nb; sc = (n0 >> 7) * 192 + (n0 & 127); }
            else { const int t2 = (nb - 32) >> 3, jj = (nb - 32) & 7, half = jj >> 2, hh = jj & 3; sc = (4 * t2 + hh) * 192 + 128 + 32 * half; }
            tr_item(a.in[30], 1536, 64 * kb, sc, a.in[29], nullptr, 64 * kb, (bf16_t*)(ws + W_UQ), 512, 32 * nb, 64 * kb, scr, lane); continue; }
        r -= I_UQ;
        { const int kb = r / 32, nb = r % 32; tr_item(a.in[31], D, 64 * kb, 32 * nb, nullptr, nullptr, 0, (bf16_t*)(ws + W_MO), D, 32 * nb, 64 * kb, scr, lane); }
    }
    const float* x = a.in[0]; bf16_t* hb = (bf16_t*)(ws + A_HB); float* slotsH = (float*)(ws + WS_SLOTH);
    for (int m = gw; m < T; m += NGW) {
        const f32x4* xr = (const f32x4*)(x + (size_t)m * D) + lane; float ss = 0.f;
#pragma unroll
        for (int j = 0; j < 4; ++j) { const f32x4 v = xr[64 * j]; ss += (v[0] * v[0] + v[1] * v[1]) + (v[2] * v[2] + v[3] * v[3]);
            u32x2 w; w.x = cvt_pk_bf16(v[0], v[1]); w.y = cvt_pk_bf16(v[2], v[3]); *((u32x2*)(hb + (size_t)m * D) + lane + 64 * j) = w; }
        ss = wave_sum(ss);
        if (lane < 16) slotsH[(size_t)m * 16 + lane] = lane == 0 ? ss : 0.f;
    }
    float* cosT = (float*)(ws + A_COS); float* sinT = (float*)(ws + A_SIN);
    for (int i = (F.vcu * 512 + tid); i < T * 32; i += F.G * 512) {
        const int tok = i >> 5, j = i & 31;
        const float inv = exp2f(-(float)j * (13.287712379549449f / 32.0f));
        const float ang = (float)a.pos[tok] * inv;
        const double rev = (double)ang * 0.15915494309189535; const float fr = (float)(rev - floor(rev));
        cosT[i] = __builtin_amdgcn_cosf(fr); sinT[i] = __builtin_amdgcn_sinf(fr);
    }
}

__device__ __forceinline__ void p_premix(const Ctx& F, const Args& a) {
    const float* h = a.out; const float* g = a.in[2] + 1 * D; const float* mix = a.in[6];
    bf16_t* X1 = (bf16_t*)(a.ws + A_X1); bf16_t* XK = (bf16_t*)(a.ws + A_XK); bf16_t* XV = (bf16_t*)(a.ws + A_XV);
    const int tid = fresh_tid(F.wave), lane = tid & 63, wave = __builtin_amdgcn_readfirstlane(tid >> 6);
    const int gw = F.vcu * 8 + wave, NGW = F.G * 8;
    for (int ch = gw; ch < T / 16; ch += NGW) {
        const int t0 = ch * 16;
        f32x4 prev[4], gv[4];
#pragma unroll
        for (int j = 0; j < 4; ++j) gv[j] = *((const f32x4*)g + lane + 64 * j);
        if ((t0 & (SEQ - 1)) == 0) {
#pragma unroll
            for (int j = 0; j < 4; ++j) prev[j] = (f32x4){0.f, 0.f, 0.f, 0.f};
        } else {
            float ss = 0.f;
#pragma unroll
            for (int j = 0; j < 4; ++j) { prev[j] = *((const f32x4*)(h + (size_t)(t0 - 1) * D) + lane + 64 * j); ss += (prev[j][0] * prev[j][0] + prev[j][1] * prev[j][1]) + (prev[j][2] * prev[j][2] + prev[j][3] * prev[j][3]); }
            const float rs = __builtin_amdgcn_rsqf(wave_sum(ss) * (1.0f / 1024.0f) + RMS_EPS);
#pragma unroll
            for (int j = 0; j < 4; ++j) prev[j] = prev[j] * rs * gv[j];
        }
        for (int t = t0; t < t0 + 16; ++t) {
            f32x4 cur[4]; float ss = 0.f;
#pragma unroll
            for (int j = 0; j < 4; ++j) { cur[j] = *((const f32x4*)(h + (size_t)t * D) + lane + 64 * j); ss += (cur[j][0] * cur[j][0] + cur[j][1] * cur[j][1]) + (cur[j][2] * cur[j][2] + cur[j][3] * cur[j][3]); }
            const float rs = __builtin_amdgcn_rsqf(wave_sum(ss) * (1.0f / 1024.0f) + RMS_EPS);
#pragma unroll
            for (int j = 0; j < 4; ++j) {
                const f32x4 hn = cur[j] * rs * gv[j]; const f32x4 xx = prev[j] - hn; prev[j] = hn;
                const f32x4 mr = *((const f32x4*)(mix + 0 * D) + lane + 64 * j), mk = *((const f32x4*)(mix + 2 * D) + lane + 64 * j), mv = *((const f32x4*)(mix + 3 * D) + lane + 64 * j);
                const f32x4 xr = hn + xx * mr, xk = hn + xx * mk, xv = hn + xx * mv;
                u32x2 w;
                w.x = cvt_pk_bf16(xr[0], xr[1]); w.y = cvt_pk_bf16(xr[2], xr[3]); *((u32x2*)(X1 + (size_t)t * 2048) + lane + 64 * j) = w;
                w.x = cvt_pk_bf16(xx[0], xx[1]); w.y = cvt_pk_bf16(xx[2], xx[3]); *((u32x2*)(X1 + (size_t)t * 2048 + 1024) + lane + 64 * j) = w;
                w.x = cvt_pk_bf16(xk[0], xk[1]); w.y = cvt_pk_bf16(xk[2], xk[3]); *((u32x2*)(XK + (size_t)t * D) + lane + 64 * j) = w;
                w.x = cvt_pk_bf16(xv[0], xv[1]); w.y = cvt_pk_bf16(xv[2], xv[3]); *((u32x2*)(XV + (size_t)t * D) + lane + 64 * j) = w;
            }
        }
    }
}

constexpr int TC = 32;
__device__ __forceinline__ void p_scan(const Ctx& F, const Args& a) {
    const bf16_t* Rb = (const bf16_t*)(a.ws + A_R); const bf16_t* Kb = (const bf16_t*)(a.ws + A_KK); const bf16_t* Vb = (const bf16_t*)(a.ws + A_VV);
    const bf16_t* Eb = (const bf16_t*)(a.ws + A_E); const bf16_t* Ab = (const bf16_t*)(a.ws + A_AA); bf16_t* Gb = (bf16_t*)(a.ws + A_G);
    const float* k_k = a.in[19]; const float* k_a = a.in[20]; const float* r_k = a.in[21]; const float* gn_w = a.in[22]; const float* gn_b = a.in[23];
    LAS float* sR = (LAS float*)(F.lds); LAS float* sW = sR + TC * 64; LAS float* sK = sW + TC * 64; LAS float* sV = sK + TC * 64;
    LAS float* sKK = sV + TC * 64; LAS float* sKA = sKK + TC * 64; LAS float* sY = sKA + TC * 64; LAS float* sBo = sY + TC * 64;
    const int tid = fresh_tid(F.wave), lane = tid & 63, wave = __builtin_amdgcn_readfirstlane(tid >> 6);
    const int irow = wave * 8 + (lane >> 3), kseg = (lane & 7) * 8;
    const int ptt = tid >> 4, pc = (tid & 15) * 4;
    for (int unit0 = F.vcu; unit0 < 2 * NB * 16; unit0 += F.G) {
        const int unit = unit0 & 127; const bool shadow = unit0 >= 128;
        const int b = unit >> 4, hd = unit & 15; const int cbase = hd * 64;
        float S[8];
#pragma unroll
        for (int j = 0; j < 8; ++j) S[j] = 0.f;
        const f32x4 kkv = *(const f32x4*)(k_k + cbase + pc), kav = *(const f32x4*)(k_a + cbase + pc), rkv = *(const f32x4*)(r_k + cbase + pc);
        const f32x4 gw = *(const f32x4*)(gn_w + cbase + pc), gb = *(const f32x4*)(gn_b + cbase + pc);
        for (int c0 = 0; c0 < SEQ; c0 += TC) {
            const size_t gidx = (size_t)(b * SEQ + c0 + ptt) * D + cbase + pc;
            {
                const f32x4 r = unpack4(*(const u32x2*)(Rb + gidx)), k = unpack4(*(const u32x2*)(Kb + gidx)), v = unpack4(*(const u32x2*)(Vb + gidx));
                const f32x4 e = unpack4(*(const u32x2*)(Eb + gidx)), aa = unpack4(*(const u32x2*)(Ab + gidx));
                f32x4 kk = k * kkv; float ss = (kk[0] * kk[0] + kk[1] * kk[1]) + (kk[2] * kk[2] + kk[3] * kk[3]); ss = red16(ss);
                kk = kk * __builtin_amdgcn_rsqf(fmaxf(ss, 1e-24f));
                const f32x4 kp = k * (1.0f + (aa - 1.0f) * kav);
                const f32x4 rk = r * kp * rkv; const float bo = red16((rk[0] + rk[1]) + (rk[2] + rk[3]));
                f32x4 w;
#pragma unroll
                for (int i = 0; i < 4; ++i) w[i] = __builtin_amdgcn_exp2f(-e[i] * LOG2E);
                const int o = ptt * 64 + pc;
                *(LAS f32x4*)(sR + o) = r; *(LAS f32x4*)(sW + o) = w; *(LAS f32x4*)(sK + o) = kp; *(LAS f32x4*)(sV + o) = v; *(LAS f32x4*)(sKK + o) = kk; *(LAS f32x4*)(sKA + o) = kk * aa;
                if ((tid & 15) == 0) sBo[ptt] = bo;
            }
            __syncthreads();
#pragma unroll 2
            for (int t = 0; t < TC; ++t) {
                const int o = t * 64 + kseg;
                const f32x4 kk0 = *(const LAS f32x4*)(sKK + o), kk1 = *(const LAS f32x4*)(sKK + o + 4);
                const f32x4 w0 = *(const LAS f32x4*)(sW + o), w1 = *(const LAS f32x4*)(sW + o + 4);
                const f32x4 ka0 = *(const LAS f32x4*)(sKA + o), ka1 = *(const LAS f32x4*)(sKA + o + 4);
                const f32x4 kp0 = *(const LAS f32x4*)(sK + o), kp1 = *(const LAS f32x4*)(sK + o + 4);
                const f32x4 r0 = *(const LAS f32x4*)(sR + o), r1 = *(const LAS f32x4*)(sR + o + 4);
                const float vv = sV[t * 64 + irow];
                float sa = ((S[0] * kk0[0] + S[1] * kk0[1]) + (S[2] * kk0[2] + S[3] * kk0[3])) + ((S[4] * kk1[0] + S[5] * kk1[1]) + (S[6] * kk1[2] + S[7] * kk1[3]));
                sa = red8(sa);
#pragma unroll
                for (int j = 0; j < 4; ++j) { S[j] = S[j] * w0[j] + (vv * kp0[j] - sa * ka0[j]); S[4 + j] = S[4 + j] * w1[j] + (vv * kp1[j] - sa * ka1[j]); }
                float y = ((S[0] * r0[0] + S[1] * r0[1]) + (S[2] * r0[2] + S[3] * r0[3])) + ((S[4] * r1[0] + S[5] * r1[1]) + (S[6] * r1[2] + S[7] * r1[3]));
                y = red8(y);
                if ((lane & 7) == 0) sY[t * 64 + irow] = y;
            }
            __syncthreads();
            {
                const int o = ptt * 64 + pc;
                const f32x4 y = *(const LAS f32x4*)(sY + o), v = *(const LAS f32x4*)(sV + o);
                const float mu = red16((y[0] + y[1]) + (y[2] + y[3])) * (1.0f / 64.0f);
                const f32x4 d = y - mu; const float var = red16((d[0] * d[0] + d[1] * d[1]) + (d[2] * d[2] + d[3] * d[3])) * (1.0f / 64.0f);
                const float rs = __builtin_amdgcn_rsqf(var + GN_EPS); const float bo = sBo[ptt];
                const f32x4 gg = unpack4(*(const u32x2*)(Gb + gidx));
                const f32x4 ov = (d * rs * gw + gb + v * bo) * gg;
                u32x2 w; w.x = cvt_pk_bf16(ov[0], ov[1]); w.y = cvt_pk_bf16(ov[2], ov[3]); if (!shadow) *(u32x2*)(Gb + gidx) = w;
            }
            __syncthreads();
        }
    }
}

constexpr int KROW = 400, VROW = 144, KBUF = 64 * KROW, VBUF = 128 * VROW, ABUF = KBUF + VBUF;
__device__ __forceinline__ void attn_unit(LAS unsigned char* lds, const bf16_t* qn, const bf16_t* qr, const bf16_t* kn, const bf16_t* kr, const bf16_t* vt, bf16_t* o_out, int b, int h, int qb, int wave_s) {
    const int tid = fresh_tid(wave_s), lane = tid & 63, wid = __builtin_amdgcn_readfirstlane(tid >> 6), r32 = lane & 31, hi = lane >> 5;
    const int tok0 = b * SEQ, q0 = qb * 256 + wid * 32;
    bf16x8 qf[12];
    { const size_t tq = (size_t)(tok0 + q0 + r32);
#pragma unroll
      for (int d = 0; d < 8; ++d) qf[d] = *(const bf16x8*)(qn + tq * D + h * 128 + d * 16 + hi * 8);
#pragma unroll
      for (int d = 0; d < 4; ++d) qf[8 + d] = *(const bf16x8*)(qr + tq * 512 + h * 64 + d * 16 + hi * 8); }
    const int NT = (qb + 1) * 4;
    const int kkey0 = tid >> 4, kch0 = tid & 15;
    const int rkey = tid >> 3, rch = tid & 7;
    const int vrow0 = tid >> 3, vch = tid & 7;
    const bf16_t* gk0 = kn + (size_t)(tok0 + kkey0) * D + h * 128 + kch0 * 8;
    const bf16_t* gk1 = gk0 + (size_t)32 * D;
    const bf16_t* gr = kr + (size_t)(tok0 + rkey) * 64 + rch * 8;
    const bf16_t* gv0 = vt + (size_t)(h * 128 + vrow0) * T + tok0 + vch * 8;
    const bf16_t* gv1 = gv0 + (size_t)64 * T;
    const int lk0 = kkey0 * KROW + kch0 * 16, lk1 = lk0 + 32 * KROW, lr = rkey * KROW + 256 + rch * 16, lv0 = KBUF + vrow0 * VROW + vch * 16, lv1 = lv0 + 64 * VROW;
    const int pr = (r32 & 0x13) | ((r32 & 4) << 1) | ((r32 & 8) >> 1);
    const int kfo = pr * KROW + hi * 16, vfo = KBUF + r32 * VROW + hi * 16;
    u32x4 ld0, ld1, ld2, ld3, ld4;
    ld0 = *(const u32x4*)gk0; ld1 = *(const u32x4*)gk1; ld2 = *(const u32x4*)gr; ld3 = *(const u32x4*)gv0; ld4 = *(const u32x4*)gv1;
    __syncthreads();
    *(LAS u32x4*)(lds + lk0) = ld0; *(LAS u32x4*)(lds + lk1) = ld1; *(LAS u32x4*)(lds + lr) = ld2; *(LAS u32x4*)(lds + lv0) = ld3; *(LAS u32x4*)(lds + lv1) = ld4;
    __syncthreads();
    float mrun = -1e30f, lrun = 0.f;
    f32x16 o[4];
#pragma unroll
    for (int d = 0; d < 4; ++d) o[d] = f32x16{};
    for (int t = 0; t < NT; ++t) {
        const int cb = (t & 1) * ABUF, nb = ((t + 1) & 1) * ABUF;
        const bool more = (t + 1 < NT);
        if (more) { const size_t ko = (size_t)(t + 1) * 64 * D, ro = (size_t)(t + 1) * 64 * 64, vo = (size_t)(t + 1) * 64;
            ld0 = *(const u32x4*)(gk0 + ko); ld1 = *(const u32x4*)(gk1 + ko); ld2 = *(const u32x4*)(gr + ro); ld3 = *(const u32x4*)(gv0 + vo); ld4 = *(const u32x4*)(gv1 + vo); }
        if (64 * t <= q0 + 31) {
            f32x16 s0 = f32x16{}, s1 = f32x16{};
#pragma unroll
            for (int d = 0; d < 12; ++d) {
                const bf16x8 k0 = *(const LAS bf16x8*)(lds + cb + kfo + d * 32), k1 = *(const LAS bf16x8*)(lds + cb + kfo + 32 * KROW + d * 32);
                s0 = __builtin_amdgcn_mfma_f32_32x32x16_bf16(k0, qf[d], s0, 0, 0, 0);
                s1 = __builtin_amdgcn_mfma_f32_32x32x16_bf16(k1, qf[d], s1, 0, 0, 0);
            }
            if (64 * t + 63 > q0) {
                const int qi = q0 + r32, kb0 = 64 * t + 8 * hi;
#pragma unroll
                for (int r = 0; r < 16; ++r) { const int key = kb0 + 16 * (r >> 3) + (r & 7); if (key > qi) s0[r] = -1e30f; if (key + 32 > qi) s1[r] = -1e30f; }
            }
            float mx = fmaxf(s0[0], s1[0]);
#pragma unroll
            for (int r = 1; r < 16; ++r) mx = fmaxf(mx, fmaxf(s0[r], s1[r]));
            mx = fmaxf(mx, __shfl_xor(mx, 32));
            const float mnew = fmaxf(mrun, mx); const float alpha = __builtin_amdgcn_exp2f(mrun - mnew); mrun = mnew;
            float ps = 0.f;
#pragma unroll
            for (int r = 0; r < 16; ++r) { s0[r] = __builtin_amdgcn_exp2f(s0[r] - mnew); s1[r] = __builtin_amdgcn_exp2f(s1[r] - mnew); ps += s0[r] + s1[r]; }
            lrun = lrun * alpha + ps;
#pragma unroll
            for (int d = 0; d < 4; ++d) o[d] = o[d] * alpha;
            bf16x8 pf[4];
            { u32x4 w;
              w.x = cvt_pk_bf16(s0[0], s0[1]); w.y = cvt_pk_bf16(s0[2], s0[3]); w.z = cvt_pk_bf16(s0[4], s0[5]); w.w = cvt_pk_bf16(s0[6], s0[7]); pf[0] = __builtin_bit_cast(bf16x8, w);
              w.x = cvt_pk_bf16(s0[8], s0[9]); w.y = cvt_pk_bf16(s0[10], s0[11]); w.z = cvt_pk_bf16(s0[12], s0[13]); w.w = cvt_pk_bf16(s0[14], s0[15]); pf[1] = __builtin_bit_cast(bf16x8, w);
              w.x = cvt_pk_bf16(s1[0], s1[1]); w.y = cvt_pk_bf16(s1[2], s1[3]); w.z = cvt_pk_bf16(s1[4], s1[5]); w.w = cvt_pk_bf16(s1[6], s1[7]); pf[2] = __builtin_bit_cast(bf16x8, w);
              w.x = cvt_pk_bf16(s1[8], s1[9]); w.y = cvt_pk_bf16(s1[10], s1[11]); w.z = cvt_pk_bf16(s1[12], s1[13]); w.w = cvt_pk_bf16(s1[14], s1[15]); pf[3] = __builtin_bit_cast(bf16x8, w); }
#pragma unroll
            for (int d = 0; d < 4; ++d)
#pragma unroll
                for (int ks = 0; ks < 4; ++ks) {
                    const bf16x8 vf = *(const LAS bf16x8*)(lds + cb + vfo + d * 32 * VROW + ks * 32);
                    o[d] = __builtin_amdgcn_mfma_f32_32x32x16_bf16(vf, pf[ks], o[d], 0, 0, 0);
                }
        }
        if (more) { *(LAS u32x4*)(lds + nb + lk0) = ld0; *(LAS u32x4*)(lds + nb + lk1) = ld1; *(LAS u32x4*)(lds + nb + lr) = ld2; *(LAS u32x4*)(lds + nb + lv0) = ld3; *(LAS u32x4*)(lds + nb + lv1) = ld4; }
        __syncthreads();
    }
    lrun += __shfl_xor(lrun, 32);
    const float rl = __builtin_amdgcn_rcpf(lrun);
    bf16_t* op = o_out + (size_t)(tok0 + q0 + r32) * D + h * 128 + 4 * hi;
#pragma unroll
    for (int d = 0; d < 4; ++d)
#pragma unroll
        for (int r4 = 0; r4 < 4; ++r4) { u32x2 w; w.x = cvt_pk_bf16(o[d][4 * r4] * rl, o[d][4 * r4 + 1] * rl); w.y = cvt_pk_bf16(o[d][4 * r4 + 2] * rl, o[d][4 * r4 + 3] * rl);
            *(u32x2*)(op + 32 * d + 8 * r4) = w; }
}
__device__ __forceinline__ void p_attn(const Ctx& F, const Args& a) {
    const bf16_t* qn = (const bf16_t*)(a.ws + A_QN); const bf16_t* qr = (const bf16_t*)(a.ws + A_QR);
    const bf16_t* kn = (const bf16_t*)(a.ws + A_KN); const bf16_t* kr = (const bf16_t*)(a.ws + A_KR); const bf16_t* vt = (const bf16_t*)(a.ws + A_VT);
    bf16_t* oo = (bf16_t*)(a.ws + A_QN);
    for (int p = F.vcu; p < 512; p += F.G) {
        const int bh = p >> 3, s = p & 7;
        attn_unit(F.lds, qn, qr, kn, kr, vt, oo, bh >> 3, bh & 7, 15 - s, F.wave);
        attn_unit(F.lds, qn, qr, kn, kr, vt, oo, bh >> 3, bh & 7, s, F.wave);
    }
}

__device__ __forceinline__ void p_final(const Ctx& F, const Args& a) {
    float* h = a.out; const float* g = a.in[32];
    const int tid = fresh_tid(F.wave), lane = tid & 63, wave = __builtin_amdgcn_readfirstlane(tid >> 6);
    const int gw = F.vcu * 8 + wave, NGW = F.G * 8;
    f32x4 gv[4];
#pragma unroll
    for (int j = 0; j < 4; ++j) gv[j] = *((const f32x4*)g + lane + 64 * j);
    for (int m = gw; m < T; m += NGW) {
        f32x4 v[4]; float ss = 0.f;
#pragma unroll
        for (int j = 0; j < 4; ++j) { v[j] = *((const f32x4*)(h + (size_t)m * D) + lane + 64 * j); ss += (v[j][0] * v[j][0] + v[j][1] * v[j][1]) + (v[j][2] * v[j][2] + v[j][3] * v[j][3]); }
        const float rs = __builtin_amdgcn_rsqf(wave_sum(ss) * (1.0f / 1024.0f) + RMS_EPS);
#pragma unroll
        for (int j = 0; j < 4; ++j) *((f32x4*)(h + (size_t)m * D) + lane + 64 * j) = v[j] * rs * gv[j];
    }
}

__device__ __forceinline__ void my_grid_sync(unsigned* cnt, unsigned G, int wave_s) {
    asm volatile("s_waitcnt vmcnt(0) lgkmcnt(0)" ::: "memory");
    __syncthreads();
    if (fresh_tid(wave_s) == 0) {
        __builtin_amdgcn_fence(__ATOMIC_RELEASE, "agent");
        asm volatile("s_waitcnt vmcnt(0)" ::: "memory");
        __hip_atomic_fetch_add(cnt, 1u, __ATOMIC_RELAXED, __HIP_MEMORY_SCOPE_AGENT);
        while (__hip_atomic_load(cnt, __ATOMIC_RELAXED, __HIP_MEMORY_SCOPE_AGENT) < G) __builtin_amdgcn_s_sleep(4);
        __builtin_amdgcn_fence(__ATOMIC_ACQUIRE, "agent");
        asm volatile("s_waitcnt vmcnt(0)" ::: "memory");
    }
    __syncthreads();
}
#define GSYNC() do { my_grid_sync(bar_words + 64 * bar_idx, (unsigned)F.G, F.wave); ++bar_idx; } while (0)
#define RUN_GEMM(EPI_T, epi, Aptr, lda_, Bptr, ldb_, M_, N_, K_) do { pg8::Gemm g_{(const bf16_t*)(Aptr), (lda_), (const bf16_t*)(Bptr), (ldb_), (M_), (N_), (K_)}; \
    pg8::StaticOrder S_; S_.init((M_), (N_), F.G, (int)blockIdx.x); pg8::gemm_phase<EPI_T>(F.lds, g_, S_, (epi), F.wave); } while (0)

__global__ void __launch_bounds__(512, 2) fwd_mega(Args a) {
    extern __shared__ __attribute__((aligned(16))) unsigned char lds_raw[];
    cg::grid_group grid = cg::this_grid();
    Ctx F; F.lds = (LAS unsigned char*)lds_raw; F.wave = __builtin_amdgcn_readfirstlane((int)threadIdx.x >> 6);
    F.G = gridDim.x; { const int bx = blockIdx.x; F.vcu = (F.G % 8 == 0) ? (bx % 8) * (F.G / 8) + bx / 8 : bx; }
    unsigned char* ws = a.ws;
    float* slotsH = (float*)(ws + WS_SLOTH); float* slotsC = (float*)(ws + WS_SLOTC); float* slotsQ = (float*)(ws + WS_SLOTQ);
    bf16_t* HB = (bf16_t*)(ws + A_HB); bf16_t* MID = (bf16_t*)(ws + A_MID);
    const float* cosT = (const float*)(ws + A_COS); const float* sinT = (const float*)(ws + A_SIN);
    bf16_t* WUG = (bf16_t*)(ws + W_UG); bf16_t* WDN = (bf16_t*)(ws + W_DN);

    unsigned* bar_words = (unsigned*)ws;
    if (a.ph_hi - a.ph_lo > 1) grid.sync();
    if (a.ph_lo <= 0 && 0 < a.ph_hi) {
    p0_prologue(F, a);
    }
    if (a.ph_lo <= 0 && 1 < a.ph_hi) my_grid_sync(bar_words + 64 * 0, (unsigned)F.G, F.wave);
    if (a.ph_lo <= 1 && 1 < a.ph_hi) {
    { EpiSwiglu E{MID, slotsH, nullptr, nullptr, nullptr, nullptr, nullptr}; RUN_GEMM(EpiSwiglu, E, HB, D, WUG, D, T, 5632, D); }
    }
    if (a.ph_lo <= 1 && 2 < a.ph_hi) my_grid_sync(bar_words + 64 * 1, (unsigned)F.G, F.wave);
    if (a.ph_lo <= 2 && 2 < a.ph_hi) {
    { EpiResid E{a.in[0], a.out, nullptr, nullptr, 0.5f}; RUN_GEMM(EpiResid, E, MID, FF, WDN, FF, T, D, FF); }
    }
    if (a.ph_lo <= 2 && 3 < a.ph_hi) my_grid_sync(bar_words + 64 * 2, (unsigned)F.G, F.wave);
    if (a.ph_lo <= 3 && 3 < a.ph_hi) {
    p_premix(F, a);
    }
    if (a.ph_lo <= 3 && 4 < a.ph_hi) my_grid_sync(bar_words + 64 * 3, (unsigned)F.G, F.wave);
    if (a.ph_lo <= 4 && 4 < a.ph_hi) {
    { EpiRL E{(bf16_t*)(ws + A_R), (bf16_t*)(ws + A_LM)}; RUN_GEMM(EpiRL, E, ws + A_X1, 2048, ws + W_RL, 2048, T, 1280, 2048); }
    }
    if (a.ph_lo <= 4 && 5 < a.ph_hi) my_grid_sync(bar_words + 64 * 4, (unsigned)F.G, F.wave);
    if (a.ph_lo <= 5 && 5 < a.ph_hi) {
    }
    if (a.ph_lo <= 5 && 6 < a.ph_hi) my_grid_sync(bar_words + 64 * 5, (unsigned)F.G, F.wave);
    if (a.ph_lo <= 6 && 6 < a.ph_hi) {
    { EpiBf16 E{(bf16_t*)(ws + A_KK), D}; RUN_GEMM(EpiBf16, E, ws + A_XK, D, ws + W_K, D, T, D, D); }
    }
    if (a.ph_lo <= 6 && 7 < a.ph_hi) my_grid_sync(bar_words + 64 * 6, (unsigned)F.G, F.wave);
    if (a.ph_lo <= 7 && 7 < a.ph_hi) {
    { EpiBf16 E{(bf16_t*)(ws + A_VV), D}; RUN_GEMM(EpiBf16, E, ws + A_XV, D, ws + W_V, D, T, D, D); }
    }
    if (a.ph_lo <= 7 && 8 < a.ph_hi) my_grid_sync(bar_words + 64 * 7, (unsigned)F.G, F.wave);
    if (a.ph_lo <= 8 && 8 < a.ph_hi) {
    { EpiLoraUp E{ws, a.in[11], a.in[14]}; RUN_GEMM(EpiLoraUp, E, ws + A_LM, 256, ws + W_LU, 256, T, 3072, 256); }
    }
    if (a.ph_lo <= 8 && 9 < a.ph_hi) my_grid_sync(bar_words + 64 * 8, (unsigned)F.G, F.wave);
    if (a.ph_lo <= 9 && 9 < a.ph_hi) {
    p_scan(F, a);
    }
    if (a.ph_lo <= 9 && 10 < a.ph_hi) my_grid_sync(bar_words + 64 * 9, (unsigned)F.G, F.wave);
    if (a.ph_lo <= 10 && 10 < a.ph_hi) {
    { EpiResid E{a.out, a.out, HB, slotsH, 1.0f}; RUN_GEMM(EpiResid, E, ws + A_G, D, ws + W_O, D, T, D, D); }
    }
    if (a.ph_lo <= 10 && 11 < a.ph_hi) my_grid_sync(bar_words + 64 * 10, (unsigned)F.G, F.wave);
    if (a.ph_lo <= 11 && 11 < a.ph_hi) {
    { EpiSwiglu E{MID, slotsH, nullptr, nullptr, nullptr, nullptr, nullptr}; RUN_GEMM(EpiSwiglu, E, HB, D, WUG + (size_t)1 * 6144 * D, D, T, 5632, D); }
    }
    if (a.ph_lo <= 11 && 12 < a.ph_hi) my_grid_sync(bar_words + 64 * 11, (unsigned)F.G, F.wave);
    if (a.ph_lo <= 12 && 12 < a.ph_hi) {
    { EpiResid E{a.out, a.out, HB, slotsH, 0.5f}; RUN_GEMM(EpiResid, E, MID, FF, WDN + (size_t)1 * D * FF, FF, T, D, FF); }
    }
    if (a.ph_lo <= 12 && 13 < a.ph_hi) my_grid_sync(bar_words + 64 * 12, (unsigned)F.G, F.wave);
    if (a.ph_lo <= 13 && 13 < a.ph_hi) {
    { EpiSwiglu E{MID, slotsH, (bf16_t*)(ws + A_C), slotsC, (bf16_t*)(ws + A_KR), cosT, sinT}; RUN_GEMM(EpiSwiglu, E, HB, D, WUG + (size_t)2 * 6144 * D, D, T, 6144, D); }
    }
    if (a.ph_lo <= 13 && 14 < a.ph_hi) my_grid_sync(bar_words + 64 * 13, (unsigned)F.G, F.wave);
    if (a.ph_lo <= 14 && 14 < a.ph_hi) {
    { EpiResid E{a.out, a.out, HB, slotsH, 0.5f}; RUN_GEMM(EpiResid, E, MID, FF, WDN + (size_t)2 * D * FF, FF, T, D, FF); }
    }
    if (a.ph_lo <= 14 && 15 < a.ph_hi) my_grid_sync(bar_words + 64 * 14, (unsigned)F.G, F.wave);
    if (a.ph_lo <= 15 && 15 < a.ph_hi) {
    { EpiKnope E{(bf16_t*)(ws + A_KN), slotsC}; RUN_GEMM(EpiKnope, E, ws + A_C, 256, ws + W_KN, 256, T, D, 256); }
    }
    if (a.ph_lo <= 15 && 16 < a.ph_hi) my_grid_sync(bar_words + 64 * 15, (unsigned)F.G, F.wave);
    if (a.ph_lo <= 16 && 16 < a.ph_hi) {
    { EpiVt E{(bf16_t*)(ws + A_VT), slotsC}; RUN_GEMM(EpiVt, E, ws + W_VT, 256, ws + A_C, 256, D, T, 256); }
    }
    if (a.ph_lo <= 16 && 17 < a.ph_hi) my_grid_sync(bar_words + 64 * 16, (unsigned)F.G, F.wave);
    if (a.ph_lo <= 17 && 17 < a.ph_hi) {
    { EpiQlat E{(bf16_t*)(ws + A_QLAT), slotsH, slotsQ}; RUN_GEMM(EpiQlat, E, HB, D, ws + W_DQ, D, T, 512, D); }
    }
    if (a.ph_lo <= 17 && 18 < a.ph_hi) my_grid_sync(bar_words + 64 * 17, (unsigned)F.G, F.wave);
    if (a.ph_lo <= 18 && 18 < a.ph_hi) {
    { EpiQ E{(bf16_t*)(ws + A_QN), (bf16_t*)(ws + A_QR), slotsQ, cosT, sinT}; RUN_GEMM(EpiQ, E, ws + A_QLAT, 512, ws + W_UQ, 512, T, 1536, 512); }
    }
    if (a.ph_lo <= 18 && 19 < a.ph_hi) my_grid_sync(bar_words + 64 * 18, (unsigned)F.G, F.wave);
    if (a.ph_lo <= 19 && 19 < a.ph_hi) {
    p_attn(F, a);
    }
    if (a.ph_lo <= 19 && 20 < a.ph_hi) my_grid_sync(bar_words + 64 * 19, (unsigned)F.G, F.wave);
    if (a.ph_lo <= 20 && 20 < a.ph_hi) {
    { EpiResid E{a.out, a.out, HB, slotsH, 1.0f}; RUN_GEMM(EpiResid, E, ws + A_QN, D, ws + W_MO, D, T, D, D); }
    }
    if (a.ph_lo <= 20 && 21 < a.ph_hi) my_grid_sync(bar_words + 64 * 20, (unsigned)F.G, F.wave);
    if (a.ph_lo <= 21 && 21 < a.ph_hi) {
    { EpiSwiglu E{MID, slotsH, nullptr, nullptr, nullptr, nullptr, nullptr}; RUN_GEMM(EpiSwiglu, E, HB, D, WUG + (size_t)3 * 6144 * D, D, T, 5632, D); }
    }
    if (a.ph_lo <= 21 && 22 < a.ph_hi) my_grid_sync(bar_words + 64 * 21, (unsigned)F.G, F.wave);
    if (a.ph_lo <= 22 && 22 < a.ph_hi) {
    { EpiResid E{a.out, a.out, nullptr, nullptr, 0.5f}; RUN_GEMM(EpiResid, E, MID, FF, WDN + (size_t)3 * D * FF, FF, T, D, FF); }
    }
    if (a.ph_lo <= 22 && 23 < a.ph_hi) my_grid_sync(bar_words + 64 * 22, (unsigned)F.G, F.wave);
    if (a.ph_lo <= 23 && 23 < a.ph_hi) {
    p_final(F, a);
    }
}

extern "C" void kernel_launch(void* const* d_in, const int* in_sizes, int n_in, void* d_out, int out_size, void* d_ws, size_t ws_size, hipStream_t stream) {
    static int grid = 0;
    if (grid == 0) {
        if (n_in != 33 || out_size != T * D || ws_size < WS_NEED) { fprintf(stderr, "kernel_launch: unexpected shapes: n_in %d out %d ws %zu (need %zu)\n", n_in, out_size, ws_size, (size_t)WS_NEED); grid = -1; return; }
        int dev = 0, cus = 0, per_cu = 0;
        (void)hipGetDevice(&dev); (void)hipDeviceGetAttribute(&cus, hipDeviceAttributeMultiprocessorCount, dev);
        (void)hipFuncSetAttribute((const void*)fwd_mega, hipFuncAttributeMaxDynamicSharedMemorySize, LDS_BYTES);
        (void)hipOccupancyMaxActiveBlocksPerMultiprocessor(&per_cu, (const void*)fwd_mega, 512, LDS_BYTES);
        (void)hipGetLastError();
        grid = cus > 0 ? cus : 256;
        if (grid > 256) grid = 256;
    }
    if (grid < 0) return;
    (void)hipMemsetAsync(d_ws, 0, 65536, stream);
    Args a{};
    for (int i = 0; i < 33; ++i) a.in[i] = (const float*)d_in[i];
    a.pos = (const int*)d_in[1]; a.out = (float*)d_out; a.ws = (unsigned char*)d_ws;
    hipError_t e = hipSuccess;
#if N_LAUNCHES == 1
    a.ph_lo = 0; a.ph_hi = NPHASES;
    { void* args[] = {&a}; e = hipLaunchCooperativeKernel((void*)fwd_mega, dim3(grid), dim3(512), args, LDS_BYTES, stream); }
#else
    for (int p = 0; p < NPHASES; ++p) { a.ph_lo = p; a.ph_hi = p + 1; hipLaunchKernelGGL(fwd_mega, dim3(grid), dim3(512), LDS_BYTES, stream, a); }
    e = hipPeekAtLastError();
#endif
    if (e != hipSuccess) fprintf(stderr, "cooperative launch failed: %s (grid %d)\n", hipGetErrorString(e), grid);
}
```

```cpp
#include <hip/hip_runtime.h>
#include <hip/hip_cooperative_groups.h>
#include <cstdio>
#include <cstdint>
namespace cg = cooperative_groups;

#define LAS __attribute__((address_space(3)))
typedef unsigned short bf16_t;
typedef short bf16x8 __attribute__((ext_vector_type(8)));
typedef float f32x4 __attribute__((ext_vector_type(4)));
typedef float f32x16 __attribute__((ext_vector_type(16)));
typedef unsigned u32x4 __attribute__((ext_vector_type(4)));
typedef unsigned u32x2 __attribute__((ext_vector_type(2)));

constexpr int T = 32768, D = 1024, FF = 2816, SEQ = 4096, NB = 8;
constexpr float RMS_EPS = 1e-6f, GN_EPS = 64e-5f;
constexpr float LOG2E = 1.4426950408889634f;
constexpr float QSCALE = 0.07216878364870322f * 1.4426950408889634f;

constexpr size_t MiB = 1u << 20;
constexpr size_t WS_SLOTH = MiB / 2;
constexpr size_t WS_SLOTC = WS_SLOTH + 2 * MiB;
constexpr size_t WS_SLOTQ = WS_SLOTC + MiB / 2;
constexpr size_t WS_W = 4 * MiB;
constexpr size_t W_UG = WS_W;
constexpr size_t W_DN = W_UG + 48 * MiB;
constexpr size_t W_R = W_DN + 22 * MiB;
constexpr size_t W_K = W_R + 2 * MiB;
constexpr size_t W_V = W_K + 2 * MiB;
constexpr size_t W_O = W_V + 2 * MiB;
constexpr size_t W_LD = W_O + 2 * MiB;
constexpr size_t W_LU = W_LD + 1 * MiB;
constexpr size_t W_KN = W_LU + 2 * MiB;
constexpr size_t W_VT = W_KN + MiB / 2;
constexpr size_t W_DQ = W_VT + MiB / 2;
constexpr size_t W_UQ = W_DQ + 1 * MiB;
constexpr size_t W_MO = W_UQ + 2 * MiB;
constexpr size_t W_END = W_MO + 2 * MiB;
constexpr size_t WS_A = 92 * MiB;
static_assert(W_END <= WS_A, "weights region");
constexpr size_t A_HB = WS_A + 0;
constexpr size_t A_MID = WS_A + 64 * MiB;
constexpr size_t A_C = WS_A + 240 * MiB;
constexpr size_t A_KR = WS_A + 256 * MiB;
constexpr size_t A_KN = WS_A + 260 * MiB;
constexpr size_t A_VT = WS_A + 324 * MiB;
constexpr size_t A_QLAT = A_MID;
constexpr size_t A_QN = A_MID + 32 * MiB;
constexpr size_t A_QR = A_MID + 96 * MiB;
constexpr size_t A_X1 = WS_A + 0;
constexpr size_t A_XK = WS_A + 128 * MiB;
constexpr size_t A_XV = WS_A + 192 * MiB;
constexpr size_t A_R = WS_A + 256 * MiB;
constexpr size_t A_LM = WS_A + 320 * MiB;
constexpr size_t A_KK = WS_A + 0;
constexpr size_t A_VV = WS_A + 64 * MiB;
constexpr size_t A_E = WS_A + 128 * MiB;
constexpr size_t A_AA = WS_A + 192 * MiB;
constexpr size_t A_G = WS_A + 336 * MiB;
constexpr size_t A_BON = WS_A + 400 * MiB;
constexpr size_t A_COS = WS_A + 404 * MiB;
constexpr size_t A_SIN = WS_A + 408 * MiB;
constexpr size_t W_RL = WS_A + 412 * MiB;
constexpr size_t WS_NEED = 512 * MiB;

constexpr int LDS_BYTES = 147456;
constexpr int NPHASES = 25;
#ifndef N_LAUNCHES
#define N_LAUNCHES 1
#endif

__device__ __forceinline__ unsigned cvt_pk_bf16(float lo, float hi) { unsigned r; asm volatile("v_cvt_pk_bf16_f32 %0, %1, %2" : "=v"(r) : "v"(lo), "v"(hi)); return r; }
__device__ __forceinline__ float fsigmoid(float x) { return __builtin_amdgcn_rcpf(1.0f + __builtin_amdgcn_exp2f(-x * LOG2E)); }
__device__ __forceinline__ float ftanh(float x) { return 1.0f - 2.0f * __builtin_amdgcn_rcpf(1.0f + __builtin_amdgcn_exp2f(2.0f * LOG2E * x)); }
__device__ __forceinline__ float wave_sum(float v) {
#pragma unroll
    for (int o = 1; o < 64; o <<= 1) v += __shfl_xor(v, o);
    return v;
}
template <int CTRL> __device__ __forceinline__ float dpp_mov(float x) { return __builtin_bit_cast(float, __builtin_amdgcn_update_dpp(0, __builtin_bit_cast(int, x), CTRL, 0xf, 0xf, true)); }
__device__ __forceinline__ float red8(float x) { x += dpp_mov<0xB1>(x); x += dpp_mov<0x4E>(x); x += dpp_mov<0x141>(x); return x; }
__device__ __forceinline__ float red16(float x) { x = red8(x); x += dpp_mov<0x140>(x); return x; }
__device__ __forceinline__ float sum4(f32x4 v) { return (v[0] + v[1]) + (v[2] + v[3]); }
__device__ __forceinline__ float rstd_slots16(const float* s, int row) {
    const f32x4* p = (const f32x4*)(s + (size_t)row * 16);
    const f32x4 a = p[0], b = p[1], c = p[2], d = p[3];
    return __builtin_amdgcn_rsqf((sum4(a) + sum4(b) + sum4(c) + sum4(d)) * (1.0f / 1024.0f) + RMS_EPS);
}
__device__ __forceinline__ f32x4 unpack4(u32x2 p) { f32x4 r; r[0] = __uint_as_float(p.x << 16); r[1] = __uint_as_float(p.x & 0xffff0000u); r[2] = __uint_as_float(p.y << 16); r[3] = __uint_as_float(p.y & 0xffff0000u); return r; }

__device__ __forceinline__ int fresh_tid(int wave_s) { int l; asm volatile("v_mbcnt_lo_u32_b32 %0, -1, 0\n\tv_mbcnt_hi_u32_b32 %0, -1, %0" : "=v"(l)); return wave_s * 64 + l; }

namespace pg8 {
constexpr int BM = 256, BK = 64, HALF = 128, HTB = HALF * BK * 2, STAGE_BYTES = 8 * HTB, NXCD = 8, WGM = 8;
__device__ __forceinline__ int lds_byte(int r, int c) { const int st = (r >> 4) * 2 + (c >> 5), rr = r & 15, cc = c & 31, ob = rr * 64 + cc * 2; return st * 1024 + (ob ^ (((ob >> 9) & 1) << 5)); }
__device__ __forceinline__ void stage_rc(int b, int& R, int& C) { const int st = b / 1024, sb = b % 1024, swz = sb ^ (((sb >> 9) & 1) << 5); R = (st >> 1) * 16 + swz / 64; C = (st & 1) * 32 + (swz % 64) / 2; }
__device__ __forceinline__ int perm32(int rho) { const int n = rho >> 4, i = rho & 15; return 8 * (i >> 2) + 4 * n + (i & 3); }
struct Unit { int pm, pn; };
struct Gemm { const bf16_t* A; int lda; const bf16_t* Bt; int ldb; int M, N, K; };
struct StaticOrder {
    int nM, nN, nwg, G, c;
    __device__ void init(int M, int N, int G_, int c_) { nM = M / BM; nN = N / BM; nwg = nM * nN; G = G_; c = c_; }
    __device__ bool next(int i, Unit& u) const {
        const long L = (long)i * G + c; if (L >= nwg) return false;
        int wgid = (int)L; { const int q = nwg / NXCD, r = nwg % NXCD, xcd = wgid % NXCD, off = wgid / NXCD; wgid = (xcd < r ? xcd * (q + 1) : r * (q + 1) + (xcd - r) * q) + off; }
        const int nig = WGM * nN, gid = wgid / nig, fm = gid * WGM, gsz = (nM - fm) < WGM ? (nM - fm) : WGM;
        u.pm = fm + ((wgid % nig) % gsz); u.pn = (wgid % nig) / gsz; return true;
    }
};

template <class Epi>
__device__ __forceinline__ void gemm_phase(LAS unsigned char* lds, const Gemm g, const StaticOrder& S, const Epi& E, int wave_s) {
    const int tid = fresh_tid(wave_s), wid = __builtin_amdgcn_readfirstlane(tid >> 6), lane = tid & 63, wr = wid >> 2, wc = wid & 3, fr = lane & 15, fq = lane >> 4;
    const int K = g.K, nt = K / BK;
    unsigned voffA[2], voffB[2];
#pragma unroll
    for (int i = 0; i < 2; ++i) { int R, C; stage_rc(tid * 16 + i * 8192, R, C); const int Rb = Epi::PERM ? ((R & ~31) + perm32(R & 31)) : R;
        voffA[i] = (unsigned)(R * g.lda + C) * 2u; voffB[i] = (unsigned)(Rb * g.ldb + C) * 2u; }
    const size_t kstep = (size_t)(BK * 2);
    const size_t hstepA = (size_t)HALF * g.lda * 2, hstepB = (size_t)HALF * g.ldb * 2;
    const size_t tstepA = 2 * hstepA, tstepB = 2 * hstepB;
    const unsigned ldsw = (unsigned)wid * 1024u;
    const int aoff = lds_byte(wr * 64 + fr, fq * 8), boff = lds_byte(wc * 32 + fr, fq * 8);
#define PG8_SA(b, h) (((b) * 2 + (h)) * HTB)
#define PG8_SB(b, h) ((4 + (b) * 2 + (h)) * HTB)
#define PG8_STAGE(bufoff, gbase, voff) do { _Pragma("unroll") for (int _i = 0; _i < 2; ++_i) \
        __builtin_amdgcn_global_load_lds((const unsigned*)((const char*)(gbase) + (voff)[_i]), (LAS unsigned*)(lds + (bufoff) + ldsw + _i * 8192), 16, 0, 0); } while (0)
#define PG8_LDA(dst, b, h) do { _Pragma("unroll") for (int m = 0; m < 4; ++m) _Pragma("unroll") for (int k = 0; k < 2; ++k) dst[m][k] = *(const LAS bf16x8*)(lds + PG8_SA(b, h) + aoff + m * 2048 + k * 1024); } while (0)
#define PG8_LDB(dst, b, h) do { _Pragma("unroll") for (int n = 0; n < 2; ++n) _Pragma("unroll") for (int k = 0; k < 2; ++k) dst[n][k] = *(const LAS bf16x8*)(lds + PG8_SB(b, h) + boff + n * 2048 + k * 1024); } while (0)
#define PG8_MMA(ai, bj, At, Bt) do { __builtin_amdgcn_s_setprio(1); _Pragma("unroll") for (int m = 0; m < 4; ++m) _Pragma("unroll") for (int n = 0; n < 2; ++n) _Pragma("unroll") for (int k = 0; k < 2; ++k) \
        acc[ai][bj][m][n] = __builtin_amdgcn_mfma_f32_16x16x32_bf16(Bt[n][k], At[m][k], acc[ai][bj][m][n], 0, 0, 0); __builtin_amdgcn_s_setprio(0); } while (0)
#define PG8_WAIT_V(n) asm volatile("s_waitcnt vmcnt(" #n ")" ::: "memory")
#define PG8_WAIT_L(n) asm volatile("s_waitcnt lgkmcnt(" #n ")" ::: "memory")
#define PG8_BAR __builtin_amdgcn_s_barrier()
#define PG8_SCHED __builtin_amdgcn_sched_barrier(0)
    Unit cur, nxt; int ui = 0;
    if (!S.next(0, cur)) return;
    f32x4 acc[2][2][4][2];
#pragma unroll
    for (int a = 0; a < 2; ++a)
#pragma unroll
        for (int b = 0; b < 2; ++b)
#pragma unroll
            for (int m = 0; m < 4; ++m)
#pragma unroll
                for (int n = 0; n < 2; ++n) acc[a][b][m][n] = (f32x4){0.f, 0.f, 0.f, 0.f};
    bf16x8 At[4][2], B0[2][2], B1[2][2];
    const char* cA = (const char*)g.A + (size_t)cur.pm * tstepA; const char* cB = (const char*)g.Bt + (size_t)cur.pn * tstepB;
    PG8_STAGE(PG8_SB(0, 0), cB, voffB); PG8_STAGE(PG8_SB(0, 1), cB + hstepB, voffB); PG8_STAGE(PG8_SA(0, 0), cA, voffA); PG8_STAGE(PG8_SA(0, 1), cA + hstepA, voffA);
    if (wr == 1) PG8_BAR;
    PG8_WAIT_V(2); PG8_BAR;
    PG8_STAGE(PG8_SB(1, 0), cB + kstep, voffB); PG8_STAGE(PG8_SA(1, 0), cA + kstep, voffA); PG8_STAGE(PG8_SB(1, 1), cB + hstepB + kstep, voffB);
    PG8_WAIT_V(6); PG8_BAR;
    for (;;) {
        const bool has_next = S.next(ui + 1, nxt);
        const char* nA = has_next ? (const char*)g.A + (size_t)nxt.pm * tstepA : cA; const char* nB = has_next ? (const char*)g.Bt + (size_t)nxt.pn * tstepB : cB;
        for (int t = 0; t < nt; t += 2) {
            const bool last = (t == nt - 2);
            const char* a1 = cA + (size_t)(t + 1) * kstep;
            const char* a2 = last ? nA : cA + (size_t)(t + 2) * kstep; const char* b2 = last ? nB : cB + (size_t)(t + 2) * kstep;
            const char* a3 = a2 + kstep; const char* b3 = b2 + kstep;
            PG8_LDB(B0, 0, 0); PG8_LDB(B1, 0, 1); PG8_SCHED; PG8_LDA(At, 0, 0); PG8_STAGE(PG8_SA(1, 1), a1 + hstepA, voffA);
            PG8_WAIT_V(8); PG8_WAIT_L(0); PG8_BAR; PG8_MMA(0, 0, At, B0); PG8_MMA(0, 1, At, B1); PG8_BAR; PG8_SCHED;
            PG8_LDA(At, 0, 1); PG8_STAGE(PG8_SB(0, 0), b2, voffB); PG8_STAGE(PG8_SB(0, 1), b2 + hstepB, voffB); PG8_STAGE(PG8_SA(0, 0), a2, voffA);
            PG8_WAIT_V(8); PG8_WAIT_L(0); PG8_BAR; PG8_MMA(1, 0, At, B0); PG8_MMA(1, 1, At, B1); PG8_BAR; PG8_SCHED;
            PG8_LDB(B0, 1, 0); PG8_LDB(B1, 1, 1); PG8_SCHED; PG8_LDA(At, 1, 0); PG8_STAGE(PG8_SA(0, 1), a2 + hstepA, voffA);
            PG8_WAIT_V(8); PG8_WAIT_L(0); PG8_BAR; PG8_MMA(0, 0, At, B0); PG8_MMA(0, 1, At, B1); PG8_BAR; PG8_SCHED;
            PG8_LDA(At, 1, 1); PG8_STAGE(PG8_SB(1, 0), b3, voffB); PG8_STAGE(PG8_SB(1, 1), b3 + hstepB, voffB); PG8_STAGE(PG8_SA(1, 0), a3, voffA);
            PG8_WAIT_V(8); PG8_WAIT_L(0); PG8_BAR; PG8_MMA(1, 0, At, B0); PG8_MMA(1, 1, At, B1); PG8_BAR; PG8_SCHED;
        }
        if (wr == 0) PG8_BAR;
        E(acc, cur, wr, wc, fr, fq);
        if (!has_next) break;
#pragma unroll
        for (int a = 0; a < 2; ++a)
#pragma unroll
            for (int b = 0; b < 2; ++b)
#pragma unroll
                for (int m = 0; m < 4; ++m)
#pragma unroll
                    for (int n = 0; n < 2; ++n) acc[a][b][m][n] = (f32x4){0.f, 0.f, 0.f, 0.f};
        cur = nxt; cA = nA; cB = nB; ++ui;
        if (wr == 1) PG8_BAR;
    }
    PG8_WAIT_V(0);
    PG8_BAR;
#undef PG8_SA
#undef PG8_SB
#undef PG8_STAGE
#undef PG8_LDA
#undef PG8_LDB
#undef PG8_MMA
#undef PG8_WAIT_V
#undef PG8_WAIT_L
#undef PG8_BAR
#undef PG8_SCHED
}
}
using pg8::Unit;
typedef f32x4 AccT[2][2][4][2];

__device__ __forceinline__ u32x4 pack8(f32x4 a, f32x4 b) { u32x4 w; w.x = cvt_pk_bf16(a[0], a[1]); w.y = cvt_pk_bf16(a[2], a[3]); w.z = cvt_pk_bf16(b[0], b[1]); w.w = cvt_pk_bf16(b[2], b[3]); return w; }

struct EpiSwiglu {
    static constexpr bool PERM = true;
    bf16_t* mid; const float* slotsH; bf16_t* cbuf; float* slotsC; bf16_t* krope; const float* cosT; const float* sinT;
    __device__ __forceinline__ void operator()(const AccT& acc, const Unit& u, int wr, int wc, int fr, int fq) const {
        const int row0 = u.pm * 256 + wr * 64 + fr;
        if (u.pn < 22) {
#pragma unroll
            for (int ai = 0; ai < 2; ++ai)
#pragma unroll
                for (int m = 0; m < 4; ++m) {
                    const int row = row0 + ai * 128 + m * 16; const float rs = rstd_slots16(slotsH, row);
                    f32x4 o[2];
#pragma unroll
                    for (int n = 0; n < 2; ++n)
#pragma unroll
                        for (int i = 0; i < 4; ++i) { const float gt = acc[ai][0][m][n][i] * rs, up = acc[ai][1][m][n][i] * rs; o[n][i] = gt * fsigmoid(gt) * up; }
                    *(u32x4*)(mid + (size_t)row * FF + u.pn * 128 + wc * 32 + fq * 8) = pack8(o[0], o[1]);
                }
        } else if (u.pn == 22) {
#pragma unroll
            for (int ai = 0; ai < 2; ++ai)
#pragma unroll
                for (int m = 0; m < 4; ++m) {
                    const int row = row0 + ai * 128 + m * 16; const float rs = rstd_slots16(slotsH, row);
                    float ss = 0.f;
#pragma unroll
                    for (int bj = 0; bj < 2; ++bj) { const f32x4 a = acc[ai][bj][m][0] * rs, b = acc[ai][bj][m][1] * rs;
                        ss += (a[0] * a[0] + a[1] * a[1]) + (a[2] * a[2] + a[3] * a[3]) + (b[0] * b[0] + b[1] * b[1]) + (b[2] * b[2] + b[3] * b[3]);
                        *(u32x4*)(cbuf + (size_t)row * 256 + bj * 128 + wc * 32 + fq * 8) = pack8(a, b); }
                    ss += __shfl_xor(ss, 16); ss += __shfl_xor(ss, 32);
                    if (fq == 0) slotsC[(size_t)row * 4 + wc] = ss;
                }
        } else if (wc == 0) {
#pragma unroll
            for (int ai = 0; ai < 2; ++ai)
#pragma unroll
                for (int m = 0; m < 4; ++m) {
                    const int row = row0 + ai * 128 + m * 16; const float rs = rstd_slots16(slotsH, row);
                    f32x4 o1[2], o2[2];
#pragma unroll
                    for (int n = 0; n < 2; ++n) { const f32x4 c = *(const f32x4*)(cosT + (size_t)row * 32 + fq * 8 + n * 4), s = *(const f32x4*)(sinT + (size_t)row * 32 + fq * 8 + n * 4);
                        const f32x4 x1 = acc[ai][0][m][n] * rs, x2 = acc[ai][1][m][n] * rs; o1[n] = x1 * c - x2 * s; o2[n] = x2 * c + x1 * s; }
                    *(u32x4*)(krope + (size_t)row * 64 + fq * 8) = pack8(o1[0], o1[1]);
                    *(u32x4*)(krope + (size_t)row * 64 + 32 + fq * 8) = pack8(o2[0], o2[1]);
                }
        }
    }
};
struct EpiResid {
    static constexpr bool PERM = false;
    const float* hin; float* hout; bf16_t* hb; float* slots; float alpha;
    __device__ __forceinline__ void operator()(const AccT& acc, const Unit& u, int wr, int wc, int fr, int fq) const {
        const int row0 = u.pm * 256 + wr * 64 + fr, col0 = u.pn * 256 + wc * 32 + 4 * fq;
#pragma unroll
        for (int ai = 0; ai < 2; ++ai)
#pragma unroll
            for (int m = 0; m < 4; ++m) {
                const int row = row0 + ai * 128 + m * 16; const size_t off = (size_t)row * D + col0; float ss = 0.f;
#pragma unroll
                for (int bj = 0; bj < 2; ++bj)
#pragma unroll
                    for (int n = 0; n < 2; ++n) { const size_t o2 = off + bj * 128 + n * 16; const f32x4 b = *(const f32x4*)(hin + o2); const f32x4 o = b + acc[ai][bj][m][n] * alpha;
                        *(f32x4*)(hout + o2) = o; ss += (o[0] * o[0] + o[1] * o[1]) + (o[2] * o[2] + o[3] * o[3]);
                        if (hb) { u32x2 w; w.x = cvt_pk_bf16(o[0], o[1]); w.y = cvt_pk_bf16(o[2], o[3]); *(u32x2*)(hb + o2) = w; } }
                if (slots) { ss += __shfl_xor(ss, 16); ss += __shfl_xor(ss, 32); if (fq == 0) slots[(size_t)row * 16 + u.pn * 4 + wc] = ss; }
                if (m & 1) asm volatile("" ::: "memory");
            }
    }
};
struct EpiBf16 {
    static constexpr bool PERM = true;
    bf16_t* O; int ldc;
    __device__ __forceinline__ void operator()(const AccT& acc, const Unit& u, int wr, int wc, int fr, int fq) const {
        const int row0 = u.pm * 256 + wr * 64 + fr, col0 = u.pn * 256 + wc * 32 + 8 * fq;
#pragma unroll
        for (int ai = 0; ai < 2; ++ai)
#pragma unroll
            for (int m = 0; m < 4; ++m) { bf16_t* rp = O + (size_t)(row0 + ai * 128 + m * 16) * ldc + col0;
#pragma unroll
                for (int bj = 0; bj < 2; ++bj) *(u32x4*)(rp + bj * 128) = pack8(acc[ai][bj][m][0], acc[ai][bj][m][1]); }
    }
};
struct EpiLoraDown {
    static constexpr bool PERM = true;
    bf16_t* O;
    __device__ __forceinline__ void operator()(const AccT& acc, const Unit& u, int wr, int wc, int fr, int fq) const {
        const int row0 = u.pm * 256 + wr * 64 + fr, col0 = wc * 32 + 8 * fq;
#pragma unroll
        for (int ai = 0; ai < 2; ++ai)
#pragma unroll
            for (int m = 0; m < 4; ++m) { bf16_t* rp = O + (size_t)(row0 + ai * 128 + m * 16) * 256 + col0;
                f32x4 a = acc[ai][0][m][0], b = acc[ai][0][m][1];
                if (wc < 2) {
#pragma unroll
                    for (int i = 0; i < 4; ++i) { a[i] = ftanh(a[i]); b[i] = ftanh(b[i]); } }
                *(u32x4*)(rp) = pack8(a, b);
                a = acc[ai][1][m][0]; b = acc[ai][1][m][1];
#pragma unroll
                for (int i = 0; i < 4; ++i) { a[i] = fsigmoid(a[i]); b[i] = fsigmoid(b[i]); }
                *(u32x4*)(rp + 128) = pack8(a, b); }
    }
};
struct EpiRL {
    static constexpr bool PERM = true;
    bf16_t* R; bf16_t* O;
    __device__ __forceinline__ void operator()(const AccT& acc, const Unit& u, int wr, int wc, int fr, int fq) const {
        const int row0 = u.pm * 256 + wr * 64 + fr;
        if (u.pn < 4) {
            const int col0 = u.pn * 256 + wc * 32 + 8 * fq;
#pragma unroll
            for (int ai = 0; ai < 2; ++ai)
#pragma unroll
                for (int m = 0; m < 4; ++m) { bf16_t* rp = R + (size_t)(row0 + ai * 128 + m * 16) * D + col0;
#pragma unroll
                    for (int bj = 0; bj < 2; ++bj) *(u32x4*)(rp + bj * 128) = pack8(acc[ai][bj][m][0], acc[ai][bj][m][1]); }
        } else {
            const int col0 = wc * 32 + 8 * fq;
#pragma unroll
            for (int ai = 0; ai < 2; ++ai)
#pragma unroll
                for (int m = 0; m < 4; ++m) { bf16_t* rp = O + (size_t)(row0 + ai * 128 + m * 16) * 256 + col0;
                    f32x4 a = acc[ai][0][m][0], b = acc[ai][0][m][1];
                    if (wc < 2) {
#pragma unroll
                        for (int i = 0; i < 4; ++i) { a[i] = ftanh(a[i]); b[i] = ftanh(b[i]); } }
                    *(u32x4*)(rp) = pack8(a, b);
                    a = acc[ai][1][m][0]; b = acc[ai][1][m][1];
#pragma unroll
                    for (int i = 0; i < 4; ++i) { a[i] = fsigmoid(a[i]); b[i] = fsigmoid(b[i]); }
                    *(u32x4*)(rp + 128) = pack8(a, b); }
        }
    }
};
struct EpiLoraUp {
    static constexpr bool PERM = true;
    unsigned char* wsb; const float* w0; const float* a0; int grp0; size_t goff;
    __device__ __forceinline__ void operator()(const AccT& acc, const Unit& u, int wr, int wc, int fr, int fq) const {
        const int grp = (u.pn >> 2) + grp0, colt = (u.pn & 3) * 256;
        const int row0 = u.pm * 256 + wr * 64 + fr, col0 = colt + wc * 32 + 8 * fq;
        size_t ooff = goff; if (grp == 0) ooff = A_E; if (grp == 1) ooff = A_AA;
        bf16_t* O = (bf16_t*)(wsb + ooff); const float* bias = grp == 0 ? w0 : a0;
#pragma unroll
        for (int ai = 0; ai < 2; ++ai)
#pragma unroll
            for (int m = 0; m < 4; ++m) { bf16_t* rp = O + (size_t)(row0 + ai * 128 + m * 16) * D + col0;
#pragma unroll
                for (int bj = 0; bj < 2; ++bj) { f32x4 a = acc[ai][bj][m][0], b = acc[ai][bj][m][1];
                    if (grp < 2) { const float sc = grp == 0 ? 0.6065306597126334f : 1.0f;
                        const f32x4 b0 = *(const f32x4*)(bias + col0 + bj * 128), b1 = *(const f32x4*)(bias + col0 + bj * 128 + 4);
                        a = a + b0; b = b + b1;
#pragma unroll
                        for (int i = 0; i < 4; ++i) { a[i] = sc * fsigmoid(a[i]); b[i] = sc * fsigmoid(b[i]); } }
                    *(u32x4*)(rp + bj * 128) = pack8(a, b); }
                asm volatile("" ::: "memory"); }
    }
};
struct EpiQlat {
    static constexpr bool PERM = true;
    bf16_t* O; const float* slotsH; float* slotsQ;
    __device__ __forceinline__ void operator()(const AccT& acc, const Unit& u, int wr, int wc, int fr, int fq) const {
        const int row0 = u.pm * 256 + wr * 64 + fr, col0 = u.pn * 256 + wc * 32 + 8 * fq;
#pragma unroll
        for (int ai = 0; ai < 2; ++ai)
#pragma unroll
            for (int m = 0; m < 4; ++m) { const int row = row0 + ai * 128 + m * 16; const float rs = rstd_slots16(slotsH, row); float ss = 0.f;
#pragma unroll
                for (int bj = 0; bj < 2; ++bj) { const f32x4 a = acc[ai][bj][m][0] * rs, b = acc[ai][bj][m][1] * rs;
                    ss += (a[0] * a[0] + a[1] * a[1]) + (a[2] * a[2] + a[3] * a[3]) + (b[0] * b[0] + b[1] * b[1]) + (b[2] * b[2] + b[3] * b[3]);
                    *(u32x4*)(O + (size_t)row * 512 + col0 + bj * 128) = pack8(a, b); }
                ss += __shfl_xor(ss, 16); ss += __shfl_xor(ss, 32);
                if (fq == 0) slotsQ[(size_t)row * 8 + u.pn * 4 + wc] = ss; }
    }
};
struct EpiQ {
    static constexpr bool PERM = true;
    bf16_t* qn; bf16_t* qr; const float* slotsQ; const float* cosT; const float* sinT;
    __device__ __forceinline__ void operator()(const AccT& acc, const Unit& u, int wr, int wc, int fr, int fq) const {
        const int row0 = u.pm * 256 + wr * 64 + fr;
#pragma unroll
        for (int ai = 0; ai < 2; ++ai)
#pragma unroll
            for (int m = 0; m < 4; ++m) { const int row = row0 + ai * 128 + m * 16;
                const f32x4 s0 = *(const f32x4*)(slotsQ + (size_t)row * 8), s1 = *(const f32x4*)(slotsQ + (size_t)row * 8 + 4);
                const float rs = __builtin_amdgcn_rsqf((sum4(s0) + sum4(s1)) * (1.0f / 512.0f) + RMS_EPS) * QSCALE;
                if (u.pn < 4) {
#pragma unroll
                    for (int bj = 0; bj < 2; ++bj) *(u32x4*)(qn + (size_t)row * D + u.pn * 256 + bj * 128 + wc * 32 + fq * 8) = pack8(acc[ai][bj][m][0] * rs, acc[ai][bj][m][1] * rs);
                } else {
                    const int head = 4 * (u.pn - 4) + wc; f32x4 o1[2], o2[2];
#pragma unroll
                    for (int n = 0; n < 2; ++n) { const f32x4 c = *(const f32x4*)(cosT + (size_t)row * 32 + fq * 8 + n * 4), s = *(const f32x4*)(sinT + (size_t)row * 32 + fq * 8 + n * 4);
                        const f32x4 x1 = acc[ai][0][m][n] * rs, x2 = acc[ai][1][m][n] * rs; o1[n] = x1 * c - x2 * s; o2[n] = x2 * c + x1 * s; }
                    *(u32x4*)(qr + (size_t)row * 512 + head * 64 + fq * 8) = pack8(o1[0], o1[1]);
                    *(u32x4*)(qr + (size_t)row * 512 + head * 64 + 32 + fq * 8) = pack8(o2[0], o2[1]);
                } }
    }
};
struct EpiKnope {
    static constexpr bool PERM = true;
    bf16_t* O; const float* slotsC;
    __device__ __forceinline__ void operator()(const AccT& acc, const Unit& u, int wr, int wc, int fr, int fq) const {
        const int row0 = u.pm * 256 + wr * 64 + fr, col0 = u.pn * 256 + wc * 32 + 8 * fq;
#pragma unroll
        for (int ai = 0; ai < 2; ++ai)
#pragma unroll
            for (int m = 0; m < 4; ++m) { const int row = row0 + ai * 128 + m * 16; const f32x4 s = *(const f32x4*)(slotsC + (size_t)row * 4);
                const float rs = __builtin_amdgcn_rsqf(sum4(s) * (1.0f / 256.0f) + RMS_EPS);
#pragma unroll
                for (int bj = 0; bj < 2; ++bj) *(u32x4*)(O + (size_t)row * D + col0 + bj * 128) = pack8(acc[ai][bj][m][0] * rs, acc[ai][bj][m][1] * rs); }
    }
};
struct EpiVt {
    static constexpr bool PERM = true;
    bf16_t* O; const float* slotsC;
    __device__ __forceinline__ void operator()(const AccT& acc, const Unit& u, int wr, int wc, int fr, int fq) const {
        const int row0 = u.pm * 256 + wr * 64 + fr, col0 = u.pn * 256 + wc * 32 + 8 * fq;
        f32x4 rs[2][2];
#pragma unroll
        for (int bj = 0; bj < 2; ++bj)
#pragma unroll
            for (int n = 0; n < 2; ++n)
#pragma unroll
                for (int i = 0; i < 4; ++i) { const f32x4 s = *(const f32x4*)(slotsC + (size_t)(col0 + bj * 128 + n * 4 + i) * 4); rs[bj][n][i] = __builtin_amdgcn_rsqf(sum4(s) * (1.0f / 256.0f) + RMS_EPS); }
#pragma unroll
        for (int ai = 0; ai < 2; ++ai)
#pragma unroll
            for (int m = 0; m < 4; ++m) { const int row = row0 + ai * 128 + m * 16;
#pragma unroll
                for (int bj = 0; bj < 2; ++bj) *(u32x4*)(O + (size_t)row * T + col0 + bj * 128) = pack8(acc[ai][bj][m][0] * rs[bj][0], acc[ai][bj][m][1] * rs[bj][1]); }
    }
};

struct Args { const float* in[33]; const int* pos; float* out; unsigned char* ws; int ph_lo, ph_hi; };

struct Ctx { LAS unsigned char* lds; int vcu, G, wave; };

__device__ __forceinline__ void tr_item(const float* W, int ldw, int k0, int n0, const float* s1, const float* s2, int ks0, bf16_t* Bt, int ldb, int nd0, int kd0, LAS float* scr, int lane) {
#pragma unroll 8
    for (int i = 0; i < 32; ++i) { const int kk = 2 * i + (lane >> 5);
        float sc = s1 ? s1[ks0 + kk] : 1.0f; if (s2) sc -= s2[ks0 + kk];
        scr[kk * 33 + (lane & 31)] = sc * W[(size_t)(k0 + kk) * ldw + n0 + (lane & 31)]; }
    asm volatile("s_waitcnt lgkmcnt(0)" ::: "memory");
    const int c = lane & 7;
#pragma unroll
    for (int j = 0; j < 4; ++j) { const int n = (lane >> 3) + 8 * j; const LAS float* s = scr + (8 * c) * 33 + n;
        u32x4 o; o.x = cvt_pk_bf16(s[0 * 33], s[1 * 33]); o.y = cvt_pk_bf16(s[2 * 33], s[3 * 33]); o.z = cvt_pk_bf16(s[4 * 33], s[5 * 33]); o.w = cvt_pk_bf16(s[6 * 33], s[7 * 33]);
        *(u32x4*)(Bt + (size_t)(nd0 + n) * ldb + kd0 + 8 * c) = o; }
    asm volatile("s_waitcnt lgkmcnt(0)" ::: "memory");
}
__device__ __forceinline__ void zero_item(bf16_t* Bt, int ldb, int nd0, int kd0, int lane) {
    const int c = lane & 7;
#pragma unroll
    for (int j = 0; j < 4; ++j) { const int n = (lane >> 3) + 8 * j; *(u32x4*)(Bt + (size_t)(nd0 + n) * ldb + kd0 + 8 * c) = (u32x4){0u, 0u, 0u, 0u}; }
}

__device__ __forceinline__ void p0_prologue(const Ctx& F, const Args& a) {
    unsigned char* ws = a.ws;
    const int tid = fresh_tid(F.wave), lane = tid & 63, wave = __builtin_amdgcn_readfirstlane(tid >> 6);
    LAS float* scr = (LAS float*)(F.lds + wave * 16384);
    const int gw = F.vcu * 8 + wave, NGW = F.G * 8;
    const float* norm_g = a.in[2];
    constexpr int I_UG = 16 * 176, I_UGX = 16 * 16, I_DN = 44 * 32, I_SQ = 16 * 32, I_LD = 32 * 8, I_LU = 4 * 96, I_KN = 4 * 32, I_DQ = 16 * 16, I_UQ = 8 * 48;
    constexpr int NITEMS = 4 * I_UG + I_UGX + 4 * I_DN + 4 * I_SQ + I_LD + I_LU + 2 * I_KN + I_DQ + I_UQ + I_SQ;
    for (int it = gw; it < NITEMS; it += NGW) {
        int r = it;
        if (r < 4 * I_UG) { const int q = r / I_UG; r -= q * I_UG; const int l = q >> 1, s = q & 1; const int kb = r / 176, nb = r % 176, pn = nb >> 3, jb = nb & 7;
            const float* src = (jb < 4 ? a.in[3] : a.in[4]) + (size_t)q * D * FF;
            tr_item(src, FF, 64 * kb, 128 * pn + 32 * (jb & 3), norm_g + (l * 3 + (s ? 2 : 0)) * D, nullptr, 64 * kb, (bf16_t*)(ws + W_UG) + (size_t)q * 6144 * D, D, 32 * nb, 64 * kb, scr, lane); continue; }
        r -= 4 * I_UG;
        if (r < I_UGX) { const int kb = r / 16, nb = r % 16; bf16_t* Bt = (bf16_t*)(ws + W_UG) + (size_t)2 * 6144 * D;
            int sc = -1; if (nb < 8) sc = 32 * nb; else if (nb == 8) sc = 256; else if (nb == 12) sc = 288;
            if (sc >= 0) tr_item(a.in[25], 320, 64 * kb, sc, a.in[24], nullptr, 64 * kb, Bt, D, 5632 + 32 * nb, 64 * kb, scr, lane); else zero_item(Bt, D, 5632 + 32 * nb, 64 * kb, lane); continue; }
        r -= I_UGX;
        if (r < 4 * I_DN) { const int q = r / I_DN; r -= q * I_DN; const int kb = r / 32, nb = r % 32;
            tr_item(a.in[5] + (size_t)q * FF * D, D, 64 * kb, 32 * nb, nullptr, nullptr, 0, (bf16_t*)(ws + W_DN) + (size_t)q * D * FF, FF, 32 * nb, 64 * kb, scr, lane); continue; }
        r -= 4 * I_DN;
        if (r < 4 * I_SQ) { const int q = r / I_SQ; r -= q * I_SQ; const int kb = r / 32, nb = r % 32;
            if (q == 0) { tr_item(a.in[7], D, 64 * kb, 32 * nb, nullptr, nullptr, 0, (bf16_t*)(ws + W_RL), 2048, 32 * nb, 64 * kb, scr, lane); zero_item((bf16_t*)(ws + W_RL), 2048, 32 * nb, 1024 + 64 * kb, lane); }
            else tr_item(a.in[7 + q], D, 64 * kb, 32 * nb, nullptr, nullptr, 0, (bf16_t*)(ws + W_R + (size_t)q * 2 * MiB), D, 32 * nb, 64 * kb, scr, lane);
            continue; }
        r -= 4 * I_SQ;
        if (r < I_LD) { const int kb = r / 8, nb = r % 8; const int kk0 = 64 * (kb & 15); const bool second = kb >= 16;
            const float* src; int ldw, nc, mi; if (nb < 2) { src = a.in[12]; ldw = 64; nc = 32 * nb; mi = 1; } else if (nb < 4) { src = a.in[15]; ldw = 64; nc = 32 * (nb - 2); mi = 4; } else { src = a.in[17]; ldw = 128; nc = 32 * (nb - 4); mi = 5; }
            tr_item(src, ldw, kk0, nc, second ? a.in[6] + mi * D : nullptr, second ? a.in[6] : nullptr, kk0, (bf16_t*)(ws + W_RL), 2048, 1024 + 32 * nb, 64 * kb, scr, lane); continue; }
        r -= I_LD;
        if (r < I_LU) { const int kb = r / 96, nb = r % 96; const int grp = nb / 32, nc = 32 * (nb % 32); bf16_t* Bt = (bf16_t*)(ws + W_LU);
            if (grp == 0) { if (kb == 0) tr_item(a.in[13], D, 0, nc, nullptr, nullptr, 0, Bt, 256, 32 * nb, 0, scr, lane); else zero_item(Bt, 256, 32 * nb, 64 * kb, lane); }
            else if (grp == 1) { if (kb == 1) tr_item(a.in[16], D, 0, nc, nullptr, nullptr, 0, Bt, 256, 32 * nb, 64, scr, lane); else zero_item(Bt, 256, 32 * nb, 64 * kb, lane); }
            else { if (kb >= 2) tr_item(a.in[18], D, 64 * (kb - 2), nc, nullptr, nullptr, 0, Bt, 256, 32 * nb, 64 * kb, scr, lane); else zero_item(Bt, 256, 32 * nb, 64 * kb, lane); }
            continue; }
        r -= I_LU;
        if (r < 2 * I_KN) { const int q = r / I_KN; r -= q * I_KN; const int kb = r / 32, nb = r % 32;
            const int n0 = 32 * nb, sc = (n0 >> 7) * 256 + (n0 & 127) + q * 128;
            tr_item(a.in[27], 2048, 64 * kb, sc, a.in[26], nullptr, 64 * kb, (bf16_t*)(ws + (q ? W_VT : W_KN)), 256, n0, 64 * kb, scr, lane); continue; }
        r -= 2 * I_KN;
        if (r < I_DQ) { const int kb = r / 16, nb = r % 16;
            tr_item(a.in[28], 512, 64 * kb, 32 * nb, norm_g + (1 * 3 + 1) * D, nullptr, 64 * kb, (bf16_t*)(ws + W_DQ), D, 32 * nb, 64 * kb, scr, lane); continue; }
        r -= I_DQ;
        if (r < I_UQ) { const int kb = r / 48, nb = r % 48; int sc;
            if (nb < 32) { const int n0 = 32 * nb; sc = (n0 >> 7) * 192 + (n0 & 127); }
            else { const int t2 = (nb - 32) >> 3, jj = (nb - 32) & 7, half = jj >> 2, hh = jj & 3; sc = (4 * t2 + hh) * 192 + 128 + 32 * half; }
            tr_item(a.in[30], 1536, 64 * kb, sc, a.in[29], nullptr, 64 * kb, (bf16_t*)(ws + W_UQ), 512, 32 * nb, 64 * kb, scr, lane); continue; }
        r -= I_UQ;
        { const int kb = r / 32, nb = r % 32; tr_item(a.in[31], D, 64 * kb, 32 * nb, nullptr, nullptr, 0, (bf16_t*)(ws + W_MO), D, 32 * nb, 64 * kb, scr, lane); }
    }
    const float* x = a.in[0]; bf16_t* hb = (bf16_t*)(ws + A_HB); float* slotsH = (float*)(ws + WS_SLOTH);
    for (int m = gw; m < T; m += NGW) {
        const f32x4* xr = (const f32x4*)(x + (size_t)m * D) + lane; float ss = 0.f;
#pragma unroll
        for (int j = 0; j < 4; ++j) { const f32x4 v = xr[64 * j]; ss += (v[0] * v[0] + v[1] * v[1]) + (v[2] * v[2] + v[3] * v[3]);
            u32x2 w; w.x = cvt_pk_bf16(v[0], v[1]); w.y = cvt_pk_bf16(v[2], v[3]); *((u32x2*)(hb + (size_t)m * D) + lane + 64 * j) = w; }
        ss = wave_sum(ss);
        if (lane < 16) slotsH[(size_t)m * 16 + lane] = lane == 0 ? ss : 0.f;
    }
    float* cosT = (float*)(ws + A_COS); float* sinT = (float*)(ws + A_SIN);
    for (int i = (F.vcu * 512 + tid); i < T * 32; i += F.G * 512) {
        const int tok = i >> 5, j = i & 31;
        const float inv = exp2f(-(float)j * (13.287712379549449f / 32.0f));
        const float ang = (float)a.pos[tok] * inv;
        const double rev = (double)ang * 0.15915494309189535; const float fr = (float)(rev - floor(rev));
        cosT[i] = __builtin_amdgcn_cosf(fr); sinT[i] = __builtin_amdgcn_sinf(fr);
    }
}

__device__ __forceinline__ void p_premix(const Ctx& F, const Args& a) {
    const float* h = a.out; const float* g = a.in[2] + 1 * D; const float* mix = a.in[6];
    bf16_t* X1 = (bf16_t*)(a.ws + A_X1); bf16_t* XK = (bf16_t*)(a.ws + A_XK); bf16_t* XV = (bf16_t*)(a.ws + A_XV);
    const int tid = fresh_tid(F.wave), lane = tid & 63, wave = __builtin_amdgcn_readfirstlane(tid >> 6);
    const int gw = F.vcu * 8 + wave, NGW = F.G * 8;
    for (int ch = gw; ch < T / 16; ch += NGW) {
        const int t0 = ch * 16;
        f32x4 prev[4], gv[4];
#pragma unroll
        for (int j = 0; j < 4; ++j) gv[j] = *((const f32x4*)g + lane + 64 * j);
        if ((t0 & (SEQ - 1)) == 0) {
#pragma unroll
            for (int j = 0; j < 4; ++j) prev[j] = (f32x4){0.f, 0.f, 0.f, 0.f};
        } else {
            float ss = 0.f;
#pragma unroll
            for (int j = 0; j < 4; ++j) { prev[j] = *((const f32x4*)(h + (size_t)(t0 - 1) * D) + lane + 64 * j); ss += (prev[j][0] * prev[j][0] + prev[j][1] * prev[j][1]) + (prev[j][2] * prev[j][2] + prev[j][3] * prev[j][3]); }
            const float rs = __builtin_amdgcn_rsqf(wave_sum(ss) * (1.0f / 1024.0f) + RMS_EPS);
#pragma unroll
            for (int j = 0; j < 4; ++j) prev[j] = prev[j] * rs * gv[j];
        }
        for (int t = t0; t < t0 + 16; ++t) {
            f32x4 cur[4]; float ss = 0.f;
#pragma unroll
            for (int j = 0; j < 4; ++j) { cur[j] = *((const f32x4*)(h + (size_t)t * D) + lane + 64 * j); ss += (cur[j][0] * cur[j][0] + cur[j][1] * cur[j][1]) + (cur[j][2] * cur[j][2] + cur[j][3] * cur[j][3]); }
            const float rs = __builtin_amdgcn_rsqf(wave_sum(ss) * (1.0f / 1024.0f) + RMS_EPS);
#pragma unroll
            for (int j = 0; j < 4; ++j) {
                const f32x4 hn = cur[j] * rs * gv[j]; const f32x4 xx = prev[j] - hn; prev[j] = hn;
                const f32x4 mr = *((const f32x4*)(mix + 0 * D) + lane + 64 * j), mk = *((const f32x4*)(mix + 2 * D) + lane + 64 * j), mv = *((const f32x4*)(mix + 3 * D) + lane + 64 * j);
                const f32x4 xr = hn + xx * mr, xk = hn + xx * mk, xv = hn + xx * mv;
                u32x2 w;
                w.x = cvt_pk_bf16(xr[0], xr[1]); w.y = cvt_pk_bf16(xr[2], xr[3]); *((u32x2*)(X1 + (size_t)t * 2048) + lane + 64 * j) = w;
                w.x = cvt_pk_bf16(xx[0], xx[1]); w.y = cvt_pk_bf16(xx[2], xx[3]); *((u32x2*)(X1 + (size_t)t * 2048 + 1024) + lane + 64 * j) = w;
                w.x = cvt_pk_bf16(xk[0], xk[1]); w.y = cvt_pk_bf16(xk[2], xk[3]); *((u32x2*)(XK + (size_t)t * D) + lane + 64 * j) = w;
                w.x = cvt_pk_bf16(xv[0], xv[1]); w.y = cvt_pk_bf16(xv[2], xv[3]); *((u32x2*)(XV + (size_t)t * D) + lane + 64 * j) = w;
            }
        }
    }
}

constexpr int TC = 32;
__device__ __forceinline__ void p_scan(const Ctx& F, const Args& a) {
    const bf16_t* Rb = (const bf16_t*)(a.ws + A_R); const bf16_t* Kb = (const bf16_t*)(a.ws + A_KK); const bf16_t* Vb = (const bf16_t*)(a.ws + A_VV);
    const bf16_t* Eb = (const bf16_t*)(a.ws + A_E); const bf16_t* Ab = (const bf16_t*)(a.ws + A_AA); bf16_t* Gb = (bf16_t*)(a.ws + A_G);
    const float* k_k = a.in[19]; const float* k_a = a.in[20]; const float* r_k = a.in[21]; const float* gn_w = a.in[22]; const float* gn_b = a.in[23];
    LAS float* sR = (LAS float*)(F.lds); LAS float* sW = sR + TC * 64; LAS float* sK = sW + TC * 64; LAS float* sV = sK + TC * 64;
    LAS float* sKK = sV + TC * 64; LAS float* sKA = sKK + TC * 64; LAS float* sY = sKA + TC * 64; LAS float* sBo = sY + TC * 64;
    const int tid = fresh_tid(F.wave), lane = tid & 63, wave = __builtin_amdgcn_readfirstlane(tid >> 6);
    const int irow = wave * 8 + (lane >> 3), kseg = (lane & 7) * 8;
    const int ptt = tid >> 4, pc = (tid & 15) * 4;
    for (int unit0 = F.vcu; unit0 < 2 * NB * 16; unit0 += F.G) {
        const int unit = unit0 & 127; const bool shadow = unit0 >= 128;
        const int b = unit >> 4, hd = unit & 15; const int cbase = hd * 64;
        float S[8];
#pragma unroll
        for (int j = 0; j < 8; ++j) S[j] = 0.f;
        const f32x4 kkv = *(const f32x4*)(k_k + cbase + pc), kav = *(const f32x4*)(k_a + cbase + pc), rkv = *(const f32x4*)(r_k + cbase + pc);
        const f32x4 gw = *(const f32x4*)(gn_w + cbase + pc), gb = *(const f32x4*)(gn_b + cbase + pc);
        for (int c0 = 0; c0 < SEQ; c0 += TC) {
            const size_t gidx = (size_t)(b * SEQ + c0 + ptt) * D + cbase + pc;
            {
                const f32x4 r = unpack4(*(const u32x2*)(Rb + gidx)), k = unpack4(*(const u32x2*)(Kb + gidx)), v = unpack4(*(const u32x2*)(Vb + gidx));
                const f32x4 e = unpack4(*(const u32x2*)(Eb + gidx)), aa = unpack4(*(const u32x2*)(Ab + gidx));
                f32x4 kk = k * kkv; float ss = (kk[0] * kk[0] + kk[1] * kk[1]) + (kk[2] * kk[2] + kk[3] * kk[3]); ss = red16(ss);
                kk = kk * __builtin_amdgcn_rsqf(fmaxf(ss, 1e-24f));
                const f32x4 kp = k * (1.0f + (aa - 1.0f) * kav);
                const f32x4 rk = r * kp * rkv; const float bo = red16((rk[0] + rk[1]) + (rk[2] + rk[3]));
                f32x4 w;
#pragma unroll
                for (int i = 0; i < 4; ++i) w[i] = __builtin_amdgcn_exp2f(-e[i] * LOG2E);
                const int o = ptt * 64 + pc;
                *(LAS f32x4*)(sR + o) = r; *(LAS f32x4*)(sW + o) = w; *(LAS f32x4*)(sK + o) = kp; *(LAS f32x4*)(sV + o) = v; *(LAS f32x4*)(sKK + o) = kk; *(LAS f32x4*)(sKA + o) = kk * aa;
                if ((tid & 15) == 0) sBo[ptt] = bo;
            }
            __syncthreads();
#pragma unroll 2
            for (int t = 0; t < TC; ++t) {
                const int o = t * 64 + kseg;
                const f32x4 kk0 = *(const LAS f32x4*)(sKK + o), kk1 = *(const LAS f32x4*)(sKK + o + 4);
                const f32x4 w0 = *(const LAS f32x4*)(sW + o), w1 = *(const LAS f32x4*)(sW + o + 4);
                const f32x4 ka0 = *(const LAS f32x4*)(sKA + o), ka1 = *(const LAS f32x4*)(sKA + o + 4);
                const f32x4 kp0 = *(const LAS f32x4*)(sK + o), kp1 = *(const LAS f32x4*)(sK + o + 4);
                const f32x4 r0 = *(const LAS f32x4*)(sR + o), r1 = *(const LAS f32x4*)(sR + o + 4);
                const float vv = sV[t * 64 + irow];
                float sa = ((S[0] * kk0[0] + S[1] * kk0[1]) + (S[2] * kk0[2] + S[3] * kk0[3])) + ((S[4] * kk1[0] + S[5] * kk1[1]) + (S[6] * kk1[2] + S[7] * kk1[3]));
                sa = red8(sa);
#pragma unroll
                for (int j = 0; j < 4; ++j) { S[j] = S[j] * w0[j] + (vv * kp0[j] - sa * ka0[j]); S[4 + j] = S[4 + j] * w1[j] + (vv * kp1[j] - sa * ka1[j]); }
                float y = ((S[0] * r0[0] + S[1] * r0[1]) + (S[2] * r0[2] + S[3] * r0[3])) + ((S[4] * r1[0] + S[5] * r1[1]) + (S[6] * r1[2] + S[7] * r1[3]));
                y = red8(y);
                if ((lane & 7) == 0) sY[t * 64 + irow] = y;
            }
            __syncthreads();
            {
                const int o = ptt * 64 + pc;
                const f32x4 y = *(const LAS f32x4*)(sY + o), v = *(const LAS f32x4*)(sV + o);
                const float mu = red16((y[0] + y[1]) + (y[2] + y[3])) * (1.0f / 64.0f);
                const f32x4 d = y - mu; const float var = red16((d[0] * d[0] + d[1] * d[1]) + (d[2] * d[2] + d[3] * d[3])) * (1.0f / 64.0f);
                const float rs = __builtin_amdgcn_rsqf(var + GN_EPS); const float bo = sBo[ptt];
                const f32x4 gg = unpack4(*(const u32x2*)(Gb + gidx));
                const f32x4 ov = (d * rs * gw + gb + v * bo) * gg;
                u32x2 w; w.x = cvt_pk_bf16(ov[0], ov[1]); w.y = cvt_pk_bf16(ov[2], ov[3]); if (!shadow) *(u32x2*)(Gb + gidx) = w;
            }
            __syncthreads();
        }
    }
}


__device__ __forceinline__ void p_scan2(const Ctx& F, const Args& a) {
    const bf16_t* Rb = (const bf16_t*)(a.ws + A_R); const bf16_t* Kb = (const bf16_t*)(a.ws + A_KK); const bf16_t* Vb = (const bf16_t*)(a.ws + A_VV);
    const bf16_t* Eb = (const bf16_t*)(a.ws + A_E); const bf16_t* Ab = (const bf16_t*)(a.ws + A_AA); bf16_t* Yb = (bf16_t*)(a.ws + A_G); float* Bon = (float*)(a.ws + A_BON);
    const float* k_k = a.in[19]; const float* k_a = a.in[20]; const float* r_k = a.in[21];
    LAS float* sR = (LAS float*)(F.lds); LAS float* sW = sR + TC * 64; LAS float* sK = sW + TC * 64; LAS float* sV = sK + TC * 64;
    LAS float* sKK = sV + TC * 64; LAS float* sKA = sKK + TC * 64; LAS float* sY = sKA + TC * 64;
    const int tid = fresh_tid(F.wave), lane = tid & 63, wave = __builtin_amdgcn_readfirstlane(tid >> 6);
    const int lrow = wave * 4 + (lane >> 4), kseg = (lane & 15) * 4;
    const int ptt = tid >> 4, pc = (tid & 15) * 4;
    for (int unit = F.vcu; unit < 2 * NB * 16; unit += F.G) {
        const int bh = unit >> 1, half = unit & 1, b = bh >> 4, hd = bh & 15, cbase = hd * 64;
        f32x4 S = (f32x4){0.f, 0.f, 0.f, 0.f};
        const f32x4 kkv = *(const f32x4*)(k_k + cbase + pc), kav = *(const f32x4*)(k_a + cbase + pc), rkv = *(const f32x4*)(r_k + cbase + pc);
        size_t gidx = (size_t)(b * SEQ + ptt) * D + cbase + pc;
        u32x2 qr = *(const u32x2*)(Rb + gidx), qk = *(const u32x2*)(Kb + gidx), qv = *(const u32x2*)(Vb + gidx), qe = *(const u32x2*)(Eb + gidx), qa = *(const u32x2*)(Ab + gidx);
        for (int c0 = 0; c0 < SEQ; c0 += TC) {
            {
                const f32x4 r = unpack4(qr), k = unpack4(qk), v = unpack4(qv), e = unpack4(qe), aa = unpack4(qa);
                f32x4 kk = k * kkv; float ss = (kk[0] * kk[0] + kk[1] * kk[1]) + (kk[2] * kk[2] + kk[3] * kk[3]); ss = red16(ss);
                kk = kk * __builtin_amdgcn_rsqf(fmaxf(ss, 1e-24f));
                const f32x4 kp = k * (1.0f + (aa - 1.0f) * kav);
                const f32x4 rk = r * kp * rkv; const float bo = red16((rk[0] + rk[1]) + (rk[2] + rk[3]));
                f32x4 w;
#pragma unroll
                for (int i = 0; i < 4; ++i) w[i] = __builtin_amdgcn_exp2f(-e[i] * LOG2E);
                const int o = ptt * 64 + pc;
                *(LAS f32x4*)(sR + o) = r; *(LAS f32x4*)(sW + o) = w; *(LAS f32x4*)(sK + o) = kp; *(LAS f32x4*)(sV + o) = v; *(LAS f32x4*)(sKK + o) = kk; *(LAS f32x4*)(sKA + o) = kk * aa;
                if (half == 0 && (tid & 15) == 0) Bon[(size_t)(b * SEQ + c0 + ptt) * 16 + hd] = bo;
            }
            __syncthreads();
            if (c0 + TC < SEQ) { gidx += (size_t)TC * D;
                qr = *(const u32x2*)(Rb + gidx); qk = *(const u32x2*)(Kb + gidx); qv = *(const u32x2*)(Vb + gidx); qe = *(const u32x2*)(Eb + gidx); qa = *(const u32x2*)(Ab + gidx); }
#pragma unroll 4
            for (int t = 0; t < TC; ++t) {
                const int o = t * 64 + kseg;
                const f32x4 kk = *(const LAS f32x4*)(sKK + o), w = *(const LAS f32x4*)(sW + o), ka = *(const LAS f32x4*)(sKA + o), kp = *(const LAS f32x4*)(sK + o), r = *(const LAS f32x4*)(sR + o);
                const float vv = sV[t * 64 + half * 32 + lrow];
                float sa = (S[0] * kk[0] + S[1] * kk[1]) + (S[2] * kk[2] + S[3] * kk[3]);
                sa = red16(sa);
                S = S * w + (kp * vv - ka * sa);
                float y = (S[0] * r[0] + S[1] * r[1]) + (S[2] * r[2] + S[3] * r[3]);
                y = red16(y);
                if ((lane & 15) == 0) sY[t * 32 + lrow] = y;
            }
            __syncthreads();
            {
                const int tok = tid >> 4, r2 = (tid & 15) * 2;
                *(unsigned*)(Yb + (size_t)(b * SEQ + c0 + tok) * D + cbase + half * 32 + r2) = cvt_pk_bf16(sY[tok * 32 + r2], sY[tok * 32 + r2 + 1]);
            }
        }
        __syncthreads();
    }
}
__device__ __forceinline__ void p_post(const Ctx& F, const Args& a) {
    bf16_t* Yb = (bf16_t*)(a.ws + A_G); const bf16_t* Vb = (const bf16_t*)(a.ws + A_VV); const bf16_t* Gg = (const bf16_t*)(a.ws + A_E); const float* Bon = (const float*)(a.ws + A_BON);
    const float* gn_w = a.in[22]; const float* gn_b = a.in[23];
    const int tid = fresh_tid(F.wave), grp = tid >> 4, gl = tid & 15;
    for (int item = F.vcu * 32 + grp; item < T * 16; item += F.G * 32) {
        const int tok = item >> 4, hd = item & 15; const size_t idx = (size_t)tok * D + hd * 64 + 4 * gl;
        const f32x4 y = unpack4(*(const u32x2*)(Yb + idx)), v = unpack4(*(const u32x2*)(Vb + idx)), g = unpack4(*(const u32x2*)(Gg + idx));
        const float bo = Bon[(size_t)tok * 16 + hd];
        const f32x4 gw = *(const f32x4*)(gn_w + hd * 64 + 4 * gl), gb = *(const f32x4*)(gn_b + hd * 64 + 4 * gl);
        const float mu = red16((y[0] + y[1]) + (y[2] + y[3])) * (1.0f / 64.0f);
        const f32x4 d = y - mu; const float var = red16((d[0] * d[0] + d[1] * d[1]) + (d[2] * d[2] + d[3] * d[3])) * (1.0f / 64.0f);
        const float rs = __builtin_amdgcn_rsqf(var + GN_EPS);
        const f32x4 ov = (d * rs * gw + gb + v * bo) * g;
        u32x2 w; w.x = cvt_pk_bf16(ov[0], ov[1]); w.y = cvt_pk_bf16(ov[2], ov[3]); *(u32x2*)(Yb + idx) = w;
    }
}

constexpr int KROW = 400, VROW = 144, KBUF = 64 * KROW, VBUF = 128 * VROW, ABUF = KBUF + VBUF;
__device__ __forceinline__ void attn_unit(LAS unsigned char* lds, const bf16_t* qn, const bf16_t* qr, const bf16_t* kn, const bf16_t* kr, const bf16_t* vt, bf16_t* o_out, int b, int h, int qb, int wave_s) {
    const int tid = fresh_tid(wave_s), lane = tid & 63, wid = __builtin_amdgcn_readfirstlane(tid >> 6), r32 = lane & 31, hi = lane >> 5;
    const int tok0 = b * SEQ, q0 = qb * 256 + wid * 32;
    bf16x8 qf[12];
    { const size_t tq = (size_t)(tok0 + q0 + r32);
#pragma unroll
      for (int d = 0; d < 8; ++d) qf[d] = *(const bf16x8*)(qn + tq * D + h * 128 + d * 16 + hi * 8);
#pragma unroll
      for (int d = 0; d < 4; ++d) qf[8 + d] = *(const bf16x8*)(qr + tq * 512 + h * 64 + d * 16 + hi * 8); }
    const int NT = (qb + 1) * 4;
    const int kkey0 = tid >> 4, kch0 = tid & 15;
    const int rkey = tid >> 3, rch = tid & 7;
    const int vrow0 = tid >> 3, vch = tid & 7;
    const bf16_t* gk0 = kn + (size_t)(tok0 + kkey0) * D + h * 128 + kch0 * 8;
    const bf16_t* gk1 = gk0 + (size_t)32 * D;
    const bf16_t* gr = kr + (size_t)(tok0 + rkey) * 64 + rch * 8;
    const bf16_t* gv0 = vt + (size_t)(h * 128 + vrow0) * T + tok0 + vch * 8;
    const bf16_t* gv1 = gv0 + (size_t)64 * T;
    const int lk0 = kkey0 * KROW + kch0 * 16, lk1 = lk0 + 32 * KROW, lr = rkey * KROW + 256 + rch * 16, lv0 = KBUF + vrow0 * VROW + vch * 16, lv1 = lv0 + 64 * VROW;
    const int pr = (r32 & 0x13) | ((r32 & 4) << 1) | ((r32 & 8) >> 1);
    const int kfo = pr * KROW + hi * 16, vfo = KBUF + r32 * VROW + hi * 16;
    u32x4 ld0, ld1, ld2, ld3, ld4;
    ld0 = *(const u32x4*)gk0; ld1 = *(const u32x4*)gk1; ld2 = *(const u32x4*)gr; ld3 = *(const u32x4*)gv0; ld4 = *(const u32x4*)gv1;
    __syncthreads();
    *(LAS u32x4*)(lds + lk0) = ld0; *(LAS u32x4*)(lds + lk1) = ld1; *(LAS u32x4*)(lds + lr) = ld2; *(LAS u32x4*)(lds + lv0) = ld3; *(LAS u32x4*)(lds + lv1) = ld4;
    __syncthreads();
    float mrun = -1e30f, lrun = 0.f;
    f32x16 o[4];
#pragma unroll
    for (int d = 0; d < 4; ++d) o[d] = f32x16{};
    for (int t = 0; t < NT; ++t) {
        const int cb = (t & 1) * ABUF, nb = ((t + 1) & 1) * ABUF;
        const bool more = (t + 1 < NT);
        if (more) { const size_t ko = (size_t)(t + 1) * 64 * D, ro = (size_t)(t + 1) * 64 * 64, vo = (size_t)(t + 1) * 64;
            ld0 = *(const u32x4*)(gk0 + ko); ld1 = *(const u32x4*)(gk1 + ko); ld2 = *(const u32x4*)(gr + ro); ld3 = *(const u32x4*)(gv0 + vo); ld4 = *(const u32x4*)(gv1 + vo); }
        if (64 * t <= q0 + 31) {
            f32x16 s0 = f32x16{}, s1 = f32x16{};
#pragma unroll
            for (int d = 0; d < 12; ++d) {
                const bf16x8 k0 = *(const LAS bf16x8*)(lds + cb + kfo + d * 32), k1 = *(const LAS bf16x8*)(lds + cb + kfo + 32 * KROW + d * 32);
                s0 = __builtin_amdgcn_mfma_f32_32x32x16_bf16(k0, qf[d], s0, 0, 0, 0);
                s1 = __builtin_amdgcn_mfma_f32_32x32x16_bf16(k1, qf[d], s1, 0, 0, 0);
            }
            if (64 * t + 63 > q0) {
                const int qi = q0 + r32, kb0 = 64 * t + 8 * hi;
#pragma unroll
                for (int r = 0; r < 16; ++r) { const int key = kb0 + 16 * (r >> 3) + (r & 7); if (key > qi) s0[r] = -1e30f; if (key + 32 > qi) s1[r] = -1e30f; }
            }
            float mx = fmaxf(s0[0], s1[0]);
#pragma unroll
            for (int r = 1; r < 16; ++r) mx = fmaxf(mx, fmaxf(s0[r], s1[r]));
            mx = fmaxf(mx, __shfl_xor(mx, 32));
            const float mnew = fmaxf(mrun, mx); const float alpha = __builtin_amdgcn_exp2f(mrun - mnew); mrun = mnew;
            float ps = 0.f;
#pragma unroll
            for (int r = 0; r < 16; ++r) { s0[r] = __builtin_amdgcn_exp2f(s0[r] - mnew); s1[r] = __builtin_amdgcn_exp2f(s1[r] - mnew); ps += s0[r] + s1[r]; }
            lrun = lrun * alpha + ps;
#pragma unroll
            for (int d = 0; d < 4; ++d) o[d] = o[d] * alpha;
            bf16x8 pf[4];
            { u32x4 w;
              w.x = cvt_pk_bf16(s0[0], s0[1]); w.y = cvt_pk_bf16(s0[2], s0[3]); w.z = cvt_pk_bf16(s0[4], s0[5]); w.w = cvt_pk_bf16(s0[6], s0[7]); pf[0] = __builtin_bit_cast(bf16x8, w);
              w.x = cvt_pk_bf16(s0[8], s0[9]); w.y = cvt_pk_bf16(s0[10], s0[11]); w.z = cvt_pk_bf16(s0[12], s0[13]); w.w = cvt_pk_bf16(s0[14], s0[15]); pf[1] = __builtin_bit_cast(bf16x8, w);
              w.x = cvt_pk_bf16(s1[0], s1[1]); w.y = cvt_pk_bf16(s1[2], s1[3]); w.z = cvt_pk_bf16(s1[4], s1[5]); w.w = cvt_pk_bf16(s1[6], s1[7]); pf[2] = __builtin_bit_cast(bf16x8, w);
              w.x = cvt_pk_bf16(s1[8], s1[9]); w.y = cvt_pk_bf16(s1[10], s1[11]); w.z = cvt_pk_bf16(s1[12], s1[13]); w.w = cvt_pk_bf16(s1[14], s1[15]); pf[3] = __builtin_bit_cast(bf16x8, w); }
#pragma unroll
            for (int d = 0; d < 4; ++d)
#pragma unroll
                for (int ks = 0; ks < 4; ++ks) {
                    const bf16x8 vf = *(const LAS bf16x8*)(lds + cb + vfo + d * 32 * VROW + ks * 32);
                    o[d] = __builtin_amdgcn_mfma_f32_32x32x16_bf16(vf, pf[ks], o[d], 0, 0, 0);
                }
        }
        if (more) { *(LAS u32x4*)(lds + nb + lk0) = ld0; *(LAS u32x4*)(lds + nb + lk1) = ld1; *(LAS u32x4*)(lds + nb + lr) = ld2; *(LAS u32x4*)(lds + nb + lv0) = ld3; *(LAS u32x4*)(lds + nb + lv1) = ld4; }
        __syncthreads();
    }
    lrun += __shfl_xor(lrun, 32);
    const float rl = __builtin_amdgcn_rcpf(lrun);
    bf16_t* op = o_out + (size_t)(tok0 + q0 + r32) * D + h * 128 + 4 * hi;
#pragma unroll
    for (int d = 0; d < 4; ++d)
#pragma unroll
        for (int r4 = 0; r4 < 4; ++r4) { u32x2 w; w.x = cvt_pk_bf16(o[d][4 * r4] * rl, o[d][4 * r4 + 1] * rl); w.y = cvt_pk_bf16(o[d][4 * r4 + 2] * rl, o[d][4 * r4 + 3] * rl);
            *(u32x2*)(op + 32 * d + 8 * r4) = w; }
}
__device__ __forceinline__ void p_attn(const Ctx& F, const Args& a) {
    const bf16_t* qn = (const bf16_t*)(a.ws + A_QN); const bf16_t* qr = (const bf16_t*)(a.ws + A_QR);
    const bf16_t* kn = (const bf16_t*)(a.ws + A_KN); const bf16_t* kr = (const bf16_t*)(a.ws + A_KR); const bf16_t* vt = (const bf16_t*)(a.ws + A_VT);
    bf16_t* oo = (bf16_t*)(a.ws + A_QN);
    for (int p = F.vcu; p < 512; p += F.G) {
        const int bh = p >> 3, s = p & 7;
        attn_unit(F.lds, qn, qr, kn, kr, vt, oo, bh >> 3, bh & 7, 15 - s, F.wave);
        attn_unit(F.lds, qn, qr, kn, kr, vt, oo, bh >> 3, bh & 7, s, F.wave);
    }
}

__device__ __forceinline__ void p_final(const Ctx& F, const Args& a) {
    float* h = a.out; const float* g = a.in[32];
    const int tid = fresh_tid(F.wave), lane = tid & 63, wave = __builtin_amdgcn_readfirstlane(tid >> 6);
    const int gw = F.vcu * 8 + wave, NGW = F.G * 8;
    f32x4 gv[4];
#pragma unroll
    for (int j = 0; j < 4; ++j) gv[j] = *((const f32x4*)g + lane + 64 * j);
    for (int m = gw; m < T; m += NGW) {
        f32x4 v[4]; float ss = 0.f;
#pragma unroll
        for (int j = 0; j < 4; ++j) { v[j] = *((const f32x4*)(h + (size_t)m * D) + lane + 64 * j); ss += (v[j][0] * v[j][0] + v[j][1] * v[j][1]) + (v[j][2] * v[j][2] + v[j][3] * v[j][3]); }
        const float rs = __builtin_amdgcn_rsqf(wave_sum(ss) * (1.0f / 1024.0f) + RMS_EPS);
#pragma unroll
        for (int j = 0; j < 4; ++j) *((f32x4*)(h + (size_t)m * D) + lane + 64 * j) = v[j] * rs * gv[j];
    }
}

__device__ __forceinline__ void my_grid_sync(unsigned* cnt, unsigned G, int wave_s) {
    asm volatile("s_waitcnt vmcnt(0) lgkmcnt(0)" ::: "memory");
    __syncthreads();
    if (fresh_tid(wave_s) == 0) {
        __builtin_amdgcn_fence(__ATOMIC_RELEASE, "agent");
        asm volatile("s_waitcnt vmcnt(0)" ::: "memory");
        __hip_atomic_fetch_add(cnt, 1u, __ATOMIC_RELAXED, __HIP_MEMORY_SCOPE_AGENT);
        while (__hip_atomic_load(cnt, __ATOMIC_RELAXED, __HIP_MEMORY_SCOPE_AGENT) < G) __builtin_amdgcn_s_sleep(4);
        __builtin_amdgcn_fence(__ATOMIC_ACQUIRE, "agent");
        asm volatile("s_waitcnt vmcnt(0)" ::: "memory");
    }
    __syncthreads();
}
#define GSYNC() do { my_grid_sync(bar_words + 64 * bar_idx, (unsigned)F.G, F.wave); ++bar_idx; } while (0)
#define RUN_GEMM(EPI_T, epi, Aptr, lda_, Bptr, ldb_, M_, N_, K_) do { pg8::Gemm g_{(const bf16_t*)(Aptr), (lda_), (const bf16_t*)(Bptr), (ldb_), (M_), (N_), (K_)}; \
    pg8::StaticOrder S_; S_.init((M_), (N_), F.G, (int)blockIdx.x); pg8::gemm_phase<EPI_T>(F.lds, g_, S_, (epi), F.wave); } while (0)

__global__ void __launch_bounds__(512, 2) fwd_mega(Args a) {
    extern __shared__ __attribute__((aligned(16))) unsigned char lds_raw[];
    cg::grid_group grid = cg::this_grid();
    Ctx F; F.lds = (LAS unsigned char*)lds_raw; F.wave = __builtin_amdgcn_readfirstlane((int)threadIdx.x >> 6);
    F.G = gridDim.x; { const int bx = blockIdx.x; F.vcu = (F.G % 8 == 0) ? (bx % 8) * (F.G / 8) + bx / 8 : bx; }
    unsigned char* ws = a.ws;
    float* slotsH = (float*)(ws + WS_SLOTH); float* slotsC = (float*)(ws + WS_SLOTC); float* slotsQ = (float*)(ws + WS_SLOTQ);
    bf16_t* HB = (bf16_t*)(ws + A_HB); bf16_t* MID = (bf16_t*)(ws + A_MID);
    const float* cosT = (const float*)(ws + A_COS); const float* sinT = (const float*)(ws + A_SIN);
    bf16_t* WUG = (bf16_t*)(ws + W_UG); bf16_t* WDN = (bf16_t*)(ws + W_DN);

    unsigned* bar_words = (unsigned*)ws;
    if (a.ph_hi - a.ph_lo > 1) grid.sync();
    if (a.ph_lo <= 0 && 0 < a.ph_hi) {
    p0_prologue(F, a);
    }
    if (a.ph_lo <= 0 && 1 < a.ph_hi) my_grid_sync(bar_words + 64 * 0, (unsigned)F.G, F.wave);
    if (a.ph_lo <= 1 && 1 < a.ph_hi) {
    { EpiSwiglu E{MID, slotsH, nullptr, nullptr, nullptr, nullptr, nullptr}; RUN_GEMM(EpiSwiglu, E, HB, D, WUG, D, T, 5632, D); }
    }
    if (a.ph_lo <= 1 && 2 < a.ph_hi) my_grid_sync(bar_words + 64 * 1, (unsigned)F.G, F.wave);
    if (a.ph_lo <= 2 && 2 < a.ph_hi) {
    { EpiResid E{a.in[0], a.out, nullptr, nullptr, 0.5f}; RUN_GEMM(EpiResid, E, MID, FF, WDN, FF, T, D, FF); }
    }
    if (a.ph_lo <= 2 && 3 < a.ph_hi) my_grid_sync(bar_words + 64 * 2, (unsigned)F.G, F.wave);
    if (a.ph_lo <= 3 && 3 < a.ph_hi) {
    p_premix(F, a);
    }
    if (a.ph_lo <= 3 && 4 < a.ph_hi) my_grid_sync(bar_words + 64 * 3, (unsigned)F.G, F.wave);
    if (a.ph_lo <= 4 && 4 < a.ph_hi) {
    { EpiRL E{(bf16_t*)(ws + A_R), (bf16_t*)(ws + A_LM)}; RUN_GEMM(EpiRL, E, ws + A_X1, 2048, ws + W_RL, 2048, T, 1280, 2048); }
    }
    if (a.ph_lo <= 4 && 5 < a.ph_hi) my_grid_sync(bar_words + 64 * 4, (unsigned)F.G, F.wave);
    if (a.ph_lo <= 5 && 5 < a.ph_hi) {
    { EpiBf16 E{(bf16_t*)(ws + A_KK), D}; RUN_GEMM(EpiBf16, E, ws + A_XK, D, ws + W_K, D, T, D, D); }
    }
    if (a.ph_lo <= 5 && 6 < a.ph_hi) my_grid_sync(bar_words + 64 * 5, (unsigned)F.G, F.wave);
    if (a.ph_lo <= 6 && 6 < a.ph_hi) {
    { EpiBf16 E{(bf16_t*)(ws + A_VV), D}; RUN_GEMM(EpiBf16, E, ws + A_XV, D, ws + W_V, D, T, D, D); }
    }
    if (a.ph_lo <= 6 && 7 < a.ph_hi) my_grid_sync(bar_words + 64 * 6, (unsigned)F.G, F.wave);
    if (a.ph_lo <= 7 && 7 < a.ph_hi) {
    { EpiLoraUp E{ws, a.in[11], a.in[14], 0, A_G}; RUN_GEMM(EpiLoraUp, E, ws + A_LM, 256, ws + W_LU, 256, T, 2048, 256); }
    }
    if (a.ph_lo <= 7 && 8 < a.ph_hi) my_grid_sync(bar_words + 64 * 7, (unsigned)F.G, F.wave);
    if (a.ph_lo <= 8 && 8 < a.ph_hi) {
    p_scan2(F, a);
    }
    if (a.ph_lo <= 8 && 9 < a.ph_hi) my_grid_sync(bar_words + 64 * 8, (unsigned)F.G, F.wave);
    if (a.ph_lo <= 9 && 9 < a.ph_hi) {
    { EpiLoraUp E{ws, a.in[11], a.in[14], 2, A_E}; RUN_GEMM(EpiLoraUp, E, ws + A_LM, 256, ws + W_LU + (size_t)2048 * 256 * 2, 256, T, 1024, 256); }
    }
    if (a.ph_lo <= 9 && 10 < a.ph_hi) my_grid_sync(bar_words + 64 * 9, (unsigned)F.G, F.wave);
    if (a.ph_lo <= 10 && 10 < a.ph_hi) {
    p_post(F, a);
    }
    if (a.ph_lo <= 10 && 11 < a.ph_hi) my_grid_sync(bar_words + 64 * 10, (unsigned)F.G, F.wave);
    if (a.ph_lo <= 11 && 11 < a.ph_hi) {
    { EpiResid E{a.out, a.out, HB, slotsH, 1.0f}; RUN_GEMM(EpiResid, E, ws + A_G, D, ws + W_O, D, T, D, D); }
    }
    if (a.ph_lo <= 11 && 12 < a.ph_hi) my_grid_sync(bar_words + 64 * 11, (unsigned)F.G, F.wave);
    if (a.ph_lo <= 12 && 12 < a.ph_hi) {
    { EpiSwiglu E{MID, slotsH, nullptr, nullptr, nullptr, nullptr, nullptr}; RUN_GEMM(EpiSwiglu, E, HB, D, WUG + (size_t)1 * 6144 * D, D, T, 5632, D); }
    }
    if (a.ph_lo <= 12 && 13 < a.ph_hi) my_grid_sync(bar_words + 64 * 12, (unsigned)F.G, F.wave);
    if (a.ph_lo <= 13 && 13 < a.ph_hi) {
    { EpiResid E{a.out, a.out, HB, slotsH, 0.5f}; RUN_GEMM(EpiResid, E, MID, FF, WDN + (size_t)1 * D * FF, FF, T, D, FF); }
    }
    if (a.ph_lo <= 13 && 14 < a.ph_hi) my_grid_sync(bar_words + 64 * 13, (unsigned)F.G, F.wave);
    if (a.ph_lo <= 14 && 14 < a.ph_hi) {
    { EpiSwiglu E{MID, slotsH, (bf16_t*)(ws + A_C), slotsC, (bf16_t*)(ws + A_KR), cosT, sinT}; RUN_GEMM(EpiSwiglu, E, HB, D, WUG + (size_t)2 * 6144 * D, D, T, 6144, D); }
    }
    if (a.ph_lo <= 14 && 15 < a.ph_hi) my_grid_sync(bar_words + 64 * 14, (unsigned)F.G, F.wave);
    if (a.ph_lo <= 15 && 15 < a.ph_hi) {
    { EpiResid E{a.out, a.out, HB, slotsH, 0.5f}; RUN_GEMM(EpiResid, E, MID, FF, WDN + (size_t)2 * D * FF, FF, T, D, FF); }
    }
    if (a.ph_lo <= 15 && 16 < a.ph_hi) my_grid_sync(bar_words + 64 * 15, (unsigned)F.G, F.wave);
    if (a.ph_lo <= 16 && 16 < a.ph_hi) {
    { EpiKnope E{(bf16_t*)(ws + A_KN), slotsC}; RUN_GEMM(EpiKnope, E, ws + A_C, 256, ws + W_KN, 256, T, D, 256); }
    }
    if (a.ph_lo <= 16 && 17 < a.ph_hi) my_grid_sync(bar_words + 64 * 16, (unsigned)F.G, F.wave);
    if (a.ph_lo <= 17 && 17 < a.ph_hi) {
    { EpiVt E{(bf16_t*)(ws + A_VT), slotsC}; RUN_GEMM(EpiVt, E, ws + W_VT, 256, ws + A_C, 256, D, T, 256); }
    }
    if (a.ph_lo <= 17 && 18 < a.ph_hi) my_grid_sync(bar_words + 64 * 17, (unsigned)F.G, F.wave);
    if (a.ph_lo <= 18 && 18 < a.ph_hi) {
    { EpiQlat E{(bf16_t*)(ws + A_QLAT), slotsH, slotsQ}; RUN_GEMM(EpiQlat, E, HB, D, ws + W_DQ, D, T, 512, D); }
    }
    if (a.ph_lo <= 18 && 19 < a.ph_hi) my_grid_sync(bar_words + 64 * 18, (unsigned)F.G, F.wave);
    if (a.ph_lo <= 19 && 19 < a.ph_hi) {
    { EpiQ E{(bf16_t*)(ws + A_QN), (bf16_t*)(ws + A_QR), slotsQ, cosT, sinT}; RUN_GEMM(EpiQ, E, ws + A_QLAT, 512, ws + W_UQ, 512, T, 1536, 512); }
    }
    if (a.ph_lo <= 19 && 20 < a.ph_hi) my_grid_sync(bar_words + 64 * 19, (unsigned)F.G, F.wave);
    if (a.ph_lo <= 20 && 20 < a.ph_hi) {
    p_attn(F, a);
    }
    if (a.ph_lo <= 20 && 21 < a.ph_hi) my_grid_sync(bar_words + 64 * 20, (unsigned)F.G, F.wave);
    if (a.ph_lo <= 21 && 21 < a.ph_hi) {
    { EpiResid E{a.out, a.out, HB, slotsH, 1.0f}; RUN_GEMM(EpiResid, E, ws + A_QN, D, ws + W_MO, D, T, D, D); }
    }
    if (a.ph_lo <= 21 && 22 < a.ph_hi) my_grid_sync(bar_words + 64 * 21, (unsigned)F.G, F.wave);
    if (a.ph_lo <= 22 && 22 < a.ph_hi) {
    { EpiSwiglu E{MID, slotsH, nullptr, nullptr, nullptr, nullptr, nullptr}; RUN_GEMM(EpiSwiglu, E, HB, D, WUG + (size_t)3 * 6144 * D, D, T, 5632, D); }
    }
    if (a.ph_lo <= 22 && 23 < a.ph_hi) my_grid_sync(bar_words + 64 * 22, (unsigned)F.G, F.wave);
    if (a.ph_lo <= 23 && 23 < a.ph_hi) {
    { EpiResid E{a.out, a.out, nullptr, nullptr, 0.5f}; RUN_GEMM(EpiResid, E, MID, FF, WDN + (size_t)3 * D * FF, FF, T, D, FF); }
    }
    if (a.ph_lo <= 23 && 24 < a.ph_hi) my_grid_sync(bar_words + 64 * 23, (unsigned)F.G, F.wave);
    if (a.ph_lo <= 24 && 24 < a.ph_hi) {
    p_final(F, a);
    }
}

extern "C" void kernel_launch(void* const* d_in, const int* in_sizes, int n_in, void* d_out, int out_size, void* d_ws, size_t ws_size, hipStream_t stream) {
    static int grid = 0;
    if (grid == 0) {
        if (n_in != 33 || out_size != T * D || ws_size < WS_NEED) { fprintf(stderr, "kernel_launch: unexpected shapes: n_in %d out %d ws %zu (need %zu)\n", n_in, out_size, ws_size, (size_t)WS_NEED); grid = -1; return; }
        int dev = 0, cus = 0, per_cu = 0;
        (void)hipGetDevice(&dev); (void)hipDeviceGetAttribute(&cus, hipDeviceAttributeMultiprocessorCount, dev);
        (void)hipFuncSetAttribute((const void*)fwd_mega, hipFuncAttributeMaxDynamicSharedMemorySize, LDS_BYTES);
        (void)hipOccupancyMaxActiveBlocksPerMultiprocessor(&per_cu, (const void*)fwd_mega, 512, LDS_BYTES);
        (void)hipGetLastError();
        grid = cus > 0 ? cus : 256;
        if (grid > 256) grid = 256;
    }
    if (grid < 0) return;
    (void)hipMemsetAsync(d_ws, 0, 65536, stream);
    Args a{};
    for (int i = 0; i < 33; ++i) a.in[i] = (const float*)d_in[i];
    a.pos = (const int*)d_in[1]; a.out = (float*)d_out; a.ws = (unsigned char*)d_ws;
    hipError_t e = hipSuccess;
#if N_LAUNCHES == 1
    a.ph_lo = 0; a.ph_hi = NPHASES;
    { void* args[] = {&a}; e = hipLaunchCooperativeKernel((void*)fwd_mega, dim3(grid), dim3(512), args, LDS_BYTES, stream); }
#else
    for (int p = 0; p < NPHASES; ++p) { a.ph_lo = p; a.ph_hi = p + 1; hipLaunchKernelGGL(fwd_mega, dim3(grid), dim3(512), LDS_BYTES, stream, a); }
    e = hipPeekAtLastError();
#endif
    if (e != hipSuccess) fprintf(stderr, "cooperative launch failed: %s (grid %d)\n", hipGetErrorString(e), grid);
}
```

```cpp
#include <hip/hip_runtime.h>
#include <hip/hip_cooperative_groups.h>
#include <cstdio>
#include <cstdint>
namespace cg = cooperative_groups;

#define LAS __attribute__((address_space(3)))
typedef unsigned short bf16_t;
typedef short bf16x8 __attribute__((ext_vector_type(8)));
typedef float f32x4 __attribute__((ext_vector_type(4)));
typedef float f32x16 __attribute__((ext_vector_type(16)));
typedef unsigned u32x4 __attribute__((ext_vector_type(4)));
typedef unsigned u32x2 __attribute__((ext_vector_type(2)));

constexpr int T = 32768, D = 1024, FF = 2816, SEQ = 4096, NB = 8;
constexpr float RMS_EPS = 1e-6f, GN_EPS = 64e-5f;
constexpr float LOG2E = 1.4426950408889634f;
constexpr float QSCALE = 0.07216878364870322f * 1.4426950408889634f;

constexpr size_t MiB = 1u << 20;
constexpr size_t WS_SLOTH = MiB / 2;
constexpr size_t WS_SLOTC = WS_SLOTH + 2 * MiB;
constexpr size_t WS_SLOTQ = WS_SLOTC + MiB / 2;
constexpr size_t WS_W = 4 * MiB;
constexpr size_t W_UG = WS_W;
constexpr size_t W_DN = W_UG + 48 * MiB;
constexpr size_t W_R = W_DN + 22 * MiB;
constexpr size_t W_K = W_R + 2 * MiB;
constexpr size_t W_V = W_K + 2 * MiB;
constexpr size_t W_O = W_V + 2 * MiB;
constexpr size_t W_LD = W_O + 2 * MiB;
constexpr size_t W_LU = W_LD + 1 * MiB;
constexpr size_t W_KN = W_LU + 2 * MiB;
constexpr size_t W_VT = W_KN + MiB / 2;
constexpr size_t W_DQ = W_VT + MiB / 2;
constexpr size_t W_UQ = W_DQ + 1 * MiB;
constexpr size_t W_MO = W_UQ + 2 * MiB;
constexpr size_t W_END = W_MO + 2 * MiB;
constexpr size_t WS_A = 92 * MiB;
static_assert(W_END <= WS_A, "weights region");
constexpr size_t A_HB = WS_A + 0;
constexpr size_t A_MID = WS_A + 64 * MiB;
constexpr size_t A_C = WS_A + 240 * MiB;
constexpr size_t A_KR = WS_A + 256 * MiB;
constexpr size_t A_KN = WS_A + 260 * MiB;
constexpr size_t A_VT = WS_A + 324 * MiB;
constexpr size_t A_QLAT = A_MID;
constexpr size_t A_QN = A_MID + 32 * MiB;
constexpr size_t A_QR = A_MID + 96 * MiB;
constexpr size_t A_X1 = WS_A + 0;
constexpr size_t A_XK = WS_A + 128 * MiB;
constexpr size_t A_XV = WS_A + 192 * MiB;
constexpr size_t A_R = WS_A + 256 * MiB;
constexpr size_t A_LM = WS_A + 320 * MiB;
constexpr size_t A_KK = WS_A + 0;
constexpr size_t A_VV = WS_A + 64 * MiB;
constexpr size_t A_E = WS_A + 128 * MiB;
constexpr size_t A_AA = WS_A + 192 * MiB;
constexpr size_t A_G = WS_A + 336 * MiB;
constexpr size_t A_BON = WS_A + 400 * MiB;
constexpr size_t A_COS = WS_A + 404 * MiB;
constexpr size_t A_SIN = WS_A + 408 * MiB;
constexpr size_t W_RL = WS_A + 412 * MiB;
constexpr size_t WS_NEED = 512 * MiB;

constexpr int LDS_BYTES = 147456;
constexpr int NPHASES = 22;
#ifndef N_LAUNCHES
#define N_LAUNCHES 1
#endif

__device__ __forceinline__ unsigned cvt_pk_bf16(float lo, float hi) { unsigned r; asm volatile("v_cvt_pk_bf16_f32 %0, %1, %2" : "=v"(r) : "v"(lo), "v"(hi)); return r; }
__device__ __forceinline__ float fsigmoid(float x) { return __builtin_amdgcn_rcpf(1.0f + __builtin_amdgcn_exp2f(-x * LOG2E)); }
__device__ __forceinline__ float ftanh(float x) { return 1.0f - 2.0f * __builtin_amdgcn_rcpf(1.0f + __builtin_amdgcn_exp2f(2.0f * LOG2E * x)); }
__device__ __forceinline__ float wave_sum(float v) {
#pragma unroll
    for (int o = 1; o < 64; o <<= 1) v += __shfl_xor(v, o);
    return v;
}
template <int CTRL> __device__ __forceinline__ float dpp_mov(float x) { return __builtin_bit_cast(float, __builtin_amdgcn_update_dpp(0, __builtin_bit_cast(int, x), CTRL, 0xf, 0xf, true)); }
__device__ __forceinline__ float red8(float x) { x += dpp_mov<0xB1>(x); x += dpp_mov<0x4E>(x); x += dpp_mov<0x141>(x); return x; }
__device__ __forceinline__ float red16(float x) { x = red8(x); x += dpp_mov<0x140>(x); return x; }
__device__ __forceinline__ float sum4(f32x4 v) { return (v[0] + v[1]) + (v[2] + v[3]); }
__device__ __forceinline__ float rstd_slots16(const float* s, int row) {
    const f32x4* p = (const f32x4*)(s + (size_t)row * 16);
    const f32x4 a = p[0], b = p[1], c = p[2], d = p[3];
    return __builtin_amdgcn_rsqf((sum4(a) + sum4(b) + sum4(c) + sum4(d)) * (1.0f / 1024.0f) + RMS_EPS);
}
__device__ __forceinline__ f32x4 unpack4(u32x2 p) { f32x4 r; r[0] = __uint_as_float(p.x << 16); r[1] = __uint_as_float(p.x & 0xffff0000u); r[2] = __uint_as_float(p.y << 16); r[3] = __uint_as_float(p.y & 0xffff0000u); return r; }

__device__ __forceinline__ int fresh_tid(int wave_s) { int l; asm volatile("v_mbcnt_lo_u32_b32 %0, -1, 0\n\tv_mbcnt_hi_u32_b32 %0, -1, %0" : "=v"(l)); return wave_s * 64 + l; }

namespace pg8 {
constexpr int BM = 256, BK = 64, HALF = 128, HTB = HALF * BK * 2, STAGE_BYTES = 8 * HTB, NXCD = 8, WGM = 8;
__device__ __forceinline__ int lds_byte(int r, int c) { const int st = (r >> 4) * 2 + (c >> 5), rr = r & 15, cc = c & 31, ob = rr * 64 + cc * 2; return st * 1024 + (ob ^ (((ob >> 9) & 1) << 5)); }
__device__ __forceinline__ void stage_rc(int b, int& R, int& C) { const int st = b / 1024, sb = b % 1024, swz = sb ^ (((sb >> 9) & 1) << 5); R = (st >> 1) * 16 + swz / 64; C = (st & 1) * 32 + (swz % 64) / 2; }
__device__ __forceinline__ int perm32(int rho) { const int n = rho >> 4, i = rho & 15; return 8 * (i >> 2) + 4 * n + (i & 3); }
struct Unit { int pm, pn; };
struct Gemm { const bf16_t* A; int lda; const bf16_t* Bt; int ldb; int M, N, K; };
struct StaticOrder {
    int nM, nN, nwg, G, c;
    __device__ void init(int M, int N, int G_, int c_) { nM = M / BM; nN = N / BM; nwg = nM * nN; G = G_; c = c_; }
    __device__ bool next(int i, Unit& u) const {
        const long L = (long)i * G + c; if (L >= nwg) return false;
        int wgid = (int)L; { const int q = nwg / NXCD, r = nwg % NXCD, xcd = wgid % NXCD, off = wgid / NXCD; wgid = (xcd < r ? xcd * (q + 1) : r * (q + 1) + (xcd - r) * q) + off; }
        const int nig = WGM * nN, gid = wgid / nig, fm = gid * WGM, gsz = (nM - fm) < WGM ? (nM - fm) : WGM;
        u.pm = fm + ((wgid % nig) % gsz); u.pn = (wgid % nig) / gsz; return true;
    }
};

template <class Epi>
__device__ __forceinline__ void gemm_phase(LAS unsigned char* lds, const Gemm g, const StaticOrder& S, const Epi& E, int wave_s) {
    const int tid = fresh_tid(wave_s), wid = __builtin_amdgcn_readfirstlane(tid >> 6), lane = tid & 63, wr = wid >> 2, wc = wid & 3, fr = lane & 15, fq = lane >> 4;
    const int K = g.K, nt = K / BK;
    unsigned voffA[2], voffB[2];
#pragma unroll
    for (int i = 0; i < 2; ++i) { int R, C; stage_rc(tid * 16 + i * 8192, R, C); const int Rb = Epi::PERM ? ((R & ~31) + perm32(R & 31)) : R;
        voffA[i] = (unsigned)(R * g.lda + C) * 2u; voffB[i] = (unsigned)(Rb * g.ldb + C) * 2u; }
    const size_t kstep = (size_t)(BK * 2);
    const size_t hstepA = (size_t)HALF * g.lda * 2, hstepB = (size_t)HALF * g.ldb * 2;
    const size_t tstepA = 2 * hstepA, tstepB = 2 * hstepB;
    const unsigned ldsw = (unsigned)wid * 1024u;
    const int aoff = lds_byte(wr * 64 + fr, fq * 8), boff = lds_byte(wc * 32 + fr, fq * 8);
#define PG8_SA(b, h) (((b) * 2 + (h)) * HTB)
#define PG8_SB(b, h) ((4 + (b) * 2 + (h)) * HTB)
#define PG8_STAGE(bufoff, gbase, voff) do { _Pragma("unroll") for (int _i = 0; _i < 2; ++_i) \
        __builtin_amdgcn_global_load_lds((const unsigned*)((const char*)(gbase) + (voff)[_i]), (LAS unsigned*)(lds + (bufoff) + ldsw + _i * 8192), 16, 0, 0); } while (0)
#define PG8_LDA(dst, b, h) do { _Pragma("unroll") for (int m = 0; m < 4; ++m) _Pragma("unroll") for (int k = 0; k < 2; ++k) dst[m][k] = *(const LAS bf16x8*)(lds + PG8_SA(b, h) + aoff + m * 2048 + k * 1024); } while (0)
#define PG8_LDB(dst, b, h) do { _Pragma("unroll") for (int n = 0; n < 2; ++n) _Pragma("unroll") for (int k = 0; k < 2; ++k) dst[n][k] = *(const LAS bf16x8*)(lds + PG8_SB(b, h) + boff + n * 2048 + k * 1024); } while (0)
#define PG8_MMA(ai, bj, At, Bt) do { __builtin_amdgcn_s_setprio(1); _Pragma("unroll") for (int m = 0; m < 4; ++m) _Pragma("unroll") for (int n = 0; n < 2; ++n) _Pragma("unroll") for (int k = 0; k < 2; ++k) \
        acc[ai][bj][m][n] = __builtin_amdgcn_mfma_f32_16x16x32_bf16(Bt[n][k], At[m][k], acc[ai][bj][m][n], 0, 0, 0); __builtin_amdgcn_s_setprio(0); } while (0)
#define PG8_WAIT_V(n) asm volatile("s_waitcnt vmcnt(" #n ")" ::: "memory")
#define PG8_WAIT_L(n) asm volatile("s_waitcnt lgkmcnt(" #n ")" ::: "memory")
#define PG8_BAR __builtin_amdgcn_s_barrier()
#define PG8_SCHED __builtin_amdgcn_sched_barrier(0)
    Unit cur, nxt; int ui = 0;
    if (!S.next(0, cur)) return;
    f32x4 acc[2][2][4][2];
#pragma unroll
    for (int a = 0; a < 2; ++a)
#pragma unroll
        for (int b = 0; b < 2; ++b)
#pragma unroll
            for (int m = 0; m < 4; ++m)
#pragma unroll
                for (int n = 0; n < 2; ++n) acc[a][b][m][n] = (f32x4){0.f, 0.f, 0.f, 0.f};
    bf16x8 At[4][2], B0[2][2], B1[2][2];
    const char* cA = (const char*)g.A + (size_t)cur.pm * tstepA; const char* cB = (const char*)g.Bt + (size_t)cur.pn * tstepB;
    PG8_STAGE(PG8_SB(0, 0), cB, voffB); PG8_STAGE(PG8_SB(0, 1), cB + hstepB, voffB); PG8_STAGE(PG8_SA(0, 0), cA, voffA); PG8_STAGE(PG8_SA(0, 1), cA + hstepA, voffA);
    if (wr == 1) PG8_BAR;
    PG8_WAIT_V(2); PG8_BAR;
    PG8_STAGE(PG8_SB(1, 0), cB + kstep, voffB); PG8_STAGE(PG8_SA(1, 0), cA + kstep, voffA); PG8_STAGE(PG8_SB(1, 1), cB + hstepB + kstep, voffB);
    PG8_WAIT_V(6); PG8_BAR;
    for (;;) {
        const bool has_next = S.next(ui + 1, nxt);
        const char* nA = has_next ? (const char*)g.A + (size_t)nxt.pm * tstepA : cA; const char* nB = has_next ? (const char*)g.Bt + (size_t)nxt.pn * tstepB : cB;
        for (int t = 0; t < nt; t += 2) {
            const bool last = (t == nt - 2);
            const char* a1 = cA + (size_t)(t + 1) * kstep;
            const char* a2 = last ? nA : cA + (size_t)(t + 2) * kstep; const char* b2 = last ? nB : cB + (size_t)(t + 2) * kstep;
            const char* a3 = a2 + kstep; const char* b3 = b2 + kstep;
            PG8_LDB(B0, 0, 0); PG8_LDB(B1, 0, 1); PG8_SCHED; PG8_LDA(At, 0, 0); PG8_STAGE(PG8_SA(1, 1), a1 + hstepA, voffA);
            PG8_WAIT_V(8); PG8_WAIT_L(0); PG8_BAR; PG8_MMA(0, 0, At, B0); PG8_MMA(0, 1, At, B1); PG8_BAR; PG8_SCHED;
            PG8_LDA(At, 0, 1); PG8_STAGE(PG8_SB(0, 0), b2, voffB); PG8_STAGE(PG8_SB(0, 1), b2 + hstepB, voffB); PG8_STAGE(PG8_SA(0, 0), a2, voffA);
            PG8_WAIT_V(8); PG8_WAIT_L(0); PG8_BAR; PG8_MMA(1, 0, At, B0); PG8_MMA(1, 1, At, B1); PG8_BAR; PG8_SCHED;
            PG8_LDB(B0, 1, 0); PG8_LDB(B1, 1, 1); PG8_SCHED; PG8_LDA(At, 1, 0); PG8_STAGE(PG8_SA(0, 1), a2 + hstepA, voffA);
            PG8_WAIT_V(8); PG8_WAIT_L(0); PG8_BAR; PG8_MMA(0, 0, At, B0); PG8_MMA(0, 1, At, B1); PG8_BAR; PG8_SCHED;
            PG8_LDA(At, 1, 1); PG8_STAGE(PG8_SB(1, 0), b3, voffB); PG8_STAGE(PG8_SB(1, 1), b3 + hstepB, voffB); PG8_STAGE(PG8_SA(1, 0), a3, voffA);
            PG8_WAIT_V(8); PG8_WAIT_L(0); PG8_BAR; PG8_MMA(1, 0, At, B0); PG8_MMA(1, 1, At, B1); PG8_BAR; PG8_SCHED;
        }
        if (wr == 0) PG8_BAR;
        E(acc, cur, wr, wc, fr, fq);
        if (!has_next) break;
#pragma unroll
        for (int a = 0; a < 2; ++a)
#pragma unroll
            for (int b = 0; b < 2; ++b)
#pragma unroll
                for (int m = 0; m < 4; ++m)
#pragma unroll
                    for (int n = 0; n < 2; ++n) acc[a][b][m][n] = (f32x4){0.f, 0.f, 0.f, 0.f};
        cur = nxt; cA = nA; cB = nB; ++ui;
        if (wr == 1) PG8_BAR;
    }
    PG8_WAIT_V(0);
    PG8_BAR;
#undef PG8_SA
#undef PG8_SB
#undef PG8_STAGE
#undef PG8_LDA
#undef PG8_LDB
#undef PG8_MMA
#undef PG8_WAIT_V
#undef PG8_WAIT_L
#undef PG8_BAR
#undef PG8_SCHED
}
}
using pg8::Unit;
typedef f32x4 AccT[2][2][4][2];

__device__ __forceinline__ u32x4 pack8(f32x4 a, f32x4 b) { u32x4 w; w.x = cvt_pk_bf16(a[0], a[1]); w.y = cvt_pk_bf16(a[2], a[3]); w.z = cvt_pk_bf16(b[0], b[1]); w.w = cvt_pk_bf16(b[2], b[3]); return w; }

struct EpiSwiglu {
    static constexpr bool PERM = true;
    bf16_t* mid; const float* slotsH; bf16_t* cbuf; float* slotsC; bf16_t* krope; const float* cosT; const float* sinT;
    __device__ __forceinline__ void operator()(const AccT& acc, const Unit& u, int wr, int wc, int fr, int fq) const {
        const int row0 = u.pm * 256 + wr * 64 + fr;
        if (u.pn < 22) {
#pragma unroll
            for (int ai = 0; ai < 2; ++ai)
#pragma unroll
                for (int m = 0; m < 4; ++m) {
                    const int row = row0 + ai * 128 + m * 16; const float rs = rstd_slots16(slotsH, row);
                    f32x4 o[2];
#pragma unroll
                    for (int n = 0; n < 2; ++n)
#pragma unroll
                        for (int i = 0; i < 4; ++i) { const float gt = acc[ai][0][m][n][i] * rs, up = acc[ai][1][m][n][i] * rs; o[n][i] = gt * fsigmoid(gt) * up; }
                    *(u32x4*)(mid + (size_t)row * FF + u.pn * 128 + wc * 32 + fq * 8) = pack8(o[0], o[1]);
                }
        } else if (u.pn == 22) {
#pragma unroll
            for (int ai = 0; ai < 2; ++ai)
#pragma unroll
                for (int m = 0; m < 4; ++m) {
                    const int row = row0 + ai * 128 + m * 16; const float rs = rstd_slots16(slotsH, row);
                    float ss = 0.f;
#pragma unroll
                    for (int bj = 0; bj < 2; ++bj) { const f32x4 a = acc[ai][bj][m][0] * rs, b = acc[ai][bj][m][1] * rs;
                        ss += (a[0] * a[0] + a[1] * a[1]) + (a[2] * a[2] + a[3] * a[3]) + (b[0] * b[0] + b[1] * b[1]) + (b[2] * b[2] + b[3] * b[3]);
                        *(u32x4*)(cbuf + (size_t)row * 256 + bj * 128 + wc * 32 + fq * 8) = pack8(a, b); }
                    ss += __shfl_xor(ss, 16); ss += __shfl_xor(ss, 32);
                    if (fq == 0) slotsC[(size_t)row * 4 + wc] = ss;
                }
        } else if (wc == 0) {
#pragma unroll
            for (int ai = 0; ai < 2; ++ai)
#pragma unroll
                for (int m = 0; m < 4; ++m) {
                    const int row = row0 + ai * 128 + m * 16; const float rs = rstd_slots16(slotsH, row);
                    f32x4 o1[2], o2[2];
#pragma unroll
                    for (int n = 0; n < 2; ++n) { const f32x4 c = *(const f32x4*)(cosT + (size_t)row * 32 + fq * 8 + n * 4), s = *(const f32x4*)(sinT + (size_t)row * 32 + fq * 8 + n * 4);
                        const f32x4 x1 = acc[ai][0][m][n] * rs, x2 = acc[ai][1][m][n] * rs; o1[n] = x1 * c - x2 * s; o2[n] = x2 * c + x1 * s; }
                    *(u32x4*)(krope + (size_t)row * 64 + fq * 8) = pack8(o1[0], o1[1]);
                    *(u32x4*)(krope + (size_t)row * 64 + 32 + fq * 8) = pack8(o2[0], o2[1]);
                }
        }
    }
};
struct EpiResid {
    static constexpr bool PERM = false;
    const float* hin; float* hout; bf16_t* hb; float* slots; float alpha;
    __device__ __forceinline__ void operator()(const AccT& acc, const Unit& u, int wr, int wc, int fr, int fq) const {
        const int row0 = u.pm * 256 + wr * 64 + fr, col0 = u.pn * 256 + wc * 32 + 4 * fq;
#pragma unroll
        for (int ai = 0; ai < 2; ++ai)
#pragma unroll
            for (int m = 0; m < 4; ++m) {
                const int row = row0 + ai * 128 + m * 16; const size_t off = (size_t)row * D + col0; float ss = 0.f;
#pragma unroll
                for (int bj = 0; bj < 2; ++bj)
#pragma unroll
                    for (int n = 0; n < 2; ++n) { const size_t o2 = off + bj * 128 + n * 16; const f32x4 b = *(const f32x4*)(hin + o2); const f32x4 o = b + acc[ai][bj][m][n] * alpha;
                        *(f32x4*)(hout + o2) = o; ss += (o[0] * o[0] + o[1] * o[1]) + (o[2] * o[2] + o[3] * o[3]);
                        if (hb) { u32x2 w; w.x = cvt_pk_bf16(o[0], o[1]); w.y = cvt_pk_bf16(o[2], o[3]); *(u32x2*)(hb + o2) = w; } }
                if (slots) { ss += __shfl_xor(ss, 16); ss += __shfl_xor(ss, 32); if (fq == 0) slots[(size_t)row * 16 + u.pn * 4 + wc] = ss; }
                if (m & 1) asm volatile("" ::: "memory");
            }
    }
};
struct EpiBf16 {
    static constexpr bool PERM = true;
    bf16_t* O; int ldc;
    __device__ __forceinline__ void operator()(const AccT& acc, const Unit& u, int wr, int wc, int fr, int fq) const {
        const int row0 = u.pm * 256 + wr * 64 + fr, col0 = u.pn * 256 + wc * 32 + 8 * fq;
#pragma unroll
        for (int ai = 0; ai < 2; ++ai)
#pragma unroll
            for (int m = 0; m < 4; ++m) { bf16_t* rp = O + (size_t)(row0 + ai * 128 + m * 16) * ldc + col0;
#pragma unroll
                for (int bj = 0; bj < 2; ++bj) *(u32x4*)(rp + bj * 128) = pack8(acc[ai][bj][m][0], acc[ai][bj][m][1]); }
    }
};
struct EpiLoraDown {
    static constexpr bool PERM = true;
    bf16_t* O;
    __device__ __forceinline__ void operator()(const AccT& acc, const Unit& u, int wr, int wc, int fr, int fq) const {
        const int row0 = u.pm * 256 + wr * 64 + fr, col0 = wc * 32 + 8 * fq;
#pragma unroll
        for (int ai = 0; ai < 2; ++ai)
#pragma unroll
            for (int m = 0; m < 4; ++m) { bf16_t* rp = O + (size_t)(row0 + ai * 128 + m * 16) * 256 + col0;
                f32x4 a = acc[ai][0][m][0], b = acc[ai][0][m][1];
                if (wc < 2) {
#pragma unroll
                    for (int i = 0; i < 4; ++i) { a[i] = ftanh(a[i]); b[i] = ftanh(b[i]); } }
                *(u32x4*)(rp) = pack8(a, b);
                a = acc[ai][1][m][0]; b = acc[ai][1][m][1];
#pragma unroll
                for (int i = 0; i < 4; ++i) { a[i] = fsigmoid(a[i]); b[i] = fsigmoid(b[i]); }
                *(u32x4*)(rp + 128) = pack8(a, b); }
    }
};
struct EpiRL {
    static constexpr bool PERM = true;
    bf16_t* R; bf16_t* O;
    __device__ __forceinline__ void operator()(const AccT& acc, const Unit& u, int wr, int wc, int fr, int fq) const {
        const int row0 = u.pm * 256 + wr * 64 + fr;
        if (u.pn < 4) {
            const int col0 = u.pn * 256 + wc * 32 + 8 * fq;
#pragma unroll
            for (int ai = 0; ai < 2; ++ai)
#pragma unroll
                for (int m = 0; m < 4; ++m) { bf16_t* rp = R + (size_t)(row0 + ai * 128 + m * 16) * D + col0;
#pragma unroll
                    for (int bj = 0; bj < 2; ++bj) *(u32x4*)(rp + bj * 128) = pack8(acc[ai][bj][m][0], acc[ai][bj][m][1]); }
        } else {
            const int col0 = wc * 32 + 8 * fq;
#pragma unroll
            for (int ai = 0; ai < 2; ++ai)
#pragma unroll
                for (int m = 0; m < 4; ++m) { bf16_t* rp = O + (size_t)(row0 + ai * 128 + m * 16) * 256 + col0;
                    f32x4 a = acc[ai][0][m][0], b = acc[ai][0][m][1];
                    if (wc < 2) {
#pragma unroll
                        for (int i = 0; i < 4; ++i) { a[i] = ftanh(a[i]); b[i] = ftanh(b[i]); } }
                    *(u32x4*)(rp) = pack8(a, b);
                    a = acc[ai][1][m][0]; b = acc[ai][1][m][1];
#pragma unroll
                    for (int i = 0; i < 4; ++i) { a[i] = fsigmoid(a[i]); b[i] = fsigmoid(b[i]); }
                    *(u32x4*)(rp + 128) = pack8(a, b); }
        }
    }
};
struct EpiLoraUp {
    static constexpr bool PERM = true;
    unsigned char* wsb; const float* w0; const float* a0; int grp0; size_t goff;
    __device__ __forceinline__ void operator()(const AccT& acc, const Unit& u, int wr, int wc, int fr, int fq) const {
        const int grp = (u.pn >> 2) + grp0, colt = (u.pn & 3) * 256;
        const int row0 = u.pm * 256 + wr * 64 + fr, col0 = colt + wc * 32 + 8 * fq;
        size_t ooff = goff; if (grp == 0) ooff = A_E; if (grp == 1) ooff = A_AA;
        bf16_t* O = (bf16_t*)(wsb + ooff); const float* bias = grp == 0 ? w0 : a0;
#pragma unroll
        for (int ai = 0; ai < 2; ++ai)
#pragma unroll
            for (int m = 0; m < 4; ++m) { bf16_t* rp = O + (size_t)(row0 + ai * 128 + m * 16) * D + col0;
#pragma unroll
                for (int bj = 0; bj < 2; ++bj) { f32x4 a = acc[ai][bj][m][0], b = acc[ai][bj][m][1];
                    if (grp < 2) { const float sc = grp == 0 ? 0.6065306597126334f : 1.0f;
                        const f32x4 b0 = *(const f32x4*)(bias + col0 + bj * 128), b1 = *(const f32x4*)(bias + col0 + bj * 128 + 4);
                        a = a + b0; b = b + b1;
#pragma unroll
                        for (int i = 0; i < 4; ++i) { a[i] = sc * fsigmoid(a[i]); b[i] = sc * fsigmoid(b[i]); } }
                    *(u32x4*)(rp + bj * 128) = pack8(a, b); }
                asm volatile("" ::: "memory"); }
    }
};
struct EpiQlat {
    static constexpr bool PERM = true;
    bf16_t* O; const float* slotsH; float* slotsQ;
    __device__ __forceinline__ void operator()(const AccT& acc, const Unit& u, int wr, int wc, int fr, int fq) const {
        const int row0 = u.pm * 256 + wr * 64 + fr, col0 = u.pn * 256 + wc * 32 + 8 * fq;
#pragma unroll
        for (int ai = 0; ai < 2; ++ai)
#pragma unroll
            for (int m = 0; m < 4; ++m) { const int row = row0 + ai * 128 + m * 16; const float rs = rstd_slots16(slotsH, row); float ss = 0.f;
#pragma unroll
                for (int bj = 0; bj < 2; ++bj) { const f32x4 a = acc[ai][bj][m][0] * rs, b = acc[ai][bj][m][1] * rs;
                    ss += (a[0] * a[0] + a[1] * a[1]) + (a[2] * a[2] + a[3] * a[3]) + (b[0] * b[0] + b[1] * b[1]) + (b[2] * b[2] + b[3] * b[3]);
                    *(u32x4*)(O + (size_t)row * 512 + col0 + bj * 128) = pack8(a, b); }
                ss += __shfl_xor(ss, 16); ss += __shfl_xor(ss, 32);
                if (fq == 0) slotsQ[(size_t)row * 8 + u.pn * 4 + wc] = ss; }
    }
};
struct EpiQ {
    static constexpr bool PERM = true;
    bf16_t* qn; bf16_t* qr; const float* slotsQ; const float* cosT; const float* sinT;
    __device__ __forceinline__ void operator()(const AccT& acc, const Unit& u, int wr, int wc, int fr, int fq) const {
        const int row0 = u.pm * 256 + wr * 64 + fr;
#pragma unroll
        for (int ai = 0; ai < 2; ++ai)
#pragma unroll
            for (int m = 0; m < 4; ++m) { const int row = row0 + ai * 128 + m * 16;
                const f32x4 s0 = *(const f32x4*)(slotsQ + (size_t)row * 8), s1 = *(const f32x4*)(slotsQ + (size_t)row * 8 + 4);
                const float rs = __builtin_amdgcn_rsqf((sum4(s0) + sum4(s1)) * (1.0f / 512.0f) + RMS_EPS) * QSCALE;
                if (u.pn < 4) {
#pragma unroll
                    for (int bj = 0; bj < 2; ++bj) *(u32x4*)(qn + (size_t)row * D + u.pn * 256 + bj * 128 + wc * 32 + fq * 8) = pack8(acc[ai][bj][m][0] * rs, acc[ai][bj][m][1] * rs);
                } else {
                    const int head = 4 * (u.pn - 4) + wc; f32x4 o1[2], o2[2];
#pragma unroll
                    for (int n = 0; n < 2; ++n) { const f32x4 c = *(const f32x4*)(cosT + (size_t)row * 32 + fq * 8 + n * 4), s = *(const f32x4*)(sinT + (size_t)row * 32 + fq * 8 + n * 4);
                        const f32x4 x1 = acc[ai][0][m][n] * rs, x2 = acc[ai][1][m][n] * rs; o1[n] = x1 * c - x2 * s; o2[n] = x2 * c + x1 * s; }
                    *(u32x4*)(qr + (size_t)row * 512 + head * 64 + fq * 8) = pack8(o1[0], o1[1]);
                    *(u32x4*)(qr + (size_t)row * 512 + head * 64 + 32 + fq * 8) = pack8(o2[0], o2[1]);
                } }
    }
};
struct EpiKnope {
    static constexpr bool PERM = true;
    bf16_t* O; const float* slotsC;
    __device__ __forceinline__ void operator()(const AccT& acc, const Unit& u, int wr, int wc, int fr, int fq) const {
        const int row0 = u.pm * 256 + wr * 64 + fr, col0 = u.pn * 256 + wc * 32 + 8 * fq;
#pragma unroll
        for (int ai = 0; ai < 2; ++ai)
#pragma unroll
            for (int m = 0; m < 4; ++m) { const int row = row0 + ai * 128 + m * 16; const f32x4 s = *(const f32x4*)(slotsC + (size_t)row * 4);
                const float rs = __builtin_amdgcn_rsqf(sum4(s) * (1.0f / 256.0f) + RMS_EPS);
#pragma unroll
                for (int bj = 0; bj < 2; ++bj) *(u32x4*)(O + (size_t)row * D + col0 + bj * 128) = pack8(acc[ai][bj][m][0] * rs, acc[ai][bj][m][1] * rs); }
    }
};
struct EpiVt {
    static constexpr bool PERM = true;
    bf16_t* O; const float* slotsC;
    __device__ __forceinline__ void operator()(const AccT& acc, const Unit& u, int wr, int wc, int fr, int fq) const {
        const int row0 = u.pm * 256 + wr * 64 + fr, col0 = u.pn * 256 + wc * 32 + 8 * fq;
        f32x4 rs[2][2];
#pragma unroll
        for (int bj = 0; bj < 2; ++bj)
#pragma unroll
            for (int n = 0; n < 2; ++n)
#pragma unroll
                for (int i = 0; i < 4; ++i) { const f32x4 s = *(const f32x4*)(slotsC + (size_t)(col0 + bj * 128 + n * 4 + i) * 4); rs[bj][n][i] = __builtin_amdgcn_rsqf(sum4(s) * (1.0f / 256.0f) + RMS_EPS); }
#pragma unroll
        for (int ai = 0; ai < 2; ++ai)
#pragma unroll
            for (int m = 0; m < 4; ++m) { const int row = row0 + ai * 128 + m * 16;
#pragma unroll
                for (int bj = 0; bj < 2; ++bj) *(u32x4*)(O + (size_t)row * T + col0 + bj * 128) = pack8(acc[ai][bj][m][0] * rs[bj][0], acc[ai][bj][m][1] * rs[bj][1]); }
    }
};

struct Args { const float* in[33]; const int* pos; float* out; unsigned char* ws; int ph_lo, ph_hi; };

struct Ctx { LAS unsigned char* lds; int vcu, G, wave; };

__device__ __forceinline__ void tr_item(const float* W, int ldw, int k0, int n0, const float* s1, const float* s2, int ks0, bf16_t* Bt, int ldb, int nd0, int kd0, LAS float* scr, int lane) {
    f32x4 v[8];
#pragma unroll
    for (int i = 0; i < 8; ++i) v[i] = *(const f32x4*)(W + (size_t)(k0 + 8 * i + (lane >> 3)) * ldw + n0 + 4 * (lane & 7));
#pragma unroll
    for (int i = 0; i < 8; ++i) { const int kk = 8 * i + (lane >> 3);
        float sc = s1 ? s1[ks0 + kk] : 1.0f; if (s2) sc -= s2[ks0 + kk];
        LAS float* d = scr + kk * 33 + 4 * (lane & 7);
        d[0] = sc * v[i][0]; d[1] = sc * v[i][1]; d[2] = sc * v[i][2]; d[3] = sc * v[i][3]; }
    asm volatile("s_waitcnt lgkmcnt(0)" ::: "memory");
    const int c = lane & 7;
#pragma unroll
    for (int j = 0; j < 4; ++j) { const int n = (lane >> 3) + 8 * j; const LAS float* s = scr + (8 * c) * 33 + n;
        u32x4 o; o.x = cvt_pk_bf16(s[0 * 33], s[1 * 33]); o.y = cvt_pk_bf16(s[2 * 33], s[3 * 33]); o.z = cvt_pk_bf16(s[4 * 33], s[5 * 33]); o.w = cvt_pk_bf16(s[6 * 33], s[7 * 33]);
        *(u32x4*)(Bt + (size_t)(nd0 + n) * ldb + kd0 + 8 * c) = o; }
    asm volatile("s_waitcnt lgkmcnt(0)" ::: "memory");
}
__device__ __forceinline__ void zero_item(bf16_t* Bt, int ldb, int nd0, int kd0, int lane) {
    const int c = lane & 7;
#pragma unroll
    for (int j = 0; j < 4; ++j) { const int n = (lane >> 3) + 8 * j; *(u32x4*)(Bt + (size_t)(nd0 + n) * ldb + kd0 + 8 * c) = (u32x4){0u, 0u, 0u, 0u}; }
}

__device__ __forceinline__ void p0_prologue(const Ctx& F, const Args& a) {
    unsigned char* ws = a.ws;
    const int tid = fresh_tid(F.wave), lane = tid & 63, wave = __builtin_amdgcn_readfirstlane(tid >> 6);
    LAS float* scr = (LAS float*)(F.lds + wave * 16384);
    const int gw = F.vcu * 8 + wave, NGW = F.G * 8;
    const float* norm_g = a.in[2];
    constexpr int I_UG = 16 * 176, I_UGX = 16 * 16, I_DN = 44 * 32, I_SQ = 16 * 32, I_LD = 32 * 8, I_LU = 4 * 96, I_KN = 4 * 32, I_DQ = 16 * 16, I_UQ = 8 * 48;
    constexpr int NITEMS = 4 * I_UG + I_UGX + 4 * I_DN + 4 * I_SQ + I_LD + I_LU + 2 * I_KN + I_DQ + I_UQ + I_SQ;
    for (int it = gw; it < NITEMS; it += NGW) {
        int r = it;
        if (r < 4 * I_UG) { const int q = r / I_UG; r -= q * I_UG; const int l = q >> 1, s = q & 1; const int kb = r / 176, nb = r % 176, pn = nb >> 3, jb = nb & 7;
            const float* src = (jb < 4 ? a.in[3] : a.in[4]) + (size_t)q * D * FF;
            tr_item(src, FF, 64 * kb, 128 * pn + 32 * (jb & 3), norm_g + (l * 3 + (s ? 2 : 0)) * D, nullptr, 64 * kb, (bf16_t*)(ws + W_UG) + (size_t)q * 6144 * D, D, 32 * nb, 64 * kb, scr, lane); continue; }
        r -= 4 * I_UG;
        if (r < I_UGX) { const int kb = r / 16, nb = r % 16; bf16_t* Bt = (bf16_t*)(ws + W_UG) + (size_t)2 * 6144 * D;
            int sc = -1; if (nb < 8) sc = 32 * nb; else if (nb == 8) sc = 256; else if (nb == 12) sc = 288;
            if (sc >= 0) tr_item(a.in[25], 320, 64 * kb, sc, a.in[24], nullptr, 64 * kb, Bt, D, 5632 + 32 * nb, 64 * kb, scr, lane); else zero_item(Bt, D, 5632 + 32 * nb, 64 * kb, lane); continue; }
        r -= I_UGX;
        if (r < 4 * I_DN) { const int q = r / I_DN; r -= q * I_DN; const int kb = r / 32, nb = r % 32;
            tr_item(a.in[5] + (size_t)q * FF * D, D, 64 * kb, 32 * nb, nullptr, nullptr, 0, (bf16_t*)(ws + W_DN) + (size_t)q * D * FF, FF, 32 * nb, 64 * kb, scr, lane); continue; }
        r -= 4 * I_DN;
        if (r < 4 * I_SQ) { const int q = r / I_SQ; r -= q * I_SQ; const int kb = r / 32, nb = r % 32;
            if (q == 0) { tr_item(a.in[7], D, 64 * kb, 32 * nb, nullptr, nullptr, 0, (bf16_t*)(ws + W_RL), 2048, 32 * nb, 64 * kb, scr, lane); zero_item((bf16_t*)(ws + W_RL), 2048, 32 * nb, 1024 + 64 * kb, lane); }
            else tr_item(a.in[7 + q], D, 64 * kb, 32 * nb, nullptr, nullptr, 0, (bf16_t*)(ws + W_R + (size_t)q * 2 * MiB), D, 32 * nb, 64 * kb, scr, lane);
            continue; }
        r -= 4 * I_SQ;
        if (r < I_LD) { const int kb = r / 8, nb = r % 8; const int kk0 = 64 * (kb & 15); const bool second = kb >= 16;
            const float* src; int ldw, nc, mi; if (nb < 2) { src = a.in[12]; ldw = 64; nc = 32 * nb; mi = 1; } else if (nb < 4) { src = a.in[15]; ldw = 64; nc = 32 * (nb - 2); mi = 4; } else { src = a.in[17]; ldw = 128; nc = 32 * (nb - 4); mi = 5; }
            tr_item(src, ldw, kk0, nc, second ? a.in[6] + mi * D : nullptr, second ? a.in[6] : nullptr, kk0, (bf16_t*)(ws + W_RL), 2048, 1024 + 32 * nb, 64 * kb, scr, lane); continue; }
        r -= I_LD;
        if (r < I_LU) { const int kb = r / 96, nb = r % 96; const int grp = nb / 32, nc = 32 * (nb % 32); bf16_t* Bt = (bf16_t*)(ws + W_LU);
            if (grp == 0) { if (kb == 0) tr_item(a.in[13], D, 0, nc, nullptr, nullptr, 0, Bt, 256, 32 * nb, 0, scr, lane); else zero_item(Bt, 256, 32 * nb, 64 * kb, lane); }
            else if (grp == 1) { if (kb == 1) tr_item(a.in[16], D, 0, nc, nullptr, nullptr, 0, Bt, 256, 32 * nb, 64, scr, lane); else zero_item(Bt, 256, 32 * nb, 64 * kb, lane); }
            else { if (kb >= 2) tr_item(a.in[18], D, 64 * (kb - 2), nc, nullptr, nullptr, 0, Bt, 256, 32 * nb, 64 * kb, scr, lane); else zero_item(Bt, 256, 32 * nb, 64 * kb, lane); }
            continue; }
        r -= I_LU;
        if (r < 2 * I_KN) { const int q = r / I_KN; r -= q * I_KN; const int kb = r / 32, nb = r % 32;
            const int n0 = 32 * nb, sc = (n0 >> 7) * 256 + (n0 & 127) + q * 128;
            tr_item(a.in[27], 2048, 64 * kb, sc, a.in[26], nullptr, 64 * kb, (bf16_t*)(ws + (q ? W_VT : W_KN)), 256, n0, 64 * kb, scr, lane); continue; }
        r -= 2 * I_KN;
        if (r < I_DQ) { const int kb = r / 16, nb = r % 16;
            tr_item(a.in[28], 512, 64 * kb, 32 * nb, norm_g + (1 * 3 + 1) * D, nullptr, 64 * kb, (bf16_t*)(ws + W_DQ), D, 32 * nb, 64 * kb, scr, lane); continue; }
        r -= I_DQ;
        if (r < I_UQ) { const int kb = r / 48, nb = r % 48; int sc;
            if (nb < 32) { const int n0 = 32 * nb; sc = (n0 >> 7) * 192 + (n0 & 127); }
            else { const int t2 = (nb - 32) >> 3, jj = (nb - 32) & 7, half = jj >> 2, hh = jj & 3; sc = (4 * t2 + hh) * 192 + 128 + 32 * half; }
            tr_item(a.in[30], 1536, 64 * kb, sc, a.in[29], nullptr, 64 * kb, (bf16_t*)(ws + W_UQ), 512, 32 * nb, 64 * kb, scr, lane); continue; }
        r -= I_UQ;
        { const int kb = r / 32, nb = r % 32; tr_item(a.in[31], D, 64 * kb, 32 * nb, nullptr, nullptr, 0, (bf16_t*)(ws + W_MO), D, 32 * nb, 64 * kb, scr, lane); }
    }
    const float* x = a.in[0]; bf16_t* hb = (bf16_t*)(ws + A_HB); float* slotsH = (float*)(ws + WS_SLOTH);
    for (int m = gw; m < T; m += NGW) {
        const f32x4* xr = (const f32x4*)(x + (size_t)m * D) + lane; float ss = 0.f;
#pragma unroll
        for (int j = 0; j < 4; ++j) { const f32x4 v = xr[64 * j]; ss += (v[0] * v[0] + v[1] * v[1]) + (v[2] * v[2] + v[3] * v[3]);
            u32x2 w; w.x = cvt_pk_bf16(v[0], v[1]); w.y = cvt_pk_bf16(v[2], v[3]); *((u32x2*)(hb + (size_t)m * D) + lane + 64 * j) = w; }
        ss = wave_sum(ss);
        if (lane < 16) slotsH[(size_t)m * 16 + lane] = lane == 0 ? ss : 0.f;
    }
    float* cosT = (float*)(ws + A_COS); float* sinT = (float*)(ws + A_SIN);
    for (int i = (F.vcu * 512 + tid); i < T * 32; i += F.G * 512) {
        const int tok = i >> 5, j = i & 31;
        const float inv = exp2f(-(float)j * (13.287712379549449f / 32.0f));
        const float ang = (float)a.pos[tok] * inv;
        const double rev = (double)ang * 0.15915494309189535; const float fr = (float)(rev - floor(rev));
        cosT[i] = __builtin_amdgcn_cosf(fr); sinT[i] = __builtin_amdgcn_sinf(fr);
    }
}

__device__ __forceinline__ void p_premix(const Ctx& F, const Args& a) {
    const float* h = a.out; const float* g = a.in[2] + 1 * D; const float* mix = a.in[6];
    bf16_t* X1 = (bf16_t*)(a.ws + A_X1); bf16_t* XK = (bf16_t*)(a.ws + A_XK); bf16_t* XV = (bf16_t*)(a.ws + A_XV);
    const int tid = fresh_tid(F.wave), lane = tid & 63, wave = __builtin_amdgcn_readfirstlane(tid >> 6);
    const int gw = F.vcu * 8 + wave, NGW = F.G * 8;
    for (int ch = gw; ch < T / 16; ch += NGW) {
        const int t0 = ch * 16;
        f32x4 prev[4], gv[4];
#pragma unroll
        for (int j = 0; j < 4; ++j) gv[j] = *((const f32x4*)g + lane + 64 * j);
        if ((t0 & (SEQ - 1)) == 0) {
#pragma unroll
            for (int j = 0; j < 4; ++j) prev[j] = (f32x4){0.f, 0.f, 0.f, 0.f};
        } else {
            float ss = 0.f;
#pragma unroll
            for (int j = 0; j < 4; ++j) { prev[j] = *((const f32x4*)(h + (size_t)(t0 - 1) * D) + lane + 64 * j); ss += (prev[j][0] * prev[j][0] + prev[j][1] * prev[j][1]) + (prev[j][2] * prev[j][2] + prev[j][3] * prev[j][3]); }
            const float rs = __builtin_amdgcn_rsqf(wave_sum(ss) * (1.0f / 1024.0f) + RMS_EPS);
#pragma unroll
            for (int j = 0; j < 4; ++j) prev[j] = prev[j] * rs * gv[j];
        }
        for (int t = t0; t < t0 + 16; ++t) {
            f32x4 cur[4]; float ss = 0.f;
#pragma unroll
            for (int j = 0; j < 4; ++j) { cur[j] = *((const f32x4*)(h + (size_t)t * D) + lane + 64 * j); ss += (cur[j][0] * cur[j][0] + cur[j][1] * cur[j][1]) + (cur[j][2] * cur[j][2] + cur[j][3] * cur[j][3]); }
            const float rs = __builtin_amdgcn_rsqf(wave_sum(ss) * (1.0f / 1024.0f) + RMS_EPS);
#pragma unroll
            for (int j = 0; j < 4; ++j) {
                const f32x4 hn = cur[j] * rs * gv[j]; const f32x4 xx = prev[j] - hn; prev[j] = hn;
                const f32x4 mr = *((const f32x4*)(mix + 0 * D) + lane + 64 * j), mk = *((const f32x4*)(mix + 2 * D) + lane + 64 * j), mv = *((const f32x4*)(mix + 3 * D) + lane + 64 * j);
                const f32x4 xr = hn + xx * mr, xk = hn + xx * mk, xv = hn + xx * mv;
                u32x2 w;
                w.x = cvt_pk_bf16(xr[0], xr[1]); w.y = cvt_pk_bf16(xr[2], xr[3]); *((u32x2*)(X1 + (size_t)t * 2048) + lane + 64 * j) = w;
                w.x = cvt_pk_bf16(xx[0], xx[1]); w.y = cvt_pk_bf16(xx[2], xx[3]); *((u32x2*)(X1 + (size_t)t * 2048 + 1024) + lane + 64 * j) = w;
                w.x = cvt_pk_bf16(xk[0], xk[1]); w.y = cvt_pk_bf16(xk[2], xk[3]); *((u32x2*)(XK + (size_t)t * D) + lane + 64 * j) = w;
                w.x = cvt_pk_bf16(xv[0], xv[1]); w.y = cvt_pk_bf16(xv[2], xv[3]); *((u32x2*)(XV + (size_t)t * D) + lane + 64 * j) = w;
            }
        }
    }
}

constexpr int TC = 32;
__device__ __forceinline__ void p_scan(const Ctx& F, const Args& a) {
    const bf16_t* Rb = (const bf16_t*)(a.ws + A_R); const bf16_t* Kb = (const bf16_t*)(a.ws + A_KK); const bf16_t* Vb = (const bf16_t*)(a.ws + A_VV);
    const bf16_t* Eb = (const bf16_t*)(a.ws + A_E); const bf16_t* Ab = (const bf16_t*)(a.ws + A_AA); bf16_t* Gb = (bf16_t*)(a.ws + A_G);
    const float* k_k = a.in[19]; const float* k_a = a.in[20]; const float* r_k = a.in[21]; const float* gn_w = a.in[22]; const float* gn_b = a.in[23];
    LAS float* sR = (LAS float*)(F.lds); LAS float* sW = sR + TC * 64; LAS float* sK = sW + TC * 64; LAS float* sV = sK + TC * 64;
    LAS float* sKK = sV + TC * 64; LAS float* sKA = sKK + TC * 64; LAS float* sY = sKA + TC * 64; LAS float* sBo = sY + TC * 64;
    const int tid = fresh_tid(F.wave), lane = tid & 63, wave = __builtin_amdgcn_readfirstlane(tid >> 6);
    const int irow = wave * 8 + (lane >> 3), kseg = (lane & 7) * 8;
    const int ptt = tid >> 4, pc = (tid & 15) * 4;
    for (int unit0 = F.vcu; unit0 < 2 * NB * 16; unit0 += F.G) {
        const int unit = unit0 & 127; const bool shadow = unit0 >= 128;
        const int b = unit >> 4, hd = unit & 15; const int cbase = hd * 64;
        float S[8];
#pragma unroll
        for (int j = 0; j < 8; ++j) S[j] = 0.f;
        const f32x4 kkv = *(const f32x4*)(k_k + cbase + pc), kav = *(const f32x4*)(k_a + cbase + pc), rkv = *(const f32x4*)(r_k + cbase + pc);
        const f32x4 gw = *(const f32x4*)(gn_w + cbase + pc), gb = *(const f32x4*)(gn_b + cbase + pc);
        for (int c0 = 0; c0 < SEQ; c0 += TC) {
            const size_t gidx = (size_t)(b * SEQ + c0 + ptt) * D + cbase + pc;
            {
                const f32x4 r = unpack4(*(const u32x2*)(Rb + gidx)), k = unpack4(*(const u32x2*)(Kb + gidx)), v = unpack4(*(const u32x2*)(Vb + gidx));
                const f32x4 e = unpack4(*(const u32x2*)(Eb + gidx)), aa = unpack4(*(const u32x2*)(Ab + gidx));
                f32x4 kk = k * kkv; float ss = (kk[0] * kk[0] + kk[1] * kk[1]) + (kk[2] * kk[2] + kk[3] * kk[3]); ss = red16(ss);
                kk = kk * __builtin_amdgcn_rsqf(fmaxf(ss, 1e-24f));
                const f32x4 kp = k * (1.0f + (aa - 1.0f) * kav);
                const f32x4 rk = r * kp * rkv; const float bo = red16((rk[0] + rk[1]) + (rk[2] + rk[3]));
                f32x4 w;
#pragma unroll
                for (int i = 0; i < 4; ++i) w[i] = __builtin_amdgcn_exp2f(-e[i] * LOG2E);
                const int o = ptt * 64 + pc;
                *(LAS f32x4*)(sR + o) = r; *(LAS f32x4*)(sW + o) = w; *(LAS f32x4*)(sK + o) = kp; *(LAS f32x4*)(sV + o) = v; *(LAS f32x4*)(sKK + o) = kk; *(LAS f32x4*)(sKA + o) = kk * aa;
                if ((tid & 15) == 0) sBo[ptt] = bo;
            }
            __syncthreads();
#pragma unroll 2
            for (int t = 0; t < TC; ++t) {
                const int o = t * 64 + kseg;
                const f32x4 kk0 = *(const LAS f32x4*)(sKK + o), kk1 = *(const LAS f32x4*)(sKK + o + 4);
                const f32x4 w0 = *(const LAS f32x4*)(sW + o), w1 = *(const LAS f32x4*)(sW + o + 4);
                const f32x4 ka0 = *(const LAS f32x4*)(sKA + o), ka1 = *(const LAS f32x4*)(sKA + o + 4);
                const f32x4 kp0 = *(const LAS f32x4*)(sK + o), kp1 = *(const LAS f32x4*)(sK + o + 4);
                const f32x4 r0 = *(const LAS f32x4*)(sR + o), r1 = *(const LAS f32x4*)(sR + o + 4);
                const float vv = sV[t * 64 + irow];
                float sa = ((S[0] * kk0[0] + S[1] * kk0[1]) + (S[2] * kk0[2] + S[3] * kk0[3])) + ((S[4] * kk1[0] + S[5] * kk1[1]) + (S[6] * kk1[2] + S[7] * kk1[3]));
                sa = red8(sa);
#pragma unroll
                for (int j = 0; j < 4; ++j) { S[j] = S[j] * w0[j] + (vv * kp0[j] - sa * ka0[j]); S[4 + j] = S[4 + j] * w1[j] + (vv * kp1[j] - sa * ka1[j]); }
                float y = ((S[0] * r0[0] + S[1] * r0[1]) + (S[2] * r0[2] + S[3] * r0[3])) + ((S[4] * r1[0] + S[5] * r1[1]) + (S[6] * r1[2] + S[7] * r1[3]));
                y = red8(y);
                if ((lane & 7) == 0) sY[t * 64 + irow] = y;
            }
            __syncthreads();
            {
                const int o = ptt * 64 + pc;
                const f32x4 y = *(const LAS f32x4*)(sY + o), v = *(const LAS f32x4*)(sV + o);
                const float mu = red16((y[0] + y[1]) + (y[2] + y[3])) * (1.0f / 64.0f);
                const f32x4 d = y - mu; const float var = red16((d[0] * d[0] + d[1] * d[1]) + (d[2] * d[2] + d[3] * d[3])) * (1.0f / 64.0f);
                const float rs = __builtin_amdgcn_rsqf(var + GN_EPS); const float bo = sBo[ptt];
                const f32x4 gg = unpack4(*(const u32x2*)(Gb + gidx));
                const f32x4 ov = (d * rs * gw + gb + v * bo) * gg;
                u32x2 w; w.x = cvt_pk_bf16(ov[0], ov[1]); w.y = cvt_pk_bf16(ov[2], ov[3]); if (!shadow) *(u32x2*)(Gb + gidx) = w;
            }
            __syncthreads();
        }
    }
}


__device__ __forceinline__ void p_scan2(const Ctx& F, const Args& a) {
    const bf16_t* Rb = (const bf16_t*)(a.ws + A_R); const bf16_t* Kb = (const bf16_t*)(a.ws + A_KK); const bf16_t* Vb = (const bf16_t*)(a.ws + A_VV);
    const bf16_t* Eb = (const bf16_t*)(a.ws + A_E); const bf16_t* Ab = (const bf16_t*)(a.ws + A_AA); bf16_t* Yb = (bf16_t*)(a.ws + A_G); float* Bon = (float*)(a.ws + A_BON);
    const float* k_k = a.in[19]; const float* k_a = a.in[20]; const float* r_k = a.in[21];
    LAS float* sR = (LAS float*)(F.lds); LAS float* sW = sR + TC * 64; LAS float* sK = sW + TC * 64; LAS float* sV = sK + TC * 64;
    LAS float* sKK = sV + TC * 64; LAS float* sKA = sKK + TC * 64; LAS float* sY = sKA + TC * 64;
    const int tid = fresh_tid(F.wave), lane = tid & 63, wave = __builtin_amdgcn_readfirstlane(tid >> 6);
    const int lrow = wave * 4 + (lane >> 4), kseg = (lane & 15) * 4;
    const int ptt = tid >> 4, pc = (tid & 15) * 4;
    for (int unit = F.vcu; unit < 2 * NB * 16; unit += F.G) {
        const int bh = unit >> 1, half = unit & 1, b = bh >> 4, hd = bh & 15, cbase = hd * 64;
        f32x4 S = (f32x4){0.f, 0.f, 0.f, 0.f};
        const f32x4 kkv = *(const f32x4*)(k_k + cbase + pc), kav = *(const f32x4*)(k_a + cbase + pc), rkv = *(const f32x4*)(r_k + cbase + pc);
        size_t gidx = (size_t)(b * SEQ + ptt) * D + cbase + pc;
        u32x2 qr = *(const u32x2*)(Rb + gidx), qk = *(const u32x2*)(Kb + gidx), qv = *(const u32x2*)(Vb + gidx), qe = *(const u32x2*)(Eb + gidx), qa = *(const u32x2*)(Ab + gidx);
        for (int c0 = 0; c0 < SEQ; c0 += TC) {
            {
                const f32x4 r = unpack4(qr), k = unpack4(qk), v = unpack4(qv), e = unpack4(qe), aa = unpack4(qa);
                f32x4 kk = k * kkv; float ss = (kk[0] * kk[0] + kk[1] * kk[1]) + (kk[2] * kk[2] + kk[3] * kk[3]); ss = red16(ss);
                kk = kk * __builtin_amdgcn_rsqf(fmaxf(ss, 1e-24f));
                const f32x4 kp = k * (1.0f + (aa - 1.0f) * kav);
                const f32x4 rk = r * kp * rkv; const float bo = red16((rk[0] + rk[1]) + (rk[2] + rk[3]));
                f32x4 w;
#pragma unroll
                for (int i = 0; i < 4; ++i) w[i] = __builtin_amdgcn_exp2f(-e[i] * LOG2E);
                const int o = ptt * 64 + pc;
                *(LAS f32x4*)(sR + o) = r; *(LAS f32x4*)(sW + o) = w; *(LAS f32x4*)(sK + o) = kp; *(LAS f32x4*)(sV + o) = v; *(LAS f32x4*)(sKK + o) = kk; *(LAS f32x4*)(sKA + o) = kk * aa;
                if (half == 0 && (tid & 15) == 0) Bon[(size_t)(b * SEQ + c0 + ptt) * 16 + hd] = bo;
            }
            __syncthreads();
            if (c0 + TC < SEQ) { gidx += (size_t)TC * D;
                qr = *(const u32x2*)(Rb + gidx); qk = *(const u32x2*)(Kb + gidx); qv = *(const u32x2*)(Vb + gidx); qe = *(const u32x2*)(Eb + gidx); qa = *(const u32x2*)(Ab + gidx); }
#pragma unroll 4
            for (int t = 0; t < TC; ++t) {
                const int o = t * 64 + kseg;
                const f32x4 kk = *(const LAS f32x4*)(sKK + o), w = *(const LAS f32x4*)(sW + o), ka = *(const LAS f32x4*)(sKA + o), kp = *(const LAS f32x4*)(sK + o), r = *(const LAS f32x4*)(sR + o);
                const float vv = sV[t * 64 + half * 32 + lrow];
                float sa = (S[0] * kk[0] + S[1] * kk[1]) + (S[2] * kk[2] + S[3] * kk[3]);
                sa = red16(sa);
                S = S * w + (kp * vv - ka * sa);
                float y = (S[0] * r[0] + S[1] * r[1]) + (S[2] * r[2] + S[3] * r[3]);
                y = red16(y);
                if ((lane & 15) == 0) sY[t * 32 + lrow] = y;
            }
            __syncthreads();
            {
                const int tok = tid >> 4, r2 = (tid & 15) * 2;
                *(unsigned*)(Yb + (size_t)(b * SEQ + c0 + tok) * D + cbase + half * 32 + r2) = cvt_pk_bf16(sY[tok * 32 + r2], sY[tok * 32 + r2 + 1]);
            }
        }
        __syncthreads();
    }
}
__device__ __forceinline__ void p_post(const Ctx& F, const Args& a) {
    bf16_t* Yb = (bf16_t*)(a.ws + A_G); const bf16_t* Vb = (const bf16_t*)(a.ws + A_VV); const bf16_t* Gg = (const bf16_t*)(a.ws + A_E); const float* Bon = (const float*)(a.ws + A_BON);
    const float* gn_w = a.in[22]; const float* gn_b = a.in[23];
    const int tid = fresh_tid(F.wave), grp = tid >> 4, gl = tid & 15;
    for (int item = F.vcu * 32 + grp; item < T * 16; item += F.G * 32) {
        const int tok = item >> 4, hd = item & 15; const size_t idx = (size_t)tok * D + hd * 64 + 4 * gl;
        const f32x4 y = unpack4(*(const u32x2*)(Yb + idx)), v = unpack4(*(const u32x2*)(Vb + idx)), g = unpack4(*(const u32x2*)(Gg + idx));
        const float bo = Bon[(size_t)tok * 16 + hd];
        const f32x4 gw = *(const f32x4*)(gn_w + hd * 64 + 4 * gl), gb = *(const f32x4*)(gn_b + hd * 64 + 4 * gl);
        const float mu = red16((y[0] + y[1]) + (y[2] + y[3])) * (1.0f / 64.0f);
        const f32x4 d = y - mu; const float var = red16((d[0] * d[0] + d[1] * d[1]) + (d[2] * d[2] + d[3] * d[3])) * (1.0f / 64.0f);
        const float rs = __builtin_amdgcn_rsqf(var + GN_EPS);
        const f32x4 ov = (d * rs * gw + gb + v * bo) * g;
        u32x2 w; w.x = cvt_pk_bf16(ov[0], ov[1]); w.y = cvt_pk_bf16(ov[2], ov[3]); *(u32x2*)(Yb + idx) = w;
    }
}

constexpr int KROW = 400, VROW = 144, KBUF = 64 * KROW, VBUF = 128 * VROW, ABUF = KBUF + VBUF;
__device__ __forceinline__ void attn_unit(LAS unsigned char* lds, const bf16_t* qn, const bf16_t* qr, const bf16_t* kn, const bf16_t* kr, const bf16_t* vt, bf16_t* o_out, int b, int h, int qb, int wave_s) {
    const int tid = fresh_tid(wave_s), lane = tid & 63, wid = __builtin_amdgcn_readfirstlane(tid >> 6), r32 = lane & 31, hi = lane >> 5;
    const int tok0 = b * SEQ, q0 = qb * 256 + wid * 32;
    bf16x8 qf[12];
    { const size_t tq = (size_t)(tok0 + q0 + r32);
#pragma unroll
      for (int d = 0; d < 8; ++d) qf[d] = *(const bf16x8*)(qn + tq * D + h * 128 + d * 16 + hi * 8);
#pragma unroll
      for (int d = 0; d < 4; ++d) qf[8 + d] = *(const bf16x8*)(qr + tq * 512 + h * 64 + d * 16 + hi * 8); }
    const int NT = (qb + 1) * 4;
    const int kkey0 = tid >> 4, kch0 = tid & 15;
    const int rkey = tid >> 3, rch = tid & 7;
    const int vrow0 = tid >> 3, vch = tid & 7;
    const bf16_t* gk0 = kn + (size_t)(tok0 + kkey0) * D + h * 128 + kch0 * 8;
    const bf16_t* gk1 = gk0 + (size_t)32 * D;
    const bf16_t* gr = kr + (size_t)(tok0 + rkey) * 64 + rch * 8;
    const bf16_t* gv0 = vt + (size_t)(h * 128 + vrow0) * T + tok0 + vch * 8;
    const bf16_t* gv1 = gv0 + (size_t)64 * T;
    const int lk0 = kkey0 * KROW + kch0 * 16, lk1 = lk0 + 32 * KROW, lr = rkey * KROW + 256 + rch * 16, lv0 = KBUF + vrow0 * VROW + vch * 16, lv1 = lv0 + 64 * VROW;
    const int pr = (r32 & 0x13) | ((r32 & 4) << 1) | ((r32 & 8) >> 1);
    const int kfo = pr * KROW + hi * 16, vfo = KBUF + r32 * VROW + hi * 16;
    u32x4 ld0, ld1, ld2, ld3, ld4;
    ld0 = *(const u32x4*)gk0; ld1 = *(const u32x4*)gk1; ld2 = *(const u32x4*)gr; ld3 = *(const u32x4*)gv0; ld4 = *(const u32x4*)gv1;
    __syncthreads();
    *(LAS u32x4*)(lds + lk0) = ld0; *(LAS u32x4*)(lds + lk1) = ld1; *(LAS u32x4*)(lds + lr) = ld2; *(LAS u32x4*)(lds + lv0) = ld3; *(LAS u32x4*)(lds + lv1) = ld4;
    __syncthreads();
    float mrun = -1e30f, lrun = 0.f;
    f32x16 o[4];
#pragma unroll
    for (int d = 0; d < 4; ++d) o[d] = f32x16{};
    for (int t = 0; t < NT; ++t) {
        const int cb = (t & 1) * ABUF, nb = ((t + 1) & 1) * ABUF;
        const bool more = (t + 1 < NT);
        if (more) { const size_t ko = (size_t)(t + 1) * 64 * D, ro = (size_t)(t + 1) * 64 * 64, vo = (size_t)(t + 1) * 64;
            ld0 = *(const u32x4*)(gk0 + ko); ld1 = *(const u32x4*)(gk1 + ko); ld2 = *(const u32x4*)(gr + ro); ld3 = *(const u32x4*)(gv0 + vo); ld4 = *(const u32x4*)(gv1 + vo); }
        if (64 * t <= q0 + 31) {
            f32x16 s0 = f32x16{}, s1 = f32x16{};
#pragma unroll
            for (int d = 0; d < 12; ++d) {
                const bf16x8 k0 = *(const LAS bf16x8*)(lds + cb + kfo + d * 32), k1 = *(const LAS bf16x8*)(lds + cb + kfo + 32 * KROW + d * 32);
                s0 = __builtin_amdgcn_mfma_f32_32x32x16_bf16(k0, qf[d], s0, 0, 0, 0);
                s1 = __builtin_amdgcn_mfma_f32_32x32x16_bf16(k1, qf[d], s1, 0, 0, 0);
            }
            if (64 * t + 63 > q0) {
                const int qi = q0 + r32, kb0 = 64 * t + 8 * hi;
#pragma unroll
                for (int r = 0; r < 16; ++r) { const int key = kb0 + 16 * (r >> 3) + (r & 7); if (key > qi) s0[r] = -1e30f; if (key + 32 > qi) s1[r] = -1e30f; }
            }
            float mx = fmaxf(s0[0], s1[0]);
#pragma unroll
            for (int r = 1; r < 16; ++r) mx = fmaxf(mx, fmaxf(s0[r], s1[r]));
            mx = fmaxf(mx, __shfl_xor(mx, 32));
            const float mnew = fmaxf(mrun, mx); const float alpha = __builtin_amdgcn_exp2f(mrun - mnew); mrun = mnew;
            float ps = 0.f;
#pragma unroll
            for (int r = 0; r < 16; ++r) { s0[r] = __builtin_amdgcn_exp2f(s0[r] - mnew); s1[r] = __builtin_amdgcn_exp2f(s1[r] - mnew); ps += s0[r] + s1[r]; }
            lrun = lrun * alpha + ps;
#pragma unroll
            for (int d = 0; d < 4; ++d) o[d] = o[d] * alpha;
            bf16x8 pf[4];
            { u32x4 w;
              w.x = cvt_pk_bf16(s0[0], s0[1]); w.y = cvt_pk_bf16(s0[2], s0[3]); w.z = cvt_pk_bf16(s0[4], s0[5]); w.w = cvt_pk_bf16(s0[6], s0[7]); pf[0] = __builtin_bit_cast(bf16x8, w);
              w.x = cvt_pk_bf16(s0[8], s0[9]); w.y = cvt_pk_bf16(s0[10], s0[11]); w.z = cvt_pk_bf16(s0[12], s0[13]); w.w = cvt_pk_bf16(s0[14], s0[15]); pf[1] = __builtin_bit_cast(bf16x8, w);
              w.x = cvt_pk_bf16(s1[0], s1[1]); w.y = cvt_pk_bf16(s1[2], s1[3]); w.z = cvt_pk_bf16(s1[4], s1[5]); w.w = cvt_pk_bf16(s1[6], s1[7]); pf[2] = __builtin_bit_cast(bf16x8, w);
              w.x = cvt_pk_bf16(s1[8], s1[9]); w.y = cvt_pk_bf16(s1[10], s1[11]); w.z = cvt_pk_bf16(s1[12], s1[13]); w.w = cvt_pk_bf16(s1[14], s1[15]); pf[3] = __builtin_bit_cast(bf16x8, w); }
#pragma unroll
            for (int d = 0; d < 4; ++d)
#pragma unroll
                for (int ks = 0; ks < 4; ++ks) {
                    const bf16x8 vf = *(const LAS bf16x8*)(lds + cb + vfo + d * 32 * VROW + ks * 32);
                    o[d] = __builtin_amdgcn_mfma_f32_32x32x16_bf16(vf, pf[ks], o[d], 0, 0, 0);
                }
        }
        if (more) { *(LAS u32x4*)(lds + nb + lk0) = ld0; *(LAS u32x4*)(lds + nb + lk1) = ld1; *(LAS u32x4*)(lds + nb + lr) = ld2; *(LAS u32x4*)(lds + nb + lv0) = ld3; *(LAS u32x4*)(lds + nb + lv1) = ld4; }
        __syncthreads();
    }
    lrun += __shfl_xor(lrun, 32);
    const float rl = __builtin_amdgcn_rcpf(lrun);
    bf16_t* op = o_out + (size_t)(tok0 + q0 + r32) * D + h * 128 + 4 * hi;
#pragma unroll
    for (int d = 0; d < 4; ++d)
#pragma unroll
        for (int r4 = 0; r4 < 4; ++r4) { u32x2 w; w.x = cvt_pk_bf16(o[d][4 * r4] * rl, o[d][4 * r4 + 1] * rl); w.y = cvt_pk_bf16(o[d][4 * r4 + 2] * rl, o[d][4 * r4 + 3] * rl);
            *(u32x2*)(op + 32 * d + 8 * r4) = w; }
}
__device__ __forceinline__ void p_attn(const Ctx& F, const Args& a) {
    const bf16_t* qn = (const bf16_t*)(a.ws + A_QN); const bf16_t* qr = (const bf16_t*)(a.ws + A_QR);
    const bf16_t* kn = (const bf16_t*)(a.ws + A_KN); const bf16_t* kr = (const bf16_t*)(a.ws + A_KR); const bf16_t* vt = (const bf16_t*)(a.ws + A_VT);
    bf16_t* oo = (bf16_t*)(a.ws + A_QN);
    for (int p = F.vcu; p < 512; p += F.G) {
        const int bh = p >> 3, s = p & 7;
        attn_unit(F.lds, qn, qr, kn, kr, vt, oo, bh >> 3, bh & 7, 15 - s, F.wave);
        attn_unit(F.lds, qn, qr, kn, kr, vt, oo, bh >> 3, bh & 7, s, F.wave);
    }
}

__device__ __forceinline__ void p_final(const Ctx& F, const Args& a) {
    float* h = a.out; const float* g = a.in[32];
    const int tid = fresh_tid(F.wave), lane = tid & 63, wave = __builtin_amdgcn_readfirstlane(tid >> 6);
    const int gw = F.vcu * 8 + wave, NGW = F.G * 8;
    f32x4 gv[4];
#pragma unroll
    for (int j = 0; j < 4; ++j) gv[j] = *((const f32x4*)g + lane + 64 * j);
    for (int m = gw; m < T; m += NGW) {
        f32x4 v[4]; float ss = 0.f;
#pragma unroll
        for (int j = 0; j < 4; ++j) { v[j] = *((const f32x4*)(h + (size_t)m * D) + lane + 64 * j); ss += (v[j][0] * v[j][0] + v[j][1] * v[j][1]) + (v[j][2] * v[j][2] + v[j][3] * v[j][3]); }
        const float rs = __builtin_amdgcn_rsqf(wave_sum(ss) * (1.0f / 1024.0f) + RMS_EPS);
#pragma unroll
        for (int j = 0; j < 4; ++j) *((f32x4*)(h + (size_t)m * D) + lane + 64 * j) = v[j] * rs * gv[j];
    }
}

__device__ __forceinline__ void my_grid_sync(unsigned* cnt, unsigned G, int wave_s) {
    asm volatile("s_waitcnt vmcnt(0) lgkmcnt(0)" ::: "memory");
    __syncthreads();
    if (fresh_tid(wave_s) == 0) {
        __builtin_amdgcn_fence(__ATOMIC_RELEASE, "agent");
        asm volatile("s_waitcnt vmcnt(0)" ::: "memory");
        __hip_atomic_fetch_add(cnt, 1u, __ATOMIC_RELAXED, __HIP_MEMORY_SCOPE_AGENT);
        while (__hip_atomic_load(cnt, __ATOMIC_RELAXED, __HIP_MEMORY_SCOPE_AGENT) < G) __builtin_amdgcn_s_sleep(4);
        __builtin_amdgcn_fence(__ATOMIC_ACQUIRE, "agent");
        asm volatile("s_waitcnt vmcnt(0)" ::: "memory");
    }
    __syncthreads();
}
#define GSYNC() do { my_grid_sync(bar_words + 64 * bar_idx, (unsigned)F.G, F.wave); ++bar_idx; } while (0)
#define RUN_GEMM(EPI_T, epi, Aptr, lda_, Bptr, ldb_, M_, N_, K_) do { pg8::Gemm g_{(const bf16_t*)(Aptr), (lda_), (const bf16_t*)(Bptr), (ldb_), (M_), (N_), (K_)}; \
    pg8::StaticOrder S_; S_.init((M_), (N_), F.G, (int)blockIdx.x); pg8::gemm_phase<EPI_T>(F.lds, g_, S_, (epi), F.wave); } while (0)

__global__ void __launch_bounds__(512, 2) fwd_mega(Args a) {
    extern __shared__ __attribute__((aligned(16))) unsigned char lds_raw[];
    cg::grid_group grid = cg::this_grid();
    Ctx F; F.lds = (LAS unsigned char*)lds_raw; F.wave = __builtin_amdgcn_readfirstlane((int)threadIdx.x >> 6);
    F.G = gridDim.x; { const int bx = blockIdx.x; F.vcu = (F.G % 8 == 0) ? (bx % 8) * (F.G / 8) + bx / 8 : bx; }
    unsigned char* ws = a.ws;
    float* slotsH = (float*)(ws + WS_SLOTH); float* slotsC = (float*)(ws + WS_SLOTC); float* slotsQ = (float*)(ws + WS_SLOTQ);
    bf16_t* HB = (bf16_t*)(ws + A_HB); bf16_t* MID = (bf16_t*)(ws + A_MID);
    const float* cosT = (const float*)(ws + A_COS); const float* sinT = (const float*)(ws + A_SIN);
    bf16_t* WUG = (bf16_t*)(ws + W_UG); bf16_t* WDN = (bf16_t*)(ws + W_DN);

    unsigned* bar_words = (unsigned*)ws;
    if (a.ph_hi - a.ph_lo > 1) grid.sync();
    if (a.ph_lo <= 0 && 0 < a.ph_hi) {
    p0_prologue(F, a);
    }
    if (a.ph_lo <= 0 && 1 < a.ph_hi) my_grid_sync(bar_words + 64 * 0, (unsigned)F.G, F.wave);
    if (a.ph_lo <= 1 && 1 < a.ph_hi) {
    { EpiSwiglu E{MID, slotsH, nullptr, nullptr, nullptr, nullptr, nullptr}; RUN_GEMM(EpiSwiglu, E, HB, D, WUG, D, T, 5632, D); }
    }
    if (a.ph_lo <= 1 && 2 < a.ph_hi) my_grid_sync(bar_words + 64 * 1, (unsigned)F.G, F.wave);
    if (a.ph_lo <= 2 && 2 < a.ph_hi) {
    { EpiResid E{a.in[0], a.out, nullptr, nullptr, 0.5f}; RUN_GEMM(EpiResid, E, MID, FF, WDN, FF, T, D, FF); }
    }
    if (a.ph_lo <= 2 && 3 < a.ph_hi) my_grid_sync(bar_words + 64 * 2, (unsigned)F.G, F.wave);
    if (a.ph_lo <= 3 && 3 < a.ph_hi) {
    p_premix(F, a);
    }
    if (a.ph_lo <= 3 && 4 < a.ph_hi) my_grid_sync(bar_words + 64 * 3, (unsigned)F.G, F.wave);
    if (a.ph_lo <= 4 && 4 < a.ph_hi) {
    { EpiRL E{(bf16_t*)(ws + A_R), (bf16_t*)(ws + A_LM)}; RUN_GEMM(EpiRL, E, ws + A_X1, 2048, ws + W_RL, 2048, T, 1280, 2048); }
    }
    if (a.ph_lo <= 4 && 5 < a.ph_hi) my_grid_sync(bar_words + 64 * 4, (unsigned)F.G, F.wave);
    if (a.ph_lo <= 5 && 5 < a.ph_hi) {
    { EpiBf16 E{(bf16_t*)(ws + A_KK), D}; RUN_GEMM(EpiBf16, E, ws + A_XK, D, ws + W_K, D, T, D, D); }
    { EpiBf16 E{(bf16_t*)(ws + A_VV), D}; RUN_GEMM(EpiBf16, E, ws + A_XV, D, ws + W_V, D, T, D, D); }
    }
    if (a.ph_lo <= 5 && 6 < a.ph_hi) my_grid_sync(bar_words + 64 * 5, (unsigned)F.G, F.wave);
    if (a.ph_lo <= 6 && 6 < a.ph_hi) {
    { EpiLoraUp E{ws, a.in[11], a.in[14], 0, A_G}; RUN_GEMM(EpiLoraUp, E, ws + A_LM, 256, ws + W_LU, 256, T, 2048, 256); }
    }
    if (a.ph_lo <= 6 && 7 < a.ph_hi) my_grid_sync(bar_words + 64 * 6, (unsigned)F.G, F.wave);
    if (a.ph_lo <= 7 && 7 < a.ph_hi) {
    p_scan2(F, a);
    }
    if (a.ph_lo <= 7 && 8 < a.ph_hi) my_grid_sync(bar_words + 64 * 7, (unsigned)F.G, F.wave);
    if (a.ph_lo <= 8 && 8 < a.ph_hi) {
    { EpiLoraUp E{ws, a.in[11], a.in[14], 2, A_E}; RUN_GEMM(EpiLoraUp, E, ws + A_LM, 256, ws + W_LU + (size_t)2048 * 256 * 2, 256, T, 1024, 256); }
    }
    if (a.ph_lo <= 8 && 9 < a.ph_hi) my_grid_sync(bar_words + 64 * 8, (unsigned)F.G, F.wave);
    if (a.ph_lo <= 9 && 9 < a.ph_hi) {
    p_post(F, a);
    }
    if (a.ph_lo <= 9 && 10 < a.ph_hi) my_grid_sync(bar_words + 64 * 9, (unsigned)F.G, F.wave);
    if (a.ph_lo <= 10 && 10 < a.ph_hi) {
    { EpiResid E{a.out, a.out, HB, slotsH, 1.0f}; RUN_GEMM(EpiResid, E, ws + A_G, D, ws + W_O, D, T, D, D); }
    }
    if (a.ph_lo <= 10 && 11 < a.ph_hi) my_grid_sync(bar_words + 64 * 10, (unsigned)F.G, F.wave);
    if (a.ph_lo <= 11 && 11 < a.ph_hi) {
    { EpiSwiglu E{MID, slotsH, nullptr, nullptr, nullptr, nullptr, nullptr}; RUN_GEMM(EpiSwiglu, E, HB, D, WUG + (size_t)1 * 6144 * D, D, T, 5632, D); }
    }
    if (a.ph_lo <= 11 && 12 < a.ph_hi) my_grid_sync(bar_words + 64 * 11, (unsigned)F.G, F.wave);
    if (a.ph_lo <= 12 && 12 < a.ph_hi) {
    { EpiResid E{a.out, a.out, HB, slotsH, 0.5f}; RUN_GEMM(EpiResid, E, MID, FF, WDN + (size_t)1 * D * FF, FF, T, D, FF); }
    }
    if (a.ph_lo <= 12 && 13 < a.ph_hi) my_grid_sync(bar_words + 64 * 12, (unsigned)F.G, F.wave);
    if (a.ph_lo <= 13 && 13 < a.ph_hi) {
    { EpiSwiglu E{MID, slotsH, (bf16_t*)(ws + A_C), slotsC, (bf16_t*)(ws + A_KR), cosT, sinT}; RUN_GEMM(EpiSwiglu, E, HB, D, WUG + (size_t)2 * 6144 * D, D, T, 6144, D); }
    }
    if (a.ph_lo <= 13 && 14 < a.ph_hi) my_grid_sync(bar_words + 64 * 13, (unsigned)F.G, F.wave);
    if (a.ph_lo <= 14 && 14 < a.ph_hi) {
    { EpiResid E{a.out, a.out, HB, slotsH, 0.5f}; RUN_GEMM(EpiResid, E, MID, FF, WDN + (size_t)2 * D * FF, FF, T, D, FF); }
    { EpiKnope E{(bf16_t*)(ws + A_KN), slotsC}; RUN_GEMM(EpiKnope, E, ws + A_C, 256, ws + W_KN, 256, T, D, 256); }
    { EpiVt E{(bf16_t*)(ws + A_VT), slotsC}; RUN_GEMM(EpiVt, E, ws + W_VT, 256, ws + A_C, 256, D, T, 256); }
    }
    if (a.ph_lo <= 14 && 15 < a.ph_hi) my_grid_sync(bar_words + 64 * 14, (unsigned)F.G, F.wave);
    if (a.ph_lo <= 15 && 15 < a.ph_hi) {
    { EpiQlat E{(bf16_t*)(ws + A_QLAT), slotsH, slotsQ}; RUN_GEMM(EpiQlat, E, HB, D, ws + W_DQ, D, T, 512, D); }
    }
    if (a.ph_lo <= 15 && 16 < a.ph_hi) my_grid_sync(bar_words + 64 * 15, (unsigned)F.G, F.wave);
    if (a.ph_lo <= 16 && 16 < a.ph_hi) {
    { EpiQ E{(bf16_t*)(ws + A_QN), (bf16_t*)(ws + A_QR), slotsQ, cosT, sinT}; RUN_GEMM(EpiQ, E, ws + A_QLAT, 512, ws + W_UQ, 512, T, 1536, 512); }
    }
    if (a.ph_lo <= 16 && 17 < a.ph_hi) my_grid_sync(bar_words + 64 * 16, (unsigned)F.G, F.wave);
    if (a.ph_lo <= 17 && 17 < a.ph_hi) {
    p_attn(F, a);
    }
    if (a.ph_lo <= 17 && 18 < a.ph_hi) my_grid_sync(bar_words + 64 * 17, (unsigned)F.G, F.wave);
    if (a.ph_lo <= 18 && 18 < a.ph_hi) {
    { EpiResid E{a.out, a.out, HB, slotsH, 1.0f}; RUN_GEMM(EpiResid, E, ws + A_QN, D, ws + W_MO, D, T, D, D); }
    }
    if (a.ph_lo <= 18 && 19 < a.ph_hi) my_grid_sync(bar_words + 64 * 18, (unsigned)F.G, F.wave);
    if (a.ph_lo <= 19 && 19 < a.ph_hi) {
    { EpiSwiglu E{MID, slotsH, nullptr, nullptr, nullptr, nullptr, nullptr}; RUN_GEMM(EpiSwiglu, E, HB, D, WUG + (size_t)3 * 6144 * D, D, T, 5632, D); }
    }
    if (a.ph_lo <= 19 && 20 < a.ph_hi) my_grid_sync(bar_words + 64 * 19, (unsigned)F.G, F.wave);
    if (a.ph_lo <= 20 && 20 < a.ph_hi) {
    { EpiResid E{a.out, a.out, nullptr, nullptr, 0.5f}; RUN_GEMM(EpiResid, E, MID, FF, WDN + (size_t)3 * D * FF, FF, T, D, FF); }
    }
    if (a.ph_lo <= 20 && 21 < a.ph_hi) my_grid_sync(bar_words + 64 * 20, (unsigned)F.G, F.wave);
    if (a.ph_lo <= 21 && 21 < a.ph_hi) {
    p_final(F, a);
    }
}

extern "C" void kernel_launch(void* const* d_in, const int* in_sizes, int n_in, void* d_out, int out_size, void* d_ws, size_t ws_size, hipStream_t stream) {
    static int grid = 0;
    if (grid == 0) {
        if (n_in != 33 || out_size != T * D || ws_size < WS_NEED) { fprintf(stderr, "kernel_launch: unexpected shapes: n_in %d out %d ws %zu (need %zu)\n", n_in, out_size, ws_size, (size_t)WS_NEED); grid = -1; return; }
        int dev = 0, cus = 0, per_cu = 0;
        (void)hipGetDevice(&dev); (void)hipDeviceGetAttribute(&cus, hipDeviceAttributeMultiprocessorCount, dev);
        (void)hipFuncSetAttribute((const void*)fwd_mega, hipFuncAttributeMaxDynamicSharedMemorySize, LDS_BYTES);
        (void)hipOccupancyMaxActiveBlocksPerMultiprocessor(&per_cu, (const void*)fwd_mega, 512, LDS_BYTES);
        (void)hipGetLastError();
        grid = cus > 0 ? cus : 256;
        if (grid > 256) grid = 256;
    }
    if (grid < 0) return;
    (void)hipMemsetAsync(d_ws, 0, 65536, stream);
    Args a{};
    for (int i = 0; i < 33; ++i) a.in[i] = (const float*)d_in[i];
    a.pos = (const int*)d_in[1]; a.out = (float*)d_out; a.ws = (unsigned char*)d_ws;
    hipError_t e = hipSuccess;
#if N_LAUNCHES == 1
    a.ph_lo = 0; a.ph_hi = NPHASES;
    { void* args[] = {&a}; e = hipLaunchCooperativeKernel((void*)fwd_mega, dim3(grid), dim3(512), args, LDS_BYTES, stream); }
#else
    for (int p = 0; p < NPHASES; ++p) { a.ph_lo = p; a.ph_hi = p + 1; hipLaunchKernelGGL(fwd_mega, dim3(grid), dim3(512), LDS_BYTES, stream, a); }
    e = hipPeekAtLastError();
#endif
    if (e != hipSuccess) fprintf(stderr, "cooperative launch failed: %s (grid %d)\n", hipGetErrorString(e), grid);
}
```

```cpp
#include <hip/hip_runtime.h>
#include <hip/hip_cooperative_groups.h>
#include <cstdio>
#include <cstdint>
namespace cg = cooperative_groups;

#define LAS __attribute__((address_space(3)))
typedef unsigned short bf16_t;
typedef short bf16x8 __attribute__((ext_vector_type(8)));
typedef float f32x4 __attribute__((ext_vector_type(4)));
typedef float f32x16 __attribute__((ext_vector_type(16)));
typedef unsigned u32x4 __attribute__((ext_vector_type(4)));
typedef unsigned u32x2 __attribute__((ext_vector_type(2)));
typedef float f32x2 __attribute__((ext_vector_type(2)));

constexpr int T = 32768, D = 1024, FF = 2816, SEQ = 4096, NB = 8;
constexpr float RMS_EPS = 1e-6f, GN_EPS = 64e-5f;
constexpr float LOG2E = 1.4426950408889634f;
constexpr float QSCALE = 0.07216878364870322f * 1.4426950408889634f;

constexpr size_t MiB = 1u << 20;
constexpr size_t WS_SLOTH = MiB / 2;
constexpr size_t WS_SLOTC = WS_SLOTH + 2 * MiB;
constexpr size_t WS_SLOTQ = WS_SLOTC + MiB / 2;
constexpr size_t WS_W = 4 * MiB;
constexpr size_t W_UG = WS_W;
constexpr size_t W_DN = W_UG + 48 * MiB;
constexpr size_t W_R = W_DN + 22 * MiB;
constexpr size_t W_K = W_R + 2 * MiB;
constexpr size_t W_V = W_K + 2 * MiB;
constexpr size_t W_O = W_V + 2 * MiB;
constexpr size_t W_LD = W_O + 2 * MiB;
constexpr size_t W_LU = W_LD + 1 * MiB;
constexpr size_t W_KN = W_LU + 2 * MiB;
constexpr size_t W_VT = W_KN + MiB / 2;
constexpr size_t W_DQ = W_VT + MiB / 2;
constexpr size_t W_UQ = W_DQ + 1 * MiB;
constexpr size_t W_MO = W_UQ + 2 * MiB;
constexpr size_t W_END = W_MO + 2 * MiB;
constexpr size_t WS_A = 92 * MiB;
static_assert(W_END <= WS_A, "weights region");
constexpr size_t A_HB = WS_A + 0;
constexpr size_t A_MID = WS_A + 64 * MiB;
constexpr size_t A_C = WS_A + 240 * MiB;
constexpr size_t A_KR = WS_A + 256 * MiB;
constexpr size_t A_KN = WS_A + 260 * MiB;
constexpr size_t A_VT = WS_A + 324 * MiB;
constexpr size_t A_QLAT = A_MID;
constexpr size_t A_QN = A_MID + 32 * MiB;
constexpr size_t A_QR = A_MID + 96 * MiB;
constexpr size_t A_X1 = WS_A + 0;
constexpr size_t A_XK = WS_A + 128 * MiB;
constexpr size_t A_XV = WS_A + 192 * MiB;
constexpr size_t A_R = WS_A + 256 * MiB;
constexpr size_t A_LM = WS_A + 320 * MiB;
constexpr size_t A_KK = WS_A + 0;
constexpr size_t A_VV = WS_A + 64 * MiB;
constexpr size_t A_E = WS_A + 128 * MiB;
constexpr size_t A_AA = WS_A + 192 * MiB;
constexpr size_t A_G = WS_A + 336 * MiB;
constexpr size_t A_BON = WS_A + 400 * MiB;
constexpr size_t A_COS = WS_A + 404 * MiB;
constexpr size_t A_SIN = WS_A + 408 * MiB;
constexpr size_t W_RL = WS_A + 412 * MiB;
constexpr size_t WS_NEED = 512 * MiB;

constexpr int LDS_BYTES = 147456;
constexpr int NPHASES = 22;
#ifndef N_LAUNCHES
#define N_LAUNCHES 1
#endif

__device__ __forceinline__ unsigned cvt_pk_bf16(float lo, float hi) { unsigned r; asm volatile("v_cvt_pk_bf16_f32 %0, %1, %2" : "=v"(r) : "v"(lo), "v"(hi)); return r; }
__device__ __forceinline__ float fsigmoid(float x) { return __builtin_amdgcn_rcpf(1.0f + __builtin_amdgcn_exp2f(-x * LOG2E)); }
__device__ __forceinline__ float ftanh(float x) { return 1.0f - 2.0f * __builtin_amdgcn_rcpf(1.0f + __builtin_amdgcn_exp2f(2.0f * LOG2E * x)); }
__device__ __forceinline__ float wave_sum(float v) {
#pragma unroll
    for (int o = 1; o < 64; o <<= 1) v += __shfl_xor(v, o);
    return v;
}
template <int CTRL> __device__ __forceinline__ float dpp_mov(float x) { return __builtin_bit_cast(float, __builtin_amdgcn_update_dpp(0, __builtin_bit_cast(int, x), CTRL, 0xf, 0xf, true)); }
__device__ __forceinline__ float red8(float x) { x += dpp_mov<0xB1>(x); x += dpp_mov<0x4E>(x); x += dpp_mov<0x141>(x); return x; }
__device__ __forceinline__ float red16(float x) { x = red8(x); x += dpp_mov<0x140>(x); return x; }
__device__ __forceinline__ float sum4(f32x4 v) { return (v[0] + v[1]) + (v[2] + v[3]); }
__device__ __forceinline__ float rstd_slots16(const float* s, int row) {
    const f32x4* p = (const f32x4*)(s + (size_t)row * 16);
    const f32x4 a = p[0], b = p[1], c = p[2], d = p[3];
    return __builtin_amdgcn_rsqf((sum4(a) + sum4(b) + sum4(c) + sum4(d)) * (1.0f / 1024.0f) + RMS_EPS);
}
__device__ __forceinline__ f32x4 unpack4(u32x2 p) { f32x4 r; r[0] = __uint_as_float(p.x << 16); r[1] = __uint_as_float(p.x & 0xffff0000u); r[2] = __uint_as_float(p.y << 16); r[3] = __uint_as_float(p.y & 0xffff0000u); return r; }

__device__ __forceinline__ int fresh_tid(int wave_s) { int l; asm volatile("v_mbcnt_lo_u32_b32 %0, -1, 0\n\tv_mbcnt_hi_u32_b32 %0, -1, %0" : "=v"(l)); return wave_s * 64 + l; }

namespace pg8 {
constexpr int BM = 256, BK = 64, HALF = 128, HTB = HALF * BK * 2, STAGE_BYTES = 8 * HTB, NXCD = 8, WGM = 8;
__device__ __forceinline__ int lds_byte(int r, int c) { const int st = (r >> 4) * 2 + (c >> 5), rr = r & 15, cc = c & 31, ob = rr * 64 + cc * 2; return st * 1024 + (ob ^ (((ob >> 9) & 1) << 5)); }
__device__ __forceinline__ void stage_rc(int b, int& R, int& C) { const int st = b / 1024, sb = b % 1024, swz = sb ^ (((sb >> 9) & 1) << 5); R = (st >> 1) * 16 + swz / 64; C = (st & 1) * 32 + (swz % 64) / 2; }
__device__ __forceinline__ int perm32(int rho) { const int n = rho >> 4, i = rho & 15; return 8 * (i >> 2) + 4 * n + (i & 3); }
struct Unit { int pm, pn; };
struct Gemm { const bf16_t* A; int lda; const bf16_t* Bt; int ldb; int M, N, K; };
struct StaticOrder {
    int nM, nN, nwg, G, c;
    __device__ void init(int M, int N, int G_, int c_) { nM = M / BM; nN = N / BM; nwg = nM * nN; G = G_; c = c_; }
    __device__ bool next(int i, Unit& u) const {
        const long L = (long)i * G + c; if (L >= nwg) return false;
        int wgid = (int)L; { const int q = nwg / NXCD, r = nwg % NXCD, xcd = wgid % NXCD, off = wgid / NXCD; wgid = (xcd < r ? xcd * (q + 1) : r * (q + 1) + (xcd - r) * q) + off; }
        const int nig = WGM * nN, gid = wgid / nig, fm = gid * WGM, gsz = (nM - fm) < WGM ? (nM - fm) : WGM;
        u.pm = fm + ((wgid % nig) % gsz); u.pn = (wgid % nig) / gsz; return true;
    }
};

template <class Epi>
__device__ __forceinline__ void gemm_phase(LAS unsigned char* lds, const Gemm g, const StaticOrder& S, const Epi& E, int wave_s) {
    const int tid = fresh_tid(wave_s), wid = __builtin_amdgcn_readfirstlane(tid >> 6), lane = tid & 63, wr = wid >> 2, wc = wid & 3, fr = lane & 15, fq = lane >> 4;
    const int K = g.K, nt = K / BK;
    unsigned voffA[2], voffB[2];
#pragma unroll
    for (int i = 0; i < 2; ++i) { int R, C; stage_rc(tid * 16 + i * 8192, R, C); const int Rb = Epi::PERM ? ((R & ~31) + perm32(R & 31)) : R;
        voffA[i] = (unsigned)(R * g.lda + C) * 2u; voffB[i] = (unsigned)(Rb * g.ldb + C) * 2u; }
    const size_t kstep = (size_t)(BK * 2);
    const size_t hstepA = (size_t)HALF * g.lda * 2, hstepB = (size_t)HALF * g.ldb * 2;
    const size_t tstepA = 2 * hstepA, tstepB = 2 * hstepB;
    const unsigned ldsw = (unsigned)wid * 1024u;
    const int aoff = lds_byte(wr * 64 + fr, fq * 8), boff = lds_byte(wc * 32 + fr, fq * 8);
#define PG8_SA(b, h) (((b) * 2 + (h)) * HTB)
#define PG8_SB(b, h) ((4 + (b) * 2 + (h)) * HTB)
#define PG8_STAGE(bufoff, gbase, voff) do { _Pragma("unroll") for (int _i = 0; _i < 2; ++_i) \
        __builtin_amdgcn_global_load_lds((const unsigned*)((const char*)(gbase) + (voff)[_i]), (LAS unsigned*)(lds + (bufoff) + ldsw + _i * 8192), 16, 0, 0); } while (0)
#define PG8_LDA(dst, b, h) do { _Pragma("unroll") for (int m = 0; m < 4; ++m) _Pragma("unroll") for (int k = 0; k < 2; ++k) dst[m][k] = *(const LAS bf16x8*)(lds + PG8_SA(b, h) + aoff + m * 2048 + k * 1024); } while (0)
#define PG8_LDB(dst, b, h) do { _Pragma("unroll") for (int n = 0; n < 2; ++n) _Pragma("unroll") for (int k = 0; k < 2; ++k) dst[n][k] = *(const LAS bf16x8*)(lds + PG8_SB(b, h) + boff + n * 2048 + k * 1024); } while (0)
#define PG8_MMA(ai, bj, At, Bt) do { __builtin_amdgcn_s_setprio(1); _Pragma("unroll") for (int m = 0; m < 4; ++m) _Pragma("unroll") for (int n = 0; n < 2; ++n) _Pragma("unroll") for (int k = 0; k < 2; ++k) \
        acc[ai][bj][m][n] = __builtin_amdgcn_mfma_f32_16x16x32_bf16(Bt[n][k], At[m][k], acc[ai][bj][m][n], 0, 0, 0); __builtin_amdgcn_s_setprio(0); } while (0)
#define PG8_WAIT_V(n) asm volatile("s_waitcnt vmcnt(" #n ")" ::: "memory")
#define PG8_WAIT_L(n) asm volatile("s_waitcnt lgkmcnt(" #n ")" ::: "memory")
#define PG8_BAR __builtin_amdgcn_s_barrier()
#define PG8_SCHED __builtin_amdgcn_sched_barrier(0)
    Unit cur, nxt; int ui = 0;
    if (!S.next(0, cur)) return;
    f32x4 acc[2][2][4][2];
#pragma unroll
    for (int a = 0; a < 2; ++a)
#pragma unroll
        for (int b = 0; b < 2; ++b)
#pragma unroll
            for (int m = 0; m < 4; ++m)
#pragma unroll
                for (int n = 0; n < 2; ++n) acc[a][b][m][n] = (f32x4){0.f, 0.f, 0.f, 0.f};
    bf16x8 At[4][2], B0[2][2], B1[2][2];
    const char* cA = (const char*)g.A + (size_t)cur.pm * tstepA; const char* cB = (const char*)g.Bt + (size_t)cur.pn * tstepB;
    PG8_STAGE(PG8_SB(0, 0), cB, voffB); PG8_STAGE(PG8_SB(0, 1), cB + hstepB, voffB); PG8_STAGE(PG8_SA(0, 0), cA, voffA); PG8_STAGE(PG8_SA(0, 1), cA + hstepA, voffA);
    if (wr == 1) PG8_BAR;
    PG8_WAIT_V(2); PG8_BAR;
    PG8_STAGE(PG8_SB(1, 0), cB + kstep, voffB); PG8_STAGE(PG8_SA(1, 0), cA + kstep, voffA); PG8_STAGE(PG8_SB(1, 1), cB + hstepB + kstep, voffB);
    PG8_WAIT_V(6); PG8_BAR;
    for (;;) {
        const bool has_next = S.next(ui + 1, nxt);
        const char* nA = has_next ? (const char*)g.A + (size_t)nxt.pm * tstepA : cA; const char* nB = has_next ? (const char*)g.Bt + (size_t)nxt.pn * tstepB : cB;
        for (int t = 0; t < nt; t += 2) {
            const bool last = (t == nt - 2);
            const char* a1 = cA + (size_t)(t + 1) * kstep;
            const char* a2 = last ? nA : cA + (size_t)(t + 2) * kstep; const char* b2 = last ? nB : cB + (size_t)(t + 2) * kstep;
            const char* a3 = a2 + kstep; const char* b3 = b2 + kstep;
            PG8_LDB(B0, 0, 0); PG8_LDB(B1, 0, 1); PG8_SCHED; PG8_LDA(At, 0, 0); PG8_STAGE(PG8_SA(1, 1), a1 + hstepA, voffA);
            PG8_WAIT_V(8); PG8_WAIT_L(0); PG8_BAR; PG8_MMA(0, 0, At, B0); PG8_MMA(0, 1, At, B1); PG8_BAR; PG8_SCHED;
            PG8_LDA(At, 0, 1); PG8_STAGE(PG8_SB(0, 0), b2, voffB); PG8_STAGE(PG8_SB(0, 1), b2 + hstepB, voffB); PG8_STAGE(PG8_SA(0, 0), a2, voffA);
            PG8_WAIT_V(8); PG8_WAIT_L(0); PG8_BAR; PG8_MMA(1, 0, At, B0); PG8_MMA(1, 1, At, B1); PG8_BAR; PG8_SCHED;
            PG8_LDB(B0, 1, 0); PG8_LDB(B1, 1, 1); PG8_SCHED; PG8_LDA(At, 1, 0); PG8_STAGE(PG8_SA(0, 1), a2 + hstepA, voffA);
            PG8_WAIT_V(8); PG8_WAIT_L(0); PG8_BAR; PG8_MMA(0, 0, At, B0); PG8_MMA(0, 1, At, B1); PG8_BAR; PG8_SCHED;
            PG8_LDA(At, 1, 1); PG8_STAGE(PG8_SB(1, 0), b3, voffB); PG8_STAGE(PG8_SB(1, 1), b3 + hstepB, voffB); PG8_STAGE(PG8_SA(1, 0), a3, voffA);
            PG8_WAIT_V(8); PG8_WAIT_L(0); PG8_BAR; PG8_MMA(1, 0, At, B0); PG8_MMA(1, 1, At, B1); PG8_BAR; PG8_SCHED;
        }
        if (wr == 0) PG8_BAR;
        E(acc, cur, wr, wc, fr, fq);
        if (!has_next) break;
#pragma unroll
        for (int a = 0; a < 2; ++a)
#pragma unroll
            for (int b = 0; b < 2; ++b)
#pragma unroll
                for (int m = 0; m < 4; ++m)
#pragma unroll
                    for (int n = 0; n < 2; ++n) acc[a][b][m][n] = (f32x4){0.f, 0.f, 0.f, 0.f};
        cur = nxt; cA = nA; cB = nB; ++ui;
        if (wr == 1) PG8_BAR;
    }
    PG8_WAIT_V(0);
    PG8_BAR;
#undef PG8_SA
#undef PG8_SB
#undef PG8_STAGE
#undef PG8_LDA
#undef PG8_LDB
#undef PG8_MMA
#undef PG8_WAIT_V
#undef PG8_WAIT_L
#undef PG8_BAR
#undef PG8_SCHED
}
}
using pg8::Unit;
typedef f32x4 AccT[2][2][4][2];

__device__ __forceinline__ u32x4 pack8(f32x4 a, f32x4 b) { u32x4 w; w.x = cvt_pk_bf16(a[0], a[1]); w.y = cvt_pk_bf16(a[2], a[3]); w.z = cvt_pk_bf16(b[0], b[1]); w.w = cvt_pk_bf16(b[2], b[3]); return w; }

struct EpiSwiglu {
    static constexpr bool PERM = true;
    bf16_t* mid; const float* slotsH; bf16_t* cbuf; float* slotsC; bf16_t* krope; const float* cosT; const float* sinT;
    __device__ __forceinline__ void operator()(const AccT& acc, const Unit& u, int wr, int wc, int fr, int fq) const {
        const int row0 = u.pm * 256 + wr * 64 + fr;
        if (u.pn < 22) {
#pragma unroll
            for (int ai = 0; ai < 2; ++ai)
#pragma unroll
                for (int m = 0; m < 4; ++m) {
                    const int row = row0 + ai * 128 + m * 16; const float rs = rstd_slots16(slotsH, row);
                    f32x4 o[2];
#pragma unroll
                    for (int n = 0; n < 2; ++n)
#pragma unroll
                        for (int i = 0; i < 4; ++i) { const float gt = acc[ai][0][m][n][i] * rs, up = acc[ai][1][m][n][i] * rs; o[n][i] = gt * fsigmoid(gt) * up; }
                    *(u32x4*)(mid + (size_t)row * FF + u.pn * 128 + wc * 32 + fq * 8) = pack8(o[0], o[1]);
                }
        } else if (u.pn == 22) {
#pragma unroll
            for (int ai = 0; ai < 2; ++ai)
#pragma unroll
                for (int m = 0; m < 4; ++m) {
                    const int row = row0 + ai * 128 + m * 16; const float rs = rstd_slots16(slotsH, row);
                    float ss = 0.f;
#pragma unroll
                    for (int bj = 0; bj < 2; ++bj) { const f32x4 a = acc[ai][bj][m][0] * rs, b = acc[ai][bj][m][1] * rs;
                        ss += (a[0] * a[0] + a[1] * a[1]) + (a[2] * a[2] + a[3] * a[3]) + (b[0] * b[0] + b[1] * b[1]) + (b[2] * b[2] + b[3] * b[3]);
                        *(u32x4*)(cbuf + (size_t)row * 256 + bj * 128 + wc * 32 + fq * 8) = pack8(a, b); }
                    ss += __shfl_xor(ss, 16); ss += __shfl_xor(ss, 32);
                    if (fq == 0) slotsC[(size_t)row * 4 + wc] = ss;
                }
        } else if (wc == 0) {
#pragma unroll
            for (int ai = 0; ai < 2; ++ai)
#pragma unroll
                for (int m = 0; m < 4; ++m) {
                    const int row = row0 + ai * 128 + m * 16; const float rs = rstd_slots16(slotsH, row);
                    f32x4 o1[2], o2[2];
#pragma unroll
                    for (int n = 0; n < 2; ++n) { const f32x4 c = *(const f32x4*)(cosT + (size_t)row * 32 + fq * 8 + n * 4), s = *(const f32x4*)(sinT + (size_t)row * 32 + fq * 8 + n * 4);
                        const f32x4 x1 = acc[ai][0][m][n] * rs, x2 = acc[ai][1][m][n] * rs; o1[n] = x1 * c - x2 * s; o2[n] = x2 * c + x1 * s; }
                    *(u32x4*)(krope + (size_t)row * 64 + fq * 8) = pack8(o1[0], o1[1]);
                    *(u32x4*)(krope + (size_t)row * 64 + 32 + fq * 8) = pack8(o2[0], o2[1]);
                }
        }
    }
};
struct EpiResid {
    static constexpr bool PERM = false;
    const float* hin; float* hout; bf16_t* hb; float* slots; float alpha;
    __device__ __forceinline__ void operator()(const AccT& acc, const Unit& u, int wr, int wc, int fr, int fq) const {
        const int row0 = u.pm * 256 + wr * 64 + fr, col0 = u.pn * 256 + wc * 32 + 4 * fq;
#pragma unroll
        for (int ai = 0; ai < 2; ++ai)
#pragma unroll
            for (int m = 0; m < 4; ++m) {
                const int row = row0 + ai * 128 + m * 16; const size_t off = (size_t)row * D + col0; float ss = 0.f;
#pragma unroll
                for (int bj = 0; bj < 2; ++bj)
#pragma unroll
                    for (int n = 0; n < 2; ++n) { const size_t o2 = off + bj * 128 + n * 16; const f32x4 b = *(const f32x4*)(hin + o2); const f32x4 o = b + acc[ai][bj][m][n] * alpha;
                        *(f32x4*)(hout + o2) = o; ss += (o[0] * o[0] + o[1] * o[1]) + (o[2] * o[2] + o[3] * o[3]);
                        if (hb) { u32x2 w; w.x = cvt_pk_bf16(o[0], o[1]); w.y = cvt_pk_bf16(o[2], o[3]); *(u32x2*)(hb + o2) = w; } }
                if (slots) { ss += __shfl_xor(ss, 16); ss += __shfl_xor(ss, 32); if (fq == 0) slots[(size_t)row * 16 + u.pn * 4 + wc] = ss; }
                if (m & 1) asm volatile("" ::: "memory");
            }
    }
};
struct EpiBf16 {
    static constexpr bool PERM = true;
    bf16_t* O; int ldc;
    __device__ __forceinline__ void operator()(const AccT& acc, const Unit& u, int wr, int wc, int fr, int fq) const {
        const int row0 = u.pm * 256 + wr * 64 + fr, col0 = u.pn * 256 + wc * 32 + 8 * fq;
#pragma unroll
        for (int ai = 0; ai < 2; ++ai)
#pragma unroll
            for (int m = 0; m < 4; ++m) { bf16_t* rp = O + (size_t)(row0 + ai * 128 + m * 16) * ldc + col0;
#pragma unroll
                for (int bj = 0; bj < 2; ++bj) *(u32x4*)(rp + bj * 128) = pack8(acc[ai][bj][m][0], acc[ai][bj][m][1]); }
    }
};
struct EpiLoraDown {
    static constexpr bool PERM = true;
    bf16_t* O;
    __device__ __forceinline__ void operator()(const AccT& acc, const Unit& u, int wr, int wc, int fr, int fq) const {
        const int row0 = u.pm * 256 + wr * 64 + fr, col0 = wc * 32 + 8 * fq;
#pragma unroll
        for (int ai = 0; ai < 2; ++ai)
#pragma unroll
            for (int m = 0; m < 4; ++m) { bf16_t* rp = O + (size_t)(row0 + ai * 128 + m * 16) * 256 + col0;
                f32x4 a = acc[ai][0][m][0], b = acc[ai][0][m][1];
                if (wc < 2) {
#pragma unroll
                    for (int i = 0; i < 4; ++i) { a[i] = ftanh(a[i]); b[i] = ftanh(b[i]); } }
                *(u32x4*)(rp) = pack8(a, b);
                a = acc[ai][1][m][0]; b = acc[ai][1][m][1];
#pragma unroll
                for (int i = 0; i < 4; ++i) { a[i] = fsigmoid(a[i]); b[i] = fsigmoid(b[i]); }
                *(u32x4*)(rp + 128) = pack8(a, b); }
    }
};
struct EpiRL {
    static constexpr bool PERM = true;
    bf16_t* R; bf16_t* O;
    __device__ __forceinline__ void operator()(const AccT& acc, const Unit& u, int wr, int wc, int fr, int fq) const {
        const int row0 = u.pm * 256 + wr * 64 + fr;
        if (u.pn < 4) {
            const int col0 = u.pn * 256 + wc * 32 + 8 * fq;
#pragma unroll
            for (int ai = 0; ai < 2; ++ai)
#pragma unroll
                for (int m = 0; m < 4; ++m) { bf16_t* rp = R + (size_t)(row0 + ai * 128 + m * 16) * D + col0;
#pragma unroll
                    for (int bj = 0; bj < 2; ++bj) *(u32x4*)(rp + bj * 128) = pack8(acc[ai][bj][m][0], acc[ai][bj][m][1]); }
        } else {
            const int col0 = wc * 32 + 8 * fq;
#pragma unroll
            for (int ai = 0; ai < 2; ++ai)
#pragma unroll
                for (int m = 0; m < 4; ++m) { bf16_t* rp = O + (size_t)(row0 + ai * 128 + m * 16) * 256 + col0;
                    f32x4 a = acc[ai][0][m][0], b = acc[ai][0][m][1];
                    if (wc < 2) {
#pragma unroll
                        for (int i = 0; i < 4; ++i) { a[i] = ftanh(a[i]); b[i] = ftanh(b[i]); } }
                    *(u32x4*)(rp) = pack8(a, b);
                    a = acc[ai][1][m][0]; b = acc[ai][1][m][1];
#pragma unroll
                    for (int i = 0; i < 4; ++i) { a[i] = fsigmoid(a[i]); b[i] = fsigmoid(b[i]); }
                    *(u32x4*)(rp + 128) = pack8(a, b); }
        }
    }
};
struct EpiLoraUp {
    static constexpr bool PERM = true;
    unsigned char* wsb; const float* w0; const float* a0; int grp0; size_t goff;
    __device__ __forceinline__ void operator()(const AccT& acc, const Unit& u, int wr, int wc, int fr, int fq) const {
        const int grp = (u.pn >> 2) + grp0, colt = (u.pn & 3) * 256;
        const int row0 = u.pm * 256 + wr * 64 + fr, col0 = colt + wc * 32 + 8 * fq;
        size_t ooff = goff; if (grp == 0) ooff = A_E; if (grp == 1) ooff = A_AA;
        bf16_t* O = (bf16_t*)(wsb + ooff); const float* bias = grp == 0 ? w0 : a0;
#pragma unroll
        for (int ai = 0; ai < 2; ++ai)
#pragma unroll
            for (int m = 0; m < 4; ++m) { bf16_t* rp = O + (size_t)(row0 + ai * 128 + m * 16) * D + col0;
#pragma unroll
                for (int bj = 0; bj < 2; ++bj) { f32x4 a = acc[ai][bj][m][0], b = acc[ai][bj][m][1];
                    if (grp < 2) { const float sc = grp == 0 ? 0.6065306597126334f : 1.0f;
                        const f32x4 b0 = *(const f32x4*)(bias + col0 + bj * 128), b1 = *(const f32x4*)(bias + col0 + bj * 128 + 4);
                        a = a + b0; b = b + b1;
#pragma unroll
                        for (int i = 0; i < 4; ++i) { a[i] = sc * fsigmoid(a[i]); b[i] = sc * fsigmoid(b[i]); } }
                    *(u32x4*)(rp + bj * 128) = pack8(a, b); }
                asm volatile("" ::: "memory"); }
    }
};
struct EpiQlat {
    static constexpr bool PERM = true;
    bf16_t* O; const float* slotsH; float* slotsQ;
    __device__ __forceinline__ void operator()(const AccT& acc, const Unit& u, int wr, int wc, int fr, int fq) const {
        const int row0 = u.pm * 256 + wr * 64 + fr, col0 = u.pn * 256 + wc * 32 + 8 * fq;
#pragma unroll
        for (int ai = 0; ai < 2; ++ai)
#pragma unroll
            for (int m = 0; m < 4; ++m) { const int row = row0 + ai * 128 + m * 16; const float rs = rstd_slots16(slotsH, row); float ss = 0.f;
#pragma unroll
                for (int bj = 0; bj < 2; ++bj) { const f32x4 a = acc[ai][bj][m][0] * rs, b = acc[ai][bj][m][1] * rs;
                    ss += (a[0] * a[0] + a[1] * a[1]) + (a[2] * a[2] + a[3] * a[3]) + (b[0] * b[0] + b[1] * b[1]) + (b[2] * b[2] + b[3] * b[3]);
                    *(u32x4*)(O + (size_t)row * 512 + col0 + bj * 128) = pack8(a, b); }
                ss += __shfl_xor(ss, 16); ss += __shfl_xor(ss, 32);
                if (fq == 0) slotsQ[(size_t)row * 8 + u.pn * 4 + wc] = ss; }
    }
};
struct EpiQ {
    static constexpr bool PERM = true;
    bf16_t* qn; bf16_t* qr; const float* slotsQ; const float* cosT; const float* sinT;
    __device__ __forceinline__ void operator()(const AccT& acc, const Unit& u, int wr, int wc, int fr, int fq) const {
        const int row0 = u.pm * 256 + wr * 64 + fr;
#pragma unroll
        for (int ai = 0; ai < 2; ++ai)
#pragma unroll
            for (int m = 0; m < 4; ++m) { const int row = row0 + ai * 128 + m * 16;
                const f32x4 s0 = *(const f32x4*)(slotsQ + (size_t)row * 8), s1 = *(const f32x4*)(slotsQ + (size_t)row * 8 + 4);
                const float rs = __builtin_amdgcn_rsqf((sum4(s0) + sum4(s1)) * (1.0f / 512.0f) + RMS_EPS) * QSCALE;
                if (u.pn < 4) {
#pragma unroll
                    for (int bj = 0; bj < 2; ++bj) *(u32x4*)(qn + (size_t)row * D + u.pn * 256 + bj * 128 + wc * 32 + fq * 8) = pack8(acc[ai][bj][m][0] * rs, acc[ai][bj][m][1] * rs);
                } else {
                    const int head = 4 * (u.pn - 4) + wc; f32x4 o1[2], o2[2];
#pragma unroll
                    for (int n = 0; n < 2; ++n) { const f32x4 c = *(const f32x4*)(cosT + (size_t)row * 32 + fq * 8 + n * 4), s = *(const f32x4*)(sinT + (size_t)row * 32 + fq * 8 + n * 4);
                        const f32x4 x1 = acc[ai][0][m][n] * rs, x2 = acc[ai][1][m][n] * rs; o1[n] = x1 * c - x2 * s; o2[n] = x2 * c + x1 * s; }
                    *(u32x4*)(qr + (size_t)row * 512 + head * 64 + fq * 8) = pack8(o1[0], o1[1]);
                    *(u32x4*)(qr + (size_t)row * 512 + head * 64 + 32 + fq * 8) = pack8(o2[0], o2[1]);
                } }
    }
};
struct EpiKnope {
    static constexpr bool PERM = true;
    bf16_t* O; const float* slotsC;
    __device__ __forceinline__ void operator()(const AccT& acc, const Unit& u, int wr, int wc, int fr, int fq) const {
        const int row0 = u.pm * 256 + wr * 64 + fr, col0 = u.pn * 256 + wc * 32 + 8 * fq;
#pragma unroll
        for (int ai = 0; ai < 2; ++ai)
#pragma unroll
            for (int m = 0; m < 4; ++m) { const int row = row0 + ai * 128 + m * 16; const f32x4 s = *(const f32x4*)(slotsC + (size_t)row * 4);
                const float rs = __builtin_amdgcn_rsqf(sum4(s) * (1.0f / 256.0f) + RMS_EPS);
#pragma unroll
                for (int bj = 0; bj < 2; ++bj) *(u32x4*)(O + (size_t)row * D + col0 + bj * 128) = pack8(acc[ai][bj][m][0] * rs, acc[ai][bj][m][1] * rs); }
    }
};
struct EpiVt {
    static constexpr bool PERM = true;
    bf16_t* O; const float* slotsC;
    __device__ __forceinline__ void operator()(const AccT& acc, const Unit& u, int wr, int wc, int fr, int fq) const {
        const int row0 = u.pm * 256 + wr * 64 + fr, col0 = u.pn * 256 + wc * 32 + 8 * fq;
        f32x4 rs[2][2];
#pragma unroll
        for (int bj = 0; bj < 2; ++bj)
#pragma unroll
            for (int n = 0; n < 2; ++n)
#pragma unroll
                for (int i = 0; i < 4; ++i) { const f32x4 s = *(const f32x4*)(slotsC + (size_t)(col0 + bj * 128 + n * 4 + i) * 4); rs[bj][n][i] = __builtin_amdgcn_rsqf(sum4(s) * (1.0f / 256.0f) + RMS_EPS); }
#pragma unroll
        for (int ai = 0; ai < 2; ++ai)
#pragma unroll
            for (int m = 0; m < 4; ++m) { const int row = row0 + ai * 128 + m * 16;
#pragma unroll
                for (int bj = 0; bj < 2; ++bj) *(u32x4*)(O + (size_t)row * T + col0 + bj * 128) = pack8(acc[ai][bj][m][0] * rs[bj][0], acc[ai][bj][m][1] * rs[bj][1]); }
    }
};

struct Args { const float* in[33]; const int* pos; float* out; unsigned char* ws; int ph_lo, ph_hi; };

struct Ctx { LAS unsigned char* lds; int vcu, G, wave; };

__device__ __forceinline__ void tr_item(const float* W, int ldw, int k0, int n0, const float* s1, const float* s2, int ks0, bf16_t* Bt, int ldb, int nd0, int kd0, LAS float* scr, int lane) {
    f32x4 v[8];
#pragma unroll
    for (int i = 0; i < 8; ++i) v[i] = *(const f32x4*)(W + (size_t)(k0 + 8 * i + (lane >> 3)) * ldw + n0 + 4 * (lane & 7));
#pragma unroll
    for (int i = 0; i < 8; ++i) { const int kk = 8 * i + (lane >> 3);
        float sc = s1 ? s1[ks0 + kk] : 1.0f; if (s2) sc -= s2[ks0 + kk];
        LAS float* d = scr + kk * 33 + 4 * (lane & 7);
        d[0] = sc * v[i][0]; d[1] = sc * v[i][1]; d[2] = sc * v[i][2]; d[3] = sc * v[i][3]; }
    asm volatile("s_waitcnt lgkmcnt(0)" ::: "memory");
    const int c = lane & 7;
#pragma unroll
    for (int j = 0; j < 4; ++j) { const int n = (lane >> 3) + 8 * j; const LAS float* s = scr + (8 * c) * 33 + n;
        u32x4 o; o.x = cvt_pk_bf16(s[0 * 33], s[1 * 33]); o.y = cvt_pk_bf16(s[2 * 33], s[3 * 33]); o.z = cvt_pk_bf16(s[4 * 33], s[5 * 33]); o.w = cvt_pk_bf16(s[6 * 33], s[7 * 33]);
        *(u32x4*)(Bt + (size_t)(nd0 + n) * ldb + kd0 + 8 * c) = o; }
    asm volatile("s_waitcnt lgkmcnt(0)" ::: "memory");
}
__device__ __forceinline__ void zero_item(bf16_t* Bt, int ldb, int nd0, int kd0, int lane) {
    const int c = lane & 7;
#pragma unroll
    for (int j = 0; j < 4; ++j) { const int n = (lane >> 3) + 8 * j; *(u32x4*)(Bt + (size_t)(nd0 + n) * ldb + kd0 + 8 * c) = (u32x4){0u, 0u, 0u, 0u}; }
}

__device__ __forceinline__ void p0_prologue(const Ctx& F, const Args& a) {
    unsigned char* ws = a.ws;
    const int tid = fresh_tid(F.wave), lane = tid & 63, wave = __builtin_amdgcn_readfirstlane(tid >> 6);
    LAS float* scr = (LAS float*)(F.lds + wave * 16384);
    const int gw = F.vcu * 8 + wave, NGW = F.G * 8;
    const float* norm_g = a.in[2];
    constexpr int I_UG = 16 * 176, I_UGX = 16 * 16, I_DN = 44 * 32, I_SQ = 16 * 32, I_LD = 32 * 8, I_LU = 4 * 96, I_KN = 4 * 32, I_DQ = 16 * 16, I_UQ = 8 * 48;
    constexpr int NITEMS = 4 * I_UG + I_UGX + 4 * I_DN + 4 * I_SQ + I_LD + I_LU + 2 * I_KN + I_DQ + I_UQ + I_SQ;
    for (int it = gw; it < NITEMS; it += NGW) {
        int r = it;
        if (r < 4 * I_UG) { const int q = r / I_UG; r -= q * I_UG; const int l = q >> 1, s = q & 1; const int kb = r / 176, nb = r % 176, pn = nb >> 3, jb = nb & 7;
            const float* src = (jb < 4 ? a.in[3] : a.in[4]) + (size_t)q * D * FF;
            tr_item(src, FF, 64 * kb, 128 * pn + 32 * (jb & 3), norm_g + (l * 3 + (s ? 2 : 0)) * D, nullptr, 64 * kb, (bf16_t*)(ws + W_UG) + (size_t)q * 6144 * D, D, 32 * nb, 64 * kb, scr, lane); continue; }
        r -= 4 * I_UG;
        if (r < I_UGX) { const int kb = r / 16, nb = r % 16; bf16_t* Bt = (bf16_t*)(ws + W_UG) + (size_t)2 * 6144 * D;
            int sc = -1; if (nb < 8) sc = 32 * nb; else if (nb == 8) sc = 256; else if (nb == 12) sc = 288;
            if (sc >= 0) tr_item(a.in[25], 320, 64 * kb, sc, a.in[24], nullptr, 64 * kb, Bt, D, 5632 + 32 * nb, 64 * kb, scr, lane); else zero_item(Bt, D, 5632 + 32 * nb, 64 * kb, lane); continue; }
        r -= I_UGX;
        if (r < 4 * I_DN) { const int q = r / I_DN; r -= q * I_DN; const int kb = r / 32, nb = r % 32;
            tr_item(a.in[5] + (size_t)q * FF * D, D, 64 * kb, 32 * nb, nullptr, nullptr, 0, (bf16_t*)(ws + W_DN) + (size_t)q * D * FF, FF, 32 * nb, 64 * kb, scr, lane); continue; }
        r -= 4 * I_DN;
        if (r < 4 * I_SQ) { const int q = r / I_SQ; r -= q * I_SQ; const int kb = r / 32, nb = r % 32;
            if (q == 0) { tr_item(a.in[7], D, 64 * kb, 32 * nb, nullptr, nullptr, 0, (bf16_t*)(ws + W_RL), 2048, 32 * nb, 64 * kb, scr, lane); zero_item((bf16_t*)(ws + W_RL), 2048, 32 * nb, 1024 + 64 * kb, lane); }
            else tr_item(a.in[7 + q], D, 64 * kb, 32 * nb, nullptr, nullptr, 0, (bf16_t*)(ws + W_R + (size_t)q * 2 * MiB), D, 32 * nb, 64 * kb, scr, lane);
            continue; }
        r -= 4 * I_SQ;
        if (r < I_LD) { const int kb = r / 8, nb = r % 8; const int kk0 = 64 * (kb & 15); const bool second = kb >= 16;
            const float* src; int ldw, nc, mi; if (nb < 2) { src = a.in[12]; ldw = 64; nc = 32 * nb; mi = 1; } else if (nb < 4) { src = a.in[15]; ldw = 64; nc = 32 * (nb - 2); mi = 4; } else { src = a.in[17]; ldw = 128; nc = 32 * (nb - 4); mi = 5; }
            tr_item(src, ldw, kk0, nc, second ? a.in[6] + mi * D : nullptr, second ? a.in[6] : nullptr, kk0, (bf16_t*)(ws + W_RL), 2048, 1024 + 32 * nb, 64 * kb, scr, lane); continue; }
        r -= I_LD;
        if (r < I_LU) { const int kb = r / 96, nb = r % 96; const int grp = nb / 32, nc = 32 * (nb % 32); bf16_t* Bt = (bf16_t*)(ws + W_LU);
            if (grp == 0) { if (kb == 0) tr_item(a.in[13], D, 0, nc, nullptr, nullptr, 0, Bt, 256, 32 * nb, 0, scr, lane); else zero_item(Bt, 256, 32 * nb, 64 * kb, lane); }
            else if (grp == 1) { if (kb == 1) tr_item(a.in[16], D, 0, nc, nullptr, nullptr, 0, Bt, 256, 32 * nb, 64, scr, lane); else zero_item(Bt, 256, 32 * nb, 64 * kb, lane); }
            else { if (kb >= 2) tr_item(a.in[18], D, 64 * (kb - 2), nc, nullptr, nullptr, 0, Bt, 256, 32 * nb, 64 * kb, scr, lane); else zero_item(Bt, 256, 32 * nb, 64 * kb, lane); }
            continue; }
        r -= I_LU;
        if (r < 2 * I_KN) { const int q = r / I_KN; r -= q * I_KN; const int kb = r / 32, nb = r % 32;
            const int n0 = 32 * nb, sc = (n0 >> 7) * 256 + (n0 & 127) + q * 128;
            tr_item(a.in[27], 2048, 64 * kb, sc, a.in[26], nullptr, 64 * kb, (bf16_t*)(ws + (q ? W_VT : W_KN)), 256, n0, 64 * kb, scr, lane); continue; }
        r -= 2 * I_KN;
        if (r < I_DQ) { const int kb = r / 16, nb = r % 16;
            tr_item(a.in[28], 512, 64 * kb, 32 * nb, norm_g + (1 * 3 + 1) * D, nullptr, 64 * kb, (bf16_t*)(ws + W_DQ), D, 32 * nb, 64 * kb, scr, lane); continue; }
        r -= I_DQ;
        if (r < I_UQ) { const int kb = r / 48, nb = r % 48; int sc;
            if (nb < 32) { const int n0 = 32 * nb; sc = (n0 >> 7) * 192 + (n0 & 127); }
            else { const int t2 = (nb - 32) >> 3, jj = (nb - 32) & 7, half = jj >> 2, hh = jj & 3; sc = (4 * t2 + hh) * 192 + 128 + 32 * half; }
            tr_item(a.in[30], 1536, 64 * kb, sc, a.in[29], nullptr, 64 * kb, (bf16_t*)(ws + W_UQ), 512, 32 * nb, 64 * kb, scr, lane); continue; }
        r -= I_UQ;
        { const int kb = r / 32, nb = r % 32; tr_item(a.in[31], D, 64 * kb, 32 * nb, nullptr, nullptr, 0, (bf16_t*)(ws + W_MO), D, 32 * nb, 64 * kb, scr, lane); }
    }
    const float* x = a.in[0]; bf16_t* hb = (bf16_t*)(ws + A_HB); float* slotsH = (float*)(ws + WS_SLOTH);
    for (int m = gw; m < T; m += NGW) {
        const f32x4* xr = (const f32x4*)(x + (size_t)m * D) + lane; float ss = 0.f;
#pragma unroll
        for (int j = 0; j < 4; ++j) { const f32x4 v = xr[64 * j]; ss += (v[0] * v[0] + v[1] * v[1]) + (v[2] * v[2] + v[3] * v[3]);
            u32x2 w; w.x = cvt_pk_bf16(v[0], v[1]); w.y = cvt_pk_bf16(v[2], v[3]); *((u32x2*)(hb + (size_t)m * D) + lane + 64 * j) = w; }
        ss = wave_sum(ss);
        if (lane < 16) slotsH[(size_t)m * 16 + lane] = lane == 0 ? ss : 0.f;
    }
    float* cosT = (float*)(ws + A_COS); float* sinT = (float*)(ws + A_SIN);
    for (int i = (F.vcu * 512 + tid); i < T * 32; i += F.G * 512) {
        const int tok = i >> 5, j = i & 31;
        const float inv = exp2f(-(float)j * (13.287712379549449f / 32.0f));
        const float ang = (float)a.pos[tok] * inv;
        const double rev = (double)ang * 0.15915494309189535; const float fr = (float)(rev - floor(rev));
        cosT[i] = __builtin_amdgcn_cosf(fr); sinT[i] = __builtin_amdgcn_sinf(fr);
    }
}

__device__ __forceinline__ void p_premix(const Ctx& F, const Args& a) {
    const float* h = a.out; const float* g = a.in[2] + 1 * D; const float* mix = a.in[6];
    bf16_t* X1 = (bf16_t*)(a.ws + A_X1); bf16_t* XK = (bf16_t*)(a.ws + A_XK); bf16_t* XV = (bf16_t*)(a.ws + A_XV);
    const int tid = fresh_tid(F.wave), lane = tid & 63, wave = __builtin_amdgcn_readfirstlane(tid >> 6);
    const int gw = F.vcu * 8 + wave, NGW = F.G * 8;
    for (int ch = gw; ch < T / 16; ch += NGW) {
        const int t0 = ch * 16;
        f32x4 prev[4], gv[4];
#pragma unroll
        for (int j = 0; j < 4; ++j) gv[j] = *((const f32x4*)g + lane + 64 * j);
        if ((t0 & (SEQ - 1)) == 0) {
#pragma unroll
            for (int j = 0; j < 4; ++j) prev[j] = (f32x4){0.f, 0.f, 0.f, 0.f};
        } else {
            float ss = 0.f;
#pragma unroll
            for (int j = 0; j < 4; ++j) { prev[j] = *((const f32x4*)(h + (size_t)(t0 - 1) * D) + lane + 64 * j); ss += (prev[j][0] * prev[j][0] + prev[j][1] * prev[j][1]) + (prev[j][2] * prev[j][2] + prev[j][3] * prev[j][3]); }
            const float rs = __builtin_amdgcn_rsqf(wave_sum(ss) * (1.0f / 1024.0f) + RMS_EPS);
#pragma unroll
            for (int j = 0; j < 4; ++j) prev[j] = prev[j] * rs * gv[j];
        }
        for (int t = t0; t < t0 + 16; ++t) {
            f32x4 cur[4]; float ss = 0.f;
#pragma unroll
            for (int j = 0; j < 4; ++j) { cur[j] = *((const f32x4*)(h + (size_t)t * D) + lane + 64 * j); ss += (cur[j][0] * cur[j][0] + cur[j][1] * cur[j][1]) + (cur[j][2] * cur[j][2] + cur[j][3] * cur[j][3]); }
            const float rs = __builtin_amdgcn_rsqf(wave_sum(ss) * (1.0f / 1024.0f) + RMS_EPS);
#pragma unroll
            for (int j = 0; j < 4; ++j) {
                const f32x4 hn = cur[j] * rs * gv[j]; const f32x4 xx = prev[j] - hn; prev[j] = hn;
                const f32x4 mr = *((const f32x4*)(mix + 0 * D) + lane + 64 * j), mk = *((const f32x4*)(mix + 2 * D) + lane + 64 * j), mv = *((const f32x4*)(mix + 3 * D) + lane + 64 * j);
                const f32x4 xr = hn + xx * mr, xk = hn + xx * mk, xv = hn + xx * mv;
                u32x2 w;
                w.x = cvt_pk_bf16(xr[0], xr[1]); w.y = cvt_pk_bf16(xr[2], xr[3]); *((u32x2*)(X1 + (size_t)t * 2048) + lane + 64 * j) = w;
                w.x = cvt_pk_bf16(xx[0], xx[1]); w.y = cvt_pk_bf16(xx[2], xx[3]); *((u32x2*)(X1 + (size_t)t * 2048 + 1024) + lane + 64 * j) = w;
                w.x = cvt_pk_bf16(xk[0], xk[1]); w.y = cvt_pk_bf16(xk[2], xk[3]); *((u32x2*)(XK + (size_t)t * D) + lane + 64 * j) = w;
                w.x = cvt_pk_bf16(xv[0], xv[1]); w.y = cvt_pk_bf16(xv[2], xv[3]); *((u32x2*)(XV + (size_t)t * D) + lane + 64 * j) = w;
            }
        }
    }
}

constexpr int TC = 32;
__device__ __forceinline__ void p_scan(const Ctx& F, const Args& a) {
    const bf16_t* Rb = (const bf16_t*)(a.ws + A_R); const bf16_t* Kb = (const bf16_t*)(a.ws + A_KK); const bf16_t* Vb = (const bf16_t*)(a.ws + A_VV);
    const bf16_t* Eb = (const bf16_t*)(a.ws + A_E); const bf16_t* Ab = (const bf16_t*)(a.ws + A_AA); bf16_t* Gb = (bf16_t*)(a.ws + A_G);
    const float* k_k = a.in[19]; const float* k_a = a.in[20]; const float* r_k = a.in[21]; const float* gn_w = a.in[22]; const float* gn_b = a.in[23];
    LAS float* sR = (LAS float*)(F.lds); LAS float* sW = sR + TC * 64; LAS float* sK = sW + TC * 64; LAS float* sV = sK + TC * 64;
    LAS float* sKK = sV + TC * 64; LAS float* sKA = sKK + TC * 64; LAS float* sY = sKA + TC * 64; LAS float* sBo = sY + TC * 64;
    const int tid = fresh_tid(F.wave), lane = tid & 63, wave = __builtin_amdgcn_readfirstlane(tid >> 6);
    const int irow = wave * 8 + (lane >> 3), kseg = (lane & 7) * 8;
    const int ptt = tid >> 4, pc = (tid & 15) * 4;
    for (int unit0 = F.vcu; unit0 < 2 * NB * 16; unit0 += F.G) {
        const int unit = unit0 & 127; const bool shadow = unit0 >= 128;
        const int b = unit >> 4, hd = unit & 15; const int cbase = hd * 64;
        float S[8];
#pragma unroll
        for (int j = 0; j < 8; ++j) S[j] = 0.f;
        const f32x4 kkv = *(const f32x4*)(k_k + cbase + pc), kav = *(const f32x4*)(k_a + cbase + pc), rkv = *(const f32x4*)(r_k + cbase + pc);
        const f32x4 gw = *(const f32x4*)(gn_w + cbase + pc), gb = *(const f32x4*)(gn_b + cbase + pc);
        for (int c0 = 0; c0 < SEQ; c0 += TC) {
            const size_t gidx = (size_t)(b * SEQ + c0 + ptt) * D + cbase + pc;
            {
                const f32x4 r = unpack4(*(const u32x2*)(Rb + gidx)), k = unpack4(*(const u32x2*)(Kb + gidx)), v = unpack4(*(const u32x2*)(Vb + gidx));
                const f32x4 e = unpack4(*(const u32x2*)(Eb + gidx)), aa = unpack4(*(const u32x2*)(Ab + gidx));
                f32x4 kk = k * kkv; float ss = (kk[0] * kk[0] + kk[1] * kk[1]) + (kk[2] * kk[2] + kk[3] * kk[3]); ss = red16(ss);
                kk = kk * __builtin_amdgcn_rsqf(fmaxf(ss, 1e-24f));
                const f32x4 kp = k * (1.0f + (aa - 1.0f) * kav);
                const f32x4 rk = r * kp * rkv; const float bo = red16((rk[0] + rk[1]) + (rk[2] + rk[3]));
                f32x4 w;
#pragma unroll
                for (int i = 0; i < 4; ++i) w[i] = __builtin_amdgcn_exp2f(-e[i] * LOG2E);
                const int o = ptt * 64 + pc;
                *(LAS f32x4*)(sR + o) = r; *(LAS f32x4*)(sW + o) = w; *(LAS f32x4*)(sK + o) = kp; *(LAS f32x4*)(sV + o) = v; *(LAS f32x4*)(sKK + o) = kk; *(LAS f32x4*)(sKA + o) = kk * aa;
                if ((tid & 15) == 0) sBo[ptt] = bo;
            }
            __syncthreads();
#pragma unroll 2
            for (int t = 0; t < TC; ++t) {
                const int o = t * 64 + kseg;
                const f32x4 kk0 = *(const LAS f32x4*)(sKK + o), kk1 = *(const LAS f32x4*)(sKK + o + 4);
                const f32x4 w0 = *(const LAS f32x4*)(sW + o), w1 = *(const LAS f32x4*)(sW + o + 4);
                const f32x4 ka0 = *(const LAS f32x4*)(sKA + o), ka1 = *(const LAS f32x4*)(sKA + o + 4);
                const f32x4 kp0 = *(const LAS f32x4*)(sK + o), kp1 = *(const LAS f32x4*)(sK + o + 4);
                const f32x4 r0 = *(const LAS f32x4*)(sR + o), r1 = *(const LAS f32x4*)(sR + o + 4);
                const float vv = sV[t * 64 + irow];
                float sa = ((S[0] * kk0[0] + S[1] * kk0[1]) + (S[2] * kk0[2] + S[3] * kk0[3])) + ((S[4] * kk1[0] + S[5] * kk1[1]) + (S[6] * kk1[2] + S[7] * kk1[3]));
                sa = red8(sa);
#pragma unroll
                for (int j = 0; j < 4; ++j) { S[j] = S[j] * w0[j] + (vv * kp0[j] - sa * ka0[j]); S[4 + j] = S[4 + j] * w1[j] + (vv * kp1[j] - sa * ka1[j]); }
                float y = ((S[0] * r0[0] + S[1] * r0[1]) + (S[2] * r0[2] + S[3] * r0[3])) + ((S[4] * r1[0] + S[5] * r1[1]) + (S[6] * r1[2] + S[7] * r1[3]));
                y = red8(y);
                if ((lane & 7) == 0) sY[t * 64 + irow] = y;
            }
            __syncthreads();
            {
                const int o = ptt * 64 + pc;
                const f32x4 y = *(const LAS f32x4*)(sY + o), v = *(const LAS f32x4*)(sV + o);
                const float mu = red16((y[0] + y[1]) + (y[2] + y[3])) * (1.0f / 64.0f);
                const f32x4 d = y - mu; const float var = red16((d[0] * d[0] + d[1] * d[1]) + (d[2] * d[2] + d[3] * d[3])) * (1.0f / 64.0f);
                const float rs = __builtin_amdgcn_rsqf(var + GN_EPS); const float bo = sBo[ptt];
                const f32x4 gg = unpack4(*(const u32x2*)(Gb + gidx));
                const f32x4 ov = (d * rs * gw + gb + v * bo) * gg;
                u32x2 w; w.x = cvt_pk_bf16(ov[0], ov[1]); w.y = cvt_pk_bf16(ov[2], ov[3]); if (!shadow) *(u32x2*)(Gb + gidx) = w;
            }
            __syncthreads();
        }
    }
}


__device__ __forceinline__ void p_scan2(const Ctx& F, const Args& a) {
    const bf16_t* Rb = (const bf16_t*)(a.ws + A_R); const bf16_t* Kb = (const bf16_t*)(a.ws + A_KK); const bf16_t* Vb = (const bf16_t*)(a.ws + A_VV);
    const bf16_t* Eb = (const bf16_t*)(a.ws + A_E); const bf16_t* Ab = (const bf16_t*)(a.ws + A_AA); bf16_t* Yb = (bf16_t*)(a.ws + A_G); float* Bon = (float*)(a.ws + A_BON);
    const float* k_k = a.in[19]; const float* k_a = a.in[20]; const float* r_k = a.in[21];
    LAS float* sR = (LAS float*)(F.lds); LAS float* sW = sR + TC * 64; LAS float* sK = sW + TC * 64; LAS float* sV = sK + TC * 64;
    LAS float* sKK = sV + TC * 64; LAS float* sKA = sKK + TC * 64; LAS float* sY = sKA + TC * 64;
    const int tid = fresh_tid(F.wave), lane = tid & 63, wave = __builtin_amdgcn_readfirstlane(tid >> 6);
    const int lrow = wave * 4 + (lane >> 4), kseg = (lane & 15) * 4;
    const int ptt = tid >> 4, pc = (tid & 15) * 4;
    for (int unit = F.vcu; unit < 2 * NB * 16; unit += F.G) {
        const int bh = unit >> 1, half = unit & 1, b = bh >> 4, hd = bh & 15, cbase = hd * 64;
        f32x4 S = (f32x4){0.f, 0.f, 0.f, 0.f};
        const f32x4 kkv = *(const f32x4*)(k_k + cbase + pc), kav = *(const f32x4*)(k_a + cbase + pc), rkv = *(const f32x4*)(r_k + cbase + pc);
        size_t gidx = (size_t)(b * SEQ + ptt) * D + cbase + pc;
        u32x2 qr = *(const u32x2*)(Rb + gidx), qk = *(const u32x2*)(Kb + gidx), qv = *(const u32x2*)(Vb + gidx), qe = *(const u32x2*)(Eb + gidx), qa = *(const u32x2*)(Ab + gidx);
        for (int c0 = 0; c0 < SEQ; c0 += TC) {
            {
                const f32x4 r = unpack4(qr), k = unpack4(qk), v = unpack4(qv), e = unpack4(qe), aa = unpack4(qa);
                f32x4 kk = k * kkv; float ss = (kk[0] * kk[0] + kk[1] * kk[1]) + (kk[2] * kk[2] + kk[3] * kk[3]); ss = red16(ss);
                kk = kk * __builtin_amdgcn_rsqf(fmaxf(ss, 1e-24f));
                const f32x4 kp = k * (1.0f + (aa - 1.0f) * kav);
                const f32x4 rk = r * kp * rkv; const float bo = red16((rk[0] + rk[1]) + (rk[2] + rk[3]));
                f32x4 w;
#pragma unroll
                for (int i = 0; i < 4; ++i) w[i] = __builtin_amdgcn_exp2f(-e[i] * LOG2E);
                const int o = ptt * 64 + pc;
                *(LAS f32x4*)(sR + o) = r; *(LAS f32x4*)(sW + o) = w; *(LAS f32x4*)(sK + o) = kp; *(LAS f32x4*)(sV + o) = v; *(LAS f32x4*)(sKK + o) = kk; *(LAS f32x4*)(sKA + o) = kk * aa;
                if (half == 0 && (tid & 15) == 0) Bon[(size_t)(b * SEQ + c0 + ptt) * 16 + hd] = bo;
            }
            __syncthreads();
            if (c0 + TC < SEQ) { gidx += (size_t)TC * D;
                qr = *(const u32x2*)(Rb + gidx); qk = *(const u32x2*)(Kb + gidx); qv = *(const u32x2*)(Vb + gidx); qe = *(const u32x2*)(Eb + gidx); qa = *(const u32x2*)(Ab + gidx); }
#pragma unroll 4
            for (int t = 0; t < TC; ++t) {
                const int o = t * 64 + kseg;
                const f32x4 kk = *(const LAS f32x4*)(sKK + o), w = *(const LAS f32x4*)(sW + o), ka = *(const LAS f32x4*)(sKA + o), kp = *(const LAS f32x4*)(sK + o), r = *(const LAS f32x4*)(sR + o);
                const float vv = sV[t * 64 + half * 32 + lrow];
                f32x2 p2 = (f32x2){S[0], S[1]} * (f32x2){kk[0], kk[1]}; p2 = (f32x2){S[2], S[3]} * (f32x2){kk[2], kk[3]} + p2;
                float sa = red16(p2[0] + p2[1]);
                S = S * w + (kp * vv - ka * sa);
                f32x2 y2 = (f32x2){S[0], S[1]} * (f32x2){r[0], r[1]}; y2 = (f32x2){S[2], S[3]} * (f32x2){r[2], r[3]} + y2;
                sY[t * 512 + tid] = y2[0] + y2[1];
            }
            __syncthreads();
            {
                const int tok = tid >> 4, r2 = (tid & 15) * 2;
                const LAS f32x4* q = (const LAS f32x4*)(sY + tok * 512 + r2 * 16);
                f32x4 s0 = (q[0] + q[1]) + (q[2] + q[3]), s1 = (q[4] + q[5]) + (q[6] + q[7]);
                *(unsigned*)(Yb + (size_t)(b * SEQ + c0 + tok) * D + cbase + half * 32 + r2) = cvt_pk_bf16((s0[0] + s0[1]) + (s0[2] + s0[3]), (s1[0] + s1[1]) + (s1[2] + s1[3]));
            }
        }
        __syncthreads();
    }
}
__device__ __forceinline__ void p_post(const Ctx& F, const Args& a) {
    bf16_t* Yb = (bf16_t*)(a.ws + A_G); const bf16_t* Vb = (const bf16_t*)(a.ws + A_VV); const bf16_t* Gg = (const bf16_t*)(a.ws + A_E); const float* Bon = (const float*)(a.ws + A_BON);
    const float* gn_w = a.in[22]; const float* gn_b = a.in[23];
    const int tid = fresh_tid(F.wave), grp = tid >> 4, gl = tid & 15;
    for (int item = F.vcu * 32 + grp; item < T * 16; item += F.G * 32) {
        const int tok = item >> 4, hd = item & 15; const size_t idx = (size_t)tok * D + hd * 64 + 4 * gl;
        const f32x4 y = unpack4(*(const u32x2*)(Yb + idx)), v = unpack4(*(const u32x2*)(Vb + idx)), g = unpack4(*(const u32x2*)(Gg + idx));
        const float bo = Bon[(size_t)tok * 16 + hd];
        const f32x4 gw = *(const f32x4*)(gn_w + hd * 64 + 4 * gl), gb = *(const f32x4*)(gn_b + hd * 64 + 4 * gl);
        const float mu = red16((y[0] + y[1]) + (y[2] + y[3])) * (1.0f / 64.0f);
        const f32x4 d = y - mu; const float var = red16((d[0] * d[0] + d[1] * d[1]) + (d[2] * d[2] + d[3] * d[3])) * (1.0f / 64.0f);
        const float rs = __builtin_amdgcn_rsqf(var + GN_EPS);
        const f32x4 ov = (d * rs * gw + gb + v * bo) * g;
        u32x2 w; w.x = cvt_pk_bf16(ov[0], ov[1]); w.y = cvt_pk_bf16(ov[2], ov[3]); *(u32x2*)(Yb + idx) = w;
    }
}

constexpr int KROW = 400, VROW = 144, KBUF = 64 * KROW, VBUF = 128 * VROW, ABUF = KBUF + VBUF;
__device__ __forceinline__ void attn_unit(LAS unsigned char* lds, const bf16_t* qn, const bf16_t* qr, const bf16_t* kn, const bf16_t* kr, const bf16_t* vt, bf16_t* o_out, int b, int h, int qb, int wave_s) {
    const int tid = fresh_tid(wave_s), lane = tid & 63, wid = __builtin_amdgcn_readfirstlane(tid >> 6), r32 = lane & 31, hi = lane >> 5;
    const int tok0 = b * SEQ, q0 = qb * 256 + wid * 32;
    bf16x8 qf[12];
    { const size_t tq = (size_t)(tok0 + q0 + r32);
#pragma unroll
      for (int d = 0; d < 8; ++d) qf[d] = *(const bf16x8*)(qn + tq * D + h * 128 + d * 16 + hi * 8);
#pragma unroll
      for (int d = 0; d < 4; ++d) qf[8 + d] = *(const bf16x8*)(qr + tq * 512 + h * 64 + d * 16 + hi * 8); }
    const int NT = (qb + 1) * 4;
    const int kkey0 = tid >> 4, kch0 = tid & 15;
    const int rkey = tid >> 3, rch = tid & 7;
    const int vrow0 = tid >> 3, vch = tid & 7;
    const bf16_t* gk0 = kn + (size_t)(tok0 + kkey0) * D + h * 128 + kch0 * 8;
    const bf16_t* gk1 = gk0 + (size_t)32 * D;
    const bf16_t* gr = kr + (size_t)(tok0 + rkey) * 64 + rch * 8;
    const bf16_t* gv0 = vt + (size_t)(h * 128 + vrow0) * T + tok0 + vch * 8;
    const bf16_t* gv1 = gv0 + (size_t)64 * T;
    const int lk0 = kkey0 * KROW + kch0 * 16, lk1 = lk0 + 32 * KROW, lr = rkey * KROW + 256 + rch * 16, lv0 = KBUF + vrow0 * VROW + vch * 16, lv1 = lv0 + 64 * VROW;
    const int pr = (r32 & 0x13) | ((r32 & 4) << 1) | ((r32 & 8) >> 1);
    const int kfo = pr * KROW + hi * 16, vfo = KBUF + r32 * VROW + hi * 16;
    u32x4 ld0, ld1, ld2, ld3, ld4;
    ld0 = *(const u32x4*)gk0; ld1 = *(const u32x4*)gk1; ld2 = *(const u32x4*)gr; ld3 = *(const u32x4*)gv0; ld4 = *(const u32x4*)gv1;
    __syncthreads();
    *(LAS u32x4*)(lds + lk0) = ld0; *(LAS u32x4*)(lds + lk1) = ld1; *(LAS u32x4*)(lds + lr) = ld2; *(LAS u32x4*)(lds + lv0) = ld3; *(LAS u32x4*)(lds + lv1) = ld4;
    __syncthreads();
    float mrun = -1e30f, lrun = 0.f;
    f32x16 o[4];
#pragma unroll
    for (int d = 0; d < 4; ++d) o[d] = f32x16{};
    for (int t = 0; t < NT; ++t) {
        const int cb = (t & 1) * ABUF, nb = ((t + 1) & 1) * ABUF;
        const bool more = (t + 1 < NT);
        if (more) { const size_t ko = (size_t)(t + 1) * 64 * D, ro = (size_t)(t + 1) * 64 * 64, vo = (size_t)(t + 1) * 64;
            ld0 = *(const u32x4*)(gk0 + ko); ld1 = *(const u32x4*)(gk1 + ko); ld2 = *(const u32x4*)(gr + ro); ld3 = *(const u32x4*)(gv0 + vo); ld4 = *(const u32x4*)(gv1 + vo); }
        if (64 * t <= q0 + 31) {
            f32x16 s0 = f32x16{}, s1 = f32x16{};
#pragma unroll
            for (int d = 0; d < 12; ++d) {
                const bf16x8 k0 = *(const LAS bf16x8*)(lds + cb + kfo + d * 32), k1 = *(const LAS bf16x8*)(lds + cb + kfo + 32 * KROW + d * 32);
                s0 = __builtin_amdgcn_mfma_f32_32x32x16_bf16(k0, qf[d], s0, 0, 0, 0);
                s1 = __builtin_amdgcn_mfma_f32_32x32x16_bf16(k1, qf[d], s1, 0, 0, 0);
            }
            if (64 * t + 63 > q0) {
                const int qi = q0 + r32, kb0 = 64 * t + 8 * hi;
#pragma unroll
                for (int r = 0; r < 16; ++r) { const int key = kb0 + 16 * (r >> 3) + (r & 7); if (key > qi) s0[r] = -1e30f; if (key + 32 > qi) s1[r] = -1e30f; }
            }
            float mx = fmaxf(s0[0], s1[0]);
#pragma unroll
            for (int r = 1; r < 16; ++r) mx = fmaxf(mx, fmaxf(s0[r], s1[r]));
            mx = fmaxf(mx, __shfl_xor(mx, 32));
            const float mnew = fmaxf(mrun, mx); const float alpha = __builtin_amdgcn_exp2f(mrun - mnew); mrun = mnew;
            float ps = 0.f;
#pragma unroll
            for (int r = 0; r < 16; ++r) { s0[r] = __builtin_amdgcn_exp2f(s0[r] - mnew); s1[r] = __builtin_amdgcn_exp2f(s1[r] - mnew); ps += s0[r] + s1[r]; }
            lrun = lrun * alpha + ps;
#pragma unroll
            for (int d = 0; d < 4; ++d) o[d] = o[d] * alpha;
            bf16x8 pf[4];
            { u32x4 w;
              w.x = cvt_pk_bf16(s0[0], s0[1]); w.y = cvt_pk_bf16(s0[2], s0[3]); w.z = cvt_pk_bf16(s0[4], s0[5]); w.w = cvt_pk_bf16(s0[6], s0[7]); pf[0] = __builtin_bit_cast(bf16x8, w);
              w.x = cvt_pk_bf16(s0[8], s0[9]); w.y = cvt_pk_bf16(s0[10], s0[11]); w.z = cvt_pk_bf16(s0[12], s0[13]); w.w = cvt_pk_bf16(s0[14], s0[15]); pf[1] = __builtin_bit_cast(bf16x8, w);
              w.x = cvt_pk_bf16(s1[0], s1[1]); w.y = cvt_pk_bf16(s1[2], s1[3]); w.z = cvt_pk_bf16(s1[4], s1[5]); w.w = cvt_pk_bf16(s1[6], s1[7]); pf[2] = __builtin_bit_cast(bf16x8, w);
              w.x = cvt_pk_bf16(s1[8], s1[9]); w.y = cvt_pk_bf16(s1[10], s1[11]); w.z = cvt_pk_bf16(s1[12], s1[13]); w.w = cvt_pk_bf16(s1[14], s1[15]); pf[3] = __builtin_bit_cast(bf16x8, w); }
#pragma unroll
            for (int d = 0; d < 4; ++d)
#pragma unroll
                for (int ks = 0; ks < 4; ++ks) {
                    const bf16x8 vf = *(const LAS bf16x8*)(lds + cb + vfo + d * 32 * VROW + ks * 32);
                    o[d] = __builtin_amdgcn_mfma_f32_32x32x16_bf16(vf, pf[ks], o[d], 0, 0, 0);
                }
        }
        if (more) { *(LAS u32x4*)(lds + nb + lk0) = ld0; *(LAS u32x4*)(lds + nb + lk1) = ld1; *(LAS u32x4*)(lds + nb + lr) = ld2; *(LAS u32x4*)(lds + nb + lv0) = ld3; *(LAS u32x4*)(lds + nb + lv1) = ld4; }
        __syncthreads();
    }
    lrun += __shfl_xor(lrun, 32);
    const float rl = __builtin_amdgcn_rcpf(lrun);
    bf16_t* op = o_out + (size_t)(tok0 + q0 + r32) * D + h * 128 + 4 * hi;
#pragma unroll
    for (int d = 0; d < 4; ++d)
#pragma unroll
        for (int r4 = 0; r4 < 4; ++r4) { u32x2 w; w.x = cvt_pk_bf16(o[d][4 * r4] * rl, o[d][4 * r4 + 1] * rl); w.y = cvt_pk_bf16(o[d][4 * r4 + 2] * rl, o[d][4 * r4 + 3] * rl);
            *(u32x2*)(op + 32 * d + 8 * r4) = w; }
}
__device__ __forceinline__ void p_attn(const Ctx& F, const Args& a) {
    const bf16_t* qn = (const bf16_t*)(a.ws + A_QN); const bf16_t* qr = (const bf16_t*)(a.ws + A_QR);
    const bf16_t* kn = (const bf16_t*)(a.ws + A_KN); const bf16_t* kr = (const bf16_t*)(a.ws + A_KR); const bf16_t* vt = (const bf16_t*)(a.ws + A_VT);
    bf16_t* oo = (bf16_t*)(a.ws + A_QN);
    for (int p = F.vcu; p < 512; p += F.G) {
        const int bh = p >> 3, s = p & 7;
        attn_unit(F.lds, qn, qr, kn, kr, vt, oo, bh >> 3, bh & 7, 15 - s, F.wave);
        attn_unit(F.lds, qn, qr, kn, kr, vt, oo, bh >> 3, bh & 7, s, F.wave);
    }
}

__device__ __forceinline__ void p_final(const Ctx& F, const Args& a) {
    float* h = a.out; const float* g = a.in[32];
    const int tid = fresh_tid(F.wave), lane = tid & 63, wave = __builtin_amdgcn_readfirstlane(tid >> 6);
    const int gw = F.vcu * 8 + wave, NGW = F.G * 8;
    f32x4 gv[4];
#pragma unroll
    for (int j = 0; j < 4; ++j) gv[j] = *((const f32x4*)g + lane + 64 * j);
    for (int m = gw; m < T; m += NGW) {
        f32x4 v[4]; float ss = 0.f;
#pragma unroll
        for (int j = 0; j < 4; ++j) { v[j] = *((const f32x4*)(h + (size_t)m * D) + lane + 64 * j); ss += (v[j][0] * v[j][0] + v[j][1] * v[j][1]) + (v[j][2] * v[j][2] + v[j][3] * v[j][3]); }
        const float rs = __builtin_amdgcn_rsqf(wave_sum(ss) * (1.0f / 1024.0f) + RMS_EPS);
#pragma unroll
        for (int j = 0; j < 4; ++j) *((f32x4*)(h + (size_t)m * D) + lane + 64 * j) = v[j] * rs * gv[j];
    }
}

__device__ __forceinline__ void my_grid_sync(unsigned* cnt, unsigned G, int wave_s) {
    asm volatile("s_waitcnt vmcnt(0) lgkmcnt(0)" ::: "memory");
    __syncthreads();
    if (fresh_tid(wave_s) == 0) {
        __builtin_amdgcn_fence(__ATOMIC_RELEASE, "agent");
        asm volatile("s_waitcnt vmcnt(0)" ::: "memory");
        __hip_atomic_fetch_add(cnt, 1u, __ATOMIC_RELAXED, __HIP_MEMORY_SCOPE_AGENT);
        while (__hip_atomic_load(cnt, __ATOMIC_RELAXED, __HIP_MEMORY_SCOPE_AGENT) < G) __builtin_amdgcn_s_sleep(4);
        __builtin_amdgcn_fence(__ATOMIC_ACQUIRE, "agent");
        asm volatile("s_waitcnt vmcnt(0)" ::: "memory");
    }
    __syncthreads();
}
#define GSYNC() do { my_grid_sync(bar_words + 64 * bar_idx, (unsigned)F.G, F.wave); ++bar_idx; } while (0)
#define RUN_GEMM(EPI_T, epi, Aptr, lda_, Bptr, ldb_, M_, N_, K_) do { pg8::Gemm g_{(const bf16_t*)(Aptr), (lda_), (const bf16_t*)(Bptr), (ldb_), (M_), (N_), (K_)}; \
    pg8::StaticOrder S_; S_.init((M_), (N_), F.G, (int)blockIdx.x); pg8::gemm_phase<EPI_T>(F.lds, g_, S_, (epi), F.wave); } while (0)

__global__ void __launch_bounds__(512, 2) fwd_mega(Args a) {
    extern __shared__ __attribute__((aligned(16))) unsigned char lds_raw[];
    cg::grid_group grid = cg::this_grid();
    Ctx F; F.lds = (LAS unsigned char*)lds_raw; F.wave = __builtin_amdgcn_readfirstlane((int)threadIdx.x >> 6);
    F.G = gridDim.x; { const int bx = blockIdx.x; F.vcu = (F.G % 8 == 0) ? (bx % 8) * (F.G / 8) + bx / 8 : bx; }
    unsigned char* ws = a.ws;
    float* slotsH = (float*)(ws + WS_SLOTH); float* slotsC = (float*)(ws + WS_SLOTC); float* slotsQ = (float*)(ws + WS_SLOTQ);
    bf16_t* HB = (bf16_t*)(ws + A_HB); bf16_t* MID = (bf16_t*)(ws + A_MID);
    const float* cosT = (const float*)(ws + A_COS); const float* sinT = (const float*)(ws + A_SIN);
    bf16_t* WUG = (bf16_t*)(ws + W_UG); bf16_t* WDN = (bf16_t*)(ws + W_DN);

    unsigned* bar_words = (unsigned*)ws;
    if (a.ph_hi - a.ph_lo > 1) grid.sync();
    if (a.ph_lo <= 0 && 0 < a.ph_hi) {
    p0_prologue(F, a);
    }
    if (a.ph_lo <= 0 && 1 < a.ph_hi) my_grid_sync(bar_words + 64 * 0, (unsigned)F.G, F.wave);
    if (a.ph_lo <= 1 && 1 < a.ph_hi) {
    { EpiSwiglu E{MID, slotsH, nullptr, nullptr, nullptr, nullptr, nullptr}; RUN_GEMM(EpiSwiglu, E, HB, D, WUG, D, T, 5632, D); }
    }
    if (a.ph_lo <= 1 && 2 < a.ph_hi) my_grid_sync(bar_words + 64 * 1, (unsigned)F.G, F.wave);
    if (a.ph_lo <= 2 && 2 < a.ph_hi) {
    { EpiResid E{a.in[0], a.out, nullptr, nullptr, 0.5f}; RUN_GEMM(EpiResid, E, MID, FF, WDN, FF, T, D, FF); }
    }
    if (a.ph_lo <= 2 && 3 < a.ph_hi) my_grid_sync(bar_words + 64 * 2, (unsigned)F.G, F.wave);
    if (a.ph_lo <= 3 && 3 < a.ph_hi) {
    p_premix(F, a);
    }
    if (a.ph_lo <= 3 && 4 < a.ph_hi) my_grid_sync(bar_words + 64 * 3, (unsigned)F.G, F.wave);
    if (a.ph_lo <= 4 && 4 < a.ph_hi) {
    { EpiRL E{(bf16_t*)(ws + A_R), (bf16_t*)(ws + A_LM)}; RUN_GEMM(EpiRL, E, ws + A_X1, 2048, ws + W_RL, 2048, T, 1280, 2048); }
    }
    if (a.ph_lo <= 4 && 5 < a.ph_hi) my_grid_sync(bar_words + 64 * 4, (unsigned)F.G, F.wave);
    if (a.ph_lo <= 5 && 5 < a.ph_hi) {
    { EpiBf16 E{(bf16_t*)(ws + A_KK), D}; RUN_GEMM(EpiBf16, E, ws + A_XK, D, ws + W_K, D, T, D, D); }
    { EpiBf16 E{(bf16_t*)(ws + A_VV), D}; RUN_GEMM(EpiBf16, E, ws + A_XV, D, ws + W_V, D, T, D, D); }
    }
    if (a.ph_lo <= 5 && 6 < a.ph_hi) my_grid_sync(bar_words + 64 * 5, (unsigned)F.G, F.wave);
    if (a.ph_lo <= 6 && 6 < a.ph_hi) {
    { EpiLoraUp E{ws, a.in[11], a.in[14], 0, A_G}; RUN_GEMM(EpiLoraUp, E, ws + A_LM, 256, ws + W_LU, 256, T, 2048, 256); }
    }
    if (a.ph_lo <= 6 && 7 < a.ph_hi) my_grid_sync(bar_words + 64 * 6, (unsigned)F.G, F.wave);
    if (a.ph_lo <= 7 && 7 < a.ph_hi) {
    p_scan2(F, a);
    }
    if (a.ph_lo <= 7 && 8 < a.ph_hi) my_grid_sync(bar_words + 64 * 7, (unsigned)F.G, F.wave);
    if (a.ph_lo <= 8 && 8 < a.ph_hi) {
    { EpiLoraUp E{ws, a.in[11], a.in[14], 2, A_E}; RUN_GEMM(EpiLoraUp, E, ws + A_LM, 256, ws + W_LU + (size_t)2048 * 256 * 2, 256, T, 1024, 256); }
    }
    if (a.ph_lo <= 8 && 9 < a.ph_hi) my_grid_sync(bar_words + 64 * 8, (unsigned)F.G, F.wave);
    if (a.ph_lo <= 9 && 9 < a.ph_hi) {
    p_post(F, a);
    }
    if (a.ph_lo <= 9 && 10 < a.ph_hi) my_grid_sync(bar_words + 64 * 9, (unsigned)F.G, F.wave);
    if (a.ph_lo <= 10 && 10 < a.ph_hi) {
    { EpiResid E{a.out, a.out, HB, slotsH, 1.0f}; RUN_GEMM(EpiResid, E, ws + A_G, D, ws + W_O, D, T, D, D); }
    }
    if (a.ph_lo <= 10 && 11 < a.ph_hi) my_grid_sync(bar_words + 64 * 10, (unsigned)F.G, F.wave);
    if (a.ph_lo <= 11 && 11 < a.ph_hi) {
    { EpiSwiglu E{MID, slotsH, nullptr, nullptr, nullptr, nullptr, nullptr}; RUN_GEMM(EpiSwiglu, E, HB, D, WUG + (size_t)1 * 6144 * D, D, T, 5632, D); }
    }
    if (a.ph_lo <= 11 && 12 < a.ph_hi) my_grid_sync(bar_words + 64 * 11, (unsigned)F.G, F.wave);
    if (a.ph_lo <= 12 && 12 < a.ph_hi) {
    { EpiResid E{a.out, a.out, HB, slotsH, 0.5f}; RUN_GEMM(EpiResid, E, MID, FF, WDN + (size_t)1 * D * FF, FF, T, D, FF); }
    }
    if (a.ph_lo <= 12 && 13 < a.ph_hi) my_grid_sync(bar_words + 64 * 12, (unsigned)F.G, F.wave);
    if (a.ph_lo <= 13 && 13 < a.ph_hi) {
    { EpiSwiglu E{MID, slotsH, (bf16_t*)(ws + A_C), slotsC, (bf16_t*)(ws + A_KR), cosT, sinT}; RUN_GEMM(EpiSwiglu, E, HB, D, WUG + (size_t)2 * 6144 * D, D, T, 6144, D); }
    }
    if (a.ph_lo <= 13 && 14 < a.ph_hi) my_grid_sync(bar_words + 64 * 13, (unsigned)F.G, F.wave);
    if (a.ph_lo <= 14 && 14 < a.ph_hi) {
    { EpiResid E{a.out, a.out, HB, slotsH, 0.5f}; RUN_GEMM(EpiResid, E, MID, FF, WDN + (size_t)2 * D * FF, FF, T, D, FF); }
    { EpiKnope E{(bf16_t*)(ws + A_KN), slotsC}; RUN_GEMM(EpiKnope, E, ws + A_C, 256, ws + W_KN, 256, T, D, 256); }
    { EpiVt E{(bf16_t*)(ws + A_VT), slotsC}; RUN_GEMM(EpiVt, E, ws + W_VT, 256, ws + A_C, 256, D, T, 256); }
    }
    if (a.ph_lo <= 14 && 15 < a.ph_hi) my_grid_sync(bar_words + 64 * 14, (unsigned)F.G, F.wave);
    if (a.ph_lo <= 15 && 15 < a.ph_hi) {
    { EpiQlat E{(bf16_t*)(ws + A_QLAT), slotsH, slotsQ}; RUN_GEMM(EpiQlat, E, HB, D, ws + W_DQ, D, T, 512, D); }
    }
    if (a.ph_lo <= 15 && 16 < a.ph_hi) my_grid_sync(bar_words + 64 * 15, (unsigned)F.G, F.wave);
    if (a.ph_lo <= 16 && 16 < a.ph_hi) {
    { EpiQ E{(bf16_t*)(ws + A_QN), (bf16_t*)(ws + A_QR), slotsQ, cosT, sinT}; RUN_GEMM(EpiQ, E, ws + A_QLAT, 512, ws + W_UQ, 512, T, 1536, 512); }
    }
    if (a.ph_lo <= 16 && 17 < a.ph_hi) my_grid_sync(bar_words + 64 * 16, (unsigned)F.G, F.wave);
    if (a.ph_lo <= 17 && 17 < a.ph_hi) {
    p_attn(F, a);
    }
    if (a.ph_lo <= 17 && 18 < a.ph_hi) my_grid_sync(bar_words + 64 * 17, (unsigned)F.G, F.wave);
    if (a.ph_lo <= 18 && 18 < a.ph_hi) {
    { EpiResid E{a.out, a.out, HB, slotsH, 1.0f}; RUN_GEMM(EpiResid, E, ws + A_QN, D, ws + W_MO, D, T, D, D); }
    }
    if (a.ph_lo <= 18 && 19 < a.ph_hi) my_grid_sync(bar_words + 64 * 18, (unsigned)F.G, F.wave);
    if (a.ph_lo <= 19 && 19 < a.ph_hi) {
    { EpiSwiglu E{MID, slotsH, nullptr, nullptr, nullptr, nullptr, nullptr}; RUN_GEMM(EpiSwiglu, E, HB, D, WUG + (size_t)3 * 6144 * D, D, T, 5632, D); }
    }
    if (a.ph_lo <= 19 && 20 < a.ph_hi) my_grid_sync(bar_words + 64 * 19, (unsigned)F.G, F.wave);
    if (a.ph_lo <= 20 && 20 < a.ph_hi) {
    { EpiResid E{a.out, a.out, nullptr, nullptr, 0.5f}; RUN_GEMM(EpiResid, E, MID, FF, WDN + (size_t)3 * D * FF, FF, T, D, FF); }
    }
    if (a.ph_lo <= 20 && 21 < a.ph_hi) my_grid_sync(bar_words + 64 * 20, (unsigned)F.G, F.wave);
    if (a.ph_lo <= 21 && 21 < a.ph_hi) {
    p_final(F, a);
    }
}

extern "C" void kernel_launch(void* const* d_in, const int* in_sizes, int n_in, void* d_out, int out_size, void* d_ws, size_t ws_size, hipStream_t stream) {
    static int grid = 0;
    if (grid == 0) {
        if (n_in != 33 || out_size != T * D || ws_size < WS_NEED) { fprintf(stderr, "kernel_launch: unexpected shapes: n_in %d out %d ws %zu (need %zu)\n", n_in, out_size, ws_size, (size_t)WS_NEED); grid = -1; return; }
        int dev = 0, cus = 0, per_cu = 0;
        (void)hipGetDevice(&dev); (void)hipDeviceGetAttribute(&cus, hipDeviceAttributeMultiprocessorCount, dev);
        (void)hipFuncSetAttribute((const void*)fwd_mega, hipFuncAttributeMaxDynamicSharedMemorySize, LDS_BYTES);
        (void)hipOccupancyMaxActiveBlocksPerMultiprocessor(&per_cu, (const void*)fwd_mega, 512, LDS_BYTES);
        (void)hipGetLastError();
        grid = cus > 0 ? cus : 256;
        if (grid > 256) grid = 256;
    }
    if (grid < 0) return;
    (void)hipMemsetAsync(d_ws, 0, 65536, stream);
    Args a{};
    for (int i = 0; i < 33; ++i) a.in[i] = (const float*)d_in[i];
    a.pos = (const int*)d_in[1]; a.out = (float*)d_out; a.ws = (unsigned char*)d_ws;
    hipError_t e = hipSuccess;
#if N_LAUNCHES == 1
    a.ph_lo = 0; a.ph_hi = NPHASES;
    { void* args[] = {&a}; e = hipLaunchCooperativeKernel((void*)fwd_mega, dim3(grid), dim3(512), args, LDS_BYTES, stream); }
#else
    for (int p = 0; p < NPHASES; ++p) { a.ph_lo = p; a.ph_hi = p + 1; hipLaunchKernelGGL(fwd_mega, dim3(grid), dim3(512), LDS_BYTES, stream, a); }
    e = hipPeekAtLastError();
#endif
    if (e != hipSuccess) fprintf(stderr, "cooperative launch failed: %s (grid %d)\n", hipGetErrorString(e), grid);
}
```

```cpp
#include <hip/hip_runtime.h>
#include <hip/hip_cooperative_groups.h>
#include <cstdio>
#include <cstdint>
namespace cg = cooperative_groups;

#define LAS __attribute__((address_space(3)))
typedef unsigned short bf16_t;
typedef short bf16x8 __attribute__((ext_vector_type(8)));
typedef float f32x4 __attribute__((ext_vector_type(4)));
typedef float f32x16 __attribute__((ext_vector_type(16)));
typedef unsigned u32x4 __attribute__((ext_vector_type(4)));
typedef unsigned u32x2 __attribute__((ext_vector_type(2)));
typedef float f32x2 __attribute__((ext_vector_type(2)));

constexpr int T = 32768, D = 1024, FF = 2816, SEQ = 4096, NB = 8;
constexpr float RMS_EPS = 1e-6f, GN_EPS = 64e-5f;
constexpr float LOG2E = 1.4426950408889634f;
constexpr float QSCALE = 0.07216878364870322f * 1.4426950408889634f;

constexpr size_t MiB = 1u << 20;
constexpr size_t WS_SLOTH = MiB / 2;
constexpr size_t WS_SLOTC = WS_SLOTH + 2 * MiB;
constexpr size_t WS_SLOTQ = WS_SLOTC + MiB / 2;
constexpr size_t WS_W = 4 * MiB;
constexpr size_t W_UG = WS_W;
constexpr size_t W_DN = W_UG + 48 * MiB;
constexpr size_t W_R = W_DN + 22 * MiB;
constexpr size_t W_K = W_R + 2 * MiB;
constexpr size_t W_V = W_K + 2 * MiB;
constexpr size_t W_O = W_V + 2 * MiB;
constexpr size_t W_LD = W_O + 2 * MiB;
constexpr size_t W_LU = W_LD + 1 * MiB;
constexpr size_t W_KN = W_LU + 2 * MiB;
constexpr size_t W_VT = W_KN + MiB / 2;
constexpr size_t W_DQ = W_VT + MiB / 2;
constexpr size_t W_UQ = W_DQ + 1 * MiB;
constexpr size_t W_MO = W_UQ + 2 * MiB;
constexpr size_t W_END = W_MO + 2 * MiB;
constexpr size_t WS_A = 92 * MiB;
static_assert(W_END <= WS_A, "weights region");
constexpr size_t A_HB = WS_A + 0;
constexpr size_t A_MID = WS_A + 64 * MiB;
constexpr size_t A_C = WS_A + 240 * MiB;
constexpr size_t A_KR = WS_A + 256 * MiB;
constexpr size_t A_KN = WS_A + 260 * MiB;
constexpr size_t A_VT = WS_A + 324 * MiB;
constexpr size_t A_QLAT = A_MID;
constexpr size_t A_QN = A_MID + 32 * MiB;
constexpr size_t A_QR = A_MID + 96 * MiB;
constexpr size_t A_X1 = WS_A + 0;
constexpr size_t A_XK = WS_A + 128 * MiB;
constexpr size_t A_XV = WS_A + 192 * MiB;
constexpr size_t A_R = WS_A + 256 * MiB;
constexpr size_t A_LM = WS_A + 320 * MiB;
constexpr size_t A_KK = WS_A + 0;
constexpr size_t A_VV = WS_A + 64 * MiB;
constexpr size_t A_E = WS_A + 128 * MiB;
constexpr size_t A_AA = WS_A + 192 * MiB;
constexpr size_t A_G = WS_A + 336 * MiB;
constexpr size_t A_BON = WS_A + 400 * MiB;
constexpr size_t A_COS = WS_A + 404 * MiB;
constexpr size_t A_SIN = WS_A + 408 * MiB;
constexpr size_t W_RL = WS_A + 412 * MiB;
constexpr size_t WS_NEED = 512 * MiB;

constexpr int LDS_BYTES = 147456;
constexpr int NPHASES = 22;
#ifndef N_LAUNCHES
#define N_LAUNCHES 1
#endif

__device__ __forceinline__ unsigned cvt_pk_bf16(float lo, float hi) { unsigned r; asm volatile("v_cvt_pk_bf16_f32 %0, %1, %2" : "=v"(r) : "v"(lo), "v"(hi)); return r; }
__device__ __forceinline__ float fsigmoid(float x) { return __builtin_amdgcn_rcpf(1.0f + __builtin_amdgcn_exp2f(-x * LOG2E)); }
__device__ __forceinline__ float ftanh(float x) { return 1.0f - 2.0f * __builtin_amdgcn_rcpf(1.0f + __builtin_amdgcn_exp2f(2.0f * LOG2E * x)); }
__device__ __forceinline__ float wave_sum(float v) {
#pragma unroll
    for (int o = 1; o < 64; o <<= 1) v += __shfl_xor(v, o);
    return v;
}
template <int CTRL> __device__ __forceinline__ float dpp_mov(float x) { return __builtin_bit_cast(float, __builtin_amdgcn_update_dpp(0, __builtin_bit_cast(int, x), CTRL, 0xf, 0xf, true)); }
__device__ __forceinline__ float red8(float x) { x += dpp_mov<0xB1>(x); x += dpp_mov<0x4E>(x); x += dpp_mov<0x141>(x); return x; }
__device__ __forceinline__ float red16(float x) { x = red8(x); x += dpp_mov<0x140>(x); return x; }
__device__ __forceinline__ float sum4(f32x4 v) { return (v[0] + v[1]) + (v[2] + v[3]); }
__device__ __forceinline__ float rstd_slots16(const float* s, int row) {
    const f32x4* p = (const f32x4*)(s + (size_t)row * 16);
    const f32x4 a = p[0], b = p[1], c = p[2], d = p[3];
    return __builtin_amdgcn_rsqf((sum4(a) + sum4(b) + sum4(c) + sum4(d)) * (1.0f / 1024.0f) + RMS_EPS);
}
__device__ __forceinline__ f32x4 unpack4(u32x2 p) { f32x4 r; r[0] = __uint_as_float(p.x << 16); r[1] = __uint_as_float(p.x & 0xffff0000u); r[2] = __uint_as_float(p.y << 16); r[3] = __uint_as_float(p.y & 0xffff0000u); return r; }

__device__ __forceinline__ int fresh_tid(int wave_s) { int l; asm volatile("v_mbcnt_lo_u32_b32 %0, -1, 0\n\tv_mbcnt_hi_u32_b32 %0, -1, %0" : "=v"(l)); return wave_s * 64 + l; }

namespace pg8 {
constexpr int BM = 256, BK = 64, HALF = 128, HTB = HALF * BK * 2, STAGE_BYTES = 8 * HTB, NXCD = 8, WGM = 8;
__device__ __forceinline__ int lds_byte(int r, int c) { const int st = (r >> 4) * 2 + (c >> 5), rr = r & 15, cc = c & 31, ob = rr * 64 + cc * 2; return st * 1024 + (ob ^ (((ob >> 9) & 1) << 5)); }
__device__ __forceinline__ void stage_rc(int b, int& R, int& C) { const int st = b / 1024, sb = b % 1024, swz = sb ^ (((sb >> 9) & 1) << 5); R = (st >> 1) * 16 + swz / 64; C = (st & 1) * 32 + (swz % 64) / 2; }
__device__ __forceinline__ int perm32(int rho) { const int n = rho >> 4, i = rho & 15; return 8 * (i >> 2) + 4 * n + (i & 3); }
struct Unit { int pm, pn; };
struct Gemm { const bf16_t* A; int lda; const bf16_t* Bt; int ldb; int M, N, K; };
struct StaticOrder {
    int nM, nN, nwg, G, c;
    __device__ void init(int M, int N, int G_, int c_) { nM = M / BM; nN = N / BM; nwg = nM * nN; G = G_; c = c_; }
    __device__ bool next(int i, Unit& u) const {
        const long L = (long)i * G + c; if (L >= nwg) return false;
        int wgid = (int)L; { const int q = nwg / NXCD, r = nwg % NXCD, xcd = wgid % NXCD, off = wgid / NXCD; wgid = (xcd < r ? xcd * (q + 1) : r * (q + 1) + (xcd - r) * q) + off; }
        const int nig = WGM * nN, gid = wgid / nig, fm = gid * WGM, gsz = (nM - fm) < WGM ? (nM - fm) : WGM;
        u.pm = fm + ((wgid % nig) % gsz); u.pn = (wgid % nig) / gsz; return true;
    }
};

template <class Epi>
__device__ __forceinline__ void gemm_phase(LAS unsigned char* lds, const Gemm g, const StaticOrder& S, const Epi& E, int wave_s) {
    const int tid = fresh_tid(wave_s), wid = __builtin_amdgcn_readfirstlane(tid >> 6), lane = tid & 63, wr = wid >> 2, wc = wid & 3, fr = lane & 15, fq = lane >> 4;
    const int K = g.K, nt = K / BK;
    unsigned voffA[2], voffB[2];
#pragma unroll
    for (int i = 0; i < 2; ++i) { int R, C; stage_rc(tid * 16 + i * 8192, R, C); const int Rb = Epi::PERM ? ((R & ~31) + perm32(R & 31)) : R;
        voffA[i] = (unsigned)(R * g.lda + C) * 2u; voffB[i] = (unsigned)(Rb * g.ldb + C) * 2u; }
    const size_t kstep = (size_t)(BK * 2);
    const size_t hstepA = (size_t)HALF * g.lda * 2, hstepB = (size_t)HALF * g.ldb * 2;
    const size_t tstepA = 2 * hstepA, tstepB = 2 * hstepB;
    const unsigned ldsw = (unsigned)wid * 1024u;
    const int aoff = lds_byte(wr * 64 + fr, fq * 8), boff = lds_byte(wc * 32 + fr, fq * 8);
#define PG8_SA(b, h) (((b) * 2 + (h)) * HTB)
#define PG8_SB(b, h) ((4 + (b) * 2 + (h)) * HTB)
#define PG8_STAGE(bufoff, gbase, voff) do { _Pragma("unroll") for (int _i = 0; _i < 2; ++_i) \
        __builtin_amdgcn_global_load_lds((const unsigned*)((const char*)(gbase) + (voff)[_i]), (LAS unsigned*)(lds + (bufoff) + ldsw + _i * 8192), 16, 0, 0); } while (0)
#define PG8_LDA(dst, b, h) do { _Pragma("unroll") for (int m = 0; m < 4; ++m) _Pragma("unroll") for (int k = 0; k < 2; ++k) dst[m][k] = *(const LAS bf16x8*)(lds + PG8_SA(b, h) + aoff + m * 2048 + k * 1024); } while (0)
#define PG8_LDB(dst, b, h) do { _Pragma("unroll") for (int n = 0; n < 2; ++n) _Pragma("unroll") for (int k = 0; k < 2; ++k) dst[n][k] = *(const LAS bf16x8*)(lds + PG8_SB(b, h) + boff + n * 2048 + k * 1024); } while (0)
#define PG8_MMA(ai, bj, At, Bt) do { __builtin_amdgcn_s_setprio(1); _Pragma("unroll") for (int m = 0; m < 4; ++m) _Pragma("unroll") for (int n = 0; n < 2; ++n) _Pragma("unroll") for (int k = 0; k < 2; ++k) \
        acc[ai][bj][m][n] = __builtin_amdgcn_mfma_f32_16x16x32_bf16(Bt[n][k], At[m][k], acc[ai][bj][m][n], 0, 0, 0); __builtin_amdgcn_s_setprio(0); } while (0)
#define PG8_WAIT_V(n) asm volatile("s_waitcnt vmcnt(" #n ")" ::: "memory")
#define PG8_WAIT_L(n) asm volatile("s_waitcnt lgkmcnt(" #n ")" ::: "memory")
#define PG8_BAR __builtin_amdgcn_s_barrier()
#define PG8_SCHED __builtin_amdgcn_sched_barrier(0)
    Unit cur, nxt; int ui = 0;
    if (!S.next(0, cur)) return;
    f32x4 acc[2][2][4][2];
#pragma unroll
    for (int a = 0; a < 2; ++a)
#pragma unroll
        for (int b = 0; b < 2; ++b)
#pragma unroll
            for (int m = 0; m < 4; ++m)
#pragma unroll
                for (int n = 0; n < 2; ++n) acc[a][b][m][n] = (f32x4){0.f, 0.f, 0.f, 0.f};
    bf16x8 At[4][2], B0[2][2], B1[2][2];
    const char* cA = (const char*)g.A + (size_t)cur.pm * tstepA; const char* cB = (const char*)g.Bt + (size_t)cur.pn * tstepB;
    PG8_STAGE(PG8_SB(0, 0), cB, voffB); PG8_STAGE(PG8_SB(0, 1), cB + hstepB, voffB); PG8_STAGE(PG8_SA(0, 0), cA, voffA); PG8_STAGE(PG8_SA(0, 1), cA + hstepA, voffA);
    if (wr == 1) PG8_BAR;
    PG8_WAIT_V(2); PG8_BAR;
    PG8_STAGE(PG8_SB(1, 0), cB + kstep, voffB); PG8_STAGE(PG8_SA(1, 0), cA + kstep, voffA); PG8_STAGE(PG8_SB(1, 1), cB + hstepB + kstep, voffB);
    PG8_WAIT_V(6); PG8_BAR;
    for (;;) {
        const bool has_next = S.next(ui + 1, nxt);
        const char* nA = has_next ? (const char*)g.A + (size_t)nxt.pm * tstepA : cA; const char* nB = has_next ? (const char*)g.Bt + (size_t)nxt.pn * tstepB : cB;
        for (int t = 0; t < nt; t += 2) {
            const bool last = (t == nt - 2);
            const char* a1 = cA + (size_t)(t + 1) * kstep;
            const char* a2 = last ? nA : cA + (size_t)(t + 2) * kstep; const char* b2 = last ? nB : cB + (size_t)(t + 2) * kstep;
            const char* a3 = a2 + kstep; const char* b3 = b2 + kstep;
            PG8_LDB(B0, 0, 0); PG8_LDB(B1, 0, 1); PG8_SCHED; PG8_LDA(At, 0, 0); PG8_STAGE(PG8_SA(1, 1), a1 + hstepA, voffA);
            PG8_WAIT_V(8); PG8_WAIT_L(0); PG8_BAR; PG8_MMA(0, 0, At, B0); PG8_MMA(0, 1, At, B1); PG8_BAR; PG8_SCHED;
            PG8_LDA(At, 0, 1); PG8_STAGE(PG8_SB(0, 0), b2, voffB); PG8_STAGE(PG8_SB(0, 1), b2 + hstepB, voffB); PG8_STAGE(PG8_SA(0, 0), a2, voffA);
            PG8_WAIT_V(8); PG8_WAIT_L(0); PG8_BAR; PG8_MMA(1, 0, At, B0); PG8_MMA(1, 1, At, B1); PG8_BAR; PG8_SCHED;
            PG8_LDB(B0, 1, 0); PG8_LDB(B1, 1, 1); PG8_SCHED; PG8_LDA(At, 1, 0); PG8_STAGE(PG8_SA(0, 1), a2 + hstepA, voffA);
            PG8_WAIT_V(8); PG8_WAIT_L(0); PG8_BAR; PG8_MMA(0, 0, At, B0); PG8_MMA(0, 1, At, B1); PG8_BAR; PG8_SCHED;
            PG8_LDA(At, 1, 1); PG8_STAGE(PG8_SB(1, 0), b3, voffB); PG8_STAGE(PG8_SB(1, 1), b3 + hstepB, voffB); PG8_STAGE(PG8_SA(1, 0), a3, voffA);
            PG8_WAIT_V(8); PG8_WAIT_L(0); PG8_BAR; PG8_MMA(1, 0, At, B0); PG8_MMA(1, 1, At, B1); PG8_BAR; PG8_SCHED;
        }
        if (wr == 0) PG8_BAR;
        E(acc, cur, wr, wc, fr, fq);
        if (!has_next) break;
#pragma unroll
        for (int a = 0; a < 2; ++a)
#pragma unroll
            for (int b = 0; b < 2; ++b)
#pragma unroll
                for (int m = 0; m < 4; ++m)
#pragma unroll
                    for (int n = 0; n < 2; ++n) acc[a][b][m][n] = (f32x4){0.f, 0.f, 0.f, 0.f};
        cur = nxt; cA = nA; cB = nB; ++ui;
        if (wr == 1) PG8_BAR;
    }
    PG8_WAIT_V(0);
    PG8_BAR;
#undef PG8_SA
#undef PG8_SB
#undef PG8_STAGE
#undef PG8_LDA
#undef PG8_LDB
#undef PG8_MMA
#undef PG8_WAIT_V
#undef PG8_WAIT_L
#undef PG8_BAR
#undef PG8_SCHED
}
}
using pg8::Unit;
typedef f32x4 AccT[2][2][4][2];

__device__ __forceinline__ u32x4 pack8(f32x4 a, f32x4 b) { u32x4 w; w.x = cvt_pk_bf16(a[0], a[1]); w.y = cvt_pk_bf16(a[2], a[3]); w.z = cvt_pk_bf16(b[0], b[1]); w.w = cvt_pk_bf16(b[2], b[3]); return w; }

struct EpiSwiglu {
    static constexpr bool PERM = true;
    bf16_t* mid; const float* slotsH; bf16_t* cbuf; float* slotsC; bf16_t* krope; const float* cosT; const float* sinT;
    __device__ __forceinline__ void operator()(const AccT& acc, const Unit& u, int wr, int wc, int fr, int fq) const {
        const int row0 = u.pm * 256 + wr * 64 + fr;
        if (u.pn < 22) {
#pragma unroll
            for (int ai = 0; ai < 2; ++ai)
#pragma unroll
                for (int m = 0; m < 4; ++m) {
                    const int row = row0 + ai * 128 + m * 16; const float rs = rstd_slots16(slotsH, row);
                    f32x4 o[2];
#pragma unroll
                    for (int n = 0; n < 2; ++n)
#pragma unroll
                        for (int i = 0; i < 4; ++i) { const float gt = acc[ai][0][m][n][i] * rs, up = acc[ai][1][m][n][i] * rs; o[n][i] = gt * fsigmoid(gt) * up; }
                    *(u32x4*)(mid + (size_t)row * FF + u.pn * 128 + wc * 32 + fq * 8) = pack8(o[0], o[1]);
                }
        } else if (u.pn == 22) {
#pragma unroll
            for (int ai = 0; ai < 2; ++ai)
#pragma unroll
                for (int m = 0; m < 4; ++m) {
                    const int row = row0 + ai * 128 + m * 16; const float rs = rstd_slots16(slotsH, row);
                    float ss = 0.f;
#pragma unroll
                    for (int bj = 0; bj < 2; ++bj) { const f32x4 a = acc[ai][bj][m][0] * rs, b = acc[ai][bj][m][1] * rs;
                        ss += (a[0] * a[0] + a[1] * a[1]) + (a[2] * a[2] + a[3] * a[3]) + (b[0] * b[0] + b[1] * b[1]) + (b[2] * b[2] + b[3] * b[3]);
                        *(u32x4*)(cbuf + (size_t)row * 256 + bj * 128 + wc * 32 + fq * 8) = pack8(a, b); }
                    ss += __shfl_xor(ss, 16); ss += __shfl_xor(ss, 32);
                    if (fq == 0) slotsC[(size_t)row * 4 + wc] = ss;
                }
        } else if (wc == 0) {
#pragma unroll
            for (int ai = 0; ai < 2; ++ai)
#pragma unroll
                for (int m = 0; m < 4; ++m) {
                    const int row = row0 + ai * 128 + m * 16; const float rs = rstd_slots16(slotsH, row);
                    f32x4 o1[2], o2[2];
#pragma unroll
                    for (int n = 0; n < 2; ++n) { const f32x4 c = *(const f32x4*)(cosT + (size_t)row * 32 + fq * 8 + n * 4), s = *(const f32x4*)(sinT + (size_t)row * 32 + fq * 8 + n * 4);
                        const f32x4 x1 = acc[ai][0][m][n] * rs, x2 = acc[ai][1][m][n] * rs; o1[n] = x1 * c - x2 * s; o2[n] = x2 * c + x1 * s; }
                    *(u32x4*)(krope + (size_t)row * 64 + fq * 8) = pack8(o1[0], o1[1]);
                    *(u32x4*)(krope + (size_t)row * 64 + 32 + fq * 8) = pack8(o2[0], o2[1]);
                }
        }
    }
};
struct EpiResid {
    static constexpr bool PERM = false;
    const float* hin; float* hout; bf16_t* hb; float* slots; float alpha;
    __device__ __forceinline__ void operator()(const AccT& acc, const Unit& u, int wr, int wc, int fr, int fq) const {
        const int row0 = u.pm * 256 + wr * 64 + fr, col0 = u.pn * 256 + wc * 32 + 4 * fq;
#pragma unroll
        for (int ai = 0; ai < 2; ++ai)
#pragma unroll
            for (int m = 0; m < 4; ++m) {
                const int row = row0 + ai * 128 + m * 16; const size_t off = (size_t)row * D + col0; float ss = 0.f;
#pragma unroll
                for (int bj = 0; bj < 2; ++bj)
#pragma unroll
                    for (int n = 0; n < 2; ++n) { const size_t o2 = off + bj * 128 + n * 16; const f32x4 b = *(const f32x4*)(hin + o2); const f32x4 o = b + acc[ai][bj][m][n] * alpha;
                        *(f32x4*)(hout + o2) = o; ss += (o[0] * o[0] + o[1] * o[1]) + (o[2] * o[2] + o[3] * o[3]);
                        if (hb) { u32x2 w; w.x = cvt_pk_bf16(o[0], o[1]); w.y = cvt_pk_bf16(o[2], o[3]); *(u32x2*)(hb + o2) = w; } }
                if (slots) { ss += __shfl_xor(ss, 16); ss += __shfl_xor(ss, 32); if (fq == 0) slots[(size_t)row * 16 + u.pn * 4 + wc] = ss; }
                if (m & 1) asm volatile("" ::: "memory");
            }
    }
};
struct EpiBf16 {
    static constexpr bool PERM = true;
    bf16_t* O; int ldc;
    __device__ __forceinline__ void operator()(const AccT& acc, const Unit& u, int wr, int wc, int fr, int fq) const {
        const int row0 = u.pm * 256 + wr * 64 + fr, col0 = u.pn * 256 + wc * 32 + 8 * fq;
#pragma unroll
        for (int ai = 0; ai < 2; ++ai)
#pragma unroll
            for (int m = 0; m < 4; ++m) { bf16_t* rp = O + (size_t)(row0 + ai * 128 + m * 16) * ldc + col0;
#pragma unroll
                for (int bj = 0; bj < 2; ++bj) *(u32x4*)(rp + bj * 128) = pack8(acc[ai][bj][m][0], acc[ai][bj][m][1]); }
    }
};
struct EpiLoraDown {
    static constexpr bool PERM = true;
    bf16_t* O;
    __device__ __forceinline__ void operator()(const AccT& acc, const Unit& u, int wr, int wc, int fr, int fq) const {
        const int row0 = u.pm * 256 + wr * 64 + fr, col0 = wc * 32 + 8 * fq;
#pragma unroll
        for (int ai = 0; ai < 2; ++ai)
#pragma unroll
            for (int m = 0; m < 4; ++m) { bf16_t* rp = O + (size_t)(row0 + ai * 128 + m * 16) * 256 + col0;
                f32x4 a = acc[ai][0][m][0], b = acc[ai][0][m][1];
                if (wc < 2) {
#pragma unroll
                    for (int i = 0; i < 4; ++i) { a[i] = ftanh(a[i]); b[i] = ftanh(b[i]); } }
                *(u32x4*)(rp) = pack8(a, b);
                a = acc[ai][1][m][0]; b = acc[ai][1][m][1];
#pragma unroll
                for (int i = 0; i < 4; ++i) { a[i] = fsigmoid(a[i]); b[i] = fsigmoid(b[i]); }
                *(u32x4*)(rp + 128) = pack8(a, b); }
    }
};
struct EpiRL {
    static constexpr bool PERM = true;
    bf16_t* R; bf16_t* O;
    __device__ __forceinline__ void operator()(const AccT& acc, const Unit& u, int wr, int wc, int fr, int fq) const {
        const int row0 = u.pm * 256 + wr * 64 + fr;
        if (u.pn < 4) {
            const int col0 = u.pn * 256 + wc * 32 + 8 * fq;
#pragma unroll
            for (int ai = 0; ai < 2; ++ai)
#pragma unroll
                for (int m = 0; m < 4; ++m) { bf16_t* rp = R + (size_t)(row0 + ai * 128 + m * 16) * D + col0;
#pragma unroll
                    for (int bj = 0; bj < 2; ++bj) *(u32x4*)(rp + bj * 128) = pack8(acc[ai][bj][m][0], acc[ai][bj][m][1]); }
        } else {
            const int col0 = wc * 32 + 8 * fq;
#pragma unroll
            for (int ai = 0; ai < 2; ++ai)
#pragma unroll
                for (int m = 0; m < 4; ++m) { bf16_t* rp = O + (size_t)(row0 + ai * 128 + m * 16) * 256 + col0;
                    f32x4 a = acc[ai][0][m][0], b = acc[ai][0][m][1];
                    if (wc < 2) {
#pragma unroll
                        for (int i = 0; i < 4; ++i) { a[i] = ftanh(a[i]); b[i] = ftanh(b[i]); } }
                    *(u32x4*)(rp) = pack8(a, b);
                    a = acc[ai][1][m][0]; b = acc[ai][1][m][1];
#pragma unroll
                    for (int i = 0; i < 4; ++i) { a[i] = fsigmoid(a[i]); b[i] = fsigmoid(b[i]); }
                    *(u32x4*)(rp + 128) = pack8(a, b); }
        }
    }
};
struct EpiLoraUp {
    static constexpr bool PERM = true;
    unsigned char* wsb; const float* w0; const float* a0; int grp0; size_t goff;
    __device__ __forceinline__ void operator()(const AccT& acc, const Unit& u, int wr, int wc, int fr, int fq) const {
        const int grp = (u.pn >> 2) + grp0, colt = (u.pn & 3) * 256;
        const int row0 = u.pm * 256 + wr * 64 + fr, col0 = colt + wc * 32 + 8 * fq;
        size_t ooff = goff; if (grp == 0) ooff = A_E; if (grp == 1) ooff = A_AA;
        bf16_t* O = (bf16_t*)(wsb + ooff); const float* bias = grp == 0 ? w0 : a0;
#pragma unroll
        for (int ai = 0; ai < 2; ++ai)
#pragma unroll
            for (int m = 0; m < 4; ++m) { bf16_t* rp = O + (size_t)(row0 + ai * 128 + m * 16) * D + col0;
#pragma unroll
                for (int bj = 0; bj < 2; ++bj) { f32x4 a = acc[ai][bj][m][0], b = acc[ai][bj][m][1];
                    if (grp < 2) { const float sc = grp == 0 ? 0.6065306597126334f : 1.0f;
                        const f32x4 b0 = *(const f32x4*)(bias + col0 + bj * 128), b1 = *(const f32x4*)(bias + col0 + bj * 128 + 4);
                        a = a + b0; b = b + b1;
#pragma unroll
                        for (int i = 0; i < 4; ++i) { a[i] = sc * fsigmoid(a[i]); b[i] = sc * fsigmoid(b[i]); } }
                    *(u32x4*)(rp + bj * 128) = pack8(a, b); }
                asm volatile("" ::: "memory"); }
    }
};
struct EpiQlat {
    static constexpr bool PERM = true;
    bf16_t* O; const float* slotsH; float* slotsQ;
    __device__ __forceinline__ void operator()(const AccT& acc, const Unit& u, int wr, int wc, int fr, int fq) const {
        const int row0 = u.pm * 256 + wr * 64 + fr, col0 = u.pn * 256 + wc * 32 + 8 * fq;
#pragma unroll
        for (int ai = 0; ai < 2; ++ai)
#pragma unroll
            for (int m = 0; m < 4; ++m) { const int row = row0 + ai * 128 + m * 16; const float rs = rstd_slots16(slotsH, row); float ss = 0.f;
#pragma unroll
                for (int bj = 0; bj < 2; ++bj) { const f32x4 a = acc[ai][bj][m][0] * rs, b = acc[ai][bj][m][1] * rs;
                    ss += (a[0] * a[0] + a[1] * a[1]) + (a[2] * a[2] + a[3] * a[3]) + (b[0] * b[0] + b[1] * b[1]) + (b[2] * b[2] + b[3] * b[3]);
                    *(u32x4*)(O + (size_t)row * 512 + col0 + bj * 128) = pack8(a, b); }
                ss += __shfl_xor(ss, 16); ss += __shfl_xor(ss, 32);
                if (fq == 0) slotsQ[(size_t)row * 8 + u.pn * 4 + wc] = ss; }
    }
};
struct EpiQ {
    static constexpr bool PERM = true;
    bf16_t* qn; bf16_t* qr; const float* slotsQ; const float* cosT; const float* sinT;
    __device__ __forceinline__ void operator()(const AccT& acc, const Unit& u, int wr, int wc, int fr, int fq) const {
        const int row0 = u.pm * 256 + wr * 64 + fr;
#pragma unroll
        for (int ai = 0; ai < 2; ++ai)
#pragma unroll
            for (int m = 0; m < 4; ++m) { const int row = row0 + ai * 128 + m * 16;
                const f32x4 s0 = *(const f32x4*)(slotsQ + (size_t)row * 8), s1 = *(const f32x4*)(slotsQ + (size_t)row * 8 + 4);
                const float rs = __builtin_amdgcn_rsqf((sum4(s0) + sum4(s1)) * (1.0f / 512.0f) + RMS_EPS) * QSCALE;
                if (u.pn < 4) {
#pragma unroll
                    for (int bj = 0; bj < 2; ++bj) *(u32x4*)(qn + (size_t)row * D + u.pn * 256 + bj * 128 + wc * 32 + fq * 8) = pack8(acc[ai][bj][m][0] * rs, acc[ai][bj][m][1] * rs);
                } else {
                    const int head = 4 * (u.pn - 4) + wc; f32x4 o1[2], o2[2];
#pragma unroll
                    for (int n = 0; n < 2; ++n) { const f32x4 c = *(const f32x4*)(cosT + (size_t)row * 32 + fq * 8 + n * 4), s = *(const f32x4*)(sinT + (size_t)row * 32 + fq * 8 + n * 4);
                        const f32x4 x1 = acc[ai][0][m][n] * rs, x2 = acc[ai][1][m][n] * rs; o1[n] = x1 * c - x2 * s; o2[n] = x2 * c + x1 * s; }
                    *(u32x4*)(qr + (size_t)row * 512 + head * 64 + fq * 8) = pack8(o1[0], o1[1]);
                    *(u32x4*)(qr + (size_t)row * 512 + head * 64 + 32 + fq * 8) = pack8(o2[0], o2[1]);
                } }
    }
};
struct EpiKnope {
    static constexpr bool PERM = true;
    bf16_t* O; const float* slotsC;
    __device__ __forceinline__ void operator()(const AccT& acc, const Unit& u, int wr, int wc, int fr, int fq) const {
        const int row0 = u.pm * 256 + wr * 64 + fr, col0 = u.pn * 256 + wc * 32 + 8 * fq;
#pragma unroll
        for (int ai = 0; ai < 2; ++ai)
#pragma unroll
            for (int m = 0; m < 4; ++m) { const int row = row0 + ai * 128 + m * 16; const f32x4 s = *(const f32x4*)(slotsC + (size_t)row * 4);
                const float rs = __builtin_amdgcn_rsqf(sum4(s) * (1.0f / 256.0f) + RMS_EPS);
#pragma unroll
                for (int bj = 0; bj < 2; ++bj) *(u32x4*)(O + (size_t)row * D + col0 + bj * 128) = pack8(acc[ai][bj][m][0] * rs, acc[ai][bj][m][1] * rs); }
    }
};
struct EpiVt {
    static constexpr bool PERM = true;
    bf16_t* O; const float* slotsC;
    __device__ __forceinline__ void operator()(const AccT& acc, const Unit& u, int wr, int wc, int fr, int fq) const {
        const int row0 = u.pm * 256 + wr * 64 + fr, col0 = u.pn * 256 + wc * 32 + 8 * fq;
        f32x4 rs[2][2];
#pragma unroll
        for (int bj = 0; bj < 2; ++bj)
#pragma unroll
            for (int n = 0; n < 2; ++n)
#pragma unroll
                for (int i = 0; i < 4; ++i) { const f32x4 s = *(const f32x4*)(slotsC + (size_t)(col0 + bj * 128 + n * 4 + i) * 4); rs[bj][n][i] = __builtin_amdgcn_rsqf(sum4(s) * (1.0f / 256.0f) + RMS_EPS); }
#pragma unroll
        for (int ai = 0; ai < 2; ++ai)
#pragma unroll
            for (int m = 0; m < 4; ++m) { const int row = row0 + ai * 128 + m * 16;
#pragma unroll
                for (int bj = 0; bj < 2; ++bj) *(u32x4*)(O + (size_t)row * T + col0 + bj * 128) = pack8(acc[ai][bj][m][0] * rs[bj][0], acc[ai][bj][m][1] * rs[bj][1]); }
    }
};

struct Args { const float* in[33]; const int* pos; float* out; unsigned char* ws; int ph_lo, ph_hi; };

struct Ctx { LAS unsigned char* lds; int vcu, G, wave; };

__device__ __forceinline__ void tr_item(const float* W, int ldw, int k0, int n0, const float* s1, const float* s2, int ks0, bf16_t* Bt, int ldb, int nd0, int kd0, LAS float* scr, int lane) {
    f32x4 v[8];
#pragma unroll
    for (int i = 0; i < 8; ++i) v[i] = *(const f32x4*)(W + (size_t)(k0 + 8 * i + (lane >> 3)) * ldw + n0 + 4 * (lane & 7));
#pragma unroll
    for (int i = 0; i < 8; ++i) { const int kk = 8 * i + (lane >> 3);
        float sc = s1 ? s1[ks0 + kk] : 1.0f; if (s2) sc -= s2[ks0 + kk];
        LAS float* d = scr + kk * 33 + 4 * (lane & 7);
        d[0] = sc * v[i][0]; d[1] = sc * v[i][1]; d[2] = sc * v[i][2]; d[3] = sc * v[i][3]; }
    asm volatile("s_waitcnt lgkmcnt(0)" ::: "memory");
    const int c = lane & 7;
#pragma unroll
    for (int j = 0; j < 4; ++j) { const int n = (lane >> 3) + 8 * j; const LAS float* s = scr + (8 * c) * 33 + n;
        u32x4 o; o.x = cvt_pk_bf16(s[0 * 33], s[1 * 33]); o.y = cvt_pk_bf16(s[2 * 33], s[3 * 33]); o.z = cvt_pk_bf16(s[4 * 33], s[5 * 33]); o.w = cvt_pk_bf16(s[6 * 33], s[7 * 33]);
        *(u32x4*)(Bt + (size_t)(nd0 + n) * ldb + kd0 + 8 * c) = o; }
    asm volatile("s_waitcnt lgkmcnt(0)" ::: "memory");
}
__device__ __forceinline__ void zero_item(bf16_t* Bt, int ldb, int nd0, int kd0, int lane) {
    const int c = lane & 7;
#pragma unroll
    for (int j = 0; j < 4; ++j) { const int n = (lane >> 3) + 8 * j; *(u32x4*)(Bt + (size_t)(nd0 + n) * ldb + kd0 + 8 * c) = (u32x4){0u, 0u, 0u, 0u}; }
}

__device__ __forceinline__ void p0_prologue(const Ctx& F, const Args& a) {
    unsigned char* ws = a.ws;
    const int tid = fresh_tid(F.wave), lane = tid & 63, wave = __builtin_amdgcn_readfirstlane(tid >> 6);
    LAS float* scr = (LAS float*)(F.lds + wave * 16384);
    const int gw = F.vcu * 8 + wave, NGW = F.G * 8;
    const float* norm_g = a.in[2];
    constexpr int I_UG = 16 * 176, I_UGX = 16 * 16, I_DN = 44 * 32, I_SQ = 16 * 32, I_LD = 32 * 8, I_LU = 4 * 96, I_KN = 4 * 32, I_DQ = 16 * 16, I_UQ = 8 * 48;
    constexpr int NITEMS = 4 * I_UG + I_UGX + 4 * I_DN + 4 * I_SQ + I_LD + I_LU + 2 * I_KN + I_DQ + I_UQ + I_SQ;
    for (int it = gw; it < NITEMS; it += NGW) {
        int r = it;
        if (r < 4 * I_UG) { const int q = r / I_UG; r -= q * I_UG; const int l = q >> 1, s = q & 1; const int kb = r / 176, nb = r % 176, pn = nb >> 3, jb = nb & 7;
            const float* src = (jb < 4 ? a.in[3] : a.in[4]) + (size_t)q * D * FF;
            tr_item(src, FF, 64 * kb, 128 * pn + 32 * (jb & 3), norm_g + (l * 3 + (s ? 2 : 0)) * D, nullptr, 64 * kb, (bf16_t*)(ws + W_UG) + (size_t)q * 6144 * D, D, 32 * nb, 64 * kb, scr, lane); continue; }
        r -= 4 * I_UG;
        if (r < I_UGX) { const int kb = r / 16, nb = r % 16; bf16_t* Bt = (bf16_t*)(ws + W_UG) + (size_t)2 * 6144 * D;
            int sc = -1; if (nb < 8) sc = 32 * nb; else if (nb == 8) sc = 256; else if (nb == 12) sc = 288;
            if (sc >= 0) tr_item(a.in[25], 320, 64 * kb, sc, a.in[24], nullptr, 64 * kb, Bt, D, 5632 + 32 * nb, 64 * kb, scr, lane); else zero_item(Bt, D, 5632 + 32 * nb, 64 * kb, lane); continue; }
        r -= I_UGX;
        if (r < 4 * I_DN) { const int q = r / I_DN; r -= q * I_DN; const int kb = r / 32, nb = r % 32;
            tr_item(a.in[5] + (size_t)q * FF * D, D, 64 * kb, 32 * nb, nullptr, nullptr, 0, (bf16_t*)(ws + W_DN) + (size_t)q * D * FF, FF, 32 * nb, 64 * kb, scr, lane); continue; }
        r -= 4 * I_DN;
        if (r < 4 * I_SQ) { const int q = r / I_SQ; r -= q * I_SQ; const int kb = r / 32, nb = r % 32;
            if (q == 0) { tr_item(a.in[7], D, 64 * kb, 32 * nb, nullptr, nullptr, 0, (bf16_t*)(ws + W_RL), 2048, 32 * nb, 64 * kb, scr, lane); zero_item((bf16_t*)(ws + W_RL), 2048, 32 * nb, 1024 + 64 * kb, lane); }
            else tr_item(a.in[7 + q], D, 64 * kb, 32 * nb, nullptr, nullptr, 0, (bf16_t*)(ws + W_R + (size_t)q * 2 * MiB), D, 32 * nb, 64 * kb, scr, lane);
            continue; }
        r -= 4 * I_SQ;
        if (r < I_LD) { const int kb = r / 8, nb = r % 8; const int kk0 = 64 * (kb & 15); const bool second = kb >= 16;
            const float* src; int ldw, nc, mi; if (nb < 2) { src = a.in[12]; ldw = 64; nc = 32 * nb; mi = 1; } else if (nb < 4) { src = a.in[15]; ldw = 64; nc = 32 * (nb - 2); mi = 4; } else { src = a.in[17]; ldw = 128; nc = 32 * (nb - 4); mi = 5; }
            tr_item(src, ldw, kk0, nc, second ? a.in[6] + mi * D : nullptr, second ? a.in[6] : nullptr, kk0, (bf16_t*)(ws + W_RL), 2048, 1024 + 32 * nb, 64 * kb, scr, lane); continue; }
        r -= I_LD;
        if (r < I_LU) { const int kb = r / 96, nb = r % 96; const int grp = nb / 32, nc = 32 * (nb % 32); bf16_t* Bt = (bf16_t*)(ws + W_LU);
            if (grp == 0) { if (kb == 0) tr_item(a.in[13], D, 0, nc, nullptr, nullptr, 0, Bt, 256, 32 * nb, 0, scr, lane); else zero_item(Bt, 256, 32 * nb, 64 * kb, lane); }
            else if (grp == 1) { if (kb == 1) tr_item(a.in[16], D, 0, nc, nullptr, nullptr, 0, Bt, 256, 32 * nb, 64, scr, lane); else zero_item(Bt, 256, 32 * nb, 64 * kb, lane); }
            else { if (kb >= 2) tr_item(a.in[18], D, 64 * (kb - 2), nc, nullptr, nullptr, 0, Bt, 256, 32 * nb, 64 * kb, scr, lane); else zero_item(Bt, 256, 32 * nb, 64 * kb, lane); }
            continue; }
        r -= I_LU;
        if (r < 2 * I_KN) { const int q = r / I_KN; r -= q * I_KN; const int kb = r / 32, nb = r % 32;
            const int n0 = 32 * nb, sc = (n0 >> 7) * 256 + (n0 & 127) + q * 128;
            tr_item(a.in[27], 2048, 64 * kb, sc, a.in[26], nullptr, 64 * kb, (bf16_t*)(ws + (q ? W_VT : W_KN)), 256, n0, 64 * kb, scr, lane); continue; }
        r -= 2 * I_KN;
        if (r < I_DQ) { const int kb = r / 16, nb = r % 16;
            tr_item(a.in[28], 512, 64 * kb, 32 * nb, norm_g + (1 * 3 + 1) * D, nullptr, 64 * kb, (bf16_t*)(ws + W_DQ), D, 32 * nb, 64 * kb, scr, lane); continue; }
        r -= I_DQ;
        if (r < I_UQ) { const int kb = r / 48, nb = r % 48; int sc;
            if (nb < 32) { const int n0 = 32 * nb; sc = (n0 >> 7) * 192 + (n0 & 127); }
            else { const int t2 = (nb - 32) >> 3, jj = (nb - 32) & 7, half = jj >> 2, hh = jj & 3; sc = (4 * t2 + hh) * 192 + 128 + 32 * half; }
            tr_item(a.in[30], 1536, 64 * kb, sc, a.in[29], nullptr, 64 * kb, (bf16_t*)(ws + W_UQ), 512, 32 * nb, 64 * kb, scr, lane); continue; }
        r -= I_UQ;
        { const int kb = r / 32, nb = r % 32; tr_item(a.in[31], D, 64 * kb, 32 * nb, nullptr, nullptr, 0, (bf16_t*)(ws + W_MO), D, 32 * nb, 64 * kb, scr, lane); }
    }
    const float* x = a.in[0]; bf16_t* hb = (bf16_t*)(ws + A_HB); float* slotsH = (float*)(ws + WS_SLOTH);
    for (int m = gw; m < T; m += NGW) {
        const f32x4* xr = (const f32x4*)(x + (size_t)m * D) + lane; float ss = 0.f;
#pragma unroll
        for (int j = 0; j < 4; ++j) { const f32x4 v = xr[64 * j]; ss += (v[0] * v[0] + v[1] * v[1]) + (v[2] * v[2] + v[3] * v[3]);
            u32x2 w; w.x = cvt_pk_bf16(v[0], v[1]); w.y = cvt_pk_bf16(v[2], v[3]); *((u32x2*)(hb + (size_t)m * D) + lane + 64 * j) = w; }
        ss = wave_sum(ss);
        if (lane < 16) slotsH[(size_t)m * 16 + lane] = lane == 0 ? ss : 0.f;
    }
    float* cosT = (float*)(ws + A_COS); float* sinT = (float*)(ws + A_SIN);
    for (int i = (F.vcu * 512 + tid); i < T * 32; i += F.G * 512) {
        const int tok = i >> 5, j = i & 31;
        const float inv = exp2f(-(float)j * (13.287712379549449f / 32.0f));
        const float ang = (float)a.pos[tok] * inv;
        const double rev = (double)ang * 0.15915494309189535; const float fr = (float)(rev - floor(rev));
        cosT[i] = __builtin_amdgcn_cosf(fr); sinT[i] = __builtin_amdgcn_sinf(fr);
    }
}

__device__ __forceinline__ void p_premix(const Ctx& F, const Args& a) {
    const float* h = a.out; const float* g = a.in[2] + 1 * D; const float* mix = a.in[6];
    bf16_t* X1 = (bf16_t*)(a.ws + A_X1); bf16_t* XK = (bf16_t*)(a.ws + A_XK); bf16_t* XV = (bf16_t*)(a.ws + A_XV);
    const int tid = fresh_tid(F.wave), lane = tid & 63, wave = __builtin_amdgcn_readfirstlane(tid >> 6);
    const int gw = F.vcu * 8 + wave, NGW = F.G * 8;
    for (int ch = gw; ch < T / 16; ch += NGW) {
        const int t0 = ch * 16;
        f32x4 prev[4], gv[4];
#pragma unroll
        for (int j = 0; j < 4; ++j) gv[j] = *((const f32x4*)g + lane + 64 * j);
        if ((t0 & (SEQ - 1)) == 0) {
#pragma unroll
            for (int j = 0; j < 4; ++j) prev[j] = (f32x4){0.f, 0.f, 0.f, 0.f};
        } else {
            float ss = 0.f;
#pragma unroll
            for (int j = 0; j < 4; ++j) { prev[j] = *((const f32x4*)(h + (size_t)(t0 - 1) * D) + lane + 64 * j); ss += (prev[j][0] * prev[j][0] + prev[j][1] * prev[j][1]) + (prev[j][2] * prev[j][2] + prev[j][3] * prev[j][3]); }
            const float rs = __builtin_amdgcn_rsqf(wave_sum(ss) * (1.0f / 1024.0f) + RMS_EPS);
#pragma unroll
            for (int j = 0; j < 4; ++j) prev[j] = prev[j] * rs * gv[j];
        }
        for (int t = t0; t < t0 + 16; ++t) {
            f32x4 cur[4]; float ss = 0.f;
#pragma unroll
            for (int j = 0; j < 4; ++j) { cur[j] = *((const f32x4*)(h + (size_t)t * D) + lane + 64 * j); ss += (cur[j][0] * cur[j][0] + cur[j][1] * cur[j][1]) + (cur[j][2] * cur[j][2] + cur[j][3] * cur[j][3]); }
            const float rs = __builtin_amdgcn_rsqf(wave_sum(ss) * (1.0f / 1024.0f) + RMS_EPS);
#pragma unroll
            for (int j = 0; j < 4; ++j) {
                const f32x4 hn = cur[j] * rs * gv[j]; const f32x4 xx = prev[j] - hn; prev[j] = hn;
                const f32x4 mr = *((const f32x4*)(mix + 0 * D) + lane + 64 * j), mk = *((const f32x4*)(mix + 2 * D) + lane + 64 * j), mv = *((const f32x4*)(mix + 3 * D) + lane + 64 * j);
                const f32x4 xr = hn + xx * mr, xk = hn + xx * mk, xv = hn + xx * mv;
                u32x2 w;
                w.x = cvt_pk_bf16(xr[0], xr[1]); w.y = cvt_pk_bf16(xr[2], xr[3]); *((u32x2*)(X1 + (size_t)t * 2048) + lane + 64 * j) = w;
                w.x = cvt_pk_bf16(xx[0], xx[1]); w.y = cvt_pk_bf16(xx[2], xx[3]); *((u32x2*)(X1 + (size_t)t * 2048 + 1024) + lane + 64 * j) = w;
                w.x = cvt_pk_bf16(xk[0], xk[1]); w.y = cvt_pk_bf16(xk[2], xk[3]); *((u32x2*)(XK + (size_t)t * D) + lane + 64 * j) = w;
                w.x = cvt_pk_bf16(xv[0], xv[1]); w.y = cvt_pk_bf16(xv[2], xv[3]); *((u32x2*)(XV + (size_t)t * D) + lane + 64 * j) = w;
            }
        }
    }
}

constexpr int TC = 32;
__device__ __forceinline__ void p_scan(const Ctx& F, const Args& a) {
    const bf16_t* Rb = (const bf16_t*)(a.ws + A_R); const bf16_t* Kb = (const bf16_t*)(a.ws + A_KK); const bf16_t* Vb = (const bf16_t*)(a.ws + A_VV);
    const bf16_t* Eb = (const bf16_t*)(a.ws + A_E); const bf16_t* Ab = (const bf16_t*)(a.ws + A_AA); bf16_t* Gb = (bf16_t*)(a.ws + A_G);
    const float* k_k = a.in[19]; const float* k_a = a.in[20]; const float* r_k = a.in[21]; const float* gn_w = a.in[22]; const float* gn_b = a.in[23];
    LAS float* sR = (LAS float*)(F.lds); LAS float* sW = sR + TC * 64; LAS float* sK = sW + TC * 64; LAS float* sV = sK + TC * 64;
    LAS float* sKK = sV + TC * 64; LAS float* sKA = sKK + TC * 64; LAS float* sY = sKA + TC * 64; LAS float* sBo = sY + TC * 64;
    const int tid = fresh_tid(F.wave), lane = tid & 63, wave = __builtin_amdgcn_readfirstlane(tid >> 6);
    const int irow = wave * 8 + (lane >> 3), kseg = (lane & 7) * 8;
    const int ptt = tid >> 4, pc = (tid & 15) * 4;
    for (int unit0 = F.vcu; unit0 < 2 * NB * 16; unit0 += F.G) {
        const int unit = unit0 & 127; const bool shadow = unit0 >= 128;
        const int b = unit >> 4, hd = unit & 15; const int cbase = hd * 64;
        float S[8];
#pragma unroll
        for (int j = 0; j < 8; ++j) S[j] = 0.f;
        const f32x4 kkv = *(const f32x4*)(k_k + cbase + pc), kav = *(const f32x4*)(k_a + cbase + pc), rkv = *(const f32x4*)(r_k + cbase + pc);
        const f32x4 gw = *(const f32x4*)(gn_w + cbase + pc), gb = *(const f32x4*)(gn_b + cbase + pc);
        for (int c0 = 0; c0 < SEQ; c0 += TC) {
            const size_t gidx = (size_t)(b * SEQ + c0 + ptt) * D + cbase + pc;
            {
                const f32x4 r = unpack4(*(const u32x2*)(Rb + gidx)), k = unpack4(*(const u32x2*)(Kb + gidx)), v = unpack4(*(const u32x2*)(Vb + gidx));
                const f32x4 e = unpack4(*(const u32x2*)(Eb + gidx)), aa = unpack4(*(const u32x2*)(Ab + gidx));
                f32x4 kk = k * kkv; float ss = (kk[0] * kk[0] + kk[1] * kk[1]) + (kk[2] * kk[2] + kk[3] * kk[3]); ss = red16(ss);
                kk = kk * __builtin_amdgcn_rsqf(fmaxf(ss, 1e-24f));
                const f32x4 kp = k * (1.0f + (aa - 1.0f) * kav);
                const f32x4 rk = r * kp * rkv; const float bo = red16((rk[0] + rk[1]) + (rk[2] + rk[3]));
                f32x4 w;
#pragma unroll
                for (int i = 0; i < 4; ++i) w[i] = __builtin_amdgcn_exp2f(-e[i] * LOG2E);
                const int o = ptt * 64 + pc;
                *(LAS f32x4*)(sR + o) = r; *(LAS f32x4*)(sW + o) = w; *(LAS f32x4*)(sK + o) = kp; *(LAS f32x4*)(sV + o) = v; *(LAS f32x4*)(sKK + o) = kk; *(LAS f32x4*)(sKA + o) = kk * aa;
                if ((tid & 15) == 0) sBo[ptt] = bo;
            }
            __syncthreads();
#pragma unroll 2
            for (int t = 0; t < TC; ++t) {
                const int o = t * 64 + kseg;
                const f32x4 kk0 = *(const LAS f32x4*)(sKK + o), kk1 = *(const LAS f32x4*)(sKK + o + 4);
                const f32x4 w0 = *(const LAS f32x4*)(sW + o), w1 = *(const LAS f32x4*)(sW + o + 4);
                const f32x4 ka0 = *(const LAS f32x4*)(sKA + o), ka1 = *(const LAS f32x4*)(sKA + o + 4);
                const f32x4 kp0 = *(const LAS f32x4*)(sK + o), kp1 = *(const LAS f32x4*)(sK + o + 4);
                const f32x4 r0 = *(const LAS f32x4*)(sR + o), r1 = *(const LAS f32x4*)(sR + o + 4);
                const float vv = sV[t * 64 + irow];
                float sa = ((S[0] * kk0[0] + S[1] * kk0[1]) + (S[2] * kk0[2] + S[3] * kk0[3])) + ((S[4] * kk1[0] + S[5] * kk1[1]) + (S[6] * kk1[2] + S[7] * kk1[3]));
                sa = red8(sa);
#pragma unroll
                for (int j = 0; j < 4; ++j) { S[j] = S[j] * w0[j] + (vv * kp0[j] - sa * ka0[j]); S[4 + j] = S[4 + j] * w1[j] + (vv * kp1[j] - sa * ka1[j]); }
                float y = ((S[0] * r0[0] + S[1] * r0[1]) + (S[2] * r0[2] + S[3] * r0[3])) + ((S[4] * r1[0] + S[5] * r1[1]) + (S[6] * r1[2] + S[7] * r1[3]));
                y = red8(y);
                if ((lane & 7) == 0) sY[t * 64 + irow] = y;
            }
            __syncthreads();
            {
                const int o = ptt * 64 + pc;
                const f32x4 y = *(const LAS f32x4*)(sY + o), v = *(const LAS f32x4*)(sV + o);
                const float mu = red16((y[0] + y[1]) + (y[2] + y[3])) * (1.0f / 64.0f);
                const f32x4 d = y - mu; const float var = red16((d[0] * d[0] + d[1] * d[1]) + (d[2] * d[2] + d[3] * d[3])) * (1.0f / 64.0f);
                const float rs = __builtin_amdgcn_rsqf(var + GN_EPS); const float bo = sBo[ptt];
                const f32x4 gg = unpack4(*(const u32x2*)(Gb + gidx));
                const f32x4 ov = (d * rs * gw + gb + v * bo) * gg;
                u32x2 w; w.x = cvt_pk_bf16(ov[0], ov[1]); w.y = cvt_pk_bf16(ov[2], ov[3]); if (!shadow) *(u32x2*)(Gb + gidx) = w;
            }
            __syncthreads();
        }
    }
}


__device__ __forceinline__ void p_scan2(const Ctx& F, const Args& a) {
    const bf16_t* Rb = (const bf16_t*)(a.ws + A_R); const bf16_t* Kb = (const bf16_t*)(a.ws + A_KK); const bf16_t* Vb = (const bf16_t*)(a.ws + A_VV);
    const bf16_t* Eb = (const bf16_t*)(a.ws + A_E); const bf16_t* Ab = (const bf16_t*)(a.ws + A_AA); bf16_t* Yb = (bf16_t*)(a.ws + A_G); float* Bon = (float*)(a.ws + A_BON);
    const float* k_k = a.in[19]; const float* k_a = a.in[20]; const float* r_k = a.in[21];
    LAS float* sR = (LAS float*)(F.lds); LAS float* sW = sR + TC * 64; LAS float* sK = sW + TC * 64; LAS float* sV = sK + TC * 64;
    LAS float* sKK = sV + TC * 64; LAS float* sKA = sKK + TC * 64; LAS float* sY = sKA + TC * 64;
    const int tid = fresh_tid(F.wave), lane = tid & 63, wave = __builtin_amdgcn_readfirstlane(tid >> 6);
    const int lrow = wave * 8 + (lane >> 3), kseg = (lane & 7) * 8;
    const int ptt = tid >> 4, pc = (tid & 15) * 4;
    for (int unit = F.vcu; unit < 2 * NB * 16; unit += F.G) {
        const int bh = unit >> 1, half = unit & 1, b = bh >> 4, hd = bh & 15, cbase = hd * 64;
        f32x4 S0 = (f32x4){0.f, 0.f, 0.f, 0.f}, S1 = (f32x4){0.f, 0.f, 0.f, 0.f};
        const f32x4 kkv = *(const f32x4*)(k_k + cbase + pc), kav = *(const f32x4*)(k_a + cbase + pc), rkv = *(const f32x4*)(r_k + cbase + pc);
        size_t gidx = (size_t)(b * SEQ + ptt) * D + cbase + pc;
        u32x2 qr = *(const u32x2*)(Rb + gidx), qk = *(const u32x2*)(Kb + gidx), qv = *(const u32x2*)(Vb + gidx), qe = *(const u32x2*)(Eb + gidx), qa = *(const u32x2*)(Ab + gidx);
        for (int c0 = 0; c0 < SEQ; c0 += TC) {
            {
                const f32x4 r = unpack4(qr), k = unpack4(qk), v = unpack4(qv), e = unpack4(qe), aa = unpack4(qa);
                f32x4 kk = k * kkv; float ss = (kk[0] * kk[0] + kk[1] * kk[1]) + (kk[2] * kk[2] + kk[3] * kk[3]); ss = red16(ss);
                kk = kk * __builtin_amdgcn_rsqf(fmaxf(ss, 1e-24f));
                const f32x4 kp = k * (1.0f + (aa - 1.0f) * kav);
                const f32x4 rk = r * kp * rkv; const float bo = red16((rk[0] + rk[1]) + (rk[2] + rk[3]));
                f32x4 w;
#pragma unroll
                for (int i = 0; i < 4; ++i) w[i] = __builtin_amdgcn_exp2f(-e[i] * LOG2E);
                const int o = ptt * 64 + pc;
                *(LAS f32x4*)(sR + o) = r; *(LAS f32x4*)(sW + o) = w; *(LAS f32x4*)(sK + o) = kp; *(LAS f32x4*)(sV + o) = v; *(LAS f32x4*)(sKK + o) = kk; *(LAS f32x4*)(sKA + o) = kk * aa;
                if (half == 0 && (tid & 15) == 0) Bon[(size_t)(b * SEQ + c0 + ptt) * 16 + hd] = bo;
            }
            __syncthreads();
            if (c0 + TC < SEQ) { gidx += (size_t)TC * D;
                qr = *(const u32x2*)(Rb + gidx); qk = *(const u32x2*)(Kb + gidx); qv = *(const u32x2*)(Vb + gidx); qe = *(const u32x2*)(Eb + gidx); qa = *(const u32x2*)(Ab + gidx); }
            if (wave < 4) {
#define SCAN_LD(P, tt) { const int o_ = (tt) * 64 + kseg; \
                kk0##P = *(const LAS f32x4*)(sKK + o_); kk1##P = *(const LAS f32x4*)(sKK + o_ + 4); w0##P = *(const LAS f32x4*)(sW + o_); w1##P = *(const LAS f32x4*)(sW + o_ + 4); \
                ka0##P = *(const LAS f32x4*)(sKA + o_); ka1##P = *(const LAS f32x4*)(sKA + o_ + 4); kp0##P = *(const LAS f32x4*)(sK + o_); kp1##P = *(const LAS f32x4*)(sK + o_ + 4); \
                r0##P = *(const LAS f32x4*)(sR + o_); r1##P = *(const LAS f32x4*)(sR + o_ + 4); vv##P = sV[(tt) * 64 + half * 32 + lrow]; }
#define SCAN_STEP(P, tt) { f32x4 p4 = S0 * kk0##P; p4 = S1 * kk1##P + p4; const float sa = red8((p4[0] + p4[1]) + (p4[2] + p4[3])); \
                S0 = S0 * w0##P + (kp0##P * vv##P - ka0##P * sa); S1 = S1 * w1##P + (kp1##P * vv##P - ka1##P * sa); \
                f32x4 y4 = S0 * r0##P; y4 = S1 * r1##P + y4; sY[(tt) * 256 + tid] = (y4[0] + y4[1]) + (y4[2] + y4[3]); }
                f32x4 kk0A, kk1A, w0A, w1A, ka0A, ka1A, kp0A, kp1A, r0A, r1A; float vvA;
                f32x4 kk0B, kk1B, w0B, w1B, ka0B, ka1B, kp0B, kp1B, r0B, r1B; float vvB;
                SCAN_LD(A, 0)
#pragma unroll 2
                for (int t = 0; t < TC; t += 2) {
                    SCAN_LD(B, t + 1)
                    SCAN_STEP(A, t)
                    SCAN_LD(A, (t + 2 < TC) ? t + 2 : t)
                    SCAN_STEP(B, t + 1)
                }
#undef SCAN_LD
#undef SCAN_STEP
            }
            __syncthreads();
            {
                const int tok = tid >> 4, r2 = (tid & 15) * 2;
                const LAS f32x4* q = (const LAS f32x4*)(sY + tok * 256 + r2 * 8);
                const f32x4 s0 = q[0] + q[1], s1 = q[2] + q[3];
                *(unsigned*)(Yb + (size_t)(b * SEQ + c0 + tok) * D + cbase + half * 32 + r2) = cvt_pk_bf16((s0[0] + s0[1]) + (s0[2] + s0[3]), (s1[0] + s1[1]) + (s1[2] + s1[3]));
            }
        }
        __syncthreads();
    }
}
__device__ __forceinline__ void p_post(const Ctx& F, const Args& a) {
    bf16_t* Yb = (bf16_t*)(a.ws + A_G); const bf16_t* Vb = (const bf16_t*)(a.ws + A_VV); const bf16_t* Gg = (const bf16_t*)(a.ws + A_E); const float* Bon = (const float*)(a.ws + A_BON);
    const float* gn_w = a.in[22]; const float* gn_b = a.in[23];
    const int tid = fresh_tid(F.wave), grp = tid >> 4, gl = tid & 15;
    for (int item = F.vcu * 32 + grp; item < T * 16; item += F.G * 32) {
        const int tok = item >> 4, hd = item & 15; const size_t idx = (size_t)tok * D + hd * 64 + 4 * gl;
        const f32x4 y = unpack4(*(const u32x2*)(Yb + idx)), v = unpack4(*(const u32x2*)(Vb + idx)), g = unpack4(*(const u32x2*)(Gg + idx));
        const float bo = Bon[(size_t)tok * 16 + hd];
        const f32x4 gw = *(const f32x4*)(gn_w + hd * 64 + 4 * gl), gb = *(const f32x4*)(gn_b + hd * 64 + 4 * gl);
        const float mu = red16((y[0] + y[1]) + (y[2] + y[3])) * (1.0f / 64.0f);
        const f32x4 d = y - mu; const float var = red16((d[0] * d[0] + d[1] * d[1]) + (d[2] * d[2] + d[3] * d[3])) * (1.0f / 64.0f);
        const float rs = __builtin_amdgcn_rsqf(var + GN_EPS);
        const f32x4 ov = (d * rs * gw + gb + v * bo) * g;
        u32x2 w; w.x = cvt_pk_bf16(ov[0], ov[1]); w.y = cvt_pk_bf16(ov[2], ov[3]); *(u32x2*)(Yb + idx) = w;
    }
}

constexpr int KROW = 400, VROW = 144, KBUF = 64 * KROW, VBUF = 128 * VROW, ABUF = KBUF + VBUF;
__device__ __forceinline__ void attn_unit(LAS unsigned char* lds, const bf16_t* qn, const bf16_t* qr, const bf16_t* kn, const bf16_t* kr, const bf16_t* vt, bf16_t* o_out, int b, int h, int qb, int wave_s) {
    const int tid = fresh_tid(wave_s), lane = tid & 63, wid = __builtin_amdgcn_readfirstlane(tid >> 6), r32 = lane & 31, hi = lane >> 5;
    const int tok0 = b * SEQ, q0 = qb * 256 + wid * 32;
    bf16x8 qf[12];
    { const size_t tq = (size_t)(tok0 + q0 + r32);
#pragma unroll
      for (int d = 0; d < 8; ++d) qf[d] = *(const bf16x8*)(qn + tq * D + h * 128 + d * 16 + hi * 8);
#pragma unroll
      for (int d = 0; d < 4; ++d) qf[8 + d] = *(const bf16x8*)(qr + tq * 512 + h * 64 + d * 16 + hi * 8); }
    const int NT = (qb + 1) * 4;
    const int kkey0 = tid >> 4, kch0 = tid & 15;
    const int rkey = tid >> 3, rch = tid & 7;
    const int vrow0 = tid >> 3, vch = tid & 7;
    const bf16_t* gk0 = kn + (size_t)(tok0 + kkey0) * D + h * 128 + kch0 * 8;
    const bf16_t* gk1 = gk0 + (size_t)32 * D;
    const bf16_t* gr = kr + (size_t)(tok0 + rkey) * 64 + rch * 8;
    const bf16_t* gv0 = vt + (size_t)(h * 128 + vrow0) * T + tok0 + vch * 8;
    const bf16_t* gv1 = gv0 + (size_t)64 * T;
    const int lk0 = kkey0 * KROW + kch0 * 16, lk1 = lk0 + 32 * KROW, lr = rkey * KROW + 256 + rch * 16, lv0 = KBUF + vrow0 * VROW + vch * 16, lv1 = lv0 + 64 * VROW;
    const int pr = (r32 & 0x13) | ((r32 & 4) << 1) | ((r32 & 8) >> 1);
    const int kfo = pr * KROW + hi * 16, vfo = KBUF + r32 * VROW + hi * 16;
    u32x4 ld0, ld1, ld2, ld3, ld4;
    ld0 = *(const u32x4*)gk0; ld1 = *(const u32x4*)gk1; ld2 = *(const u32x4*)gr; ld3 = *(const u32x4*)gv0; ld4 = *(const u32x4*)gv1;
    __syncthreads();
    *(LAS u32x4*)(lds + lk0) = ld0; *(LAS u32x4*)(lds + lk1) = ld1; *(LAS u32x4*)(lds + lr) = ld2; *(LAS u32x4*)(lds + lv0) = ld3; *(LAS u32x4*)(lds + lv1) = ld4;
    __syncthreads();
    float mrun = -1e30f, lrun = 0.f;
    f32x16 o[4];
#pragma unroll
    for (int d = 0; d < 4; ++d) o[d] = f32x16{};
    for (int t = 0; t < NT; ++t) {
        const int cb = (t & 1) * ABUF, nb = ((t + 1) & 1) * ABUF;
        const bool more = (t + 1 < NT);
        if (more) { const size_t ko = (size_t)(t + 1) * 64 * D, ro = (size_t)(t + 1) * 64 * 64, vo = (size_t)(t + 1) * 64;
            ld0 = *(const u32x4*)(gk0 + ko); ld1 = *(const u32x4*)(gk1 + ko); ld2 = *(const u32x4*)(gr + ro); ld3 = *(const u32x4*)(gv0 + vo); ld4 = *(const u32x4*)(gv1 + vo); }
        if (64 * t <= q0 + 31) {
            f32x16 s0 = f32x16{}, s1 = f32x16{};
#pragma unroll
            for (int d = 0; d < 12; ++d) {
                const bf16x8 k0 = *(const LAS bf16x8*)(lds + cb + kfo + d * 32), k1 = *(const LAS bf16x8*)(lds + cb + kfo + 32 * KROW + d * 32);
                s0 = __builtin_amdgcn_mfma_f32_32x32x16_bf16(k0, qf[d], s0, 0, 0, 0);
                s1 = __builtin_amdgcn_mfma_f32_32x32x16_bf16(k1, qf[d], s1, 0, 0, 0);
            }
            if (64 * t + 63 > q0) {
                const int qi = q0 + r32, kb0 = 64 * t + 8 * hi;
#pragma unroll
                for (int r = 0; r < 16; ++r) { const int key = kb0 + 16 * (r >> 3) + (r & 7); if (key > qi) s0[r] = -1e30f; if (key + 32 > qi) s1[r] = -1e30f; }
            }
            float mx = fmaxf(s0[0], s1[0]);
#pragma unroll
            for (int r = 1; r < 16; ++r) mx = fmaxf(mx, fmaxf(s0[r], s1[r]));
            mx = fmaxf(mx, __shfl_xor(mx, 32));
            const float mnew = fmaxf(mrun, mx); const float alpha = __builtin_amdgcn_exp2f(mrun - mnew); mrun = mnew;
            float ps = 0.f;
#pragma unroll
            for (int r = 0; r < 16; ++r) { s0[r] = __builtin_amdgcn_exp2f(s0[r] - mnew); s1[r] = __builtin_amdgcn_exp2f(s1[r] - mnew); ps += s0[r] + s1[r]; }
            lrun = lrun * alpha + ps;
#pragma unroll
            for (int d = 0; d < 4; ++d) o[d] = o[d] * alpha;
            bf16x8 pf[4];
            { u32x4 w;
              w.x = cvt_pk_bf16(s0[0], s0[1]); w.y = cvt_pk_bf16(s0[2], s0[3]); w.z = cvt_pk_bf16(s0[4], s0[5]); w.w = cvt_pk_bf16(s0[6], s0[7]); pf[0] = __builtin_bit_cast(bf16x8, w);
              w.x = cvt_pk_bf16(s0[8], s0[9]); w.y = cvt_pk_bf16(s0[10], s0[11]); w.z = cvt_pk_bf16(s0[12], s0[13]); w.w = cvt_pk_bf16(s0[14], s0[15]); pf[1] = __builtin_bit_cast(bf16x8, w);
              w.x = cvt_pk_bf16(s1[0], s1[1]); w.y = cvt_pk_bf16(s1[2], s1[3]); w.z = cvt_pk_bf16(s1[4], s1[5]); w.w = cvt_pk_bf16(s1[6], s1[7]); pf[2] = __builtin_bit_cast(bf16x8, w);
              w.x = cvt_pk_bf16(s1[8], s1[9]); w.y = cvt_pk_bf16(s1[10], s1[11]); w.z = cvt_pk_bf16(s1[12], s1[13]); w.w = cvt_pk_bf16(s1[14], s1[15]); pf[3] = __builtin_bit_cast(bf16x8, w); }
#pragma unroll
            for (int d = 0; d < 4; ++d)
#pragma unroll
                for (int ks = 0; ks < 4; ++ks) {
                    const bf16x8 vf = *(const LAS bf16x8*)(lds + cb + vfo + d * 32 * VROW + ks * 32);
                    o[d] = __builtin_amdgcn_mfma_f32_32x32x16_bf16(vf, pf[ks], o[d], 0, 0, 0);
                }
        }
        if (more) { *(LAS u32x4*)(lds + nb + lk0) = ld0; *(LAS u32x4*)(lds + nb + lk1) = ld1; *(LAS u32x4*)(lds + nb + lr) = ld2; *(LAS u32x4*)(lds + nb + lv0) = ld3; *(LAS u32x4*)(lds + nb + lv1) = ld4; }
        __syncthreads();
    }
    lrun += __shfl_xor(lrun, 32);
    const float rl = __builtin_amdgcn_rcpf(lrun);
    bf16_t* op = o_out + (size_t)(tok0 + q0 + r32) * D + h * 128 + 4 * hi;
#pragma unroll
    for (int d = 0; d < 4; ++d)
#pragma unroll
        for (int r4 = 0; r4 < 4; ++r4) { u32x2 w; w.x = cvt_pk_bf16(o[d][4 * r4] * rl, o[d][4 * r4 + 1] * rl); w.y = cvt_pk_bf16(o[d][4 * r4 + 2] * rl, o[d][4 * r4 + 3] * rl);
            *(u32x2*)(op + 32 * d + 8 * r4) = w; }
}
__device__ __forceinline__ void p_attn(const Ctx& F, const Args& a) {
    const bf16_t* qn = (const bf16_t*)(a.ws + A_QN); const bf16_t* qr = (const bf16_t*)(a.ws + A_QR);
    const bf16_t* kn = (const bf16_t*)(a.ws + A_KN); const bf16_t* kr = (const bf16_t*)(a.ws + A_KR); const bf16_t* vt = (const bf16_t*)(a.ws + A_VT);
    bf16_t* oo = (bf16_t*)(a.ws + A_QN);
    for (int p = F.vcu; p < 512; p += F.G) {
        const int bh = p >> 3, s = p & 7;
        attn_unit(F.lds, qn, qr, kn, kr, vt, oo, bh >> 3, bh & 7, 15 - s, F.wave);
        attn_unit(F.lds, qn, qr, kn, kr, vt, oo, bh >> 3, bh & 7, s, F.wave);
    }
}

__device__ __forceinline__ void p_final(const Ctx& F, const Args& a) {
    float* h = a.out; const float* g = a.in[32];
    const int tid = fresh_tid(F.wave), lane = tid & 63, wave = __builtin_amdgcn_readfirstlane(tid >> 6);
    const int gw = F.vcu * 8 + wave, NGW = F.G * 8;
    f32x4 gv[4];
#pragma unroll
    for (int j = 0; j < 4; ++j) gv[j] = *((const f32x4*)g + lane + 64 * j);
    for (int m = gw; m < T; m += NGW) {
        f32x4 v[4]; float ss = 0.f;
#pragma unroll
        for (int j = 0; j < 4; ++j) { v[j] = *((const f32x4*)(h + (size_t)m * D) + lane + 64 * j); ss += (v[j][0] * v[j][0] + v[j][1] * v[j][1]) + (v[j][2] * v[j][2] + v[j][3] * v[j][3]); }
        const float rs = __builtin_amdgcn_rsqf(wave_sum(ss) * (1.0f / 1024.0f) + RMS_EPS);
#pragma unroll
        for (int j = 0; j < 4; ++j) *((f32x4*)(h + (size_t)m * D) + lane + 64 * j) = v[j] * rs * gv[j];
    }
}

__device__ __forceinline__ void my_grid_sync(unsigned* cnt, unsigned G, int wave_s) {
    asm volatile("s_waitcnt vmcnt(0) lgkmcnt(0)" ::: "memory");
    __syncthreads();
    if (fresh_tid(wave_s) == 0) {
        __builtin_amdgcn_fence(__ATOMIC_RELEASE, "agent");
        asm volatile("s_waitcnt vmcnt(0)" ::: "memory");
        __hip_atomic_fetch_add(cnt, 1u, __ATOMIC_RELAXED, __HIP_MEMORY_SCOPE_AGENT);
        while (__hip_atomic_load(cnt, __ATOMIC_RELAXED, __HIP_MEMORY_SCOPE_AGENT) < G) __builtin_amdgcn_s_sleep(4);
        __builtin_amdgcn_fence(__ATOMIC_ACQUIRE, "agent");
        asm volatile("s_waitcnt vmcnt(0)" ::: "memory");
    }
    __syncthreads();
}
#define GSYNC() do { my_grid_sync(bar_words + 64 * bar_idx, (unsigned)F.G, F.wave); ++bar_idx; } while (0)
#define RUN_GEMM(EPI_T, epi, Aptr, lda_, Bptr, ldb_, M_, N_, K_) do { pg8::Gemm g_{(const bf16_t*)(Aptr), (lda_), (const bf16_t*)(Bptr), (ldb_), (M_), (N_), (K_)}; \
    pg8::StaticOrder S_; S_.init((M_), (N_), F.G, (int)blockIdx.x); pg8::gemm_phase<EPI_T>(F.lds, g_, S_, (epi), F.wave); } while (0)

__global__ void __launch_bounds__(512, 2) fwd_mega(Args a) {
    extern __shared__ __attribute__((aligned(16))) unsigned char lds_raw[];
    cg::grid_group grid = cg::this_grid();
    Ctx F; F.lds = (LAS unsigned char*)lds_raw; F.wave = __builtin_amdgcn_readfirstlane((int)threadIdx.x >> 6);
    F.G = gridDim.x; { const int bx = blockIdx.x; F.vcu = (F.G % 8 == 0) ? (bx % 8) * (F.G / 8) + bx / 8 : bx; }
    unsigned char* ws = a.ws;
    float* slotsH = (float*)(ws + WS_SLOTH); float* slotsC = (float*)(ws + WS_SLOTC); float* slotsQ = (float*)(ws + WS_SLOTQ);
    bf16_t* HB = (bf16_t*)(ws + A_HB); bf16_t* MID = (bf16_t*)(ws + A_MID);
    const float* cosT = (const float*)(ws + A_COS); const float* sinT = (const float*)(ws + A_SIN);
    bf16_t* WUG = (bf16_t*)(ws + W_UG); bf16_t* WDN = (bf16_t*)(ws + W_DN);

    unsigned* bar_words = (unsigned*)ws;
    if (a.ph_hi - a.ph_lo > 1) grid.sync();
    if (a.ph_lo <= 0 && 0 < a.ph_hi) {
    p0_prologue(F, a);
    }
    if (a.ph_lo <= 0 && 1 < a.ph_hi) my_grid_sync(bar_words + 64 * 0, (unsigned)F.G, F.wave);
    if (a.ph_lo <= 1 && 1 < a.ph_hi) {
    { EpiSwiglu E{MID, slotsH, nullptr, nullptr, nullptr, nullptr, nullptr}; RUN_GEMM(EpiSwiglu, E, HB, D, WUG, D, T, 5632, D); }
    }
    if (a.ph_lo <= 1 && 2 < a.ph_hi) my_grid_sync(bar_words + 64 * 1, (unsigned)F.G, F.wave);
    if (a.ph_lo <= 2 && 2 < a.ph_hi) {
    { EpiResid E{a.in[0], a.out, nullptr, nullptr, 0.5f}; RUN_GEMM(EpiResid, E, MID, FF, WDN, FF, T, D, FF); }
    }
    if (a.ph_lo <= 2 && 3 < a.ph_hi) my_grid_sync(bar_words + 64 * 2, (unsigned)F.G, F.wave);
    if (a.ph_lo <= 3 && 3 < a.ph_hi) {
    p_premix(F, a);
    }
    if (a.ph_lo <= 3 && 4 < a.ph_hi) my_grid_sync(bar_words + 64 * 3, (unsigned)F.G, F.wave);
    if (a.ph_lo <= 4 && 4 < a.ph_hi) {
    { EpiRL E{(bf16_t*)(ws + A_R), (bf16_t*)(ws + A_LM)}; RUN_GEMM(EpiRL, E, ws + A_X1, 2048, ws + W_RL, 2048, T, 1280, 2048); }
    }
    if (a.ph_lo <= 4 && 5 < a.ph_hi) my_grid_sync(bar_words + 64 * 4, (unsigned)F.G, F.wave);
    if (a.ph_lo <= 5 && 5 < a.ph_hi) {
    { EpiBf16 E{(bf16_t*)(ws + A_KK), D}; RUN_GEMM(EpiBf16, E, ws + A_XK, D, ws + W_K, D, T, D, D); }
    { EpiBf16 E{(bf16_t*)(ws + A_VV), D}; RUN_GEMM(EpiBf16, E, ws + A_XV, D, ws + W_V, D, T, D, D); }
    }
    if (a.ph_lo <= 5 && 6 < a.ph_hi) my_grid_sync(bar_words + 64 * 5, (unsigned)F.G, F.wave);
    if (a.ph_lo <= 6 && 6 < a.ph_hi) {
    { EpiLoraUp E{ws, a.in[11], a.in[14], 0, A_G}; RUN_GEMM(EpiLoraUp, E, ws + A_LM, 256, ws + W_LU, 256, T, 2048, 256); }
    }
    if (a.ph_lo <= 6 && 7 < a.ph_hi) my_grid_sync(bar_words + 64 * 6, (unsigned)F.G, F.wave);
    if (a.ph_lo <= 7 && 7 < a.ph_hi) {
    p_scan2(F, a);
    }
    if (a.ph_lo <= 7 && 8 < a.ph_hi) my_grid_sync(bar_words + 64 * 7, (unsigned)F.G, F.wave);
    if (a.ph_lo <= 8 && 8 < a.ph_hi) {
    { EpiLoraUp E{ws, a.in[11], a.in[14], 2, A_E}; RUN_GEMM(EpiLoraUp, E, ws + A_LM, 256, ws + W_LU + (size_t)2048 * 256 * 2, 256, T, 1024, 256); }
    }
    if (a.ph_lo <= 8 && 9 < a.ph_hi) my_grid_sync(bar_words + 64 * 8, (unsigned)F.G, F.wave);
    if (a.ph_lo <= 9 && 9 < a.ph_hi) {
    p_post(F, a);
    }
    if (a.ph_lo <= 9 && 10 < a.ph_hi) my_grid_sync(bar_words + 64 * 9, (unsigned)F.G, F.wave);
    if (a.ph_lo <= 10 && 10 < a.ph_hi) {
    { EpiResid E{a.out, a.out, HB, slotsH, 1.0f}; RUN_GEMM(EpiResid, E, ws + A_G, D, ws + W_O, D, T, D, D); }
    }
    if (a.ph_lo <= 10 && 11 < a.ph_hi) my_grid_sync(bar_words + 64 * 10, (unsigned)F.G, F.wave);
    if (a.ph_lo <= 11 && 11 < a.ph_hi) {
    { EpiSwiglu E{MID, slotsH, nullptr, nullptr, nullptr, nullptr, nullptr}; RUN_GEMM(EpiSwiglu, E, HB, D, WUG + (size_t)1 * 6144 * D, D, T, 5632, D); }
    }
    if (a.ph_lo <= 11 && 12 < a.ph_hi) my_grid_sync(bar_words + 64 * 11, (unsigned)F.G, F.wave);
    if (a.ph_lo <= 12 && 12 < a.ph_hi) {
    { EpiResid E{a.out, a.out, HB, slotsH, 0.5f}; RUN_GEMM(EpiResid, E, MID, FF, WDN + (size_t)1 * D * FF, FF, T, D, FF); }
    }
    if (a.ph_lo <= 12 && 13 < a.ph_hi) my_grid_sync(bar_words + 64 * 12, (unsigned)F.G, F.wave);
    if (a.ph_lo <= 13 && 13 < a.ph_hi) {
    { EpiSwiglu E{MID, slotsH, (bf16_t*)(ws + A_C), slotsC, (bf16_t*)(ws + A_KR), cosT, sinT}; RUN_GEMM(EpiSwiglu, E, HB, D, WUG + (size_t)2 * 6144 * D, D, T, 6144, D); }
    }
    if (a.ph_lo <= 13 && 14 < a.ph_hi) my_grid_sync(bar_words + 64 * 13, (unsigned)F.G, F.wave);
    if (a.ph_lo <= 14 && 14 < a.ph_hi) {
    { EpiResid E{a.out, a.out, HB, slotsH, 0.5f}; RUN_GEMM(EpiResid, E, MID, FF, WDN + (size_t)2 * D * FF, FF, T, D, FF); }
    { EpiKnope E{(bf16_t*)(ws + A_KN), slotsC}; RUN_GEMM(EpiKnope, E, ws + A_C, 256, ws + W_KN, 256, T, D, 256); }
    { EpiVt E{(bf16_t*)(ws + A_VT), slotsC}; RUN_GEMM(EpiVt, E, ws + W_VT, 256, ws + A_C, 256, D, T, 256); }
    }
    if (a.ph_lo <= 14 && 15 < a.ph_hi) my_grid_sync(bar_words + 64 * 14, (unsigned)F.G, F.wave);
    if (a.ph_lo <= 15 && 15 < a.ph_hi) {
    { EpiQlat E{(bf16_t*)(ws + A_QLAT), slotsH, slotsQ}; RUN_GEMM(EpiQlat, E, HB, D, ws + W_DQ, D, T, 512, D); }
    }
    if (a.ph_lo <= 15 && 16 < a.ph_hi) my_grid_sync(bar_words + 64 * 15, (unsigned)F.G, F.wave);
    if (a.ph_lo <= 16 && 16 < a.ph_hi) {
    { EpiQ E{(bf16_t*)(ws + A_QN), (bf16_t*)(ws + A_QR), slotsQ, cosT, sinT}; RUN_GEMM(EpiQ, E, ws + A_QLAT, 512, ws + W_UQ, 512, T, 1536, 512); }
    }
    if (a.ph_lo <= 16 && 17 < a.ph_hi) my_grid_sync(bar_words + 64 * 16, (unsigned)F.G, F.wave);
    if (a.ph_lo <= 17 && 17 < a.ph_hi) {
    p_attn(F, a);
    }
    if (a.ph_lo <= 17 && 18 < a.ph_hi) my_grid_sync(bar_words + 64 * 17, (unsigned)F.G, F.wave);
    if (a.ph_lo <= 18 && 18 < a.ph_hi) {
    { EpiResid E{a.out, a.out, HB, slotsH, 1.0f}; RUN_GEMM(EpiResid, E, ws + A_QN, D, ws + W_MO, D, T, D, D); }
    }
    if (a.ph_lo <= 18 && 19 < a.ph_hi) my_grid_sync(bar_words + 64 * 18, (unsigned)F.G, F.wave);
    if (a.ph_lo <= 19 && 19 < a.ph_hi) {
    { EpiSwiglu E{MID, slotsH, nullptr, nullptr, nullptr, nullptr, nullptr}; RUN_GEMM(EpiSwiglu, E, HB, D, WUG + (size_t)3 * 6144 * D, D, T, 5632, D); }
    }
    if (a.ph_lo <= 19 && 20 < a.ph_hi) my_grid_sync(bar_words + 64 * 19, (unsigned)F.G, F.wave);
    if (a.ph_lo <= 20 && 20 < a.ph_hi) {
    { EpiResid E{a.out, a.out, nullptr, nullptr, 0.5f}; RUN_GEMM(EpiResid, E, MID, FF, WDN + (size_t)3 * D * FF, FF, T, D, FF); }
    }
    if (a.ph_lo <= 20 && 21 < a.ph_hi) my_grid_sync(bar_words + 64 * 20, (unsigned)F.G, F.wave);
    if (a.ph_lo <= 21 && 21 < a.ph_hi) {
    p_final(F, a);
    }
}

extern "C" void kernel_launch(void* const* d_in, const int* in_sizes, int n_in, void* d_out, int out_size, void* d_ws, size_t ws_size, hipStream_t stream) {
    static int grid = 0;
    if (grid == 0) {
        if (n_in != 33 || out_size != T * D || ws_size < WS_NEED) { fprintf(stderr, "kernel_launch: unexpected shapes: n_in %d out %d ws %zu (need %zu)\n", n_in, out_size, ws_size, (size_t)WS_NEED); grid = -1; return; }
        int dev = 0, cus = 0, per_cu = 0;
        (void)hipGetDevice(&dev); (void)hipDeviceGetAttribute(&cus, hipDeviceAttributeMultiprocessorCount, dev);
        (void)hipFuncSetAttribute((const void*)fwd_mega, hipFuncAttributeMaxDynamicSharedMemorySize, LDS_BYTES);
        (void)hipOccupancyMaxActiveBlocksPerMultiprocessor(&per_cu, (const void*)fwd_mega, 512, LDS_BYTES);
        (void)hipGetLastError();
        grid = cus > 0 ? cus : 256;
        if (grid > 256) grid = 256;
    }
    if (grid < 0) return;
    (void)hipMemsetAsync(d_ws, 0, 65536, stream);
    Args a{};
    for (int i = 0; i < 33; ++i) a.in[i] = (const float*)d_in[i];
    a.pos = (const int*)d_in[1]; a.out = (float*)d_out; a.ws = (unsigned char*)d_ws;
    hipError_t e = hipSuccess;
#if N_LAUNCHES == 1
    a.ph_lo = 0; a.ph_hi = NPHASES;
    { void* args[] = {&a}; e = hipLaunchCooperativeKernel((void*)fwd_mega, dim3(grid), dim3(512), args, LDS_BYTES, stream); }
#else
    for (int p = 0; p < NPHASES; ++p) { a.ph_lo = p; a.ph_hi = p + 1; hipLaunchKernelGGL(fwd_mega, dim3(grid), dim3(512), LDS_BYTES, stream, a); }
    e = hipPeekAtLastError();
#endif
    if (e != hipSuccess) fprintf(stderr, "cooperative launch failed: %s (grid %d)\n", hipGetErrorString(e), grid);
}
```

```cpp
#include <hip/hip_runtime.h>
#include <hip/hip_cooperative_groups.h>
#include <cstdio>
#include <cstdint>
namespace cg = cooperative_groups;

#define LAS __attribute__((address_space(3)))
typedef unsigned short bf16_t;
typedef short bf16x8 __attribute__((ext_vector_type(8)));
typedef float f32x4 __attribute__((ext_vector_type(4)));
typedef float f32x16 __attribute__((ext_vector_type(16)));
typedef unsigned u32x4 __attribute__((ext_vector_type(4)));
typedef unsigned u32x2 __attribute__((ext_vector_type(2)));
typedef float f32x2 __attribute__((ext_vector_type(2)));

constexpr int T = 32768, D = 1024, FF = 2816, SEQ = 4096, NB = 8;
constexpr float RMS_EPS = 1e-6f, GN_EPS = 64e-5f;
constexpr float LOG2E = 1.4426950408889634f;
constexpr float QSCALE = 0.07216878364870322f * 1.4426950408889634f;

constexpr size_t MiB = 1u << 20;
constexpr size_t WS_SLOTH = MiB / 2;
constexpr size_t WS_SLOTC = WS_SLOTH + 2 * MiB;
constexpr size_t WS_SLOTQ = WS_SLOTC + MiB / 2;
constexpr size_t WS_W = 4 * MiB;
constexpr size_t W_UG = WS_W;
constexpr size_t W_DN = W_UG + 48 * MiB;
constexpr size_t W_R = W_DN + 22 * MiB;
constexpr size_t W_K = W_R + 2 * MiB;
constexpr size_t W_V = W_K + 2 * MiB;
constexpr size_t W_O = W_V + 2 * MiB;
constexpr size_t W_LD = W_O + 2 * MiB;
constexpr size_t W_LU = W_LD + 1 * MiB;
constexpr size_t W_KN = W_LU + 2 * MiB;
constexpr size_t W_VT = W_KN + MiB / 2;
constexpr size_t W_DQ = W_VT + MiB / 2;
constexpr size_t W_UQ = W_DQ + 1 * MiB;
constexpr size_t W_MO = W_UQ + 2 * MiB;
constexpr size_t W_END = W_MO + 2 * MiB;
constexpr size_t WS_A = 92 * MiB;
static_assert(W_END <= WS_A, "weights region");
constexpr size_t A_HB = WS_A + 0;
constexpr size_t A_MID = WS_A + 64 * MiB;
constexpr size_t A_C = WS_A + 240 * MiB;
constexpr size_t A_KR = WS_A + 256 * MiB;
constexpr size_t A_KN = WS_A + 260 * MiB;
constexpr size_t A_VT = WS_A + 324 * MiB;
constexpr size_t A_QLAT = A_MID;
constexpr size_t A_QN = A_MID + 32 * MiB;
constexpr size_t A_QR = A_MID + 96 * MiB;
constexpr size_t A_X1 = WS_A + 0;
constexpr size_t A_XK = WS_A + 128 * MiB;
constexpr size_t A_XV = WS_A + 192 * MiB;
constexpr size_t A_R = WS_A + 256 * MiB;
constexpr size_t A_LM = WS_A + 320 * MiB;
constexpr size_t A_KK = WS_A + 0;
constexpr size_t A_VV = WS_A + 64 * MiB;
constexpr size_t A_E = WS_A + 128 * MiB;
constexpr size_t A_AA = WS_A + 192 * MiB;
constexpr size_t A_G = WS_A + 336 * MiB;
constexpr size_t A_BON = WS_A + 400 * MiB;
constexpr size_t A_COS = WS_A + 404 * MiB;
constexpr size_t A_SIN = WS_A + 408 * MiB;
constexpr size_t W_RL = WS_A + 412 * MiB;
constexpr size_t WS_NEED = 512 * MiB;

constexpr int LDS_BYTES = 147456;
constexpr int NPHASES = 22;
#ifndef N_LAUNCHES
#define N_LAUNCHES 1
#endif

__device__ __forceinline__ unsigned cvt_pk_bf16(float lo, float hi) { unsigned r; asm volatile("v_cvt_pk_bf16_f32 %0, %1, %2" : "=v"(r) : "v"(lo), "v"(hi)); return r; }
__device__ __forceinline__ float fsigmoid(float x) { return __builtin_amdgcn_rcpf(1.0f + __builtin_amdgcn_exp2f(-x * LOG2E)); }
__device__ __forceinline__ float ftanh(float x) { return 1.0f - 2.0f * __builtin_amdgcn_rcpf(1.0f + __builtin_amdgcn_exp2f(2.0f * LOG2E * x)); }
__device__ __forceinline__ float wave_sum(float v) {
#pragma unroll
    for (int o = 1; o < 64; o <<= 1) v += __shfl_xor(v, o);
    return v;
}
template <int CTRL> __device__ __forceinline__ float dpp_mov(float x) { return __builtin_bit_cast(float, __builtin_amdgcn_update_dpp(0, __builtin_bit_cast(int, x), CTRL, 0xf, 0xf, true)); }
__device__ __forceinline__ float red8(float x) { x += dpp_mov<0xB1>(x); x += dpp_mov<0x4E>(x); x += dpp_mov<0x141>(x); return x; }
__device__ __forceinline__ float red16(float x) { x = red8(x); x += dpp_mov<0x140>(x); return x; }
__device__ __forceinline__ float sum4(f32x4 v) { return (v[0] + v[1]) + (v[2] + v[3]); }
__device__ __forceinline__ float rstd_slots16(const float* s, int row) {
    const f32x4* p = (const f32x4*)(s + (size_t)row * 16);
    const f32x4 a = p[0], b = p[1], c = p[2], d = p[3];
    return __builtin_amdgcn_rsqf((sum4(a) + sum4(b) + sum4(c) + sum4(d)) * (1.0f / 1024.0f) + RMS_EPS);
}
__device__ __forceinline__ f32x4 unpack4(u32x2 p) { f32x4 r; r[0] = __uint_as_float(p.x << 16); r[1] = __uint_as_float(p.x & 0xffff0000u); r[2] = __uint_as_float(p.y << 16); r[3] = __uint_as_float(p.y & 0xffff0000u); return r; }

__device__ __forceinline__ int fresh_tid(int wave_s) { int l; asm volatile("v_mbcnt_lo_u32_b32 %0, -1, 0\n\tv_mbcnt_hi_u32_b32 %0, -1, %0" : "=v"(l)); return wave_s * 64 + l; }

namespace pg8 {
constexpr int BM = 256, BK = 64, HALF = 128, HTB = HALF * BK * 2, STAGE_BYTES = 8 * HTB, NXCD = 8, WGM = 8;
__device__ __forceinline__ int lds_byte(int r, int c) { const int st = (r >> 4) * 2 + (c >> 5), rr = r & 15, cc = c & 31, ob = rr * 64 + cc * 2; return st * 1024 + (ob ^ (((ob >> 9) & 1) << 5)); }
__device__ __forceinline__ void stage_rc(int b, int& R, int& C) { const int st = b / 1024, sb = b % 1024, swz = sb ^ (((sb >> 9) & 1) << 5); R = (st >> 1) * 16 + swz / 64; C = (st & 1) * 32 + (swz % 64) / 2; }
__device__ __forceinline__ int perm32(int rho) { const int n = rho >> 4, i = rho & 15; return 8 * (i >> 2) + 4 * n + (i & 3); }
struct Unit { int pm, pn; };
struct Gemm { const bf16_t* A; int lda; const bf16_t* Bt; int ldb; int M, N, K; };
struct StaticOrder {
    int nM, nN, nwg, G, c;
    __device__ void init(int M, int N, int G_, int c_) { nM = M / BM; nN = N / BM; nwg = nM * nN; G = G_; c = c_; }
    __device__ bool next(int i, Unit& u) const {
        const long L = (long)i * G + c; if (L >= nwg) return false;
        int wgid = (int)L; { const int q = nwg / NXCD, r = nwg % NXCD, xcd = wgid % NXCD, off = wgid / NXCD; wgid = (xcd < r ? xcd * (q + 1) : r * (q + 1) + (xcd - r) * q) + off; }
        const int nig = WGM * nN, gid = wgid / nig, fm = gid * WGM, gsz = (nM - fm) < WGM ? (nM - fm) : WGM;
        u.pm = fm + ((wgid % nig) % gsz); u.pn = (wgid % nig) / gsz; return true;
    }
};

template <class Epi>
__device__ __forceinline__ void gemm_phase(LAS unsigned char* lds, const Gemm g, const StaticOrder& S, const Epi& E, int wave_s) {
    const int tid = fresh_tid(wave_s), wid = __builtin_amdgcn_readfirstlane(tid >> 6), lane = tid & 63, wr = wid >> 2, wc = wid & 3, fr = lane & 15, fq = lane >> 4;
    const int K = g.K, nt = K / BK;
    unsigned voffA[2], voffB[2];
#pragma unroll
    for (int i = 0; i < 2; ++i) { int R, C; stage_rc(tid * 16 + i * 8192, R, C); const int Rb = Epi::PERM ? ((R & ~31) + perm32(R & 31)) : R;
        voffA[i] = (unsigned)(R * g.lda + C) * 2u; voffB[i] = (unsigned)(Rb * g.ldb + C) * 2u; }
    const size_t kstep = (size_t)(BK * 2);
    const size_t hstepA = (size_t)HALF * g.lda * 2, hstepB = (size_t)HALF * g.ldb * 2;
    const size_t tstepA = 2 * hstepA, tstepB = 2 * hstepB;
    const unsigned ldsw = (unsigned)wid * 1024u;
    const int aoff = lds_byte(wr * 64 + fr, fq * 8), boff = lds_byte(wc * 32 + fr, fq * 8);
#define PG8_SA(b, h) (((b) * 2 + (h)) * HTB)
#define PG8_SB(b, h) ((4 + (b) * 2 + (h)) * HTB)
#define PG8_STAGE(bufoff, gbase, voff) do { _Pragma("unroll") for (int _i = 0; _i < 2; ++_i) \
        __builtin_amdgcn_global_load_lds((const unsigned*)((const char*)(gbase) + (voff)[_i]), (LAS unsigned*)(lds + (bufoff) + ldsw + _i * 8192), 16, 0, 0); } while (0)
#define PG8_LDA(dst, b, h) do { _Pragma("unroll") for (int m = 0; m < 4; ++m) _Pragma("unroll") for (int k = 0; k < 2; ++k) dst[m][k] = *(const LAS bf16x8*)(lds + PG8_SA(b, h) + aoff + m * 2048 + k * 1024); } while (0)
#define PG8_LDB(dst, b, h) do { _Pragma("unroll") for (int n = 0; n < 2; ++n) _Pragma("unroll") for (int k = 0; k < 2; ++k) dst[n][k] = *(const LAS bf16x8*)(lds + PG8_SB(b, h) + boff + n * 2048 + k * 1024); } while (0)
#define PG8_MMA(ai, bj, At, Bt) do { __builtin_amdgcn_s_setprio(1); _Pragma("unroll") for (int m = 0; m < 4; ++m) _Pragma("unroll") for (int n = 0; n < 2; ++n) _Pragma("unroll") for (int k = 0; k < 2; ++k) \
        acc[ai][bj][m][n] = __builtin_amdgcn_mfma_f32_16x16x32_bf16(Bt[n][k], At[m][k], acc[ai][bj][m][n], 0, 0, 0); __builtin_amdgcn_s_setprio(0); } while (0)
#define PG8_WAIT_V(n) asm volatile("s_waitcnt vmcnt(" #n ")" ::: "memory")
#define PG8_WAIT_L(n) asm volatile("s_waitcnt lgkmcnt(" #n ")" ::: "memory")
#define PG8_BAR __builtin_amdgcn_s_barrier()
#define PG8_SCHED __builtin_amdgcn_sched_barrier(0)
    Unit cur, nxt; int ui = 0;
    if (!S.next(0, cur)) return;
    f32x4 acc[2][2][4][2];
#pragma unroll
    for (int a = 0; a < 2; ++a)
#pragma unroll
        for (int b = 0; b < 2; ++b)
#pragma unroll
            for (int m = 0; m < 4; ++m)
#pragma unroll
                for (int n = 0; n < 2; ++n) acc[a][b][m][n] = (f32x4){0.f, 0.f, 0.f, 0.f};
    bf16x8 At[4][2], B0[2][2], B1[2][2];
    const char* cA = (const char*)g.A + (size_t)cur.pm * tstepA; const char* cB = (const char*)g.Bt + (size_t)cur.pn * tstepB;
    PG8_STAGE(PG8_SB(0, 0), cB, voffB); PG8_STAGE(PG8_SB(0, 1), cB + hstepB, voffB); PG8_STAGE(PG8_SA(0, 0), cA, voffA); PG8_STAGE(PG8_SA(0, 1), cA + hstepA, voffA);
    if (wr == 1) PG8_BAR;
    PG8_WAIT_V(2); PG8_BAR;
    PG8_STAGE(PG8_SB(1, 0), cB + kstep, voffB); PG8_STAGE(PG8_SA(1, 0), cA + kstep, voffA); PG8_STAGE(PG8_SB(1, 1), cB + hstepB + kstep, voffB);
    PG8_WAIT_V(6); PG8_BAR;
    for (;;) {
        const bool has_next = S.next(ui + 1, nxt);
        const char* nA = has_next ? (const char*)g.A + (size_t)nxt.pm * tstepA : cA; const char* nB = has_next ? (const char*)g.Bt + (size_t)nxt.pn * tstepB : cB;
        for (int t = 0; t < nt; t += 2) {
            const bool last = (t == nt - 2);
            const char* a1 = cA + (size_t)(t + 1) * kstep;
            const char* a2 = last ? nA : cA + (size_t)(t + 2) * kstep; const char* b2 = last ? nB : cB + (size_t)(t + 2) * kstep;
            const char* a3 = a2 + kstep; const char* b3 = b2 + kstep;
            PG8_LDB(B0, 0, 0); PG8_LDB(B1, 0, 1); PG8_SCHED; PG8_LDA(At, 0, 0); PG8_STAGE(PG8_SA(1, 1), a1 + hstepA, voffA);
            PG8_WAIT_V(8); PG8_WAIT_L(0); PG8_BAR; PG8_MMA(0, 0, At, B0); PG8_MMA(0, 1, At, B1); PG8_BAR; PG8_SCHED;
            PG8_LDA(At, 0, 1); PG8_STAGE(PG8_SB(0, 0), b2, voffB); PG8_STAGE(PG8_SB(0, 1), b2 + hstepB, voffB); PG8_STAGE(PG8_SA(0, 0), a2, voffA);
            PG8_WAIT_V(8); PG8_WAIT_L(0); PG8_BAR; PG8_MMA(1, 0, At, B0); PG8_MMA(1, 1, At, B1); PG8_BAR; PG8_SCHED;
            PG8_LDB(B0, 1, 0); PG8_LDB(B1, 1, 1); PG8_SCHED; PG8_LDA(At, 1, 0); PG8_STAGE(PG8_SA(0, 1), a2 + hstepA, voffA);
            PG8_WAIT_V(8); PG8_WAIT_L(0); PG8_BAR; PG8_MMA(0, 0, At, B0); PG8_MMA(0, 1, At, B1); PG8_BAR; PG8_SCHED;
            PG8_LDA(At, 1, 1); PG8_STAGE(PG8_SB(1, 0), b3, voffB); PG8_STAGE(PG8_SB(1, 1), b3 + hstepB, voffB); PG8_STAGE(PG8_SA(1, 0), a3, voffA);
            PG8_WAIT_V(8); PG8_WAIT_L(0); PG8_BAR; PG8_MMA(1, 0, At, B0); PG8_MMA(1, 1, At, B1); PG8_BAR; PG8_SCHED;
        }
        if (wr == 0) PG8_BAR;
        E(acc, cur, wr, wc, fr, fq);
        if (!has_next) break;
#pragma unroll
        for (int a = 0; a < 2; ++a)
#pragma unroll
            for (int b = 0; b < 2; ++b)
#pragma unroll
                for (int m = 0; m < 4; ++m)
#pragma unroll
                    for (int n = 0; n < 2; ++n) acc[a][b][m][n] = (f32x4){0.f, 0.f, 0.f, 0.f};
        cur = nxt; cA = nA; cB = nB; ++ui;
        if (wr == 1) PG8_BAR;
    }
    PG8_WAIT_V(0);
    PG8_BAR;
#undef PG8_SA
#undef PG8_SB
#undef PG8_STAGE
#undef PG8_LDA
#undef PG8_LDB
#undef PG8_MMA
#undef PG8_WAIT_V
#undef PG8_WAIT_L
#undef PG8_BAR
#undef PG8_SCHED
}
}
using pg8::Unit;
typedef f32x4 AccT[2][2][4][2];

__device__ __forceinline__ u32x4 pack8(f32x4 a, f32x4 b) { u32x4 w; w.x = cvt_pk_bf16(a[0], a[1]); w.y = cvt_pk_bf16(a[2], a[3]); w.z = cvt_pk_bf16(b[0], b[1]); w.w = cvt_pk_bf16(b[2], b[3]); return w; }

struct EpiSwiglu {
    static constexpr bool PERM = true;
    bf16_t* mid; const float* slotsH; bf16_t* cbuf; float* slotsC; bf16_t* krope; const float* cosT; const float* sinT;
    __device__ __forceinline__ void operator()(const AccT& acc, const Unit& u, int wr, int wc, int fr, int fq) const {
        const int row0 = u.pm * 256 + wr * 64 + fr;
        if (u.pn < 22) {
#pragma unroll
            for (int ai = 0; ai < 2; ++ai)
#pragma unroll
                for (int m = 0; m < 4; ++m) {
                    const int row = row0 + ai * 128 + m * 16; const float rs = rstd_slots16(slotsH, row);
                    f32x4 o[2];
#pragma unroll
                    for (int n = 0; n < 2; ++n)
#pragma unroll
                        for (int i = 0; i < 4; ++i) { const float gt = acc[ai][0][m][n][i] * rs, up = acc[ai][1][m][n][i] * rs; o[n][i] = gt * fsigmoid(gt) * up; }
                    *(u32x4*)(mid + (size_t)row * FF + u.pn * 128 + wc * 32 + fq * 8) = pack8(o[0], o[1]);
                }
        } else if (u.pn == 22) {
#pragma unroll
            for (int ai = 0; ai < 2; ++ai)
#pragma unroll
                for (int m = 0; m < 4; ++m) {
                    const int row = row0 + ai * 128 + m * 16; const float rs = rstd_slots16(slotsH, row);
                    float ss = 0.f;
#pragma unroll
                    for (int bj = 0; bj < 2; ++bj) { const f32x4 a = acc[ai][bj][m][0] * rs, b = acc[ai][bj][m][1] * rs;
                        ss += (a[0] * a[0] + a[1] * a[1]) + (a[2] * a[2] + a[3] * a[3]) + (b[0] * b[0] + b[1] * b[1]) + (b[2] * b[2] + b[3] * b[3]);
                        *(u32x4*)(cbuf + (size_t)row * 256 + bj * 128 + wc * 32 + fq * 8) = pack8(a, b); }
                    ss += __shfl_xor(ss, 16); ss += __shfl_xor(ss, 32);
                    if (fq == 0) slotsC[(size_t)row * 4 + wc] = ss;
                }
        } else if (wc == 0) {
#pragma unroll
            for (int ai = 0; ai < 2; ++ai)
#pragma unroll
                for (int m = 0; m < 4; ++m) {
                    const int row = row0 + ai * 128 + m * 16; const float rs = rstd_slots16(slotsH, row);
                    f32x4 o1[2], o2[2];
#pragma unroll
                    for (int n = 0; n < 2; ++n) { const f32x4 c = *(const f32x4*)(cosT + (size_t)row * 32 + fq * 8 + n * 4), s = *(const f32x4*)(sinT + (size_t)row * 32 + fq * 8 + n * 4);
                        const f32x4 x1 = acc[ai][0][m][n] * rs, x2 = acc[ai][1][m][n] * rs; o1[n] = x1 * c - x2 * s; o2[n] = x2 * c + x1 * s; }
                    *(u32x4*)(krope + (size_t)row * 64 + fq * 8) = pack8(o1[0], o1[1]);
                    *(u32x4*)(krope + (size_t)row * 64 + 32 + fq * 8) = pack8(o2[0], o2[1]);
                }
        }
    }
};
struct EpiResid {
    static constexpr bool PERM = false;
    const float* hin; float* hout; bf16_t* hb; float* slots; float alpha;
    __device__ __forceinline__ void operator()(const AccT& acc, const Unit& u, int wr, int wc, int fr, int fq) const {
        const int row0 = u.pm * 256 + wr * 64 + fr, col0 = u.pn * 256 + wc * 32 + 4 * fq;
#pragma unroll
        for (int ai = 0; ai < 2; ++ai)
#pragma unroll
            for (int m = 0; m < 4; ++m) {
                const int row = row0 + ai * 128 + m * 16; const size_t off = (size_t)row * D + col0; float ss = 0.f;
#pragma unroll
                for (int bj = 0; bj < 2; ++bj)
#pragma unroll
                    for (int n = 0; n < 2; ++n) { const size_t o2 = off + bj * 128 + n * 16; const f32x4 b = *(const f32x4*)(hin + o2); const f32x4 o = b + acc[ai][bj][m][n] * alpha;
                        *(f32x4*)(hout + o2) = o; ss += (o[0] * o[0] + o[1] * o[1]) + (o[2] * o[2] + o[3] * o[3]);
                        if (hb) { u32x2 w; w.x = cvt_pk_bf16(o[0], o[1]); w.y = cvt_pk_bf16(o[2], o[3]); *(u32x2*)(hb + o2) = w; } }
                if (slots) { ss += __shfl_xor(ss, 16); ss += __shfl_xor(ss, 32); if (fq == 0) slots[(size_t)row * 16 + u.pn * 4 + wc] = ss; }
                if (m & 1) asm volatile("" ::: "memory");
            }
    }
};
struct EpiBf16 {
    static constexpr bool PERM = true;
    bf16_t* O; int ldc;
    __device__ __forceinline__ void operator()(const AccT& acc, const Unit& u, int wr, int wc, int fr, int fq) const {
        const int row0 = u.pm * 256 + wr * 64 + fr, col0 = u.pn * 256 + wc * 32 + 8 * fq;
#pragma unroll
        for (int ai = 0; ai < 2; ++ai)
#pragma unroll
            for (int m = 0; m < 4; ++m) { bf16_t* rp = O + (size_t)(row0 + ai * 128 + m * 16) * ldc + col0;
#pragma unroll
                for (int bj = 0; bj < 2; ++bj) *(u32x4*)(rp + bj * 128) = pack8(acc[ai][bj][m][0], acc[ai][bj][m][1]); }
    }
};
struct EpiLoraDown {
    static constexpr bool PERM = true;
    bf16_t* O;
    __device__ __forceinline__ void operator()(const AccT& acc, const Unit& u, int wr, int wc, int fr, int fq) const {
        const int row0 = u.pm * 256 + wr * 64 + fr, col0 = wc * 32 + 8 * fq;
#pragma unroll
        for (int ai = 0; ai < 2; ++ai)
#pragma unroll
            for (int m = 0; m < 4; ++m) { bf16_t* rp = O + (size_t)(row0 + ai * 128 + m * 16) * 256 + col0;
                f32x4 a = acc[ai][0][m][0], b = acc[ai][0][m][1];
                if (wc < 2) {
#pragma unroll
                    for (int i = 0; i < 4; ++i) { a[i] = ftanh(a[i]); b[i] = ftanh(b[i]); } }
                *(u32x4*)(rp) = pack8(a, b);
                a = acc[ai][1][m][0]; b = acc[ai][1][m][1];
#pragma unroll
                for (int i = 0; i < 4; ++i) { a[i] = fsigmoid(a[i]); b[i] = fsigmoid(b[i]); }
                *(u32x4*)(rp + 128) = pack8(a, b); }
    }
};
struct EpiRL {
    static constexpr bool PERM = true;
    bf16_t* R; bf16_t* O;
    __device__ __forceinline__ void operator()(const AccT& acc, const Unit& u, int wr, int wc, int fr, int fq) const {
        const int row0 = u.pm * 256 + wr * 64 + fr;
        if (u.pn < 4) {
            const int col0 = u.pn * 256 + wc * 32 + 8 * fq;
#pragma unroll
            for (int ai = 0; ai < 2; ++ai)
#pragma unroll
                for (int m = 0; m < 4; ++m) { bf16_t* rp = R + (size_t)(row0 + ai * 128 + m * 16) * D + col0;
#pragma unroll
                    for (int bj = 0; bj < 2; ++bj) *(u32x4*)(rp + bj * 128) = pack8(acc[ai][bj][m][0], acc[ai][bj][m][1]); }
        } else {
            const int col0 = wc * 32 + 8 * fq;
#pragma unroll
            for (int ai = 0; ai < 2; ++ai)
#pragma unroll
                for (int m = 0; m < 4; ++m) { bf16_t* rp = O + (size_t)(row0 + ai * 128 + m * 16) * 256 + col0;
                    f32x4 a = acc[ai][0][m][0], b = acc[ai][0][m][1];
                    if (wc < 2) {
#pragma unroll
                        for (int i = 0; i < 4; ++i) { a[i] = ftanh(a[i]); b[i] = ftanh(b[i]); } }
                    *(u32x4*)(rp) = pack8(a, b);
                    a = acc[ai][1][m][0]; b = acc[ai][1][m][1];
#pragma unroll
                    for (int i = 0; i < 4; ++i) { a[i] = fsigmoid(a[i]); b[i] = fsigmoid(b[i]); }
                    *(u32x4*)(rp + 128) = pack8(a, b); }
        }
    }
};
struct EpiLoraUp {
    static constexpr bool PERM = true;
    unsigned char* wsb; const float* w0; const float* a0; int grp0; size_t goff;
    __device__ __forceinline__ void operator()(const AccT& acc, const Unit& u, int wr, int wc, int fr, int fq) const {
        const int grp = (u.pn >> 2) + grp0, colt = (u.pn & 3) * 256;
        const int row0 = u.pm * 256 + wr * 64 + fr, col0 = colt + wc * 32 + 8 * fq;
        size_t ooff = goff; if (grp == 0) ooff = A_E; if (grp == 1) ooff = A_AA;
        bf16_t* O = (bf16_t*)(wsb + ooff); const float* bias = grp == 0 ? w0 : a0;
#pragma unroll
        for (int ai = 0; ai < 2; ++ai)
#pragma unroll
            for (int m = 0; m < 4; ++m) { bf16_t* rp = O + (size_t)(row0 + ai * 128 + m * 16) * D + col0;
#pragma unroll
                for (int bj = 0; bj < 2; ++bj) { f32x4 a = acc[ai][bj][m][0], b = acc[ai][bj][m][1];
                    if (grp < 2) { const float sc = grp == 0 ? 0.6065306597126334f : 1.0f;
                        const f32x4 b0 = *(const f32x4*)(bias + col0 + bj * 128), b1 = *(const f32x4*)(bias + col0 + bj * 128 + 4);
                        a = a + b0; b = b + b1;
#pragma unroll
                        for (int i = 0; i < 4; ++i) { a[i] = sc * fsigmoid(a[i]); b[i] = sc * fsigmoid(b[i]); } }
                    *(u32x4*)(rp + bj * 128) = pack8(a, b); }
                asm volatile("" ::: "memory"); }
    }
};
struct EpiQlat {
    static constexpr bool PERM = true;
    bf16_t* O; const float* slotsH; float* slotsQ;
    __device__ __forceinline__ void operator()(const AccT& acc, const Unit& u, int wr, int wc, int fr, int fq) const {
        const int row0 = u.pm * 256 + wr * 64 + fr, col0 = u.pn * 256 + wc * 32 + 8 * fq;
#pragma unroll
        for (int ai = 0; ai < 2; ++ai)
#pragma unroll
            for (int m = 0; m < 4; ++m) { const int row = row0 + ai * 128 + m * 16; const float rs = rstd_slots16(slotsH, row); float ss = 0.f;
#pragma unroll
                for (int bj = 0; bj < 2; ++bj) { const f32x4 a = acc[ai][bj][m][0] * rs, b = acc[ai][bj][m][1] * rs;
                    ss += (a[0] * a[0] + a[1] * a[1]) + (a[2] * a[2] + a[3] * a[3]) + (b[0] * b[0] + b[1] * b[1]) + (b[2] * b[2] + b[3] * b[3]);
                    *(u32x4*)(O + (size_t)row * 512 + col0 + bj * 128) = pack8(a, b); }
                ss += __shfl_xor(ss, 16); ss += __shfl_xor(ss, 32);
                if (fq == 0) slotsQ[(size_t)row * 8 + u.pn * 4 + wc] = ss; }
    }
};
struct EpiQ {
    static constexpr bool PERM = true;
    bf16_t* qn; bf16_t* qr; const float* slotsQ; const float* cosT; const float* sinT;
    __device__ __forceinline__ void operator()(const AccT& acc, const Unit& u, int wr, int wc, int fr, int fq) const {
        const int row0 = u.pm * 256 + wr * 64 + fr;
#pragma unroll
        for (int ai = 0; ai < 2; ++ai)
#pragma unroll
            for (int m = 0; m < 4; ++m) { const int row = row0 + ai * 128 + m * 16;
                const f32x4 s0 = *(const f32x4*)(slotsQ + (size_t)row * 8), s1 = *(const f32x4*)(slotsQ + (size_t)row * 8 + 4);
                const float rs = __builtin_amdgcn_rsqf((sum4(s0) + sum4(s1)) * (1.0f / 512.0f) + RMS_EPS) * QSCALE;
                if (u.pn < 4) {
#pragma unroll
                    for (int bj = 0; bj < 2; ++bj) *(u32x4*)(qn + (size_t)row * D + u.pn * 256 + bj * 128 + wc * 32 + fq * 8) = pack8(acc[ai][bj][m][0] * rs, acc[ai][bj][m][1] * rs);
                } else {
                    const int head = 4 * (u.pn - 4) + wc; f32x4 o1[2], o2[2];
#pragma unroll
                    for (int n = 0; n < 2; ++n) { const f32x4 c = *(const f32x4*)(cosT + (size_t)row * 32 + fq * 8 + n * 4), s = *(const f32x4*)(sinT + (size_t)row * 32 + fq * 8 + n * 4);
                        const f32x4 x1 = acc[ai][0][m][n] * rs, x2 = acc[ai][1][m][n] * rs; o1[n] = x1 * c - x2 * s; o2[n] = x2 * c + x1 * s; }
                    *(u32x4*)(qr + (size_t)row * 512 + head * 64 + fq * 8) = pack8(o1[0], o1[1]);
                    *(u32x4*)(qr + (size_t)row * 512 + head * 64 + 32 + fq * 8) = pack8(o2[0], o2[1]);
                } }
    }
};
struct EpiKnope {
    static constexpr bool PERM = true;
    bf16_t* O; const float* slotsC;
    __device__ __forceinline__ void operator()(const AccT& acc, const Unit& u, int wr, int wc, int fr, int fq) const {
        const int row0 = u.pm * 256 + wr * 64 + fr, col0 = u.pn * 256 + wc * 32 + 8 * fq;
#pragma unroll
        for (int ai = 0; ai < 2; ++ai)
#pragma unroll
            for (int m = 0; m < 4; ++m) { const int row = row0 + ai * 128 + m * 16; const f32x4 s = *(const f32x4*)(slotsC + (size_t)row * 4);
                const float rs = __builtin_amdgcn_rsqf(sum4(s) * (1.0f / 256.0f) + RMS_EPS);
#pragma unroll
                for (int bj = 0; bj < 2; ++bj) *(u32x4*)(O + (size_t)row * D + col0 + bj * 128) = pack8(acc[ai][bj][m][0] * rs, acc[ai][bj][m][1] * rs); }
    }
};
struct EpiVt {
    static constexpr bool PERM = true;
    bf16_t* O; const float* slotsC;
    __device__ __forceinline__ void operator()(const AccT& acc, const Unit& u, int wr, int wc, int fr, int fq) const {
        const int row0 = u.pm * 256 + wr * 64 + fr, col0 = u.pn * 256 + wc * 32 + 8 * fq;
        f32x4 rs[2][2];
#pragma unroll
        for (int bj = 0; bj < 2; ++bj)
#pragma unroll
            for (int n = 0; n < 2; ++n)
#pragma unroll
                for (int i = 0; i < 4; ++i) { const f32x4 s = *(const f32x4*)(slotsC + (size_t)(col0 + bj * 128 + n * 4 + i) * 4); rs[bj][n][i] = __builtin_amdgcn_rsqf(sum4(s) * (1.0f / 256.0f) + RMS_EPS); }
#pragma unroll
        for (int ai = 0; ai < 2; ++ai)
#pragma unroll
            for (int m = 0; m < 4; ++m) { const int row = row0 + ai * 128 + m * 16;
#pragma unroll
                for (int bj = 0; bj < 2; ++bj) *(u32x4*)(O + (size_t)row * T + col0 + bj * 128) = pack8(acc[ai][bj][m][0] * rs[bj][0], acc[ai][bj][m][1] * rs[bj][1]); }
    }
};

struct Args { const float* in[33]; const int* pos; float* out; unsigned char* ws; int ph_lo, ph_hi; };

struct Ctx { LAS unsigned char* lds; int vcu, G, wave; };

__device__ __forceinline__ void tr_item(const float* W, int ldw, int k0, int n0, const float* s1, const float* s2, int ks0, bf16_t* Bt, int ldb, int nd0, int kd0, LAS float* scr, int lane) {
    f32x4 v[8];
#pragma unroll
    for (int i = 0; i < 8; ++i) v[i] = *(const f32x4*)(W + (size_t)(k0 + 8 * i + (lane >> 3)) * ldw + n0 + 4 * (lane & 7));
#pragma unroll
    for (int i = 0; i < 8; ++i) { const int kk = 8 * i + (lane >> 3);
        float sc = s1 ? s1[ks0 + kk] : 1.0f; if (s2) sc -= s2[ks0 + kk];
        LAS float* d = scr + kk * 33 + 4 * (lane & 7);
        d[0] = sc * v[i][0]; d[1] = sc * v[i][1]; d[2] = sc * v[i][2]; d[3] = sc * v[i][3]; }
    asm volatile("s_waitcnt lgkmcnt(0)" ::: "memory");
    const int c = lane & 7;
#pragma unroll
    for (int j = 0; j < 4; ++j) { const int n = (lane >> 3) + 8 * j; const LAS float* s = scr + (8 * c) * 33 + n;
        u32x4 o; o.x = cvt_pk_bf16(s[0 * 33], s[1 * 33]); o.y = cvt_pk_bf16(s[2 * 33], s[3 * 33]); o.z = cvt_pk_bf16(s[4 * 33], s[5 * 33]); o.w = cvt_pk_bf16(s[6 * 33], s[7 * 33]);
        *(u32x4*)(Bt + (size_t)(nd0 + n) * ldb + kd0 + 8 * c) = o; }
    asm volatile("s_waitcnt lgkmcnt(0)" ::: "memory");
}
__device__ __forceinline__ void zero_item(bf16_t* Bt, int ldb, int nd0, int kd0, int lane) {
    const int c = lane & 7;
#pragma unroll
    for (int j = 0; j < 4; ++j) { const int n = (lane >> 3) + 8 * j; *(u32x4*)(Bt + (size_t)(nd0 + n) * ldb + kd0 + 8 * c) = (u32x4){0u, 0u, 0u, 0u}; }
}

__device__ __forceinline__ void p0_prologue(const Ctx& F, const Args& a) {
    unsigned char* ws = a.ws;
    const int tid = fresh_tid(F.wave), lane = tid & 63, wave = __builtin_amdgcn_readfirstlane(tid >> 6);
    LAS float* scr = (LAS float*)(F.lds + wave * 16384);
    const int gw = F.vcu * 8 + wave, NGW = F.G * 8;
    const float* norm_g = a.in[2];
    constexpr int I_UG = 16 * 176, I_UGX = 16 * 16, I_DN = 44 * 32, I_SQ = 16 * 32, I_LD = 32 * 8, I_LU = 4 * 96, I_KN = 4 * 32, I_DQ = 16 * 16, I_UQ = 8 * 48;
    constexpr int NITEMS = 4 * I_UG + I_UGX + 4 * I_DN + 4 * I_SQ + I_LD + I_LU + 2 * I_KN + I_DQ + I_UQ + I_SQ;
    for (int it = gw; it < NITEMS; it += NGW) {
        int r = it;
        if (r < 4 * I_UG) { const int q = r / I_UG; r -= q * I_UG; const int l = q >> 1, s = q & 1; const int kb = r / 176, nb = r % 176, pn = nb >> 3, jb = nb & 7;
            const float* src = (jb < 4 ? a.in[3] : a.in[4]) + (size_t)q * D * FF;
            tr_item(src, FF, 64 * kb, 128 * pn + 32 * (jb & 3), norm_g + (l * 3 + (s ? 2 : 0)) * D, nullptr, 64 * kb, (bf16_t*)(ws + W_UG) + (size_t)q * 6144 * D, D, 32 * nb, 64 * kb, scr, lane); continue; }
        r -= 4 * I_UG;
        if (r < I_UGX) { const int kb = r / 16, nb = r % 16; bf16_t* Bt = (bf16_t*)(ws + W_UG) + (size_t)2 * 6144 * D;
            int sc = -1; if (nb < 8) sc = 32 * nb; else if (nb == 8) sc = 256; else if (nb == 12) sc = 288;
            if (sc >= 0) tr_item(a.in[25], 320, 64 * kb, sc, a.in[24], nullptr, 64 * kb, Bt, D, 5632 + 32 * nb, 64 * kb, scr, lane); else zero_item(Bt, D, 5632 + 32 * nb, 64 * kb, lane); continue; }
        r -= I_UGX;
        if (r < 4 * I_DN) { const int q = r / I_DN; r -= q * I_DN; const int kb = r / 32, nb = r % 32;
            tr_item(a.in[5] + (size_t)q * FF * D, D, 64 * kb, 32 * nb, nullptr, nullptr, 0, (bf16_t*)(ws + W_DN) + (size_t)q * D * FF, FF, 32 * nb, 64 * kb, scr, lane); continue; }
        r -= 4 * I_DN;
        if (r < 4 * I_SQ) { const int q = r / I_SQ; r -= q * I_SQ; const int kb = r / 32, nb = r % 32;
            if (q == 0) { tr_item(a.in[7], D, 64 * kb, 32 * nb, nullptr, nullptr, 0, (bf16_t*)(ws + W_RL), 2048, 32 * nb, 64 * kb, scr, lane); zero_item((bf16_t*)(ws + W_RL), 2048, 32 * nb, 1024 + 64 * kb, lane); }
            else tr_item(a.in[7 + q], D, 64 * kb, 32 * nb, nullptr, nullptr, 0, (bf16_t*)(ws + W_R + (size_t)q * 2 * MiB), D, 32 * nb, 64 * kb, scr, lane);
            continue; }
        r -= 4 * I_SQ;
        if (r < I_LD) { const int kb = r / 8, nb = r % 8; const int kk0 = 64 * (kb & 15); const bool second = kb >= 16;
            const float* src; int ldw, nc, mi; if (nb < 2) { src = a.in[12]; ldw = 64; nc = 32 * nb; mi = 1; } else if (nb < 4) { src = a.in[15]; ldw = 64; nc = 32 * (nb - 2); mi = 4; } else { src = a.in[17]; ldw = 128; nc = 32 * (nb - 4); mi = 5; }
            tr_item(src, ldw, kk0, nc, second ? a.in[6] + mi * D : nullptr, second ? a.in[6] : nullptr, kk0, (bf16_t*)(ws + W_RL), 2048, 1024 + 32 * nb, 64 * kb, scr, lane); continue; }
        r -= I_LD;
        if (r < I_LU) { const int kb = r / 96, nb = r % 96; const int grp = nb / 32, nc = 32 * (nb % 32); bf16_t* Bt = (bf16_t*)(ws + W_LU);
            if (grp == 0) { if (kb == 0) tr_item(a.in[13], D, 0, nc, nullptr, nullptr, 0, Bt, 256, 32 * nb, 0, scr, lane); else zero_item(Bt, 256, 32 * nb, 64 * kb, lane); }
            else if (grp == 1) { if (kb == 1) tr_item(a.in[16], D, 0, nc, nullptr, nullptr, 0, Bt, 256, 32 * nb, 64, scr, lane); else zero_item(Bt, 256, 32 * nb, 64 * kb, lane); }
            else { if (kb >= 2) tr_item(a.in[18], D, 64 * (kb - 2), nc, nullptr, nullptr, 0, Bt, 256, 32 * nb, 64 * kb, scr, lane); else zero_item(Bt, 256, 32 * nb, 64 * kb, lane); }
            continue; }
        r -= I_LU;
        if (r < 2 * I_KN) { const int q = r / I_KN; r -= q * I_KN; const int kb = r / 32, nb = r % 32;
            const int n0 = 32 * nb, sc = (n0 >> 7) * 256 + (n0 & 127) + q * 128;
            tr_item(a.in[27], 2048, 64 * kb, sc, a.in[26], nullptr, 64 * kb, (bf16_t*)(ws + (q ? W_VT : W_KN)), 256, n0, 64 * kb, scr, lane); continue; }
        r -= 2 * I_KN;
        if (r < I_DQ) { const int kb = r / 16, nb = r % 16;
            tr_item(a.in[28], 512, 64 * kb, 32 * nb, norm_g + (1 * 3 + 1) * D, nullptr, 64 * kb, (bf16_t*)(ws + W_DQ), D, 32 * nb, 64 * kb, scr, lane); continue; }
        r -= I_DQ;
        if (r < I_UQ) { const int kb = r / 48, nb = r % 48; int sc;
            if (nb < 32) { const int n0 = 32 * nb; sc = (n0 >> 7) * 192 + (n0 & 127); }
            else { const int t2 = (nb - 32) >> 3, jj = (nb - 32) & 7, half = jj >> 2, hh = jj & 3; sc = (4 * t2 + hh) * 192 + 128 + 32 * half; }
            tr_item(a.in[30], 1536, 64 * kb, sc, a.in[29], nullptr, 64 * kb, (bf16_t*)(ws + W_UQ), 512, 32 * nb, 64 * kb, scr, lane); continue; }
        r -= I_UQ;
        { const int kb = r / 32, nb = r % 32; tr_item(a.in[31], D, 64 * kb, 32 * nb, nullptr, nullptr, 0, (bf16_t*)(ws + W_MO), D, 32 * nb, 64 * kb, scr, lane); }
    }
    const float* x = a.in[0]; bf16_t* hb = (bf16_t*)(ws + A_HB); float* slotsH = (float*)(ws + WS_SLOTH);
    for (int m = gw; m < T; m += NGW) {
        const f32x4* xr = (const f32x4*)(x + (size_t)m * D) + lane; float ss = 0.f;
#pragma unroll
        for (int j = 0; j < 4; ++j) { const f32x4 v = xr[64 * j]; ss += (v[0] * v[0] + v[1] * v[1]) + (v[2] * v[2] + v[3] * v[3]);
            u32x2 w; w.x = cvt_pk_bf16(v[0], v[1]); w.y = cvt_pk_bf16(v[2], v[3]); *((u32x2*)(hb + (size_t)m * D) + lane + 64 * j) = w; }
        ss = wave_sum(ss);
        if (lane < 16) slotsH[(size_t)m * 16 + lane] = lane == 0 ? ss : 0.f;
    }
    float* cosT = (float*)(ws + A_COS); float* sinT = (float*)(ws + A_SIN);
    for (int i = (F.vcu * 512 + tid); i < T * 32; i += F.G * 512) {
        const int tok = i >> 5, j = i & 31;
        const float inv = exp2f(-(float)j * (13.287712379549449f / 32.0f));
        const float ang = (float)a.pos[tok] * inv;
        const double rev = (double)ang * 0.15915494309189535; const float fr = (float)(rev - floor(rev));
        cosT[i] = __builtin_amdgcn_cosf(fr); sinT[i] = __builtin_amdgcn_sinf(fr);
    }
}

__device__ __forceinline__ void p_premix(const Ctx& F, const Args& a) {
    const float* h = a.out; const float* g = a.in[2] + 1 * D; const float* mix = a.in[6];
    bf16_t* X1 = (bf16_t*)(a.ws + A_X1); bf16_t* XK = (bf16_t*)(a.ws + A_XK); bf16_t* XV = (bf16_t*)(a.ws + A_XV);
    const int tid = fresh_tid(F.wave), lane = tid & 63, wave = __builtin_amdgcn_readfirstlane(tid >> 6);
    const int gw = F.vcu * 8 + wave, NGW = F.G * 8;
    for (int ch = gw; ch < T / 16; ch += NGW) {
        const int t0 = ch * 16;
        f32x4 prev[4], gv[4];
#pragma unroll
        for (int j = 0; j < 4; ++j) gv[j] = *((const f32x4*)g + lane + 64 * j);
        if ((t0 & (SEQ - 1)) == 0) {
#pragma unroll
            for (int j = 0; j < 4; ++j) prev[j] = (f32x4){0.f, 0.f, 0.f, 0.f};
        } else {
            float ss = 0.f;
#pragma unroll
            for (int j = 0; j < 4; ++j) { prev[j] = *((const f32x4*)(h + (size_t)(t0 - 1) * D) + lane + 64 * j); ss += (prev[j][0] * prev[j][0] + prev[j][1] * prev[j][1]) + (prev[j][2] * prev[j][2] + prev[j][3] * prev[j][3]); }
            const float rs = __builtin_amdgcn_rsqf(wave_sum(ss) * (1.0f / 1024.0f) + RMS_EPS);
#pragma unroll
            for (int j = 0; j < 4; ++j) prev[j] = prev[j] * rs * gv[j];
        }
        for (int t = t0; t < t0 + 16; ++t) {
            f32x4 cur[4]; float ss = 0.f;
#pragma unroll
            for (int j = 0; j < 4; ++j) { cur[j] = *((const f32x4*)(h + (size_t)t * D) + lane + 64 * j); ss += (cur[j][0] * cur[j][0] + cur[j][1] * cur[j][1]) + (cur[j][2] * cur[j][2] + cur[j][3] * cur[j][3]); }
            const float rs = __builtin_amdgcn_rsqf(wave_sum(ss) * (1.0f / 1024.0f) + RMS_EPS);
#pragma unroll
            for (int j = 0; j < 4; ++j) {
                const f32x4 hn = cur[j] * rs * gv[j]; const f32x4 xx = prev[j] - hn; prev[j] = hn;
                const f32x4 mr = *((const f32x4*)(mix + 0 * D) + lane + 64 * j), mk = *((const f32x4*)(mix + 2 * D) + lane + 64 * j), mv = *((const f32x4*)(mix + 3 * D) + lane + 64 * j);
                const f32x4 xr = hn + xx * mr, xk = hn + xx * mk, xv = hn + xx * mv;
                u32x2 w;
                w.x = cvt_pk_bf16(xr[0], xr[1]); w.y = cvt_pk_bf16(xr[2], xr[3]); *((u32x2*)(X1 + (size_t)t * 2048) + lane + 64 * j) = w;
                w.x = cvt_pk_bf16(xx[0], xx[1]); w.y = cvt_pk_bf16(xx[2], xx[3]); *((u32x2*)(X1 + (size_t)t * 2048 + 1024) + lane + 64 * j) = w;
                w.x = cvt_pk_bf16(xk[0], xk[1]); w.y = cvt_pk_bf16(xk[2], xk[3]); *((u32x2*)(XK + (size_t)t * D) + lane + 64 * j) = w;
                w.x = cvt_pk_bf16(xv[0], xv[1]); w.y = cvt_pk_bf16(xv[2], xv[3]); *((u32x2*)(XV + (size_t)t * D) + lane + 64 * j) = w;
            }
        }
    }
}

constexpr int TC = 32;
__device__ __forceinline__ void p_scan(const Ctx& F, const Args& a) {
    const bf16_t* Rb = (const bf16_t*)(a.ws + A_R); const bf16_t* Kb = (const bf16_t*)(a.ws + A_KK); const bf16_t* Vb = (const bf16_t*)(a.ws + A_VV);
    const bf16_t* Eb = (const bf16_t*)(a.ws + A_E); const bf16_t* Ab = (const bf16_t*)(a.ws + A_AA); bf16_t* Gb = (bf16_t*)(a.ws + A_G);
    const float* k_k = a.in[19]; const float* k_a = a.in[20]; const float* r_k = a.in[21]; const float* gn_w = a.in[22]; const float* gn_b = a.in[23];
    LAS float* sR = (LAS float*)(F.lds); LAS float* sW = sR + TC * 64; LAS float* sK = sW + TC * 64; LAS float* sV = sK + TC * 64;
    LAS float* sKK = sV + TC * 64; LAS float* sKA = sKK + TC * 64; LAS float* sY = sKA + TC * 64; LAS float* sBo = sY + TC * 64;
    const int tid = fresh_tid(F.wave), lane = tid & 63, wave = __builtin_amdgcn_readfirstlane(tid >> 6);
    const int irow = wave * 8 + (lane >> 3), kseg = (lane & 7) * 8;
    const int ptt = tid >> 4, pc = (tid & 15) * 4;
    for (int unit0 = F.vcu; unit0 < 2 * NB * 16; unit0 += F.G) {
        const int unit = unit0 & 127; const bool shadow = unit0 >= 128;
        const int b = unit >> 4, hd = unit & 15; const int cbase = hd * 64;
        float S[8];
#pragma unroll
        for (int j = 0; j < 8; ++j) S[j] = 0.f;
        const f32x4 kkv = *(const f32x4*)(k_k + cbase + pc), kav = *(const f32x4*)(k_a + cbase + pc), rkv = *(const f32x4*)(r_k + cbase + pc);
        const f32x4 gw = *(const f32x4*)(gn_w + cbase + pc), gb = *(const f32x4*)(gn_b + cbase + pc);
        for (int c0 = 0; c0 < SEQ; c0 += TC) {
            const size_t gidx = (size_t)(b * SEQ + c0 + ptt) * D + cbase + pc;
            {
                const f32x4 r = unpack4(*(const u32x2*)(Rb + gidx)), k = unpack4(*(const u32x2*)(Kb + gidx)), v = unpack4(*(const u32x2*)(Vb + gidx));
                const f32x4 e = unpack4(*(const u32x2*)(Eb + gidx)), aa = unpack4(*(const u32x2*)(Ab + gidx));
                f32x4 kk = k * kkv; float ss = (kk[0] * kk[0] + kk[1] * kk[1]) + (kk[2] * kk[2] + kk[3] * kk[3]); ss = red16(ss);
                kk = kk * __builtin_amdgcn_rsqf(fmaxf(ss, 1e-24f));
                const f32x4 kp = k * (1.0f + (aa - 1.0f) * kav);
                const f32x4 rk = r * kp * rkv; const float bo = red16((rk[0] + rk[1]) + (rk[2] + rk[3]));
                f32x4 w;
#pragma unroll
                for (int i = 0; i < 4; ++i) w[i] = __builtin_amdgcn_exp2f(-e[i] * LOG2E);
                const int o = ptt * 64 + pc;
                *(LAS f32x4*)(sR + o) = r; *(LAS f32x4*)(sW + o) = w; *(LAS f32x4*)(sK + o) = kp; *(LAS f32x4*)(sV + o) = v; *(LAS f32x4*)(sKK + o) = kk; *(LAS f32x4*)(sKA + o) = kk * aa;
                if ((tid & 15) == 0) sBo[ptt] = bo;
            }
            __syncthreads();
#pragma unroll 2
            for (int t = 0; t < TC; ++t) {
                const int o = t * 64 + kseg;
                const f32x4 kk0 = *(const LAS f32x4*)(sKK + o), kk1 = *(const LAS f32x4*)(sKK + o + 4);
                const f32x4 w0 = *(const LAS f32x4*)(sW + o), w1 = *(const LAS f32x4*)(sW + o + 4);
                const f32x4 ka0 = *(const LAS f32x4*)(sKA + o), ka1 = *(const LAS f32x4*)(sKA + o + 4);
                const f32x4 kp0 = *(const LAS f32x4*)(sK + o), kp1 = *(const LAS f32x4*)(sK + o + 4);
                const f32x4 r0 = *(const LAS f32x4*)(sR + o), r1 = *(const LAS f32x4*)(sR + o + 4);
                const float vv = sV[t * 64 + irow];
                float sa = ((S[0] * kk0[0] + S[1] * kk0[1]) + (S[2] * kk0[2] + S[3] * kk0[3])) + ((S[4] * kk1[0] + S[5] * kk1[1]) + (S[6] * kk1[2] + S[7] * kk1[3]));
                sa = red8(sa);
#pragma unroll
                for (int j = 0; j < 4; ++j) { S[j] = S[j] * w0[j] + (vv * kp0[j] - sa * ka0[j]); S[4 + j] = S[4 + j] * w1[j] + (vv * kp1[j] - sa * ka1[j]); }
                float y = ((S[0] * r0[0] + S[1] * r0[1]) + (S[2] * r0[2] + S[3] * r0[3])) + ((S[4] * r1[0] + S[5] * r1[1]) + (S[6] * r1[2] + S[7] * r1[3]));
                y = red8(y);
                if ((lane & 7) == 0) sY[t * 64 + irow] = y;
            }
            __syncthreads();
            {
                const int o = ptt * 64 + pc;
                const f32x4 y = *(const LAS f32x4*)(sY + o), v = *(const LAS f32x4*)(sV + o);
                const float mu = red16((y[0] + y[1]) + (y[2] + y[3])) * (1.0f / 64.0f);
                const f32x4 d = y - mu; const float var = red16((d[0] * d[0] + d[1] * d[1]) + (d[2] * d[2] + d[3] * d[3])) * (1.0f / 64.0f);
                const float rs = __builtin_amdgcn_rsqf(var + GN_EPS); const float bo = sBo[ptt];
                const f32x4 gg = unpack4(*(const u32x2*)(Gb + gidx));
                const f32x4 ov = (d * rs * gw + gb + v * bo) * gg;
                u32x2 w; w.x = cvt_pk_bf16(ov[0], ov[1]); w.y = cvt_pk_bf16(ov[2], ov[3]); if (!shadow) *(u32x2*)(Gb + gidx) = w;
            }
            __syncthreads();
        }
    }
}


__device__ __forceinline__ void p_scan2(const Ctx& F, const Args& a) {
    const bf16_t* Rb = (const bf16_t*)(a.ws + A_R); const bf16_t* Kb = (const bf16_t*)(a.ws + A_KK); const bf16_t* Vb = (const bf16_t*)(a.ws + A_VV);
    const bf16_t* Eb = (const bf16_t*)(a.ws + A_E); const bf16_t* Ab = (const bf16_t*)(a.ws + A_AA); bf16_t* Yb = (bf16_t*)(a.ws + A_G); float* Bon = (float*)(a.ws + A_BON);
    const float* k_k = a.in[19]; const float* k_a = a.in[20]; const float* r_k = a.in[21];
    LAS float* sR = (LAS float*)(F.lds); LAS float* sW = sR + TC * 64; LAS float* sK = sW + TC * 64; LAS float* sV = sK + TC * 64;
    LAS float* sKK = sV + TC * 64; LAS float* sKA = sKK + TC * 64; LAS float* sY = sKA + TC * 64;
    const int tid = fresh_tid(F.wave), lane = tid & 63, wave = __builtin_amdgcn_readfirstlane(tid >> 6);
    const int lrow = wave * 8 + (lane >> 3), kseg = (lane & 7) * 8;
    const int ptt = tid >> 4, pc = (tid & 15) * 4;
    for (int unit = F.vcu; unit < 2 * NB * 16; unit += F.G) {
        const int bh = unit >> 1, half = unit & 1, b = bh >> 4, hd = bh & 15, cbase = hd * 64;
        f32x4 S0 = (f32x4){0.f, 0.f, 0.f, 0.f}, S1 = (f32x4){0.f, 0.f, 0.f, 0.f};
        const f32x4 kkv = *(const f32x4*)(k_k + cbase + pc), kav = *(const f32x4*)(k_a + cbase + pc), rkv = *(const f32x4*)(r_k + cbase + pc);
        size_t gidx = (size_t)(b * SEQ + ptt) * D + cbase + pc;
        u32x2 qr = *(const u32x2*)(Rb + gidx), qk = *(const u32x2*)(Kb + gidx), qv = *(const u32x2*)(Vb + gidx), qe = *(const u32x2*)(Eb + gidx), qa = *(const u32x2*)(Ab + gidx);
        for (int c0 = 0; c0 < SEQ; c0 += TC) {
            {
                const f32x4 r = unpack4(qr), k = unpack4(qk), v = unpack4(qv), e = unpack4(qe), aa = unpack4(qa);
                f32x4 kk = k * kkv; float ss = (kk[0] * kk[0] + kk[1] * kk[1]) + (kk[2] * kk[2] + kk[3] * kk[3]); ss = red16(ss);
                kk = kk * __builtin_amdgcn_rsqf(fmaxf(ss, 1e-24f));
                const f32x4 kp = k * (1.0f + (aa - 1.0f) * kav);
                const f32x4 rk = r * kp * rkv; const float bo = red16((rk[0] + rk[1]) + (rk[2] + rk[3]));
                f32x4 w;
#pragma unroll
                for (int i = 0; i < 4; ++i) w[i] = __builtin_amdgcn_exp2f(-e[i] * LOG2E);
                const int o = ptt * 64 + pc;
                *(LAS f32x4*)(sR + o) = r; *(LAS f32x4*)(sW + o) = w; *(LAS f32x4*)(sK + o) = kp; *(LAS f32x4*)(sV + o) = v; *(LAS f32x4*)(sKK + o) = kk; *(LAS f32x4*)(sKA + o) = kk * aa;
                if (half == 0 && (tid & 15) == 0) Bon[(size_t)(b * SEQ + c0 + ptt) * 16 + hd] = bo;
            }
            __syncthreads();
            if (c0 + TC < SEQ) { gidx += (size_t)TC * D;
                qr = *(const u32x2*)(Rb + gidx); qk = *(const u32x2*)(Kb + gidx); qv = *(const u32x2*)(Vb + gidx); qe = *(const u32x2*)(Eb + gidx); qa = *(const u32x2*)(Ab + gidx); }
            if (wave < 4) {
#define SCAN_LD(P, tt) { const int o_ = (tt) * 64 + kseg; \
                kk0##P = *(const LAS f32x4*)(sKK + o_); kk1##P = *(const LAS f32x4*)(sKK + o_ + 4); w0##P = *(const LAS f32x4*)(sW + o_); w1##P = *(const LAS f32x4*)(sW + o_ + 4); \
                ka0##P = *(const LAS f32x4*)(sKA + o_); ka1##P = *(const LAS f32x4*)(sKA + o_ + 4); kp0##P = *(const LAS f32x4*)(sK + o_); kp1##P = *(const LAS f32x4*)(sK + o_ + 4); \
                r0##P = *(const LAS f32x4*)(sR + o_); r1##P = *(const LAS f32x4*)(sR + o_ + 4); vv##P = sV[(tt) * 64 + half * 32 + lrow]; }
#define SCAN_STEP(P, tt) { f32x4 p4 = S0 * kk0##P; p4 = S1 * kk1##P + p4; const float sa = red8((p4[0] + p4[1]) + (p4[2] + p4[3])); \
                S0 = S0 * w0##P + (kp0##P * vv##P - ka0##P * sa); S1 = S1 * w1##P + (kp1##P * vv##P - ka1##P * sa); \
                f32x4 y4 = S0 * r0##P; y4 = S1 * r1##P + y4; sY[(tt) * 256 + tid] = (y4[0] + y4[1]) + (y4[2] + y4[3]); }
                f32x4 kk0A, kk1A, w0A, w1A, ka0A, ka1A, kp0A, kp1A, r0A, r1A; float vvA;
                f32x4 kk0B, kk1B, w0B, w1B, ka0B, ka1B, kp0B, kp1B, r0B, r1B; float vvB;
                SCAN_LD(A, 0)
#pragma unroll 2
                for (int t = 0; t < TC; t += 2) {
                    SCAN_LD(B, t + 1)
                    SCAN_STEP(A, t)
                    SCAN_LD(A, (t + 2 < TC) ? t + 2 : t)
                    SCAN_STEP(B, t + 1)
                }
#undef SCAN_LD
#undef SCAN_STEP
            }
            __syncthreads();
            {
                const int tok = tid >> 4, r2 = (tid & 15) * 2;
                const LAS f32x4* q = (const LAS f32x4*)(sY + tok * 256 + r2 * 8);
                const f32x4 s0 = q[0] + q[1], s1 = q[2] + q[3];
                *(unsigned*)(Yb + (size_t)(b * SEQ + c0 + tok) * D + cbase + half * 32 + r2) = cvt_pk_bf16((s0[0] + s0[1]) + (s0[2] + s0[3]), (s1[0] + s1[1]) + (s1[2] + s1[3]));
            }
        }
        __syncthreads();
    }
}
__device__ __forceinline__ void p_post(const Ctx& F, const Args& a) {
    bf16_t* Yb = (bf16_t*)(a.ws + A_G); const bf16_t* Vb = (const bf16_t*)(a.ws + A_VV); const bf16_t* Gg = (const bf16_t*)(a.ws + A_E); const float* Bon = (const float*)(a.ws + A_BON);
    const float* gn_w = a.in[22]; const float* gn_b = a.in[23];
    const int tid = fresh_tid(F.wave), grp = tid >> 4, gl = tid & 15;
    for (int item = F.vcu * 32 + grp; item < T * 16; item += F.G * 32) {
        const int tok = item >> 4, hd = item & 15; const size_t idx = (size_t)tok * D + hd * 64 + 4 * gl;
        const f32x4 y = unpack4(*(const u32x2*)(Yb + idx)), v = unpack4(*(const u32x2*)(Vb + idx)), g = unpack4(*(const u32x2*)(Gg + idx));
        const float bo = Bon[(size_t)tok * 16 + hd];
        const f32x4 gw = *(const f32x4*)(gn_w + hd * 64 + 4 * gl), gb = *(const f32x4*)(gn_b + hd * 64 + 4 * gl);
        const float mu = red16((y[0] + y[1]) + (y[2] + y[3])) * (1.0f / 64.0f);
        const f32x4 d = y - mu; const float var = red16((d[0] * d[0] + d[1] * d[1]) + (d[2] * d[2] + d[3] * d[3])) * (1.0f / 64.0f);
        const float rs = __builtin_amdgcn_rsqf(var + GN_EPS);
        const f32x4 ov = (d * rs * gw + gb + v * bo) * g;
        u32x2 w; w.x = cvt_pk_bf16(ov[0], ov[1]); w.y = cvt_pk_bf16(ov[2], ov[3]); *(u32x2*)(Yb + idx) = w;
    }
}

constexpr int KROW = 400, VROW = 144, KBUF = 64 * KROW, VBUF = 128 * VROW, ABUF = KBUF + VBUF;
__device__ __forceinline__ void attn_unit(LAS unsigned char* lds, const bf16_t* qn, const bf16_t* qr, const bf16_t* kn, const bf16_t* kr, const bf16_t* vt, bf16_t* o_out, int b, int h, int qb, int wave_s) {
    const int tid = fresh_tid(wave_s), lane = tid & 63, wid = __builtin_amdgcn_readfirstlane(tid >> 6), r32 = lane & 31, hi = lane >> 5;
    const int tok0 = b * SEQ, q0 = qb * 256 + wid * 32;
    bf16x8 qf[12];
    { const size_t tq = (size_t)(tok0 + q0 + r32);
#pragma unroll
      for (int d = 0; d < 8; ++d) qf[d] = *(const bf16x8*)(qn + tq * D + h * 128 + d * 16 + hi * 8);
#pragma unroll
      for (int d = 0; d < 4; ++d) qf[8 + d] = *(const bf16x8*)(qr + tq * 512 + h * 64 + d * 16 + hi * 8); }
    const int NT = (qb + 1) * 4;
    const int kkey0 = tid >> 4, kch0 = tid & 15;
    const int rkey = tid >> 3, rch = tid & 7;
    const int vrow0 = tid >> 3, vch = tid & 7;
    const bf16_t* gk0 = kn + (size_t)(tok0 + kkey0) * D + h * 128 + kch0 * 8;
    const bf16_t* gk1 = gk0 + (size_t)32 * D;
    const bf16_t* gr = kr + (size_t)(tok0 + rkey) * 64 + rch * 8;
    const bf16_t* gv0 = vt + (size_t)(h * 128 + vrow0) * T + tok0 + vch * 8;
    const bf16_t* gv1 = gv0 + (size_t)64 * T;
    const int lk0 = kkey0 * KROW + kch0 * 16, lk1 = lk0 + 32 * KROW, lr = rkey * KROW + 256 + rch * 16, lv0 = KBUF + vrow0 * VROW + vch * 16, lv1 = lv0 + 64 * VROW;
    const int pr = (r32 & 0x13) | ((r32 & 4) << 1) | ((r32 & 8) >> 1);
    const int kfo = pr * KROW + hi * 16, vfo = KBUF + r32 * VROW + hi * 16;
    u32x4 ld0, ld1, ld2, ld3, ld4;
    ld0 = *(const u32x4*)gk0; ld1 = *(const u32x4*)gk1; ld2 = *(const u32x4*)gr; ld3 = *(const u32x4*)gv0; ld4 = *(const u32x4*)gv1;
    __syncthreads();
    *(LAS u32x4*)(lds + lk0) = ld0; *(LAS u32x4*)(lds + lk1) = ld1; *(LAS u32x4*)(lds + lr) = ld2; *(LAS u32x4*)(lds + lv0) = ld3; *(LAS u32x4*)(lds + lv1) = ld4;
    __syncthreads();
    float mrun = -1e30f, lrun = 0.f;
    f32x16 o[4];
#pragma unroll
    for (int d = 0; d < 4; ++d) o[d] = f32x16{};
    for (int t = 0; t < NT; ++t) {
        const int cb = (t & 1) * ABUF, nb = ((t + 1) & 1) * ABUF;
        const bool more = (t + 1 < NT);
        if (more) { const size_t ko = (size_t)(t + 1) * 64 * D, ro = (size_t)(t + 1) * 64 * 64, vo = (size_t)(t + 1) * 64;
            ld0 = *(const u32x4*)(gk0 + ko); ld1 = *(const u32x4*)(gk1 + ko); ld2 = *(const u32x4*)(gr + ro); ld3 = *(const u32x4*)(gv0 + vo); ld4 = *(const u32x4*)(gv1 + vo); }
        if (64 * t <= q0 + 31) {
            f32x16 s0 = f32x16{}, s1 = f32x16{};
            __builtin_amdgcn_s_setprio(1);
#pragma unroll
            for (int d = 0; d < 12; ++d) {
                const bf16x8 k0 = *(const LAS bf16x8*)(lds + cb + kfo + d * 32), k1 = *(const LAS bf16x8*)(lds + cb + kfo + 32 * KROW + d * 32);
                s0 = __builtin_amdgcn_mfma_f32_32x32x16_bf16(k0, qf[d], s0, 0, 0, 0);
                s1 = __builtin_amdgcn_mfma_f32_32x32x16_bf16(k1, qf[d], s1, 0, 0, 0);
            }
            __builtin_amdgcn_s_setprio(0);
            if (64 * t + 63 > q0) {
                const int qi = q0 + r32, kb0 = 64 * t + 8 * hi;
#pragma unroll
                for (int r = 0; r < 16; ++r) { const int key = kb0 + 16 * (r >> 3) + (r & 7); if (key > qi) s0[r] = -1e30f; if (key + 32 > qi) s1[r] = -1e30f; }
            }
            float mx = fmaxf(fmaxf(s0[0], s1[0]), s0[1]);
#pragma unroll
            for (int r = 1; r < 16; ++r) mx = fmaxf(fmaxf(mx, s1[r]), (r < 15) ? s0[r + 1] : s1[r]);
            { auto rr = __builtin_amdgcn_permlane32_swap(__float_as_uint(mx), __float_as_uint(mx), false, false); mx = fmaxf(__uint_as_float(rr[0]), __uint_as_float(rr[1])); }
            if (__any(mx - mrun > 8.0f)) {
                const float mnew = fmaxf(mrun, mx); const float alpha = __builtin_amdgcn_exp2f(mrun - mnew); mrun = mnew; lrun *= alpha;
#pragma unroll
                for (int d = 0; d < 4; ++d) o[d] = o[d] * alpha;
            }
            float ps = 0.f;
#pragma unroll
            for (int r = 0; r < 16; ++r) { s0[r] = __builtin_amdgcn_exp2f(s0[r] - mrun); s1[r] = __builtin_amdgcn_exp2f(s1[r] - mrun); ps += s0[r] + s1[r]; }
            lrun += ps;
            bf16x8 pf[4];
            { u32x4 w;
              w.x = cvt_pk_bf16(s0[0], s0[1]); w.y = cvt_pk_bf16(s0[2], s0[3]); w.z = cvt_pk_bf16(s0[4], s0[5]); w.w = cvt_pk_bf16(s0[6], s0[7]); pf[0] = __builtin_bit_cast(bf16x8, w);
              w.x = cvt_pk_bf16(s0[8], s0[9]); w.y = cvt_pk_bf16(s0[10], s0[11]); w.z = cvt_pk_bf16(s0[12], s0[13]); w.w = cvt_pk_bf16(s0[14], s0[15]); pf[1] = __builtin_bit_cast(bf16x8, w);
              w.x = cvt_pk_bf16(s1[0], s1[1]); w.y = cvt_pk_bf16(s1[2], s1[3]); w.z = cvt_pk_bf16(s1[4], s1[5]); w.w = cvt_pk_bf16(s1[6], s1[7]); pf[2] = __builtin_bit_cast(bf16x8, w);
              w.x = cvt_pk_bf16(s1[8], s1[9]); w.y = cvt_pk_bf16(s1[10], s1[11]); w.z = cvt_pk_bf16(s1[12], s1[13]); w.w = cvt_pk_bf16(s1[14], s1[15]); pf[3] = __builtin_bit_cast(bf16x8, w); }
            __builtin_amdgcn_s_setprio(1);
#pragma unroll
            for (int d = 0; d < 4; ++d)
#pragma unroll
                for (int ks = 0; ks < 4; ++ks) {
                    const bf16x8 vf = *(const LAS bf16x8*)(lds + cb + vfo + d * 32 * VROW + ks * 32);
                    o[d] = __builtin_amdgcn_mfma_f32_32x32x16_bf16(vf, pf[ks], o[d], 0, 0, 0);
                }
            __builtin_amdgcn_s_setprio(0);
        }
        if (more) { *(LAS u32x4*)(lds + nb + lk0) = ld0; *(LAS u32x4*)(lds + nb + lk1) = ld1; *(LAS u32x4*)(lds + nb + lr) = ld2; *(LAS u32x4*)(lds + nb + lv0) = ld3; *(LAS u32x4*)(lds + nb + lv1) = ld4; }
        __syncthreads();
    }
    { auto rr = __builtin_amdgcn_permlane32_swap(__float_as_uint(lrun), __float_as_uint(lrun), false, false); lrun = __uint_as_float(rr[0]) + __uint_as_float(rr[1]); }
    const float rl = __builtin_amdgcn_rcpf(lrun);
    bf16_t* op = o_out + (size_t)(tok0 + q0 + r32) * D + h * 128 + 4 * hi;
#pragma unroll
    for (int d = 0; d < 4; ++d)
#pragma unroll
        for (int r4 = 0; r4 < 4; ++r4) { u32x2 w; w.x = cvt_pk_bf16(o[d][4 * r4] * rl, o[d][4 * r4 + 1] * rl); w.y = cvt_pk_bf16(o[d][4 * r4 + 2] * rl, o[d][4 * r4 + 3] * rl);
            *(u32x2*)(op + 32 * d + 8 * r4) = w; }
}
__device__ __forceinline__ void p_attn(const Ctx& F, const Args& a) {
    const bf16_t* qn = (const bf16_t*)(a.ws + A_QN); const bf16_t* qr = (const bf16_t*)(a.ws + A_QR);
    const bf16_t* kn = (const bf16_t*)(a.ws + A_KN); const bf16_t* kr = (const bf16_t*)(a.ws + A_KR); const bf16_t* vt = (const bf16_t*)(a.ws + A_VT);
    bf16_t* oo = (bf16_t*)(a.ws + A_QN);
    for (int p = F.vcu; p < 512; p += F.G) {
        const int bh = p >> 3, s = p & 7;
        attn_unit(F.lds, qn, qr, kn, kr, vt, oo, bh >> 3, bh & 7, 15 - s, F.wave);
        attn_unit(F.lds, qn, qr, kn, kr, vt, oo, bh >> 3, bh & 7, s, F.wave);
    }
}

__device__ __forceinline__ void p_final(const Ctx& F, const Args& a) {
    float* h = a.out; const float* g = a.in[32];
    const int tid = fresh_tid(F.wave), lane = tid & 63, wave = __builtin_amdgcn_readfirstlane(tid >> 6);
    const int gw = F.vcu * 8 + wave, NGW = F.G * 8;
    f32x4 gv[4];
#pragma unroll
    for (int j = 0; j < 4; ++j) gv[j] = *((const f32x4*)g + lane + 64 * j);
    for (int m = gw; m < T; m += NGW) {
        f32x4 v[4]; float ss = 0.f;
#pragma unroll
        for (int j = 0; j < 4; ++j) { v[j] = *((const f32x4*)(h + (size_t)m * D) + lane + 64 * j); ss += (v[j][0] * v[j][0] + v[j][1] * v[j][1]) + (v[j][2] * v[j][2] + v[j][3] * v[j][3]); }
        const float rs = __builtin_amdgcn_rsqf(wave_sum(ss) * (1.0f / 1024.0f) + RMS_EPS);
#pragma unroll
        for (int j = 0; j < 4; ++j) *((f32x4*)(h + (size_t)m * D) + lane + 64 * j) = v[j] * rs * gv[j];
    }
}

__device__ __forceinline__ void my_grid_sync(unsigned* cnt, unsigned G, int wave_s) {
    asm volatile("s_waitcnt vmcnt(0) lgkmcnt(0)" ::: "memory");
    __syncthreads();
    if (fresh_tid(wave_s) == 0) {
        __builtin_amdgcn_fence(__ATOMIC_RELEASE, "agent");
        asm volatile("s_waitcnt vmcnt(0)" ::: "memory");
        __hip_atomic_fetch_add(cnt, 1u, __ATOMIC_RELAXED, __HIP_MEMORY_SCOPE_AGENT);
        while (__hip_atomic_load(cnt, __ATOMIC_RELAXED, __HIP_MEMORY_SCOPE_AGENT) < G) __builtin_amdgcn_s_sleep(4);
        __builtin_amdgcn_fence(__ATOMIC_ACQUIRE, "agent");
        asm volatile("s_waitcnt vmcnt(0)" ::: "memory");
    }
    __syncthreads();
}
#define GSYNC() do { my_grid_sync(bar_words + 64 * bar_idx, (unsigned)F.G, F.wave); ++bar_idx; } while (0)
#define RUN_GEMM(EPI_T, epi, Aptr, lda_, Bptr, ldb_, M_, N_, K_) do { pg8::Gemm g_{(const bf16_t*)(Aptr), (lda_), (const bf16_t*)(Bptr), (ldb_), (M_), (N_), (K_)}; \
    pg8::StaticOrder S_; S_.init((M_), (N_), F.G, (int)blockIdx.x); pg8::gemm_phase<EPI_T>(F.lds, g_, S_, (epi), F.wave); } while (0)

__global__ void __launch_bounds__(512, 2) fwd_mega(Args a) {
    extern __shared__ __attribute__((aligned(16))) unsigned char lds_raw[];
    cg::grid_group grid = cg::this_grid();
    Ctx F; F.lds = (LAS unsigned char*)lds_raw; F.wave = __builtin_amdgcn_readfirstlane((int)threadIdx.x >> 6);
    F.G = gridDim.x; { const int bx = blockIdx.x; F.vcu = (F.G % 8 == 0) ? (bx % 8) * (F.G / 8) + bx / 8 : bx; }
    unsigned char* ws = a.ws;
    float* slotsH = (float*)(ws + WS_SLOTH); float* slotsC = (float*)(ws + WS_SLOTC); float* slotsQ = (float*)(ws + WS_SLOTQ);
    bf16_t* HB = (bf16_t*)(ws + A_HB); bf16_t* MID = (bf16_t*)(ws + A_MID);
    const float* cosT = (const float*)(ws + A_COS); const float* sinT = (const float*)(ws + A_SIN);
    bf16_t* WUG = (bf16_t*)(ws + W_UG); bf16_t* WDN = (bf16_t*)(ws + W_DN);

    unsigned* bar_words = (unsigned*)ws;
    if (a.ph_hi - a.ph_lo > 1) grid.sync();
    if (a.ph_lo <= 0 && 0 < a.ph_hi) {
    p0_prologue(F, a);
    }
    if (a.ph_lo <= 0 && 1 < a.ph_hi) my_grid_sync(bar_words + 64 * 0, (unsigned)F.G, F.wave);
    if (a.ph_lo <= 1 && 1 < a.ph_hi) {
    { EpiSwiglu E{MID, slotsH, nullptr, nullptr, nullptr, nullptr, nullptr}; RUN_GEMM(EpiSwiglu, E, HB, D, WUG, D, T, 5632, D); }
    }
    if (a.ph_lo <= 1 && 2 < a.ph_hi) my_grid_sync(bar_words + 64 * 1, (unsigned)F.G, F.wave);
    if (a.ph_lo <= 2 && 2 < a.ph_hi) {
    { EpiResid E{a.in[0], a.out, nullptr, nullptr, 0.5f}; RUN_GEMM(EpiResid, E, MID, FF, WDN, FF, T, D, FF); }
    }
    if (a.ph_lo <= 2 && 3 < a.ph_hi) my_grid_sync(bar_words + 64 * 2, (unsigned)F.G, F.wave);
    if (a.ph_lo <= 3 && 3 < a.ph_hi) {
    p_premix(F, a);
    }
    if (a.ph_lo <= 3 && 4 < a.ph_hi) my_grid_sync(bar_words + 64 * 3, (unsigned)F.G, F.wave);
    if (a.ph_lo <= 4 && 4 < a.ph_hi) {
    { EpiRL E{(bf16_t*)(ws + A_R), (bf16_t*)(ws + A_LM)}; RUN_GEMM(EpiRL, E, ws + A_X1, 2048, ws + W_RL, 2048, T, 1280, 2048); }
    }
    if (a.ph_lo <= 4 && 5 < a.ph_hi) my_grid_sync(bar_words + 64 * 4, (unsigned)F.G, F.wave);
    if (a.ph_lo <= 5 && 5 < a.ph_hi) {
    { EpiBf16 E{(bf16_t*)(ws + A_KK), D}; RUN_GEMM(EpiBf16, E, ws + A_XK, D, ws + W_K, D, T, D, D); }
    { EpiBf16 E{(bf16_t*)(ws + A_VV), D}; RUN_GEMM(EpiBf16, E, ws + A_XV, D, ws + W_V, D, T, D, D); }
    }
    if (a.ph_lo <= 5 && 6 < a.ph_hi) my_grid_sync(bar_words + 64 * 5, (unsigned)F.G, F.wave);
    if (a.ph_lo <= 6 && 6 < a.ph_hi) {
    { EpiLoraUp E{ws, a.in[11], a.in[14], 0, A_G}; RUN_GEMM(EpiLoraUp, E, ws + A_LM, 256, ws + W_LU, 256, T, 2048, 256); }
    }
    if (a.ph_lo <= 6 && 7 < a.ph_hi) my_grid_sync(bar_words + 64 * 6, (unsigned)F.G, F.wave);
    if (a.ph_lo <= 7 && 7 < a.ph_hi) {
    p_scan2(F, a);
    }
    if (a.ph_lo <= 7 && 8 < a.ph_hi) my_grid_sync(bar_words + 64 * 7, (unsigned)F.G, F.wave);
    if (a.ph_lo <= 8 && 8 < a.ph_hi) {
    { EpiLoraUp E{ws, a.in[11], a.in[14], 2, A_E}; RUN_GEMM(EpiLoraUp, E, ws + A_LM, 256, ws + W_LU + (size_t)2048 * 256 * 2, 256, T, 1024, 256); }
    }
    if (a.ph_lo <= 8 && 9 < a.ph_hi) my_grid_sync(bar_words + 64 * 8, (unsigned)F.G, F.wave);
    if (a.ph_lo <= 9 && 9 < a.ph_hi) {
    p_post(F, a);
    }
    if (a.ph_lo <= 9 && 10 < a.ph_hi) my_grid_sync(bar_words + 64 * 9, (unsigned)F.G, F.wave);
    if (a.ph_lo <= 10 && 10 < a.ph_hi) {
    { EpiResid E{a.out, a.out, HB, slotsH, 1.0f}; RUN_GEMM(EpiResid, E, ws + A_G, D, ws + W_O, D, T, D, D); }
    }
    if (a.ph_lo <= 10 && 11 < a.ph_hi) my_grid_sync(bar_words + 64 * 10, (unsigned)F.G, F.wave);
    if (a.ph_lo <= 11 && 11 < a.ph_hi) {
    { EpiSwiglu E{MID, slotsH, nullptr, nullptr, nullptr, nullptr, nullptr}; RUN_GEMM(EpiSwiglu, E, HB, D, WUG + (size_t)1 * 6144 * D, D, T, 5632, D); }
    }
    if (a.ph_lo <= 11 && 12 < a.ph_hi) my_grid_sync(bar_words + 64 * 11, (unsigned)F.G, F.wave);
    if (a.ph_lo <= 12 && 12 < a.ph_hi) {
    { EpiResid E{a.out, a.out, HB, slotsH, 0.5f}; RUN_GEMM(EpiResid, E, MID, FF, WDN + (size_t)1 * D * FF, FF, T, D, FF); }
    }
    if (a.ph_lo <= 12 && 13 < a.ph_hi) my_grid_sync(bar_words + 64 * 12, (unsigned)F.G, F.wave);
    if (a.ph_lo <= 13 && 13 < a.ph_hi) {
    { EpiSwiglu E{MID, slotsH, (bf16_t*)(ws + A_C), slotsC, (bf16_t*)(ws + A_KR), cosT, sinT}; RUN_GEMM(EpiSwiglu, E, HB, D, WUG + (size_t)2 * 6144 * D, D, T, 6144, D); }
    }
    if (a.ph_lo <= 13 && 14 < a.ph_hi) my_grid_sync(bar_words + 64 * 13, (unsigned)F.G, F.wave);
    if (a.ph_lo <= 14 && 14 < a.ph_hi) {
    { EpiResid E{a.out, a.out, HB, slotsH, 0.5f}; RUN_GEMM(EpiResid, E, MID, FF, WDN + (size_t)2 * D * FF, FF, T, D, FF); }
    { EpiKnope E{(bf16_t*)(ws + A_KN), slotsC}; RUN_GEMM(EpiKnope, E, ws + A_C, 256, ws + W_KN, 256, T, D, 256); }
    { EpiVt E{(bf16_t*)(ws + A_VT), slotsC}; RUN_GEMM(EpiVt, E, ws + W_VT, 256, ws + A_C, 256, D, T, 256); }
    }
    if (a.ph_lo <= 14 && 15 < a.ph_hi) my_grid_sync(bar_words + 64 * 14, (unsigned)F.G, F.wave);
    if (a.ph_lo <= 15 && 15 < a.ph_hi) {
    { EpiQlat E{(bf16_t*)(ws + A_QLAT), slotsH, slotsQ}; RUN_GEMM(EpiQlat, E, HB, D, ws + W_DQ, D, T, 512, D); }
    }
    if (a.ph_lo <= 15 && 16 < a.ph_hi) my_grid_sync(bar_words + 64 * 15, (unsigned)F.G, F.wave);
    if (a.ph_lo <= 16 && 16 < a.ph_hi) {
    { EpiQ E{(bf16_t*)(ws + A_QN), (bf16_t*)(ws + A_QR), slotsQ, cosT, sinT}; RUN_GEMM(EpiQ, E, ws + A_QLAT, 512, ws + W_UQ, 512, T, 1536, 512); }
    }
    if (a.ph_lo <= 16 && 17 < a.ph_hi) my_grid_sync(bar_words + 64 * 16, (unsigned)F.G, F.wave);
    if (a.ph_lo <= 17 && 17 < a.ph_hi) {
    p_attn(F, a);
    }
    if (a.ph_lo <= 17 && 18 < a.ph_hi) my_grid_sync(bar_words + 64 * 17, (unsigned)F.G, F.wave);
    if (a.ph_lo <= 18 && 18 < a.ph_hi) {
    { EpiResid E{a.out, a.out, HB, slotsH, 1.0f}; RUN_GEMM(EpiResid, E, ws + A_QN, D, ws + W_MO, D, T, D, D); }
    }
    if (a.ph_lo <= 18 && 19 < a.ph_hi) my_grid_sync(bar_words + 64 * 18, (unsigned)F.G, F.wave);
    if (a.ph_lo <= 19 && 19 < a.ph_hi) {
    { EpiSwiglu E{MID, slotsH, nullptr, nullptr, nullptr, nullptr, nullptr}; RUN_GEMM(EpiSwiglu, E, HB, D, WUG + (size_t)3 * 6144 * D, D, T, 5632, D); }
    }
    if (a.ph_lo <= 19 && 20 < a.ph_hi) my_grid_sync(bar_words + 64 * 19, (unsigned)F.G, F.wave);
    if (a.ph_lo <= 20 && 20 < a.ph_hi) {
    { EpiResid E{a.out, a.out, nullptr, nullptr, 0.5f}; RUN_GEMM(EpiResid, E, MID, FF, WDN + (size_t)3 * D * FF, FF, T, D, FF); }
    }
    if (a.ph_lo <= 20 && 21 < a.ph_hi) my_grid_sync(bar_words + 64 * 20, (unsigned)F.G, F.wave);
    if (a.ph_lo <= 21 && 21 < a.ph_hi) {
    p_final(F, a);
    }
}

extern "C" void kernel_launch(void* const* d_in, const int* in_sizes, int n_in, void* d_out, int out_size, void* d_ws, size_t ws_size, hipStream_t stream) {
    static int grid = 0;
    if (grid == 0) {
        if (n_in != 33 || out_size != T * D || ws_size < WS_NEED) { fprintf(stderr, "kernel_launch: unexpected shapes: n_in %d out %d ws %zu (need %zu)\n", n_in, out_size, ws_size, (size_t)WS_NEED); grid = -1; return; }
        int dev = 0, cus = 0, per_cu = 0;
        (void)hipGetDevice(&dev); (void)hipDeviceGetAttribute(&cus, hipDeviceAttributeMultiprocessorCount, dev);
        (void)hipFuncSetAttribute((const void*)fwd_mega, hipFuncAttributeMaxDynamicSharedMemorySize, LDS_BYTES);
        (void)hipOccupancyMaxActiveBlocksPerMultiprocessor(&per_cu, (const void*)fwd_mega, 512, LDS_BYTES);
        (void)hipGetLastError();
        grid = cus > 0 ? cus : 256;
        if (grid > 256) grid = 256;
    }
    if (grid < 0) return;
    (void)hipMemsetAsync(d_ws, 0, 65536, stream);
    Args a{};
    for (int i = 0; i < 33; ++i) a.in[i] = (const float*)d_in[i];
    a.pos = (const int*)d_in[1]; a.out = (float*)d_out; a.ws = (unsigned char*)d_ws;
    hipError_t e = hipSuccess;
#if N_LAUNCHES == 1
    a.ph_lo = 0; a.ph_hi = NPHASES;
    { void* args[] = {&a}; e = hipLaunchCooperativeKernel((void*)fwd_mega, dim3(grid), dim3(512), args, LDS_BYTES, stream); }
#else
    for (int p = 0; p < NPHASES; ++p) { a.ph_lo = p; a.ph_hi = p + 1; hipLaunchKernelGGL(fwd_mega, dim3(grid), dim3(512), LDS_BYTES, stream, a); }
    e = hipPeekAtLastError();
#endif
    if (e != hipSuccess) fprintf(stderr, "cooperative launch failed: %s (grid %d)\n", hipGetErrorString(e), grid);
}
```

```cpp
#include <hip/hip_runtime.h>
#include <hip/hip_cooperative_groups.h>
#include <cstdio>
#include <cstdint>
namespace cg = cooperative_groups;

#define LAS __attribute__((address_space(3)))
typedef unsigned short bf16_t;
typedef short bf16x8 __attribute__((ext_vector_type(8)));
typedef float f32x4 __attribute__((ext_vector_type(4)));
typedef float f32x16 __attribute__((ext_vector_type(16)));
typedef unsigned u32x4 __attribute__((ext_vector_type(4)));
typedef unsigned u32x2 __attribute__((ext_vector_type(2)));
typedef float f32x2 __attribute__((ext_vector_type(2)));

constexpr int T = 32768, D = 1024, FF = 2816, SEQ = 4096, NB = 8;
constexpr float RMS_EPS = 1e-6f, GN_EPS = 64e-5f;
constexpr float LOG2E = 1.4426950408889634f;
constexpr float QSCALE = 0.07216878364870322f * 1.4426950408889634f;

constexpr size_t MiB = 1u << 20;
constexpr size_t WS_SLOTH = MiB / 2;
constexpr size_t WS_SLOTC = WS_SLOTH + 2 * MiB;
constexpr size_t WS_SLOTQ = WS_SLOTC + MiB / 2;
constexpr size_t WS_W = 4 * MiB;
constexpr size_t W_UG = WS_W;
constexpr size_t W_DN = W_UG + 48 * MiB;
constexpr size_t W_R = W_DN + 22 * MiB;
constexpr size_t W_K = W_R + 2 * MiB;
constexpr size_t W_V = W_K + 2 * MiB;
constexpr size_t W_O = W_V + 2 * MiB;
constexpr size_t W_LD = W_O + 2 * MiB;
constexpr size_t W_LU = W_LD + 1 * MiB;
constexpr size_t W_KN = W_LU + 2 * MiB;
constexpr size_t W_VT = W_KN + MiB / 2;
constexpr size_t W_DQ = W_VT + MiB / 2;
constexpr size_t W_UQ = W_DQ + 1 * MiB;
constexpr size_t W_MO = W_UQ + 2 * MiB;
constexpr size_t W_END = W_MO + 2 * MiB;
constexpr size_t WS_A = 92 * MiB;
static_assert(W_END <= WS_A, "weights region");
constexpr size_t A_HB = WS_A + 0;
constexpr size_t A_MID = WS_A + 64 * MiB;
constexpr size_t A_C = WS_A + 240 * MiB;
constexpr size_t A_KR = WS_A + 256 * MiB;
constexpr size_t A_KN = WS_A + 260 * MiB;
constexpr size_t A_VT = WS_A + 324 * MiB;
constexpr size_t A_QLAT = A_MID;
constexpr size_t A_QN = A_MID + 32 * MiB;
constexpr size_t A_QR = A_MID + 96 * MiB;
constexpr size_t A_X1 = WS_A + 0;
constexpr size_t A_XK = WS_A + 128 * MiB;
constexpr size_t A_XV = WS_A + 192 * MiB;
constexpr size_t A_R = WS_A + 256 * MiB;
constexpr size_t A_LM = WS_A + 320 * MiB;
constexpr size_t A_KK = WS_A + 0;
constexpr size_t A_VV = WS_A + 64 * MiB;
constexpr size_t A_E = WS_A + 128 * MiB;
constexpr size_t A_AA = WS_A + 192 * MiB;
constexpr size_t A_G = WS_A + 336 * MiB;
constexpr size_t A_BON = WS_A + 400 * MiB;
constexpr size_t A_COS = WS_A + 404 * MiB;
constexpr size_t A_SIN = WS_A + 408 * MiB;
constexpr size_t W_RL = WS_A + 412 * MiB;
constexpr size_t WS_NEED = 512 * MiB;

constexpr int LDS_BYTES = 147456;
constexpr int NPHASES = 22;
#ifndef N_LAUNCHES
#define N_LAUNCHES 1
#endif

__device__ __forceinline__ unsigned cvt_pk_bf16(float lo, float hi) { unsigned r; asm volatile("v_cvt_pk_bf16_f32 %0, %1, %2" : "=v"(r) : "v"(lo), "v"(hi)); return r; }
__device__ __forceinline__ float fsigmoid(float x) { return __builtin_amdgcn_rcpf(1.0f + __builtin_amdgcn_exp2f(-x * LOG2E)); }
__device__ __forceinline__ float ftanh(float x) { return 1.0f - 2.0f * __builtin_amdgcn_rcpf(1.0f + __builtin_amdgcn_exp2f(2.0f * LOG2E * x)); }
__device__ __forceinline__ float wave_sum(float v) {
#pragma unroll
    for (int o = 1; o < 64; o <<= 1) v += __shfl_xor(v, o);
    return v;
}
template <int CTRL> __device__ __forceinline__ float dpp_mov(float x) { return __builtin_bit_cast(float, __builtin_amdgcn_update_dpp(0, __builtin_bit_cast(int, x), CTRL, 0xf, 0xf, true)); }
__device__ __forceinline__ float red8(float x) { x += dpp_mov<0xB1>(x); x += dpp_mov<0x4E>(x); x += dpp_mov<0x141>(x); return x; }
__device__ __forceinline__ float red16(float x) { x = red8(x); x += dpp_mov<0x140>(x); return x; }
__device__ __forceinline__ float sum4(f32x4 v) { return (v[0] + v[1]) + (v[2] + v[3]); }
__device__ __forceinline__ float rstd_slots16(const float* s, int row) {
    const f32x4* p = (const f32x4*)(s + (size_t)row * 16);
    const f32x4 a = p[0], b = p[1], c = p[2], d = p[3];
    return __builtin_amdgcn_rsqf((sum4(a) + sum4(b) + sum4(c) + sum4(d)) * (1.0f / 1024.0f) + RMS_EPS);
}
__device__ __forceinline__ f32x4 unpack4(u32x2 p) { f32x4 r; r[0] = __uint_as_float(p.x << 16); r[1] = __uint_as_float(p.x & 0xffff0000u); r[2] = __uint_as_float(p.y << 16); r[3] = __uint_as_float(p.y & 0xffff0000u); return r; }

__device__ __forceinline__ int fresh_tid(int wave_s) { int l; asm volatile("v_mbcnt_lo_u32_b32 %0, -1, 0\n\tv_mbcnt_hi_u32_b32 %0, -1, %0" : "=v"(l)); return wave_s * 64 + l; }

namespace pg8 {
constexpr int BM = 256, BK = 64, HALF = 128, HTB = HALF * BK * 2, STAGE_BYTES = 8 * HTB, NXCD = 8, WGM = 8;
__device__ __forceinline__ int lds_byte(int r, int c) { const int st = (r >> 4) * 2 + (c >> 5), rr = r & 15, cc = c & 31, ob = rr * 64 + cc * 2; return st * 1024 + (ob ^ (((ob >> 9) & 1) << 5)); }
__device__ __forceinline__ void stage_rc(int b, int& R, int& C) { const int st = b / 1024, sb = b % 1024, swz = sb ^ (((sb >> 9) & 1) << 5); R = (st >> 1) * 16 + swz / 64; C = (st & 1) * 32 + (swz % 64) / 2; }
__device__ __forceinline__ int perm32(int rho) { const int n = rho >> 4, i = rho & 15; return 8 * (i >> 2) + 4 * n + (i & 3); }
struct Unit { int pm, pn; };
struct Gemm { const bf16_t* A; int lda; const bf16_t* Bt; int ldb; int M, N, K; };
struct StaticOrder {
    int nM, nN, nwg, G, c;
    __device__ void init(int M, int N, int G_, int c_) { nM = M / BM; nN = N / BM; nwg = nM * nN; G = G_; c = c_; }
    __device__ bool next(int i, Unit& u) const {
        const long L = (long)i * G + c; if (L >= nwg) return false;
        int wgid = (int)L; { const int q = nwg / NXCD, r = nwg % NXCD, xcd = wgid % NXCD, off = wgid / NXCD; wgid = (xcd < r ? xcd * (q + 1) : r * (q + 1) + (xcd - r) * q) + off; }
        const int nig = WGM * nN, gid = wgid / nig, fm = gid * WGM, gsz = (nM - fm) < WGM ? (nM - fm) : WGM;
        u.pm = fm + ((wgid % nig) % gsz); u.pn = (wgid % nig) / gsz; return true;
    }
};

template <class Epi>
__device__ __forceinline__ void gemm_phase(LAS unsigned char* lds, const Gemm g, const StaticOrder& S, const Epi& E, int wave_s) {
    const int tid = fresh_tid(wave_s), wid = __builtin_amdgcn_readfirstlane(tid >> 6), lane = tid & 63, wr = wid >> 2, wc = wid & 3, fr = lane & 15, fq = lane >> 4;
    const int K = g.K, nt = K / BK;
    unsigned voffA[2], voffB[2];
#pragma unroll
    for (int i = 0; i < 2; ++i) { int R, C; stage_rc(tid * 16 + i * 8192, R, C); const int Rb = Epi::PERM ? ((R & ~31) + perm32(R & 31)) : R;
        voffA[i] = (unsigned)(R * g.lda + C) * 2u; voffB[i] = (unsigned)(Rb * g.ldb + C) * 2u; }
    const size_t kstep = (size_t)(BK * 2);
    const size_t hstepA = (size_t)HALF * g.lda * 2, hstepB = (size_t)HALF * g.ldb * 2;
    const size_t tstepA = 2 * hstepA, tstepB = 2 * hstepB;
    const unsigned ldsw = (unsigned)wid * 1024u;
    const int aoff = lds_byte(wr * 64 + fr, fq * 8), boff = lds_byte(wc * 32 + fr, fq * 8);
#define PG8_SA(b, h) (((b) * 2 + (h)) * HTB)
#define PG8_SB(b, h) ((4 + (b) * 2 + (h)) * HTB)
#define PG8_STAGE(bufoff, gbase, voff) do { _Pragma("unroll") for (int _i = 0; _i < 2; ++_i) \
        __builtin_amdgcn_global_load_lds((const unsigned*)((const char*)(gbase) + (voff)[_i]), (LAS unsigned*)(lds + (bufoff) + ldsw + _i * 8192), 16, 0, 0); } while (0)
#define PG8_LDA(dst, b, h) do { _Pragma("unroll") for (int m = 0; m < 4; ++m) _Pragma("unroll") for (int k = 0; k < 2; ++k) dst[m][k] = *(const LAS bf16x8*)(lds + PG8_SA(b, h) + aoff + m * 2048 + k * 1024); } while (0)
#define PG8_LDB(dst, b, h) do { _Pragma("unroll") for (int n = 0; n < 2; ++n) _Pragma("unroll") for (int k = 0; k < 2; ++k) dst[n][k] = *(const LAS bf16x8*)(lds + PG8_SB(b, h) + boff + n * 2048 + k * 1024); } while (0)
#define PG8_MMA(ai, bj, At, Bt) do { __builtin_amdgcn_s_setprio(1); _Pragma("unroll") for (int m = 0; m < 4; ++m) _Pragma("unroll") for (int n = 0; n < 2; ++n) _Pragma("unroll") for (int k = 0; k < 2; ++k) \
        acc[ai][bj][m][n] = __builtin_amdgcn_mfma_f32_16x16x32_bf16(Bt[n][k], At[m][k], acc[ai][bj][m][n], 0, 0, 0); __builtin_amdgcn_s_setprio(0); } while (0)
#define PG8_WAIT_V(n) asm volatile("s_waitcnt vmcnt(" #n ")" ::: "memory")
#define PG8_WAIT_L(n) asm volatile("s_waitcnt lgkmcnt(" #n ")" ::: "memory")
#define PG8_BAR __builtin_amdgcn_s_barrier()
#define PG8_SCHED __builtin_amdgcn_sched_barrier(0)
    Unit cur, nxt; int ui = 0;
    if (!S.next(0, cur)) return;
    f32x4 acc[2][2][4][2];
#pragma unroll
    for (int a = 0; a < 2; ++a)
#pragma unroll
        for (int b = 0; b < 2; ++b)
#pragma unroll
            for (int m = 0; m < 4; ++m)
#pragma unroll
                for (int n = 0; n < 2; ++n) acc[a][b][m][n] = (f32x4){0.f, 0.f, 0.f, 0.f};
    bf16x8 At[4][2], B0[2][2], B1[2][2];
    const char* cA = (const char*)g.A + (size_t)cur.pm * tstepA; const char* cB = (const char*)g.Bt + (size_t)cur.pn * tstepB;
    PG8_STAGE(PG8_SB(0, 0), cB, voffB); PG8_STAGE(PG8_SB(0, 1), cB + hstepB, voffB); PG8_STAGE(PG8_SA(0, 0), cA, voffA); PG8_STAGE(PG8_SA(0, 1), cA + hstepA, voffA);
    if (wr == 1) PG8_BAR;
    PG8_WAIT_V(2); PG8_BAR;
    PG8_STAGE(PG8_SB(1, 0), cB + kstep, voffB); PG8_STAGE(PG8_SA(1, 0), cA + kstep, voffA); PG8_STAGE(PG8_SB(1, 1), cB + hstepB + kstep, voffB);
    PG8_WAIT_V(6); PG8_BAR;
    for (;;) {
        const bool has_next = S.next(ui + 1, nxt);
        const char* nA = has_next ? (const char*)g.A + (size_t)nxt.pm * tstepA : cA; const char* nB = has_next ? (const char*)g.Bt + (size_t)nxt.pn * tstepB : cB;
        for (int t = 0; t < nt; t += 2) {
            const bool last = (t == nt - 2);
            const char* a1 = cA + (size_t)(t + 1) * kstep;
            const char* a2 = last ? nA : cA + (size_t)(t + 2) * kstep; const char* b2 = last ? nB : cB + (size_t)(t + 2) * kstep;
            const char* a3 = a2 + kstep; const char* b3 = b2 + kstep;
            PG8_LDB(B0, 0, 0); PG8_LDB(B1, 0, 1); PG8_SCHED; PG8_LDA(At, 0, 0); PG8_STAGE(PG8_SA(1, 1), a1 + hstepA, voffA);
            PG8_WAIT_V(8); PG8_WAIT_L(0); PG8_BAR; PG8_MMA(0, 0, At, B0); PG8_MMA(0, 1, At, B1); PG8_BAR; PG8_SCHED;
            PG8_LDA(At, 0, 1); PG8_STAGE(PG8_SB(0, 0), b2, voffB); PG8_STAGE(PG8_SB(0, 1), b2 + hstepB, voffB); PG8_STAGE(PG8_SA(0, 0), a2, voffA);
            PG8_WAIT_V(8); PG8_WAIT_L(0); PG8_BAR; PG8_MMA(1, 0, At, B0); PG8_MMA(1, 1, At, B1); PG8_BAR; PG8_SCHED;
            PG8_LDB(B0, 1, 0); PG8_LDB(B1, 1, 1); PG8_SCHED; PG8_LDA(At, 1, 0); PG8_STAGE(PG8_SA(0, 1), a2 + hstepA, voffA);
            PG8_WAIT_V(8); PG8_WAIT_L(0); PG8_BAR; PG8_MMA(0, 0, At, B0); PG8_MMA(0, 1, At, B1); PG8_BAR; PG8_SCHED;
            PG8_LDA(At, 1, 1); PG8_STAGE(PG8_SB(1, 0), b3, voffB); PG8_STAGE(PG8_SB(1, 1), b3 + hstepB, voffB); PG8_STAGE(PG8_SA(1, 0), a3, voffA);
            PG8_WAIT_V(8); PG8_WAIT_L(0); PG8_BAR; PG8_MMA(1, 0, At, B0); PG8_MMA(1, 1, At, B1); PG8_BAR; PG8_SCHED;
        }
        if (wr == 0) PG8_BAR;
        E(acc, cur, wr, wc, fr, fq);
        if (!has_next) break;
#pragma unroll
        for (int a = 0; a < 2; ++a)
#pragma unroll
            for (int b = 0; b < 2; ++b)
#pragma unroll
                for (int m = 0; m < 4; ++m)
#pragma unroll
                    for (int n = 0; n < 2; ++n) acc[a][b][m][n] = (f32x4){0.f, 0.f, 0.f, 0.f};
        cur = nxt; cA = nA; cB = nB; ++ui;
        if (wr == 1) PG8_BAR;
    }
    PG8_WAIT_V(0);
    PG8_BAR;
#undef PG8_SA
#undef PG8_SB
#undef PG8_STAGE
#undef PG8_LDA
#undef PG8_LDB
#undef PG8_MMA
#undef PG8_WAIT_V
#undef PG8_WAIT_L
#undef PG8_BAR
#undef PG8_SCHED
}
}
using pg8::Unit;
typedef f32x4 AccT[2][2][4][2];

__device__ __forceinline__ u32x4 pack8(f32x4 a, f32x4 b) { u32x4 w; w.x = cvt_pk_bf16(a[0], a[1]); w.y = cvt_pk_bf16(a[2], a[3]); w.z = cvt_pk_bf16(b[0], b[1]); w.w = cvt_pk_bf16(b[2], b[3]); return w; }

struct EpiSwiglu {
    static constexpr bool PERM = true;
    bf16_t* mid; const float* slotsH; bf16_t* cbuf; float* slotsC; bf16_t* krope; const float* cosT; const float* sinT;
    __device__ __forceinline__ void operator()(const AccT& acc, const Unit& u, int wr, int wc, int fr, int fq) const {
        const int row0 = u.pm * 256 + wr * 64 + fr;
        if (u.pn < 22) {
#pragma unroll
            for (int ai = 0; ai < 2; ++ai)
#pragma unroll
                for (int m = 0; m < 4; ++m) {
                    const int row = row0 + ai * 128 + m * 16; const float rs = rstd_slots16(slotsH, row);
                    f32x4 o[2];
#pragma unroll
                    for (int n = 0; n < 2; ++n)
#pragma unroll
                        for (int i = 0; i < 4; ++i) { const float gt = acc[ai][0][m][n][i] * rs, up = acc[ai][1][m][n][i] * rs; o[n][i] = gt * fsigmoid(gt) * up; }
                    *(u32x4*)(mid + (size_t)row * FF + u.pn * 128 + wc * 32 + fq * 8) = pack8(o[0], o[1]);
                }
        } else if (u.pn == 22) {
#pragma unroll
            for (int ai = 0; ai < 2; ++ai)
#pragma unroll
                for (int m = 0; m < 4; ++m) {
                    const int row = row0 + ai * 128 + m * 16; const float rs = rstd_slots16(slotsH, row);
                    float ss = 0.f;
#pragma unroll
                    for (int bj = 0; bj < 2; ++bj) { const f32x4 a = acc[ai][bj][m][0] * rs, b = acc[ai][bj][m][1] * rs;
                        ss += (a[0] * a[0] + a[1] * a[1]) + (a[2] * a[2] + a[3] * a[3]) + (b[0] * b[0] + b[1] * b[1]) + (b[2] * b[2] + b[3] * b[3]);
                        *(u32x4*)(cbuf + (size_t)row * 256 + bj * 128 + wc * 32 + fq * 8) = pack8(a, b); }
                    ss += __shfl_xor(ss, 16); ss += __shfl_xor(ss, 32);
                    if (fq == 0) slotsC[(size_t)row * 4 + wc] = ss;
                }
        } else if (wc == 0) {
#pragma unroll
            for (int ai = 0; ai < 2; ++ai)
#pragma unroll
                for (int m = 0; m < 4; ++m) {
                    const int row = row0 + ai * 128 + m * 16; const float rs = rstd_slots16(slotsH, row);
                    f32x4 o1[2], o2[2];
#pragma unroll
                    for (int n = 0; n < 2; ++n) { const f32x4 c = *(const f32x4*)(cosT + (size_t)row * 32 + fq * 8 + n * 4), s = *(const f32x4*)(sinT + (size_t)row * 32 + fq * 8 + n * 4);
                        const f32x4 x1 = acc[ai][0][m][n] * rs, x2 = acc[ai][1][m][n] * rs; o1[n] = x1 * c - x2 * s; o2[n] = x2 * c + x1 * s; }
                    *(u32x4*)(krope + (size_t)row * 64 + fq * 8) = pack8(o1[0], o1[1]);
                    *(u32x4*)(krope + (size_t)row * 64 + 32 + fq * 8) = pack8(o2[0], o2[1]);
                }
        }
    }
};
struct EpiResid {
    static constexpr bool PERM = false;
    const float* hin; float* hout; bf16_t* hb; float* slots; float alpha;
    __device__ __forceinline__ void operator()(const AccT& acc, const Unit& u, int wr, int wc, int fr, int fq) const {
        const int row0 = u.pm * 256 + wr * 64 + fr, col0 = u.pn * 256 + wc * 32 + 4 * fq;
#pragma unroll
        for (int ai = 0; ai < 2; ++ai)
#pragma unroll
            for (int m = 0; m < 4; ++m) {
                const int row = row0 + ai * 128 + m * 16; const size_t off = (size_t)row * D + col0; float ss = 0.f;
#pragma unroll
                for (int bj = 0; bj < 2; ++bj)
#pragma unroll
                    for (int n = 0; n < 2; ++n) { const size_t o2 = off + bj * 128 + n * 16; const f32x4 b = *(const f32x4*)(hin + o2); const f32x4 o = b + acc[ai][bj][m][n] * alpha;
                        *(f32x4*)(hout + o2) = o; ss += (o[0] * o[0] + o[1] * o[1]) + (o[2] * o[2] + o[3] * o[3]);
                        if (hb) { u32x2 w; w.x = cvt_pk_bf16(o[0], o[1]); w.y = cvt_pk_bf16(o[2], o[3]); *(u32x2*)(hb + o2) = w; } }
                if (slots) { ss += __shfl_xor(ss, 16); ss += __shfl_xor(ss, 32); if (fq == 0) slots[(size_t)row * 16 + u.pn * 4 + wc] = ss; }
                if (m & 1) asm volatile("" ::: "memory");
            }
    }
};
struct EpiBf16 {
    static constexpr bool PERM = true;
    bf16_t* O; int ldc;
    __device__ __forceinline__ void operator()(const AccT& acc, const Unit& u, int wr, int wc, int fr, int fq) const {
        const int row0 = u.pm * 256 + wr * 64 + fr, col0 = u.pn * 256 + wc * 32 + 8 * fq;
#pragma unroll
        for (int ai = 0; ai < 2; ++ai)
#pragma unroll
            for (int m = 0; m < 4; ++m) { bf16_t* rp = O + (size_t)(row0 + ai * 128 + m * 16) * ldc + col0;
#pragma unroll
                for (int bj = 0; bj < 2; ++bj) *(u32x4*)(rp + bj * 128) = pack8(acc[ai][bj][m][0], acc[ai][bj][m][1]); }
    }
};
struct EpiLoraDown {
    static constexpr bool PERM = true;
    bf16_t* O;
    __device__ __forceinline__ void operator()(const AccT& acc, const Unit& u, int wr, int wc, int fr, int fq) const {
        const int row0 = u.pm * 256 + wr * 64 + fr, col0 = wc * 32 + 8 * fq;
#pragma unroll
        for (int ai = 0; ai < 2; ++ai)
#pragma unroll
            for (int m = 0; m < 4; ++m) { bf16_t* rp = O + (size_t)(row0 + ai * 128 + m * 16) * 256 + col0;
                f32x4 a = acc[ai][0][m][0], b = acc[ai][0][m][1];
                if (wc < 2) {
#pragma unroll
                    for (int i = 0; i < 4; ++i) { a[i] = ftanh(a[i]); b[i] = ftanh(b[i]); } }
                *(u32x4*)(rp) = pack8(a, b);
                a = acc[ai][1][m][0]; b = acc[ai][1][m][1];
#pragma unroll
                for (int i = 0; i < 4; ++i) { a[i] = fsigmoid(a[i]); b[i] = fsigmoid(b[i]); }
                *(u32x4*)(rp + 128) = pack8(a, b); }
    }
};
struct EpiRL {
    static constexpr bool PERM = true;
    bf16_t* R; bf16_t* O;
    __device__ __forceinline__ void operator()(const AccT& acc, const Unit& u, int wr, int wc, int fr, int fq) const {
        const int row0 = u.pm * 256 + wr * 64 + fr;
        if (u.pn < 4) {
            const int col0 = u.pn * 256 + wc * 32 + 8 * fq;
#pragma unroll
            for (int ai = 0; ai < 2; ++ai)
#pragma unroll
                for (int m = 0; m < 4; ++m) { bf16_t* rp = R + (size_t)(row0 + ai * 128 + m * 16) * D + col0;
#pragma unroll
                    for (int bj = 0; bj < 2; ++bj) *(u32x4*)(rp + bj * 128) = pack8(acc[ai][bj][m][0], acc[ai][bj][m][1]); }
        } else {
            const int col0 = wc * 32 + 8 * fq;
#pragma unroll
            for (int ai = 0; ai < 2; ++ai)
#pragma unroll
                for (int m = 0; m < 4; ++m) { bf16_t* rp = O + (size_t)(row0 + ai * 128 + m * 16) * 256 + col0;
                    f32x4 a = acc[ai][0][m][0], b = acc[ai][0][m][1];
                    if (wc < 2) {
#pragma unroll
                        for (int i = 0; i < 4; ++i) { a[i] = ftanh(a[i]); b[i] = ftanh(b[i]); } }
                    *(u32x4*)(rp) = pack8(a, b);
                    a = acc[ai][1][m][0]; b = acc[ai][1][m][1];
#pragma unroll
                    for (int i = 0; i < 4; ++i) { a[i] = fsigmoid(a[i]); b[i] = fsigmoid(b[i]); }
                    *(u32x4*)(rp + 128) = pack8(a, b); }
        }
    }
};
struct EpiLoraUp {
    static constexpr bool PERM = true;
    unsigned char* wsb; const float* w0; const float* a0; int grp0; size_t goff;
    __device__ __forceinline__ void operator()(const AccT& acc, const Unit& u, int wr, int wc, int fr, int fq) const {
        const int grp = (u.pn >> 2) + grp0, colt = (u.pn & 3) * 256;
        const int row0 = u.pm * 256 + wr * 64 + fr, col0 = colt + wc * 32 + 8 * fq;
        size_t ooff = goff; if (grp == 0) ooff = A_E; if (grp == 1) ooff = A_AA;
        bf16_t* O = (bf16_t*)(wsb + ooff); const float* bias = grp == 0 ? w0 : a0;
#pragma unroll
        for (int ai = 0; ai < 2; ++ai)
#pragma unroll
            for (int m = 0; m < 4; ++m) { bf16_t* rp = O + (size_t)(row0 + ai * 128 + m * 16) * D + col0;
#pragma unroll
                for (int bj = 0; bj < 2; ++bj) { f32x4 a = acc[ai][bj][m][0], b = acc[ai][bj][m][1];
                    if (grp < 2) { const float sc = grp == 0 ? 0.6065306597126334f : 1.0f;
                        const f32x4 b0 = *(const f32x4*)(bias + col0 + bj * 128), b1 = *(const f32x4*)(bias + col0 + bj * 128 + 4);
                        a = a + b0; b = b + b1;
#pragma unroll
                        for (int i = 0; i < 4; ++i) { a[i] = sc * fsigmoid(a[i]); b[i] = sc * fsigmoid(b[i]); } }
                    *(u32x4*)(rp + bj * 128) = pack8(a, b); }
                asm volatile("" ::: "memory"); }
    }
};
struct EpiQlat {
    static constexpr bool PERM = true;
    bf16_t* O; const float* slotsH; float* slotsQ;
    __device__ __forceinline__ void operator()(const AccT& acc, const Unit& u, int wr, int wc, int fr, int fq) const {
        const int row0 = u.pm * 256 + wr * 64 + fr, col0 = u.pn * 256 + wc * 32 + 8 * fq;
#pragma unroll
        for (int ai = 0; ai < 2; ++ai)
#pragma unroll
            for (int m = 0; m < 4; ++m) { const int row = row0 + ai * 128 + m * 16; const float rs = rstd_slots16(slotsH, row); float ss = 0.f;
#pragma unroll
                for (int bj = 0; bj < 2; ++bj) { const f32x4 a = acc[ai][bj][m][0] * rs, b = acc[ai][bj][m][1] * rs;
                    ss += (a[0] * a[0] + a[1] * a[1]) + (a[2] * a[2] + a[3] * a[3]) + (b[0] * b[0] + b[1] * b[1]) + (b[2] * b[2] + b[3] * b[3]);
                    *(u32x4*)(O + (size_t)row * 512 + col0 + bj * 128) = pack8(a, b); }
                ss += __shfl_xor(ss, 16); ss += __shfl_xor(ss, 32);
                if (fq == 0) slotsQ[(size_t)row * 8 + u.pn * 4 + wc] = ss; }
    }
};
struct EpiQ {
    static constexpr bool PERM = true;
    bf16_t* qn; bf16_t* qr; const float* slotsQ; const float* cosT; const float* sinT;
    __device__ __forceinline__ void operator()(const AccT& acc, const Unit& u, int wr, int wc, int fr, int fq) const {
        const int row0 = u.pm * 256 + wr * 64 + fr;
#pragma unroll
        for (int ai = 0; ai < 2; ++ai)
#pragma unroll
            for (int m = 0; m < 4; ++m) { const int row = row0 + ai * 128 + m * 16;
                const f32x4 s0 = *(const f32x4*)(slotsQ + (size_t)row * 8), s1 = *(const f32x4*)(slotsQ + (size_t)row * 8 + 4);
                const float rs = __builtin_amdgcn_rsqf((sum4(s0) + sum4(s1)) * (1.0f / 512.0f) + RMS_EPS) * QSCALE;
                if (u.pn < 4) {
#pragma unroll
                    for (int bj = 0; bj < 2; ++bj) *(u32x4*)(qn + (size_t)row * D + u.pn * 256 + bj * 128 + wc * 32 + fq * 8) = pack8(acc[ai][bj][m][0] * rs, acc[ai][bj][m][1] * rs);
                } else {
                    const int head = 4 * (u.pn - 4) + wc; f32x4 o1[2], o2[2];
#pragma unroll
                    for (int n = 0; n < 2; ++n) { const f32x4 c = *(const f32x4*)(cosT + (size_t)row * 32 + fq * 8 + n * 4), s = *(const f32x4*)(sinT + (size_t)row * 32 + fq * 8 + n * 4);
                        const f32x4 x1 = acc[ai][0][m][n] * rs, x2 = acc[ai][1][m][n] * rs; o1[n] = x1 * c - x2 * s; o2[n] = x2 * c + x1 * s; }
                    *(u32x4*)(qr + (size_t)row * 512 + head * 64 + fq * 8) = pack8(o1[0], o1[1]);
                    *(u32x4*)(qr + (size_t)row * 512 + head * 64 + 32 + fq * 8) = pack8(o2[0], o2[1]);
                } }
    }
};
struct EpiKnope {
    static constexpr bool PERM = true;
    bf16_t* O; const float* slotsC;
    __device__ __forceinline__ void operator()(const AccT& acc, const Unit& u, int wr, int wc, int fr, int fq) const {
        const int row0 = u.pm * 256 + wr * 64 + fr, col0 = u.pn * 256 + wc * 32 + 8 * fq;
#pragma unroll
        for (int ai = 0; ai < 2; ++ai)
#pragma unroll
            for (int m = 0; m < 4; ++m) { const int row = row0 + ai * 128 + m * 16; const f32x4 s = *(const f32x4*)(slotsC + (size_t)row * 4);
                const float rs = __builtin_amdgcn_rsqf(sum4(s) * (1.0f / 256.0f) + RMS_EPS);
#pragma unroll
                for (int bj = 0; bj < 2; ++bj) *(u32x4*)(O + (size_t)row * D + col0 + bj * 128) = pack8(acc[ai][bj][m][0] * rs, acc[ai][bj][m][1] * rs); }
    }
};
struct EpiVt {
    static constexpr bool PERM = true;
    bf16_t* O; const float* slotsC;
    __device__ __forceinline__ void operator()(const AccT& acc, const Unit& u, int wr, int wc, int fr, int fq) const {
        const int row0 = u.pm * 256 + wr * 64 + fr, col0 = u.pn * 256 + wc * 32 + 8 * fq;
        f32x4 rs[2][2];
#pragma unroll
        for (int bj = 0; bj < 2; ++bj)
#pragma unroll
            for (int n = 0; n < 2; ++n)
#pragma unroll
                for (int i = 0; i < 4; ++i) { const f32x4 s = *(const f32x4*)(slotsC + (size_t)(col0 + bj * 128 + n * 4 + i) * 4); rs[bj][n][i] = __builtin_amdgcn_rsqf(sum4(s) * (1.0f / 256.0f) + RMS_EPS); }
#pragma unroll
        for (int ai = 0; ai < 2; ++ai)
#pragma unroll
            for (int m = 0; m < 4; ++m) { const int row = row0 + ai * 128 + m * 16;
#pragma unroll
                for (int bj = 0; bj < 2; ++bj) *(u32x4*)(O + (size_t)row * T + col0 + bj * 128) = pack8(acc[ai][bj][m][0] * rs[bj][0], acc[ai][bj][m][1] * rs[bj][1]); }
    }
};

struct Args { const float* in[33]; const int* pos; float* out; unsigned char* ws; int ph_lo, ph_hi; };

struct Ctx { LAS unsigned char* lds; int vcu, G, wave; };

__device__ __forceinline__ void tr_item(const float* W, int ldw, int k0, int n0, const float* s1, const float* s2, int ks0, bf16_t* Bt, int ldb, int nd0, int kd0, LAS float* scr, int lane) {
    f32x4 v[8];
#pragma unroll
    for (int i = 0; i < 8; ++i) v[i] = *(const f32x4*)(W + (size_t)(k0 + 8 * i + (lane >> 3)) * ldw + n0 + 4 * (lane & 7));
#pragma unroll
    for (int i = 0; i < 8; ++i) { const int kk = 8 * i + (lane >> 3);
        float sc = s1 ? s1[ks0 + kk] : 1.0f; if (s2) sc -= s2[ks0 + kk];
        LAS float* d = scr + kk * 33 + 4 * (lane & 7);
        d[0] = sc * v[i][0]; d[1] = sc * v[i][1]; d[2] = sc * v[i][2]; d[3] = sc * v[i][3]; }
    asm volatile("s_waitcnt lgkmcnt(0)" ::: "memory");
    const int c = lane & 7;
#pragma unroll
    for (int j = 0; j < 4; ++j) { const int n = (lane >> 3) + 8 * j; const LAS float* s = scr + (8 * c) * 33 + n;
        u32x4 o; o.x = cvt_pk_bf16(s[0 * 33], s[1 * 33]); o.y = cvt_pk_bf16(s[2 * 33], s[3 * 33]); o.z = cvt_pk_bf16(s[4 * 33], s[5 * 33]); o.w = cvt_pk_bf16(s[6 * 33], s[7 * 33]);
        *(u32x4*)(Bt + (size_t)(nd0 + n) * ldb + kd0 + 8 * c) = o; }
    asm volatile("s_waitcnt lgkmcnt(0)" ::: "memory");
}
__device__ __forceinline__ void zero_item(bf16_t* Bt, int ldb, int nd0, int kd0, int lane) {
    const int c = lane & 7;
#pragma unroll
    for (int j = 0; j < 4; ++j) { const int n = (lane >> 3) + 8 * j; *(u32x4*)(Bt + (size_t)(nd0 + n) * ldb + kd0 + 8 * c) = (u32x4){0u, 0u, 0u, 0u}; }
}

__device__ __forceinline__ void p0_prologue(const Ctx& F, const Args& a) {
    unsigned char* ws = a.ws;
    const int tid = fresh_tid(F.wave), lane = tid & 63, wave = __builtin_amdgcn_readfirstlane(tid >> 6);
    LAS float* scr = (LAS float*)(F.lds + wave * 16384);
    const int gw = F.vcu * 8 + wave, NGW = F.G * 8;
    const float* norm_g = a.in[2];
    constexpr int I_UG = 16 * 176, I_UGX = 16 * 16, I_DN = 44 * 32, I_SQ = 16 * 32, I_LD = 32 * 8, I_LU = 4 * 96, I_KN = 4 * 32, I_DQ = 16 * 16, I_UQ = 8 * 48;
    constexpr int NITEMS = 4 * I_UG + I_UGX + 4 * I_DN + 4 * I_SQ + I_LD + I_LU + 2 * I_KN + I_DQ + I_UQ + I_SQ;
    for (int it = gw; it < NITEMS; it += NGW) {
        int r = it;
        if (r < 4 * I_UG) { const int q = r / I_UG; r -= q * I_UG; const int l = q >> 1, s = q & 1; const int kb = r / 176, nb = r % 176, pn = nb >> 3, jb = nb & 7;
            const float* src = (jb < 4 ? a.in[3] : a.in[4]) + (size_t)q * D * FF;
            tr_item(src, FF, 64 * kb, 128 * pn + 32 * (jb & 3), norm_g + (l * 3 + (s ? 2 : 0)) * D, nullptr, 64 * kb, (bf16_t*)(ws + W_UG) + (size_t)q * 6144 * D, D, 32 * nb, 64 * kb, scr, lane); continue; }
        r -= 4 * I_UG;
        if (r < I_UGX) { const int kb = r / 16, nb = r % 16; bf16_t* Bt = (bf16_t*)(ws + W_UG) + (size_t)2 * 6144 * D;
            int sc = -1; if (nb < 8) sc = 32 * nb; else if (nb == 8) sc = 256; else if (nb == 12) sc = 288;
            if (sc >= 0) tr_item(a.in[25], 320, 64 * kb, sc, a.in[24], nullptr, 64 * kb, Bt, D, 5632 + 32 * nb, 64 * kb, scr, lane); else zero_item(Bt, D, 5632 + 32 * nb, 64 * kb, lane); continue; }
        r -= I_UGX;
        if (r < 4 * I_DN) { const int q = r / I_DN; r -= q * I_DN; const int kb = r / 32, nb = r % 32;
            tr_item(a.in[5] + (size_t)q * FF * D, D, 64 * kb, 32 * nb, nullptr, nullptr, 0, (bf16_t*)(ws + W_DN) + (size_t)q * D * FF, FF, 32 * nb, 64 * kb, scr, lane); continue; }
        r -= 4 * I_DN;
        if (r < 4 * I_SQ) { const int q = r / I_SQ; r -= q * I_SQ; const int kb = r / 32, nb = r % 32;
            if (q == 0) { tr_item(a.in[7], D, 64 * kb, 32 * nb, nullptr, nullptr, 0, (bf16_t*)(ws + W_RL), 2048, 32 * nb, 64 * kb, scr, lane); zero_item((bf16_t*)(ws + W_RL), 2048, 32 * nb, 1024 + 64 * kb, lane); }
            else tr_item(a.in[7 + q], D, 64 * kb, 32 * nb, nullptr, nullptr, 0, (bf16_t*)(ws + W_R + (size_t)q * 2 * MiB), D, 32 * nb, 64 * kb, scr, lane);
            continue; }
        r -= 4 * I_SQ;
        if (r < I_LD) { const int kb = r / 8, nb = r % 8; const int kk0 = 64 * (kb & 15); const bool second = kb >= 16;
            const float* src; int ldw, nc, mi; if (nb < 2) { src = a.in[12]; ldw = 64; nc = 32 * nb; mi = 1; } else if (nb < 4) { src = a.in[15]; ldw = 64; nc = 32 * (nb - 2); mi = 4; } else { src = a.in[17]; ldw = 128; nc = 32 * (nb - 4); mi = 5; }
            tr_item(src, ldw, kk0, nc, second ? a.in[6] + mi * D : nullptr, second ? a.in[6] : nullptr, kk0, (bf16_t*)(ws + W_RL), 2048, 1024 + 32 * nb, 64 * kb, scr, lane); continue; }
        r -= I_LD;
        if (r < I_LU) { const int kb = r / 96, nb = r % 96; const int grp = nb / 32, nc = 32 * (nb % 32); bf16_t* Bt = (bf16_t*)(ws + W_LU);
            if (grp == 0) { if (kb == 0) tr_item(a.in[13], D, 0, nc, nullptr, nullptr, 0, Bt, 256, 32 * nb, 0, scr, lane); else zero_item(Bt, 256, 32 * nb, 64 * kb, lane); }
            else if (grp == 1) { if (kb == 1) tr_item(a.in[16], D, 0, nc, nullptr, nullptr, 0, Bt, 256, 32 * nb, 64, scr, lane); else zero_item(Bt, 256, 32 * nb, 64 * kb, lane); }
            else { if (kb >= 2) tr_item(a.in[18], D, 64 * (kb - 2), nc, nullptr, nullptr, 0, Bt, 256, 32 * nb, 64 * kb, scr, lane); else zero_item(Bt, 256, 32 * nb, 64 * kb, lane); }
            continue; }
        r -= I_LU;
        if (r < 2 * I_KN) { const int q = r / I_KN; r -= q * I_KN; const int kb = r / 32, nb = r % 32;
            const int n0 = 32 * nb, sc = (n0 >> 7) * 256 + (n0 & 127) + q * 128;
            tr_item(a.in[27], 2048, 64 * kb, sc, a.in[26], nullptr, 64 * kb, (bf16_t*)(ws + (q ? W_VT : W_KN)), 256, n0, 64 * kb, scr, lane); continue; }
        r -= 2 * I_KN;
        if (r < I_DQ) { const int kb = r / 16, nb = r % 16;
            tr_item(a.in[28], 512, 64 * kb, 32 * nb, norm_g + (1 * 3 + 1) * D, nullptr, 64 * kb, (bf16_t*)(ws + W_DQ), D, 32 * nb, 64 * kb, scr, lane); continue; }
        r -= I_DQ;
        if (r < I_UQ) { const int kb = r / 48, nb = r % 48; int sc;
            if (nb < 32) { const int n0 = 32 * nb; sc = (n0 >> 7) * 192 + (n0 & 127); }
            else { const int t2 = (nb - 32) >> 3, jj = (nb - 32) & 7, half = jj >> 2, hh = jj & 3; sc = (4 * t2 + hh) * 192 + 128 + 32 * half; }
            tr_item(a.in[30], 1536, 64 * kb, sc, a.in[29], nullptr, 64 * kb, (bf16_t*)(ws + W_UQ), 512, 32 * nb, 64 * kb, scr, lane); continue; }
        r -= I_UQ;
        { const int kb = r / 32, nb = r % 32; tr_item(a.in[31], D, 64 * kb, 32 * nb, nullptr, nullptr, 0, (bf16_t*)(ws + W_MO), D, 32 * nb, 64 * kb, scr, lane); }
    }
    const float* x = a.in[0]; bf16_t* hb = (bf16_t*)(ws + A_HB); float* slotsH = (float*)(ws + WS_SLOTH);
    for (int m = gw; m < T; m += NGW) {
        const f32x4* xr = (const f32x4*)(x + (size_t)m * D) + lane; float ss = 0.f;
#pragma unroll
        for (int j = 0; j < 4; ++j) { const f32x4 v = xr[64 * j]; ss += (v[0] * v[0] + v[1] * v[1]) + (v[2] * v[2] + v[3] * v[3]);
            u32x2 w; w.x = cvt_pk_bf16(v[0], v[1]); w.y = cvt_pk_bf16(v[2], v[3]); *((u32x2*)(hb + (size_t)m * D) + lane + 64 * j) = w; }
        ss = wave_sum(ss);
        if (lane < 16) slotsH[(size_t)m * 16 + lane] = lane == 0 ? ss : 0.f;
    }
    float* cosT = (float*)(ws + A_COS); float* sinT = (float*)(ws + A_SIN);
    for (int i = (F.vcu * 512 + tid); i < T * 32; i += F.G * 512) {
        const int tok = i >> 5, j = i & 31;
        const float inv = exp2f(-(float)j * (13.287712379549449f / 32.0f));
        const float ang = (float)a.pos[tok] * inv;
        const double rev = (double)ang * 0.15915494309189535; const float fr = (float)(rev - floor(rev));
        cosT[i] = __builtin_amdgcn_cosf(fr); sinT[i] = __builtin_amdgcn_sinf(fr);
    }
}

__device__ __forceinline__ void p_premix(const Ctx& F, const Args& a) {
    const float* h = a.out; const float* g = a.in[2] + 1 * D; const float* mix = a.in[6];
    bf16_t* X1 = (bf16_t*)(a.ws + A_X1); bf16_t* XK = (bf16_t*)(a.ws + A_XK); bf16_t* XV = (bf16_t*)(a.ws + A_XV);
    const int tid = fresh_tid(F.wave), lane = tid & 63, wave = __builtin_amdgcn_readfirstlane(tid >> 6);
    const int gw = F.vcu * 8 + wave, NGW = F.G * 8;
    for (int ch = gw; ch < T / 16; ch += NGW) {
        const int t0 = ch * 16;
        f32x4 prev[4], gv[4];
#pragma unroll
        for (int j = 0; j < 4; ++j) gv[j] = *((const f32x4*)g + lane + 64 * j);
        if ((t0 & (SEQ - 1)) == 0) {
#pragma unroll
            for (int j = 0; j < 4; ++j) prev[j] = (f32x4){0.f, 0.f, 0.f, 0.f};
        } else {
            float ss = 0.f;
#pragma unroll
            for (int j = 0; j < 4; ++j) { prev[j] = *((const f32x4*)(h + (size_t)(t0 - 1) * D) + lane + 64 * j); ss += (prev[j][0] * prev[j][0] + prev[j][1] * prev[j][1]) + (prev[j][2] * prev[j][2] + prev[j][3] * prev[j][3]); }
            const float rs = __builtin_amdgcn_rsqf(wave_sum(ss) * (1.0f / 1024.0f) + RMS_EPS);
#pragma unroll
            for (int j = 0; j < 4; ++j) prev[j] = prev[j] * rs * gv[j];
        }
        for (int t = t0; t < t0 + 16; ++t) {
            f32x4 cur[4]; float ss = 0.f;
#pragma unroll
            for (int j = 0; j < 4; ++j) { cur[j] = *((const f32x4*)(h + (size_t)t * D) + lane + 64 * j); ss += (cur[j][0] * cur[j][0] + cur[j][1] * cur[j][1]) + (cur[j][2] * cur[j][2] + cur[j][3] * cur[j][3]); }
            const float rs = __builtin_amdgcn_rsqf(wave_sum(ss) * (1.0f / 1024.0f) + RMS_EPS);
#pragma unroll
            for (int j = 0; j < 4; ++j) {
                const f32x4 hn = cur[j] * rs * gv[j]; const f32x4 xx = prev[j] - hn; prev[j] = hn;
                const f32x4 mr = *((const f32x4*)(mix + 0 * D) + lane + 64 * j), mk = *((const f32x4*)(mix + 2 * D) + lane + 64 * j), mv = *((const f32x4*)(mix + 3 * D) + lane + 64 * j);
                const f32x4 xr = hn + xx * mr, xk = hn + xx * mk, xv = hn + xx * mv;
                u32x2 w;
                w.x = cvt_pk_bf16(xr[0], xr[1]); w.y = cvt_pk_bf16(xr[2], xr[3]); *((u32x2*)(X1 + (size_t)t * 2048) + lane + 64 * j) = w;
                w.x = cvt_pk_bf16(xx[0], xx[1]); w.y = cvt_pk_bf16(xx[2], xx[3]); *((u32x2*)(X1 + (size_t)t * 2048 + 1024) + lane + 64 * j) = w;
                w.x = cvt_pk_bf16(xk[0], xk[1]); w.y = cvt_pk_bf16(xk[2], xk[3]); *((u32x2*)(XK + (size_t)t * D) + lane + 64 * j) = w;
                w.x = cvt_pk_bf16(xv[0], xv[1]); w.y = cvt_pk_bf16(xv[2], xv[3]); *((u32x2*)(XV + (size_t)t * D) + lane + 64 * j) = w;
            }
        }
    }
}

constexpr int TC = 32;
__device__ __forceinline__ void p_scan(const Ctx& F, const Args& a) {
    const bf16_t* Rb = (const bf16_t*)(a.ws + A_R); const bf16_t* Kb = (const bf16_t*)(a.ws + A_KK); const bf16_t* Vb = (const bf16_t*)(a.ws + A_VV);
    const bf16_t* Eb = (const bf16_t*)(a.ws + A_E); const bf16_t* Ab = (const bf16_t*)(a.ws + A_AA); bf16_t* Gb = (bf16_t*)(a.ws + A_G);
    const float* k_k = a.in[19]; const float* k_a = a.in[20]; const float* r_k = a.in[21]; const float* gn_w = a.in[22]; const float* gn_b = a.in[23];
    LAS float* sR = (LAS float*)(F.lds); LAS float* sW = sR + TC * 64; LAS float* sK = sW + TC * 64; LAS float* sV = sK + TC * 64;
    LAS float* sKK = sV + TC * 64; LAS float* sKA = sKK + TC * 64; LAS float* sY = sKA + TC * 64; LAS float* sBo = sY + TC * 64;
    const int tid = fresh_tid(F.wave), lane = tid & 63, wave = __builtin_amdgcn_readfirstlane(tid >> 6);
    const int irow = wave * 8 + (lane >> 3), kseg = (lane & 7) * 8;
    const int ptt = tid >> 4, pc = (tid & 15) * 4;
    for (int unit0 = F.vcu; unit0 < 2 * NB * 16; unit0 += F.G) {
        const int unit = unit0 & 127; const bool shadow = unit0 >= 128;
        const int b = unit >> 4, hd = unit & 15; const int cbase = hd * 64;
        float S[8];
#pragma unroll
        for (int j = 0; j < 8; ++j) S[j] = 0.f;
        const f32x4 kkv = *(const f32x4*)(k_k + cbase + pc), kav = *(const f32x4*)(k_a + cbase + pc), rkv = *(const f32x4*)(r_k + cbase + pc);
        const f32x4 gw = *(const f32x4*)(gn_w + cbase + pc), gb = *(const f32x4*)(gn_b + cbase + pc);
        for (int c0 = 0; c0 < SEQ; c0 += TC) {
            const size_t gidx = (size_t)(b * SEQ + c0 + ptt) * D + cbase + pc;
            {
                const f32x4 r = unpack4(*(const u32x2*)(Rb + gidx)), k = unpack4(*(const u32x2*)(Kb + gidx)), v = unpack4(*(const u32x2*)(Vb + gidx));
                const f32x4 e = unpack4(*(const u32x2*)(Eb + gidx)), aa = unpack4(*(const u32x2*)(Ab + gidx));
                f32x4 kk = k * kkv; float ss = (kk[0] * kk[0] + kk[1] * kk[1]) + (kk[2] * kk[2] + kk[3] * kk[3]); ss = red16(ss);
                kk = kk * __builtin_amdgcn_rsqf(fmaxf(ss, 1e-24f));
                const f32x4 kp = k * (1.0f + (aa - 1.0f) * kav);
                const f32x4 rk = r * kp * rkv; const float bo = red16((rk[0] + rk[1]) + (rk[2] + rk[3]));
                f32x4 w;
#pragma unroll
                for (int i = 0; i < 4; ++i) w[i] = __builtin_amdgcn_exp2f(-e[i] * LOG2E);
                const int o = ptt * 64 + pc;
                *(LAS f32x4*)(sR + o) = r; *(LAS f32x4*)(sW + o) = w; *(LAS f32x4*)(sK + o) = kp; *(LAS f32x4*)(sV + o) = v; *(LAS f32x4*)(sKK + o) = kk; *(LAS f32x4*)(sKA + o) = kk * aa;
                if ((tid & 15) == 0) sBo[ptt] = bo;
            }
            __syncthreads();
#pragma unroll 2
            for (int t = 0; t < TC; ++t) {
                const int o = t * 64 + kseg;
                const f32x4 kk0 = *(const LAS f32x4*)(sKK + o), kk1 = *(const LAS f32x4*)(sKK + o + 4);
                const f32x4 w0 = *(const LAS f32x4*)(sW + o), w1 = *(const LAS f32x4*)(sW + o + 4);
                const f32x4 ka0 = *(const LAS f32x4*)(sKA + o), ka1 = *(const LAS f32x4*)(sKA + o + 4);
                const f32x4 kp0 = *(const LAS f32x4*)(sK + o), kp1 = *(const LAS f32x4*)(sK + o + 4);
                const f32x4 r0 = *(const LAS f32x4*)(sR + o), r1 = *(const LAS f32x4*)(sR + o + 4);
                const float vv = sV[t * 64 + irow];
                float sa = ((S[0] * kk0[0] + S[1] * kk0[1]) + (S[2] * kk0[2] + S[3] * kk0[3])) + ((S[4] * kk1[0] + S[5] * kk1[1]) + (S[6] * kk1[2] + S[7] * kk1[3]));
                sa = red8(sa);
#pragma unroll
                for (int j = 0; j < 4; ++j) { S[j] = S[j] * w0[j] + (vv * kp0[j] - sa * ka0[j]); S[4 + j] = S[4 + j] * w1[j] + (vv * kp1[j] - sa * ka1[j]); }
                float y = ((S[0] * r0[0] + S[1] * r0[1]) + (S[2] * r0[2] + S[3] * r0[3])) + ((S[4] * r1[0] + S[5] * r1[1]) + (S[6] * r1[2] + S[7] * r1[3]));
                y = red8(y);
                if ((lane & 7) == 0) sY[t * 64 + irow] = y;
            }
            __syncthreads();
            {
                const int o = ptt * 64 + pc;
                const f32x4 y = *(const LAS f32x4*)(sY + o), v = *(const LAS f32x4*)(sV + o);
                const float mu = red16((y[0] + y[1]) + (y[2] + y[3])) * (1.0f / 64.0f);
                const f32x4 d = y - mu; const float var = red16((d[0] * d[0] + d[1] * d[1]) + (d[2] * d[2] + d[3] * d[3])) * (1.0f / 64.0f);
                const float rs = __builtin_amdgcn_rsqf(var + GN_EPS); const float bo = sBo[ptt];
                const f32x4 gg = unpack4(*(const u32x2*)(Gb + gidx));
                const f32x4 ov = (d * rs * gw + gb + v * bo) * gg;
                u32x2 w; w.x = cvt_pk_bf16(ov[0], ov[1]); w.y = cvt_pk_bf16(ov[2], ov[3]); if (!shadow) *(u32x2*)(Gb + gidx) = w;
            }
            __syncthreads();
        }
    }
}


__device__ __forceinline__ void p_scan2(const Ctx& F, const Args& a) {
    const bf16_t* Rb = (const bf16_t*)(a.ws + A_R); const bf16_t* Kb = (const bf16_t*)(a.ws + A_KK); const bf16_t* Vb = (const bf16_t*)(a.ws + A_VV);
    const bf16_t* Eb = (const bf16_t*)(a.ws + A_E); const bf16_t* Ab = (const bf16_t*)(a.ws + A_AA); bf16_t* Yb = (bf16_t*)(a.ws + A_G); float* Bon = (float*)(a.ws + A_BON);
    const float* k_k = a.in[19]; const float* k_a = a.in[20]; const float* r_k = a.in[21];
    LAS float* sR = (LAS float*)(F.lds); LAS float* sW = sR + TC * 64; LAS float* sK = sW + TC * 64; LAS float* sV = sK + TC * 64;
    LAS float* sKK = sV + TC * 64; LAS float* sKA = sKK + TC * 64; LAS float* sY = sKA + TC * 64;
    const int tid = fresh_tid(F.wave), lane = tid & 63, wave = __builtin_amdgcn_readfirstlane(tid >> 6);
    const int lrow = wave * 8 + (lane >> 3), kseg = (lane & 7) * 8;
    const int ptt = tid >> 4, pc = (tid & 15) * 4;
    for (int unit = F.vcu; unit < 2 * NB * 16; unit += F.G) {
        const int bh = unit >> 1, half = unit & 1, b = bh >> 4, hd = bh & 15, cbase = hd * 64;
        f32x4 S0 = (f32x4){0.f, 0.f, 0.f, 0.f}, S1 = (f32x4){0.f, 0.f, 0.f, 0.f};
        const f32x4 kkv = *(const f32x4*)(k_k + cbase + pc), kav = *(const f32x4*)(k_a + cbase + pc), rkv = *(const f32x4*)(r_k + cbase + pc);
        size_t gidx = (size_t)(b * SEQ + ptt) * D + cbase + pc;
        u32x2 qr = *(const u32x2*)(Rb + gidx), qk = *(const u32x2*)(Kb + gidx), qv = *(const u32x2*)(Vb + gidx), qe = *(const u32x2*)(Eb + gidx), qa = *(const u32x2*)(Ab + gidx);
        for (int c0 = 0; c0 < SEQ; c0 += TC) {
            {
                const f32x4 r = unpack4(qr), k = unpack4(qk), v = unpack4(qv), e = unpack4(qe), aa = unpack4(qa);
                f32x4 kk = k * kkv; float ss = (kk[0] * kk[0] + kk[1] * kk[1]) + (kk[2] * kk[2] + kk[3] * kk[3]); ss = red16(ss);
                kk = kk * __builtin_amdgcn_rsqf(fmaxf(ss, 1e-24f));
                const f32x4 kp = k * (1.0f + (aa - 1.0f) * kav);
                const f32x4 rk = r * kp * rkv; const float bo = red16((rk[0] + rk[1]) + (rk[2] + rk[3]));
                f32x4 w;
#pragma unroll
                for (int i = 0; i < 4; ++i) w[i] = __builtin_amdgcn_exp2f(-e[i] * LOG2E);
                const int o = ptt * 64 + pc;
                *(LAS f32x4*)(sR + o) = r; *(LAS f32x4*)(sW + o) = w; *(LAS f32x4*)(sK + o) = kp; *(LAS f32x4*)(sV + o) = v; *(LAS f32x4*)(sKK + o) = kk; *(LAS f32x4*)(sKA + o) = kk * aa;
                if (half == 0 && (tid & 15) == 0) Bon[(size_t)(b * SEQ + c0 + ptt) * 16 + hd] = bo;
            }
            __syncthreads();
            if (c0 + TC < SEQ) { gidx += (size_t)TC * D;
                qr = *(const u32x2*)(Rb + gidx); qk = *(const u32x2*)(Kb + gidx); qv = *(const u32x2*)(Vb + gidx); qe = *(const u32x2*)(Eb + gidx); qa = *(const u32x2*)(Ab + gidx); }
            if (wave < 4) {
#define SCAN_LD(P, tt) { const int o_ = (tt) * 64 + kseg; \
                kk0##P = *(const LAS f32x4*)(sKK + o_); kk1##P = *(const LAS f32x4*)(sKK + o_ + 4); w0##P = *(const LAS f32x4*)(sW + o_); w1##P = *(const LAS f32x4*)(sW + o_ + 4); \
                ka0##P = *(const LAS f32x4*)(sKA + o_); ka1##P = *(const LAS f32x4*)(sKA + o_ + 4); kp0##P = *(const LAS f32x4*)(sK + o_); kp1##P = *(const LAS f32x4*)(sK + o_ + 4); \
                r0##P = *(const LAS f32x4*)(sR + o_); r1##P = *(const LAS f32x4*)(sR + o_ + 4); vv##P = sV[(tt) * 64 + half * 32 + lrow]; }
#define SCAN_STEP(P, tt) { f32x4 p4 = S0 * kk0##P; p4 = S1 * kk1##P + p4; const float sa = red8((p4[0] + p4[1]) + (p4[2] + p4[3])); \
                S0 = S0 * w0##P + (kp0##P * vv##P - ka0##P * sa); S1 = S1 * w1##P + (kp1##P * vv##P - ka1##P * sa); \
                f32x4 y4 = S0 * r0##P; y4 = S1 * r1##P + y4; sY[(tt) * 256 + tid] = (y4[0] + y4[1]) + (y4[2] + y4[3]); }
                f32x4 kk0A, kk1A, w0A, w1A, ka0A, ka1A, kp0A, kp1A, r0A, r1A; float vvA;
                f32x4 kk0B, kk1B, w0B, w1B, ka0B, ka1B, kp0B, kp1B, r0B, r1B; float vvB;
                SCAN_LD(A, 0)
#pragma unroll 2
                for (int t = 0; t < TC; t += 2) {
                    SCAN_LD(B, t + 1)
                    SCAN_STEP(A, t)
                    SCAN_LD(A, (t + 2 < TC) ? t + 2 : t)
                    SCAN_STEP(B, t + 1)
                }
#undef SCAN_LD
#undef SCAN_STEP
            }
            __syncthreads();
            {
                const int tok = tid >> 4, r2 = (tid & 15) * 2;
                const LAS f32x4* q = (const LAS f32x4*)(sY + tok * 256 + r2 * 8);
                const f32x4 s0 = q[0] + q[1], s1 = q[2] + q[3];
                *(unsigned*)(Yb + (size_t)(b * SEQ + c0 + tok) * D + cbase + half * 32 + r2) = cvt_pk_bf16((s0[0] + s0[1]) + (s0[2] + s0[3]), (s1[0] + s1[1]) + (s1[2] + s1[3]));
            }
        }
        __syncthreads();
    }
}
__device__ __forceinline__ void p_post(const Ctx& F, const Args& a) {
    bf16_t* Yb = (bf16_t*)(a.ws + A_G); const bf16_t* Vb = (const bf16_t*)(a.ws + A_VV); const bf16_t* Gg = (const bf16_t*)(a.ws + A_E); const float* Bon = (const float*)(a.ws + A_BON);
    const float* gn_w = a.in[22]; const float* gn_b = a.in[23];
    const int tid = fresh_tid(F.wave), grp = tid >> 4, gl = tid & 15;
    for (int item = F.vcu * 32 + grp; item < T * 16; item += F.G * 32) {
        const int tok = item >> 4, hd = item & 15; const size_t idx = (size_t)tok * D + hd * 64 + 4 * gl;
        const f32x4 y = unpack4(*(const u32x2*)(Yb + idx)), v = unpack4(*(const u32x2*)(Vb + idx)), g = unpack4(*(const u32x2*)(Gg + idx));
        const float bo = Bon[(size_t)tok * 16 + hd];
        const f32x4 gw = *(const f32x4*)(gn_w + hd * 64 + 4 * gl), gb = *(const f32x4*)(gn_b + hd * 64 + 4 * gl);
        const float mu = red16((y[0] + y[1]) + (y[2] + y[3])) * (1.0f / 64.0f);
        const f32x4 d = y - mu; const float var = red16((d[0] * d[0] + d[1] * d[1]) + (d[2] * d[2] + d[3] * d[3])) * (1.0f / 64.0f);
        const float rs = __builtin_amdgcn_rsqf(var + GN_EPS);
        const f32x4 ov = (d * rs * gw + gb + v * bo) * g;
        u32x2 w; w.x = cvt_pk_bf16(ov[0], ov[1]); w.y = cvt_pk_bf16(ov[2], ov[3]); *(u32x2*)(Yb + idx) = w;
    }
}

constexpr int KROW = 400, VROW = 144, KBUF = 64 * KROW, VBUF = 128 * VROW, ABUF = KBUF + VBUF;
__device__ __forceinline__ void attn_unit(LAS unsigned char* lds, const bf16_t* qn, const bf16_t* qr, const bf16_t* kn, const bf16_t* kr, const bf16_t* vt, bf16_t* o_out, int b, int h, int qb, int wave_s) {
    const int tid = fresh_tid(wave_s), lane = tid & 63, wid = __builtin_amdgcn_readfirstlane(tid >> 6), r32 = lane & 31, hi = lane >> 5;
    const int tok0 = b * SEQ, q0 = qb * 256 + wid * 32;
    bf16x8 qf[12];
    { const size_t tq = (size_t)(tok0 + q0 + r32);
#pragma unroll
      for (int d = 0; d < 8; ++d) qf[d] = *(const bf16x8*)(qn + tq * D + h * 128 + d * 16 + hi * 8);
#pragma unroll
      for (int d = 0; d < 4; ++d) qf[8 + d] = *(const bf16x8*)(qr + tq * 512 + h * 64 + d * 16 + hi * 8); }
    const int NT = (qb + 1) * 4;
    const int kkey0 = tid >> 4, kch0 = tid & 15;
    const int rkey = tid >> 3, rch = tid & 7;
    const int vrow0 = tid >> 3, vch = tid & 7;
    const bf16_t* gk0 = kn + (size_t)(tok0 + kkey0) * D + h * 128 + kch0 * 8;
    const bf16_t* gk1 = gk0 + (size_t)32 * D;
    const bf16_t* gr = kr + (size_t)(tok0 + rkey) * 64 + rch * 8;
    const bf16_t* gv0 = vt + (size_t)(h * 128 + vrow0) * T + tok0 + vch * 8;
    const bf16_t* gv1 = gv0 + (size_t)64 * T;
    const int lk0 = kkey0 * KROW + kch0 * 16, lk1 = lk0 + 32 * KROW, lr = rkey * KROW + 256 + rch * 16, lv0 = KBUF + vrow0 * VROW + vch * 16, lv1 = lv0 + 64 * VROW;
    const int pr = (r32 & 0x13) | ((r32 & 4) << 1) | ((r32 & 8) >> 1);
    const int kfo = pr * KROW + hi * 16, vfo = KBUF + r32 * VROW + hi * 16;
    u32x4 ld0, ld1, ld2, ld3, ld4;
    ld0 = *(const u32x4*)gk0; ld1 = *(const u32x4*)gk1; ld2 = *(const u32x4*)gr; ld3 = *(const u32x4*)gv0; ld4 = *(const u32x4*)gv1;
    __syncthreads();
    *(LAS u32x4*)(lds + lk0) = ld0; *(LAS u32x4*)(lds + lk1) = ld1; *(LAS u32x4*)(lds + lr) = ld2; *(LAS u32x4*)(lds + lv0) = ld3; *(LAS u32x4*)(lds + lv1) = ld4;
    __syncthreads();
    float mrun = -1e30f, lrun = 0.f;
    f32x16 o[4];
#pragma unroll
    for (int d = 0; d < 4; ++d) o[d] = f32x16{};
    for (int t = 0; t < NT; ++t) {
        const int cb = (t & 1) * ABUF, nb = ((t + 1) & 1) * ABUF;
        const bool more = (t + 1 < NT);
        if (more) { const size_t ko = (size_t)(t + 1) * 64 * D, ro = (size_t)(t + 1) * 64 * 64, vo = (size_t)(t + 1) * 64;
            ld0 = *(const u32x4*)(gk0 + ko); ld1 = *(const u32x4*)(gk1 + ko); ld2 = *(const u32x4*)(gr + ro); ld3 = *(const u32x4*)(gv0 + vo); ld4 = *(const u32x4*)(gv1 + vo); }
        if (64 * t <= q0 + 31) {
            f32x16 s0 = f32x16{}, s1 = f32x16{};
            __builtin_amdgcn_s_setprio(1);
#pragma unroll
            for (int d = 0; d < 12; ++d) {
                const bf16x8 k0 = *(const LAS bf16x8*)(lds + cb + kfo + d * 32), k1 = *(const LAS bf16x8*)(lds + cb + kfo + 32 * KROW + d * 32);
                s0 = __builtin_amdgcn_mfma_f32_32x32x16_bf16(k0, qf[d], s0, 0, 0, 0);
                s1 = __builtin_amdgcn_mfma_f32_32x32x16_bf16(k1, qf[d], s1, 0, 0, 0);
            }
            __builtin_amdgcn_s_setprio(0);
            if (64 * t + 63 > q0) {
                const int qi = q0 + r32, kb0 = 64 * t + 8 * hi;
#pragma unroll
                for (int r = 0; r < 16; ++r) { const int key = kb0 + 16 * (r >> 3) + (r & 7); if (key > qi) s0[r] = -1e30f; if (key + 32 > qi) s1[r] = -1e30f; }
            }
            float mx = fmaxf(fmaxf(s0[0], s1[0]), s0[1]);
#pragma unroll
            for (int r = 1; r < 16; ++r) mx = fmaxf(fmaxf(mx, s1[r]), (r < 15) ? s0[r + 1] : s1[r]);
            { auto rr = __builtin_amdgcn_permlane32_swap(__float_as_uint(mx), __float_as_uint(mx), false, false); mx = fmaxf(__uint_as_float(rr[0]), __uint_as_float(rr[1])); }
            if (__any(mx - mrun > 8.0f)) {
                const float mnew = fmaxf(mrun, mx); const float alpha = __builtin_amdgcn_exp2f(mrun - mnew); mrun = mnew; lrun *= alpha;
#pragma unroll
                for (int d = 0; d < 4; ++d) o[d] = o[d] * alpha;
            }
            float ps = 0.f;
#pragma unroll
            for (int r = 0; r < 16; ++r) { s0[r] = __builtin_amdgcn_exp2f(s0[r] - mrun); s1[r] = __builtin_amdgcn_exp2f(s1[r] - mrun); ps += s0[r] + s1[r]; }
            lrun += ps;
            bf16x8 pf[4];
            { u32x4 w;
              w.x = cvt_pk_bf16(s0[0], s0[1]); w.y = cvt_pk_bf16(s0[2], s0[3]); w.z = cvt_pk_bf16(s0[4], s0[5]); w.w = cvt_pk_bf16(s0[6], s0[7]); pf[0] = __builtin_bit_cast(bf16x8, w);
              w.x = cvt_pk_bf16(s0[8], s0[9]); w.y = cvt_pk_bf16(s0[10], s0[11]); w.z = cvt_pk_bf16(s0[12], s0[13]); w.w = cvt_pk_bf16(s0[14], s0[15]); pf[1] = __builtin_bit_cast(bf16x8, w);
              w.x = cvt_pk_bf16(s1[0], s1[1]); w.y = cvt_pk_bf16(s1[2], s1[3]); w.z = cvt_pk_bf16(s1[4], s1[5]); w.w = cvt_pk_bf16(s1[6], s1[7]); pf[2] = __builtin_bit_cast(bf16x8, w);
              w.x = cvt_pk_bf16(s1[8], s1[9]); w.y = cvt_pk_bf16(s1[10], s1[11]); w.z = cvt_pk_bf16(s1[12], s1[13]); w.w = cvt_pk_bf16(s1[14], s1[15]); pf[3] = __builtin_bit_cast(bf16x8, w); }
            __builtin_amdgcn_s_setprio(1);
#pragma unroll
            for (int d = 0; d < 4; ++d)
#pragma unroll
                for (int ks = 0; ks < 4; ++ks) {
                    const bf16x8 vf = *(const LAS bf16x8*)(lds + cb + vfo + d * 32 * VROW + ks * 32);
                    o[d] = __builtin_amdgcn_mfma_f32_32x32x16_bf16(vf, pf[ks], o[d], 0, 0, 0);
                }
            __builtin_amdgcn_s_setprio(0);
        }
        if (more) { *(LAS u32x4*)(lds + nb + lk0) = ld0; *(LAS u32x4*)(lds + nb + lk1) = ld1; *(LAS u32x4*)(lds + nb + lr) = ld2; *(LAS u32x4*)(lds + nb + lv0) = ld3; *(LAS u32x4*)(lds + nb + lv1) = ld4; }
        __syncthreads();
    }
    { auto rr = __builtin_amdgcn_permlane32_swap(__float_as_uint(lrun), __float_as_uint(lrun), false, false); lrun = __uint_as_float(rr[0]) + __uint_as_float(rr[1]); }
    const float rl = __builtin_amdgcn_rcpf(lrun);
    bf16_t* op = o_out + (size_t)(tok0 + q0 + r32) * D + h * 128 + 4 * hi;
#pragma unroll
    for (int d = 0; d < 4; ++d)
#pragma unroll
        for (int r4 = 0; r4 < 4; ++r4) { u32x2 w; w.x = cvt_pk_bf16(o[d][4 * r4] * rl, o[d][4 * r4 + 1] * rl); w.y = cvt_pk_bf16(o[d][4 * r4 + 2] * rl, o[d][4 * r4 + 3] * rl);
            *(u32x2*)(op + 32 * d + 8 * r4) = w; }
}
__device__ __forceinline__ void p_attn(const Ctx& F, const Args& a) {
    const bf16_t* qn = (const bf16_t*)(a.ws + A_QN); const bf16_t* qr = (const bf16_t*)(a.ws + A_QR);
    const bf16_t* kn = (const bf16_t*)(a.ws + A_KN); const bf16_t* kr = (const bf16_t*)(a.ws + A_KR); const bf16_t* vt = (const bf16_t*)(a.ws + A_VT);
    bf16_t* oo = (bf16_t*)(a.ws + A_QN);
    for (int p = F.vcu; p < 512; p += F.G) {
        const int bh = p >> 3, s = p & 7;
        attn_unit(F.lds, qn, qr, kn, kr, vt, oo, bh >> 3, bh & 7, 15 - s, F.wave);
        attn_unit(F.lds, qn, qr, kn, kr, vt, oo, bh >> 3, bh & 7, s, F.wave);
    }
}

__device__ __forceinline__ void p_final(const Ctx& F, const Args& a) {
    float* h = a.out; const float* g = a.in[32];
    const int tid = fresh_tid(F.wave), lane = tid & 63, wave = __builtin_amdgcn_readfirstlane(tid >> 6);
    const int gw = F.vcu * 8 + wave, NGW = F.G * 8;
    f32x4 gv[4];
#pragma unroll
    for (int j = 0; j < 4; ++j) gv[j] = *((const f32x4*)g + lane + 64 * j);
    for (int m = gw; m < T; m += NGW) {
        f32x4 v[4]; float ss = 0.f;
#pragma unroll
        for (int j = 0; j < 4; ++j) { v[j] = *((const f32x4*)(h + (size_t)m * D) + lane + 64 * j); ss += (v[j][0] * v[j][0] + v[j][1] * v[j][1]) + (v[j][2] * v[j][2] + v[j][3] * v[j][3]); }
        const float rs = __builtin_amdgcn_rsqf(wave_sum(ss) * (1.0f / 1024.0f) + RMS_EPS);
#pragma unroll
        for (int j = 0; j < 4; ++j) *((f32x4*)(h + (size_t)m * D) + lane + 64 * j) = v[j] * rs * gv[j];
    }
}

#define XB_XCNT(j)  (256  + 64 * (j))
#define XB_XSUB(j)  (1280 + 64 * (j))
#define XB_XGEN(j)  (2304 + 64 * (j))
#define XB_TOP      3328
#define XB_TOPGEN   3392
__device__ __forceinline__ unsigned xb_ld(unsigned* p)              { return __hip_atomic_load(p, __ATOMIC_RELAXED, __HIP_MEMORY_SCOPE_AGENT); }
__device__ __forceinline__ unsigned xb_add(unsigned* p, unsigned v) { return __hip_atomic_fetch_add(p, v, __ATOMIC_RELAXED, __HIP_MEMORY_SCOPE_AGENT); }
__device__ __forceinline__ void my_grid_sync(unsigned* bar, unsigned G, int wave_s, unsigned x, volatile LAS unsigned* st) {
    asm volatile("s_waitcnt vmcnt(0) lgkmcnt(0)" ::: "memory");
    __syncthreads();
    if (fresh_tid(wave_s) == 0) {
        unsigned nloc = st[0], nx = st[1];
        if (nloc == 0u) {
            for (;;) { unsigned sum = 0u, cnt = 0u, mine = 0u;
#pragma unroll
                for (unsigned j = 0; j < 16; ++j) { const unsigned c = xb_ld(&bar[XB_XCNT(j)]); sum += c; cnt += (c > 0u) ? 1u : 0u; mine = (j == x) ? c : mine; }
                if (sum == G) { nloc = mine; nx = cnt; break; }
                __builtin_amdgcn_s_sleep(1); }
            st[0] = nloc; st[1] = nx;
        }
        const unsigned old = xb_add(&bar[XB_XSUB(x)], 1u);
        const unsigned gen = old / nloc;
        if (old + 1u == (gen + 1u) * nloc) {
            __builtin_amdgcn_fence(__ATOMIC_RELEASE, "agent");
            asm volatile("s_waitcnt vmcnt(0)" ::: "memory");
            const unsigned og = xb_add(&bar[XB_TOP], 1u);
            const unsigned tg = og / nx;
            if (og + 1u == (tg + 1u) * nx) xb_add(&bar[XB_TOPGEN], 1u);
            else while (xb_ld(&bar[XB_TOPGEN]) == tg) __builtin_amdgcn_s_sleep(1);
            __builtin_amdgcn_fence(__ATOMIC_ACQUIRE, "agent");
            xb_add(&bar[XB_XGEN(x)], 1u);
            asm volatile("s_waitcnt vmcnt(0)" ::: "memory");
        } else {
            while (xb_ld(&bar[XB_XGEN(x)]) == gen) __builtin_amdgcn_s_sleep(1);
            __builtin_amdgcn_fence(__ATOMIC_ACQUIRE, "agent");
            asm volatile("s_waitcnt vmcnt(0)" ::: "memory");
        }
    }
    __syncthreads();
}
#define GSYNC() do { my_grid_sync(bar_words + 64 * bar_idx, (unsigned)F.G, F.wave); ++bar_idx; } while (0)
#define RUN_GEMM(EPI_T, epi, Aptr, lda_, Bptr, ldb_, M_, N_, K_) do { pg8::Gemm g_{(const bf16_t*)(Aptr), (lda_), (const bf16_t*)(Bptr), (ldb_), (M_), (N_), (K_)}; \
    pg8::StaticOrder S_; S_.init((M_), (N_), F.G, (int)blockIdx.x); pg8::gemm_phase<EPI_T>(F.lds, g_, S_, (epi), F.wave); } while (0)

__global__ void __launch_bounds__(512, 2) fwd_mega(Args a) {
    extern __shared__ __attribute__((aligned(16))) unsigned char lds_raw[];
    cg::grid_group grid = cg::this_grid();
    Ctx F; F.lds = (LAS unsigned char*)lds_raw; F.wave = __builtin_amdgcn_readfirstlane((int)threadIdx.x >> 6);
    F.G = gridDim.x; { const int bx = blockIdx.x; F.vcu = (F.G % 8 == 0) ? (bx % 8) * (F.G / 8) + bx / 8 : bx; }
    unsigned char* ws = a.ws;
    float* slotsH = (float*)(ws + WS_SLOTH); float* slotsC = (float*)(ws + WS_SLOTC); float* slotsQ = (float*)(ws + WS_SLOTQ);
    bf16_t* HB = (bf16_t*)(ws + A_HB); bf16_t* MID = (bf16_t*)(ws + A_MID);
    const float* cosT = (const float*)(ws + A_COS); const float* sinT = (const float*)(ws + A_SIN);
    bf16_t* WUG = (bf16_t*)(ws + W_UG); bf16_t* WDN = (bf16_t*)(ws + W_DN);

    unsigned* bar_words = (unsigned*)ws;
    if (a.ph_hi > 1000) grid.sync();
    const unsigned xcc = (unsigned)__builtin_amdgcn_s_getreg((3 << 11) | 20) & 0xFu;
    volatile LAS unsigned* xst = (volatile LAS unsigned*)(F.lds + 131072 + 64);
    if (fresh_tid(F.wave) == 0) { xst[0] = 0u; xst[1] = 0u; (void)xb_add(&bar_words[XB_XCNT(xcc)], 1u); }
    __syncthreads();
    if (a.ph_lo <= 0 && 0 < a.ph_hi) {
    p0_prologue(F, a);
    }
    if (a.ph_lo <= 0 && 1 < a.ph_hi) my_grid_sync(bar_words, (unsigned)F.G, F.wave, xcc, xst);
    if (a.ph_lo <= 1 && 1 < a.ph_hi) {
    { EpiSwiglu E{MID, slotsH, nullptr, nullptr, nullptr, nullptr, nullptr}; RUN_GEMM(EpiSwiglu, E, HB, D, WUG, D, T, 5632, D); }
    }
    if (a.ph_lo <= 1 && 2 < a.ph_hi) my_grid_sync(bar_words, (unsigned)F.G, F.wave, xcc, xst);
    if (a.ph_lo <= 2 && 2 < a.ph_hi) {
    { EpiResid E{a.in[0], a.out, nullptr, nullptr, 0.5f}; RUN_GEMM(EpiResid, E, MID, FF, WDN, FF, T, D, FF); }
    }
    if (a.ph_lo <= 2 && 3 < a.ph_hi) my_grid_sync(bar_words, (unsigned)F.G, F.wave, xcc, xst);
    if (a.ph_lo <= 3 && 3 < a.ph_hi) {
    p_premix(F, a);
    }
    if (a.ph_lo <= 3 && 4 < a.ph_hi) my_grid_sync(bar_words, (unsigned)F.G, F.wave, xcc, xst);
    if (a.ph_lo <= 4 && 4 < a.ph_hi) {
    { EpiRL E{(bf16_t*)(ws + A_R), (bf16_t*)(ws + A_LM)}; RUN_GEMM(EpiRL, E, ws + A_X1, 2048, ws + W_RL, 2048, T, 1280, 2048); }
    }
    if (a.ph_lo <= 4 && 5 < a.ph_hi) my_grid_sync(bar_words, (unsigned)F.G, F.wave, xcc, xst);
    if (a.ph_lo <= 5 && 5 < a.ph_hi) {
    { EpiBf16 E{(bf16_t*)(ws + A_KK), D}; RUN_GEMM(EpiBf16, E, ws + A_XK, D, ws + W_K, D, T, D, D); }
    { EpiBf16 E{(bf16_t*)(ws + A_VV), D}; RUN_GEMM(EpiBf16, E, ws + A_XV, D, ws + W_V, D, T, D, D); }
    }
    if (a.ph_lo <= 5 && 6 < a.ph_hi) my_grid_sync(bar_words, (unsigned)F.G, F.wave, xcc, xst);
    if (a.ph_lo <= 6 && 6 < a.ph_hi) {
    { EpiLoraUp E{ws, a.in[11], a.in[14], 0, A_G}; RUN_GEMM(EpiLoraUp, E, ws + A_LM, 256, ws + W_LU, 256, T, 2048, 256); }
    }
    if (a.ph_lo <= 6 && 7 < a.ph_hi) my_grid_sync(bar_words, (unsigned)F.G, F.wave, xcc, xst);
    if (a.ph_lo <= 7 && 7 < a.ph_hi) {
    p_scan2(F, a);
    }
    if (a.ph_lo <= 7 && 8 < a.ph_hi) my_grid_sync(bar_words, (unsigned)F.G, F.wave, xcc, xst);
    if (a.ph_lo <= 8 && 8 < a.ph_hi) {
    { EpiLoraUp E{ws, a.in[11], a.in[14], 2, A_E}; RUN_GEMM(EpiLoraUp, E, ws + A_LM, 256, ws + W_LU + (size_t)2048 * 256 * 2, 256, T, 1024, 256); }
    }
    if (a.ph_lo <= 8 && 9 < a.ph_hi) my_grid_sync(bar_words, (unsigned)F.G, F.wave, xcc, xst);
    if (a.ph_lo <= 9 && 9 < a.ph_hi) {
    p_post(F, a);
    }
    if (a.ph_lo <= 9 && 10 < a.ph_hi) my_grid_sync(bar_words, (unsigned)F.G, F.wave, xcc, xst);
    if (a.ph_lo <= 10 && 10 < a.ph_hi) {
    { EpiResid E{a.out, a.out, HB, slotsH, 1.0f}; RUN_GEMM(EpiResid, E, ws + A_G, D, ws + W_O, D, T, D, D); }
    }
    if (a.ph_lo <= 10 && 11 < a.ph_hi) my_grid_sync(bar_words, (unsigned)F.G, F.wave, xcc, xst);
    if (a.ph_lo <= 11 && 11 < a.ph_hi) {
    { EpiSwiglu E{MID, slotsH, nullptr, nullptr, nullptr, nullptr, nullptr}; RUN_GEMM(EpiSwiglu, E, HB, D, WUG + (size_t)1 * 6144 * D, D, T, 5632, D); }
    }
    if (a.ph_lo <= 11 && 12 < a.ph_hi) my_grid_sync(bar_words, (unsigned)F.G, F.wave, xcc, xst);
    if (a.ph_lo <= 12 && 12 < a.ph_hi) {
    { EpiResid E{a.out, a.out, HB, slotsH, 0.5f}; RUN_GEMM(EpiResid, E, MID, FF, WDN + (size_t)1 * D * FF, FF, T, D, FF); }
    }
    if (a.ph_lo <= 12 && 13 < a.ph_hi) my_grid_sync(bar_words, (unsigned)F.G, F.wave, xcc, xst);
    if (a.ph_lo <= 13 && 13 < a.ph_hi) {
    { EpiSwiglu E{MID, slotsH, (bf16_t*)(ws + A_C), slotsC, (bf16_t*)(ws + A_KR), cosT, sinT}; RUN_GEMM(EpiSwiglu, E, HB, D, WUG + (size_t)2 * 6144 * D, D, T, 6144, D); }
    }
    if (a.ph_lo <= 13 && 14 < a.ph_hi) my_grid_sync(bar_words, (unsigned)F.G, F.wave, xcc, xst);
    if (a.ph_lo <= 14 && 14 < a.ph_hi) {
    { EpiResid E{a.out, a.out, HB, slotsH, 0.5f}; RUN_GEMM(EpiResid, E, MID, FF, WDN + (size_t)2 * D * FF, FF, T, D, FF); }
    { EpiKnope E{(bf16_t*)(ws + A_KN), slotsC}; RUN_GEMM(EpiKnope, E, ws + A_C, 256, ws + W_KN, 256, T, D, 256); }
    { EpiVt E{(bf16_t*)(ws + A_VT), slotsC}; RUN_GEMM(EpiVt, E, ws + W_VT, 256, ws + A_C, 256, D, T, 256); }
    }
    if (a.ph_lo <= 14 && 15 < a.ph_hi) my_grid_sync(bar_words, (unsigned)F.G, F.wave, xcc, xst);
    if (a.ph_lo <= 15 && 15 < a.ph_hi) {
    { EpiQlat E{(bf16_t*)(ws + A_QLAT), slotsH, slotsQ}; RUN_GEMM(EpiQlat, E, HB, D, ws + W_DQ, D, T, 512, D); }
    }
    if (a.ph_lo <= 15 && 16 < a.ph_hi) my_grid_sync(bar_words, (unsigned)F.G, F.wave, xcc, xst);
    if (a.ph_lo <= 16 && 16 < a.ph_hi) {
    { EpiQ E{(bf16_t*)(ws + A_QN), (bf16_t*)(ws + A_QR), slotsQ, cosT, sinT}; RUN_GEMM(EpiQ, E, ws + A_QLAT, 512, ws + W_UQ, 512, T, 1536, 512); }
    }
    if (a.ph_lo <= 16 && 17 < a.ph_hi) my_grid_sync(bar_words, (unsigned)F.G, F.wave, xcc, xst);
    if (a.ph_lo <= 17 && 17 < a.ph_hi) {
    p_attn(F, a);
    }
    if (a.ph_lo <= 17 && 18 < a.ph_hi) my_grid_sync(bar_words, (unsigned)F.G, F.wave, xcc, xst);
    if (a.ph_lo <= 18 && 18 < a.ph_hi) {
    { EpiResid E{a.out, a.out, HB, slotsH, 1.0f}; RUN_GEMM(EpiResid, E, ws + A_QN, D, ws + W_MO, D, T, D, D); }
    }
    if (a.ph_lo <= 18 && 19 < a.ph_hi) my_grid_sync(bar_words, (unsigned)F.G, F.wave, xcc, xst);
    if (a.ph_lo <= 19 && 19 < a.ph_hi) {
    { EpiSwiglu E{MID, slotsH, nullptr, nullptr, nullptr, nullptr, nullptr}; RUN_GEMM(EpiSwiglu, E, HB, D, WUG + (size_t)3 * 6144 * D, D, T, 5632, D); }
    }
    if (a.ph_lo <= 19 && 20 < a.ph_hi) my_grid_sync(bar_words, (unsigned)F.G, F.wave, xcc, xst);
    if (a.ph_lo <= 20 && 20 < a.ph_hi) {
    { EpiResid E{a.out, a.out, nullptr, nullptr, 0.5f}; RUN_GEMM(EpiResid, E, MID, FF, WDN + (size_t)3 * D * FF, FF, T, D, FF); }
    }
    if (a.ph_lo <= 20 && 21 < a.ph_hi) my_grid_sync(bar_words, (unsigned)F.G, F.wave, xcc, xst);
    if (a.ph_lo <= 21 && 21 < a.ph_hi) {
    p_final(F, a);
    }
}

extern "C" void kernel_launch(void* const* d_in, const int* in_sizes, int n_in, void* d_out, int out_size, void* d_ws, size_t ws_size, hipStream_t stream) {
    static int grid = 0;
    if (grid == 0) {
        if (n_in != 33 || out_size != T * D || ws_size < WS_NEED) { fprintf(stderr, "kernel_launch: unexpected shapes: n_in %d out %d ws %zu (need %zu)\n", n_in, out_size, ws_size, (size_t)WS_NEED); grid = -1; return; }
        int dev = 0, cus = 0, per_cu = 0;
        (void)hipGetDevice(&dev); (void)hipDeviceGetAttribute(&cus, hipDeviceAttributeMultiprocessorCount, dev);
        (void)hipFuncSetAttribute((const void*)fwd_mega, hipFuncAttributeMaxDynamicSharedMemorySize, LDS_BYTES);
        (void)hipOccupancyMaxActiveBlocksPerMultiprocessor(&per_cu, (const void*)fwd_mega, 512, LDS_BYTES);
        (void)hipGetLastError();
        grid = cus > 0 ? cus : 256;
        if (grid > 256) grid = 256;
    }
    if (grid < 0) return;
    (void)hipMemsetAsync(d_ws, 0, 65536, stream);
    Args a{};
    for (int i = 0; i < 33; ++i) a.in[i] = (const float*)d_in[i];
    a.pos = (const int*)d_in[1]; a.out = (float*)d_out; a.ws = (unsigned char*)d_ws;
    hipError_t e = hipSuccess;
#if N_LAUNCHES == 1
    a.ph_lo = 0; a.ph_hi = NPHASES;
    { void* args[] = {&a}; e = hipLaunchCooperativeKernel((void*)fwd_mega, dim3(grid), dim3(512), args, LDS_BYTES, stream); }
#else
    for (int p = 0; p < NPHASES; ++p) { a.ph_lo = p; a.ph_hi = p + 1; hipLaunchKernelGGL(fwd_mega, dim3(grid), dim3(512), LDS_BYTES, stream, a); }
    e = hipPeekAtLastError();
#endif
    if (e != hipSuccess) fprintf(stderr, "cooperative launch failed: %s (grid %d)\n", hipGetErrorString(e), grid);
}
```

```cpp
#include <hip/hip_runtime.h>
#include <hip/hip_cooperative_groups.h>
#include <cstdio>
#include <cstdint>
namespace cg = cooperative_groups;

#define LAS __attribute__((address_space(3)))
typedef unsigned short bf16_t;
typedef short bf16x8 __attribute__((ext_vector_type(8)));
typedef float f32x4 __attribute__((ext_vector_type(4)));
typedef float f32x16 __attribute__((ext_vector_type(16)));
typedef unsigned u32x4 __attribute__((ext_vector_type(4)));
typedef unsigned u32x2 __attribute__((ext_vector_type(2)));
typedef float f32x2 __attribute__((ext_vector_type(2)));

constexpr int T = 32768, D = 1024, FF = 2816, SEQ = 4096, NB = 8;
constexpr float RMS_EPS = 1e-6f, GN_EPS = 64e-5f;
constexpr float LOG2E = 1.4426950408889634f;
constexpr float QSCALE = 0.07216878364870322f * 1.4426950408889634f;

constexpr size_t MiB = 1u << 20;
constexpr size_t WS_SLOTH = MiB / 2;
constexpr size_t WS_SLOTC = WS_SLOTH + 2 * MiB;
constexpr size_t WS_SLOTQ = WS_SLOTC + MiB / 2;
constexpr size_t WS_W = 4 * MiB;
constexpr size_t W_UG = WS_W;
constexpr size_t W_DN = W_UG + 48 * MiB;
constexpr size_t W_R = W_DN + 22 * MiB;
constexpr size_t W_K = W_R + 2 * MiB;
constexpr size_t W_V = W_K + 2 * MiB;
constexpr size_t W_O = W_V + 2 * MiB;
constexpr size_t W_LD = W_O + 2 * MiB;
constexpr size_t W_LU = W_LD + 1 * MiB;
constexpr size_t W_KN = W_LU + 2 * MiB;
constexpr size_t W_VT = W_KN + MiB / 2;
constexpr size_t W_DQ = W_VT + MiB / 2;
constexpr size_t W_UQ = W_DQ + 1 * MiB;
constexpr size_t W_MO = W_UQ + 2 * MiB;
constexpr size_t W_END = W_MO + 2 * MiB;
constexpr size_t WS_A = 92 * MiB;
static_assert(W_END <= WS_A, "weights region");
constexpr size_t A_HB = WS_A + 0;
constexpr size_t A_MID = WS_A + 64 * MiB;
constexpr size_t A_C = WS_A + 240 * MiB;
constexpr size_t A_KR = WS_A + 256 * MiB;
constexpr size_t A_KN = WS_A + 260 * MiB;
constexpr size_t A_VT = WS_A + 324 * MiB;
constexpr size_t A_QLAT = A_MID;
constexpr size_t A_QN = A_MID + 32 * MiB;
constexpr size_t A_QR = A_MID + 96 * MiB;
constexpr size_t A_X1 = WS_A + 0;
constexpr size_t A_XK = WS_A + 128 * MiB;
constexpr size_t A_XV = WS_A + 192 * MiB;
constexpr size_t A_R = WS_A + 256 * MiB;
constexpr size_t A_LM = WS_A + 320 * MiB;
constexpr size_t A_KK = WS_A + 0;
constexpr size_t A_VV = WS_A + 64 * MiB;
constexpr size_t A_E = WS_A + 128 * MiB;
constexpr size_t A_AA = WS_A + 192 * MiB;
constexpr size_t A_G = WS_A + 336 * MiB;
constexpr size_t A_BON = WS_A + 400 * MiB;
constexpr size_t A_COS = WS_A + 404 * MiB;
constexpr size_t A_SIN = WS_A + 408 * MiB;
constexpr size_t W_RL = WS_A + 412 * MiB;
constexpr size_t WS_NEED = 512 * MiB;

constexpr int LDS_BYTES = 147456;
constexpr int NPHASES = 22;
#ifndef N_LAUNCHES
#define N_LAUNCHES 1
#endif

__device__ __forceinline__ unsigned cvt_pk_bf16(float lo, float hi) { unsigned r; asm volatile("v_cvt_pk_bf16_f32 %0, %1, %2" : "=v"(r) : "v"(lo), "v"(hi)); return r; }
__device__ __forceinline__ float fsigmoid(float x) { return __builtin_amdgcn_rcpf(1.0f + __builtin_amdgcn_exp2f(-x * LOG2E)); }
__device__ __forceinline__ float ftanh(float x) { return 1.0f - 2.0f * __builtin_amdgcn_rcpf(1.0f + __builtin_amdgcn_exp2f(2.0f * LOG2E * x)); }
__device__ __forceinline__ float wave_sum(float v) {
#pragma unroll
    for (int o = 1; o < 64; o <<= 1) v += __shfl_xor(v, o);
    return v;
}
template <int CTRL> __device__ __forceinline__ float dpp_mov(float x) { return __builtin_bit_cast(float, __builtin_amdgcn_update_dpp(0, __builtin_bit_cast(int, x), CTRL, 0xf, 0xf, true)); }
__device__ __forceinline__ float red8(float x) { x += dpp_mov<0xB1>(x); x += dpp_mov<0x4E>(x); x += dpp_mov<0x141>(x); return x; }
__device__ __forceinline__ float red16(float x) { x = red8(x); x += dpp_mov<0x140>(x); return x; }
__device__ __forceinline__ float sum4(f32x4 v) { return (v[0] + v[1]) + (v[2] + v[3]); }
__device__ __forceinline__ float rstd_slots16(const float* s, int row) {
    const f32x4* p = (const f32x4*)(s + (size_t)row * 16);
    const f32x4 a = p[0], b = p[1], c = p[2], d = p[3];
    return __builtin_amdgcn_rsqf((sum4(a) + sum4(b) + sum4(c) + sum4(d)) * (1.0f / 1024.0f) + RMS_EPS);
}
__device__ __forceinline__ f32x4 unpack4(u32x2 p) { f32x4 r; r[0] = __uint_as_float(p.x << 16); r[1] = __uint_as_float(p.x & 0xffff0000u); r[2] = __uint_as_float(p.y << 16); r[3] = __uint_as_float(p.y & 0xffff0000u); return r; }

__device__ __forceinline__ int fresh_tid(int wave_s) { int l; asm volatile("v_mbcnt_lo_u32_b32 %0, -1, 0\n\tv_mbcnt_hi_u32_b32 %0, -1, %0" : "=v"(l)); return wave_s * 64 + l; }

namespace pg8 {
constexpr int BM = 256, BK = 64, HALF = 128, HTB = HALF * BK * 2, STAGE_BYTES = 8 * HTB, NXCD = 8, WGM = 8;
__device__ __forceinline__ int lds_byte(int r, int c) { const int st = (r >> 4) * 2 + (c >> 5), rr = r & 15, cc = c & 31, ob = rr * 64 + cc * 2; return st * 1024 + (ob ^ (((ob >> 9) & 1) << 5)); }
__device__ __forceinline__ void stage_rc(int b, int& R, int& C) { const int st = b / 1024, sb = b % 1024, swz = sb ^ (((sb >> 9) & 1) << 5); R = (st >> 1) * 16 + swz / 64; C = (st & 1) * 32 + (swz % 64) / 2; }
__device__ __forceinline__ int perm32(int rho) { const int n = rho >> 4, i = rho & 15; return 8 * (i >> 2) + 4 * n + (i & 3); }
struct Unit { int pm, pn; };
struct Gemm { const bf16_t* A; int lda; const bf16_t* Bt; int ldb; int M, N, K; };
struct StaticOrder {
    int nM, nN, nwg, G, c;
    __device__ void init(int M, int N, int G_, int c_) { nM = M / BM; nN = N / BM; nwg = nM * nN; G = G_; c = c_; }
    __device__ bool next(int i, Unit& u) const {
        const long L = (long)i * G + c; if (L >= nwg) return false;
        int wgid = (int)L; { const int q = nwg / NXCD, r = nwg % NXCD, xcd = wgid % NXCD, off = wgid / NXCD; wgid = (xcd < r ? xcd * (q + 1) : r * (q + 1) + (xcd - r) * q) + off; }
        const int nig = WGM * nN, gid = wgid / nig, fm = gid * WGM, gsz = (nM - fm) < WGM ? (nM - fm) : WGM;
        u.pm = fm + ((wgid % nig) % gsz); u.pn = (wgid % nig) / gsz; return true;
    }
    __device__ __forceinline__ int unit_nt(const Unit&, int nt) const { return nt; }
};
struct OrderRL {
    int c;
    __device__ bool next(int i, Unit& u) const {
        int idx;
        if (c < 128) { if (i == 0) { u.pm = c; u.pn = 4; return true; } if (i > 1) return false; idx = c; }
        else { if (i > 2) return false; idx = 128 + 3 * (c - 128) + i; }
        u.pm = idx >> 2; u.pn = idx & 3; return true;
    }
    __device__ __forceinline__ int unit_nt(const Unit& u, int nt) const { return u.pn < 4 ? nt / 2 : nt; }
};

template <class Epi, class Sched>
__device__ __forceinline__ void gemm_phase(LAS unsigned char* lds, const Gemm g, const Sched& S, const Epi& E, int wave_s) {
    const int tid = fresh_tid(wave_s), wid = __builtin_amdgcn_readfirstlane(tid >> 6), lane = tid & 63, wr = wid >> 2, wc = wid & 3, fr = lane & 15, fq = lane >> 4;
    const int K = g.K, nt_full = K / BK;
    unsigned voffA[2], voffB[2];
#pragma unroll
    for (int i = 0; i < 2; ++i) { int R, C; stage_rc(tid * 16 + i * 8192, R, C); const int Rb = Epi::PERM ? ((R & ~31) + perm32(R & 31)) : R;
        voffA[i] = (unsigned)(R * g.lda + C) * 2u; voffB[i] = (unsigned)(Rb * g.ldb + C) * 2u; }
    const size_t kstep = (size_t)(BK * 2);
    const size_t hstepA = (size_t)HALF * g.lda * 2, hstepB = (size_t)HALF * g.ldb * 2;
    const size_t tstepA = 2 * hstepA, tstepB = 2 * hstepB;
    const unsigned ldsw = (unsigned)wid * 1024u;
    const int aoff = lds_byte(wr * 64 + fr, fq * 8), boff = lds_byte(wc * 32 + fr, fq * 8);
#define PG8_SA(b, h) (((b) * 2 + (h)) * HTB)
#define PG8_SB(b, h) ((4 + (b) * 2 + (h)) * HTB)
#define PG8_STAGE(bufoff, gbase, voff) do { _Pragma("unroll") for (int _i = 0; _i < 2; ++_i) \
        __builtin_amdgcn_global_load_lds((const unsigned*)((const char*)(gbase) + (voff)[_i]), (LAS unsigned*)(lds + (bufoff) + ldsw + _i * 8192), 16, 0, 0); } while (0)
#define PG8_LDA(dst, b, h) do { _Pragma("unroll") for (int m = 0; m < 4; ++m) _Pragma("unroll") for (int k = 0; k < 2; ++k) dst[m][k] = *(const LAS bf16x8*)(lds + PG8_SA(b, h) + aoff + m * 2048 + k * 1024); } while (0)
#define PG8_LDB(dst, b, h) do { _Pragma("unroll") for (int n = 0; n < 2; ++n) _Pragma("unroll") for (int k = 0; k < 2; ++k) dst[n][k] = *(const LAS bf16x8*)(lds + PG8_SB(b, h) + boff + n * 2048 + k * 1024); } while (0)
#define PG8_MMA(ai, bj, At, Bt) do { __builtin_amdgcn_s_setprio(1); _Pragma("unroll") for (int m = 0; m < 4; ++m) _Pragma("unroll") for (int n = 0; n < 2; ++n) _Pragma("unroll") for (int k = 0; k < 2; ++k) \
        acc[ai][bj][m][n] = __builtin_amdgcn_mfma_f32_16x16x32_bf16(Bt[n][k], At[m][k], acc[ai][bj][m][n], 0, 0, 0); __builtin_amdgcn_s_setprio(0); } while (0)
#define PG8_WAIT_V(n) asm volatile("s_waitcnt vmcnt(" #n ")" ::: "memory")
#define PG8_WAIT_L(n) asm volatile("s_waitcnt lgkmcnt(" #n ")" ::: "memory")
#define PG8_BAR __builtin_amdgcn_s_barrier()
#define PG8_SCHED __builtin_amdgcn_sched_barrier(0)
    Unit cur, nxt; int ui = 0;
    if (!S.next(0, cur)) return;
    f32x4 acc[2][2][4][2];
#pragma unroll
    for (int a = 0; a < 2; ++a)
#pragma unroll
        for (int b = 0; b < 2; ++b)
#pragma unroll
            for (int m = 0; m < 4; ++m)
#pragma unroll
                for (int n = 0; n < 2; ++n) acc[a][b][m][n] = (f32x4){0.f, 0.f, 0.f, 0.f};
    bf16x8 At[4][2], B0[2][2], B1[2][2];
    const char* cA = (const char*)g.A + (size_t)cur.pm * tstepA; const char* cB = (const char*)g.Bt + (size_t)cur.pn * tstepB;
    PG8_STAGE(PG8_SB(0, 0), cB, voffB); PG8_STAGE(PG8_SB(0, 1), cB + hstepB, voffB); PG8_STAGE(PG8_SA(0, 0), cA, voffA); PG8_STAGE(PG8_SA(0, 1), cA + hstepA, voffA);
    if (wr == 1) PG8_BAR;
    PG8_WAIT_V(2); PG8_BAR;
    PG8_STAGE(PG8_SB(1, 0), cB + kstep, voffB); PG8_STAGE(PG8_SA(1, 0), cA + kstep, voffA); PG8_STAGE(PG8_SB(1, 1), cB + hstepB + kstep, voffB);
    PG8_WAIT_V(6); PG8_BAR;
    for (;;) {
        const bool has_next = S.next(ui + 1, nxt);
        const char* nA = has_next ? (const char*)g.A + (size_t)nxt.pm * tstepA : cA; const char* nB = has_next ? (const char*)g.Bt + (size_t)nxt.pn * tstepB : cB;
        const int nt = S.unit_nt(cur, nt_full);
        for (int t = 0; t < nt; t += 2) {
            const bool last = (t == nt - 2);
            const char* a1 = cA + (size_t)(t + 1) * kstep;
            const char* a2 = last ? nA : cA + (size_t)(t + 2) * kstep; const char* b2 = last ? nB : cB + (size_t)(t + 2) * kstep;
            const char* a3 = a2 + kstep; const char* b3 = b2 + kstep;
            PG8_LDB(B0, 0, 0); PG8_LDB(B1, 0, 1); PG8_SCHED; PG8_LDA(At, 0, 0); PG8_STAGE(PG8_SA(1, 1), a1 + hstepA, voffA);
            PG8_WAIT_V(8); PG8_WAIT_L(0); PG8_BAR; PG8_MMA(0, 0, At, B0); PG8_MMA(0, 1, At, B1); PG8_BAR; PG8_SCHED;
            PG8_LDA(At, 0, 1); PG8_STAGE(PG8_SB(0, 0), b2, voffB); PG8_STAGE(PG8_SB(0, 1), b2 + hstepB, voffB); PG8_STAGE(PG8_SA(0, 0), a2, voffA);
            PG8_WAIT_V(8); PG8_WAIT_L(0); PG8_BAR; PG8_MMA(1, 0, At, B0); PG8_MMA(1, 1, At, B1); PG8_BAR; PG8_SCHED;
            PG8_LDB(B0, 1, 0); PG8_LDB(B1, 1, 1); PG8_SCHED; PG8_LDA(At, 1, 0); PG8_STAGE(PG8_SA(0, 1), a2 + hstepA, voffA);
            PG8_WAIT_V(8); PG8_WAIT_L(0); PG8_BAR; PG8_MMA(0, 0, At, B0); PG8_MMA(0, 1, At, B1); PG8_BAR; PG8_SCHED;
            PG8_LDA(At, 1, 1); PG8_STAGE(PG8_SB(1, 0), b3, voffB); PG8_STAGE(PG8_SB(1, 1), b3 + hstepB, voffB); PG8_STAGE(PG8_SA(1, 0), a3, voffA);
            PG8_WAIT_V(8); PG8_WAIT_L(0); PG8_BAR; PG8_MMA(1, 0, At, B0); PG8_MMA(1, 1, At, B1); PG8_BAR; PG8_SCHED;
        }
        if (wr == 0) PG8_BAR;
        E(acc, cur, wr, wc, fr, fq);
        if (!has_next) break;
#pragma unroll
        for (int a = 0; a < 2; ++a)
#pragma unroll
            for (int b = 0; b < 2; ++b)
#pragma unroll
                for (int m = 0; m < 4; ++m)
#pragma unroll
                    for (int n = 0; n < 2; ++n) acc[a][b][m][n] = (f32x4){0.f, 0.f, 0.f, 0.f};
        cur = nxt; cA = nA; cB = nB; ++ui;
        if (wr == 1) PG8_BAR;
    }
    PG8_WAIT_V(0);
    PG8_BAR;
#undef PG8_SA
#undef PG8_SB
#undef PG8_STAGE
#undef PG8_LDA
#undef PG8_LDB
#undef PG8_MMA
#undef PG8_WAIT_V
#undef PG8_WAIT_L
#undef PG8_BAR
#undef PG8_SCHED
}
}
using pg8::Unit;
typedef f32x4 AccT[2][2][4][2];

__device__ __forceinline__ u32x4 pack8(f32x4 a, f32x4 b) { u32x4 w; w.x = cvt_pk_bf16(a[0], a[1]); w.y = cvt_pk_bf16(a[2], a[3]); w.z = cvt_pk_bf16(b[0], b[1]); w.w = cvt_pk_bf16(b[2], b[3]); return w; }

struct EpiSwiglu {
    static constexpr bool PERM = true;
    bf16_t* mid; const float* slotsH; bf16_t* cbuf; float* slotsC; bf16_t* krope; const float* cosT; const float* sinT;
    __device__ __forceinline__ void operator()(const AccT& acc, const Unit& u, int wr, int wc, int fr, int fq) const {
        const int row0 = u.pm * 256 + wr * 64 + fr;
        if (u.pn < 22) {
#pragma unroll
            for (int ai = 0; ai < 2; ++ai)
#pragma unroll
                for (int m = 0; m < 4; ++m) {
                    const int row = row0 + ai * 128 + m * 16; const float rs = rstd_slots16(slotsH, row);
                    f32x4 o[2];
#pragma unroll
                    for (int n = 0; n < 2; ++n)
#pragma unroll
                        for (int i = 0; i < 4; ++i) { const float gt = acc[ai][0][m][n][i] * rs, up = acc[ai][1][m][n][i] * rs; o[n][i] = gt * fsigmoid(gt) * up; }
                    *(u32x4*)(mid + (size_t)row * FF + u.pn * 128 + wc * 32 + fq * 8) = pack8(o[0], o[1]);
                }
        } else if (u.pn == 22) {
#pragma unroll
            for (int ai = 0; ai < 2; ++ai)
#pragma unroll
                for (int m = 0; m < 4; ++m) {
                    const int row = row0 + ai * 128 + m * 16; const float rs = rstd_slots16(slotsH, row);
                    float ss = 0.f;
#pragma unroll
                    for (int bj = 0; bj < 2; ++bj) { const f32x4 a = acc[ai][bj][m][0] * rs, b = acc[ai][bj][m][1] * rs;
                        ss += (a[0] * a[0] + a[1] * a[1]) + (a[2] * a[2] + a[3] * a[3]) + (b[0] * b[0] + b[1] * b[1]) + (b[2] * b[2] + b[3] * b[3]);
                        *(u32x4*)(cbuf + (size_t)row * 256 + bj * 128 + wc * 32 + fq * 8) = pack8(a, b); }
                    ss += __shfl_xor(ss, 16); ss += __shfl_xor(ss, 32);
                    if (fq == 0) slotsC[(size_t)row * 4 + wc] = ss;
                }
        } else if (wc == 0) {
#pragma unroll
            for (int ai = 0; ai < 2; ++ai)
#pragma unroll
                for (int m = 0; m < 4; ++m) {
                    const int row = row0 + ai * 128 + m * 16; const float rs = rstd_slots16(slotsH, row);
                    f32x4 o1[2], o2[2];
#pragma unroll
                    for (int n = 0; n < 2; ++n) { const f32x4 c = *(const f32x4*)(cosT + (size_t)row * 32 + fq * 8 + n * 4), s = *(const f32x4*)(sinT + (size_t)row * 32 + fq * 8 + n * 4);
                        const f32x4 x1 = acc[ai][0][m][n] * rs, x2 = acc[ai][1][m][n] * rs; o1[n] = x1 * c - x2 * s; o2[n] = x2 * c + x1 * s; }
                    *(u32x4*)(krope + (size_t)row * 64 + fq * 8) = pack8(o1[0], o1[1]);
                    *(u32x4*)(krope + (size_t)row * 64 + 32 + fq * 8) = pack8(o2[0], o2[1]);
                }
        }
    }
};
struct EpiResid {
    static constexpr bool PERM = false;
    const float* hin; float* hout; bf16_t* hb; float* slots; float alpha;
    __device__ __forceinline__ void operator()(const AccT& acc, const Unit& u, int wr, int wc, int fr, int fq) const {
        const int row0 = u.pm * 256 + wr * 64 + fr, col0 = u.pn * 256 + wc * 32 + 4 * fq;
#pragma unroll
        for (int ai = 0; ai < 2; ++ai)
#pragma unroll
            for (int m = 0; m < 4; ++m) {
                const int row = row0 + ai * 128 + m * 16; const size_t off = (size_t)row * D + col0; float ss = 0.f;
#pragma unroll
                for (int bj = 0; bj < 2; ++bj)
#pragma unroll
                    for (int n = 0; n < 2; ++n) { const size_t o2 = off + bj * 128 + n * 16; const f32x4 b = *(const f32x4*)(hin + o2); const f32x4 o = b + acc[ai][bj][m][n] * alpha;
                        *(f32x4*)(hout + o2) = o; ss += (o[0] * o[0] + o[1] * o[1]) + (o[2] * o[2] + o[3] * o[3]);
                        if (hb) { u32x2 w; w.x = cvt_pk_bf16(o[0], o[1]); w.y = cvt_pk_bf16(o[2], o[3]); *(u32x2*)(hb + o2) = w; } }
                if (slots) { ss += __shfl_xor(ss, 16); ss += __shfl_xor(ss, 32); if (fq == 0) slots[(size_t)row * 16 + u.pn * 4 + wc] = ss; }
                if (m & 1) asm volatile("" ::: "memory");
            }
    }
};
struct EpiBf16 {
    static constexpr bool PERM = true;
    bf16_t* O; int ldc;
    __device__ __forceinline__ void operator()(const AccT& acc, const Unit& u, int wr, int wc, int fr, int fq) const {
        const int row0 = u.pm * 256 + wr * 64 + fr, col0 = u.pn * 256 + wc * 32 + 8 * fq;
#pragma unroll
        for (int ai = 0; ai < 2; ++ai)
#pragma unroll
            for (int m = 0; m < 4; ++m) { bf16_t* rp = O + (size_t)(row0 + ai * 128 + m * 16) * ldc + col0;
#pragma unroll
                for (int bj = 0; bj < 2; ++bj) *(u32x4*)(rp + bj * 128) = pack8(acc[ai][bj][m][0], acc[ai][bj][m][1]); }
    }
};
struct EpiLoraDown {
    static constexpr bool PERM = true;
    bf16_t* O;
    __device__ __forceinline__ void operator()(const AccT& acc, const Unit& u, int wr, int wc, int fr, int fq) const {
        const int row0 = u.pm * 256 + wr * 64 + fr, col0 = wc * 32 + 8 * fq;
#pragma unroll
        for (int ai = 0; ai < 2; ++ai)
#pragma unroll
            for (int m = 0; m < 4; ++m) { bf16_t* rp = O + (size_t)(row0 + ai * 128 + m * 16) * 256 + col0;
                f32x4 a = acc[ai][0][m][0], b = acc[ai][0][m][1];
                if (wc < 2) {
#pragma unroll
                    for (int i = 0; i < 4; ++i) { a[i] = ftanh(a[i]); b[i] = ftanh(b[i]); } }
                *(u32x4*)(rp) = pack8(a, b);
                a = acc[ai][1][m][0]; b = acc[ai][1][m][1];
#pragma unroll
                for (int i = 0; i < 4; ++i) { a[i] = fsigmoid(a[i]); b[i] = fsigmoid(b[i]); }
                *(u32x4*)(rp + 128) = pack8(a, b); }
    }
};
struct EpiRL {
    static constexpr bool PERM = true;
    bf16_t* R; bf16_t* O;
    __device__ __forceinline__ void operator()(const AccT& acc, const Unit& u, int wr, int wc, int fr, int fq) const {
        const int row0 = u.pm * 256 + wr * 64 + fr;
        if (u.pn < 4) {
            const int col0 = u.pn * 256 + wc * 32 + 8 * fq;
#pragma unroll
            for (int ai = 0; ai < 2; ++ai)
#pragma unroll
                for (int m = 0; m < 4; ++m) { bf16_t* rp = R + (size_t)(row0 + ai * 128 + m * 16) * D + col0;
#pragma unroll
                    for (int bj = 0; bj < 2; ++bj) *(u32x4*)(rp + bj * 128) = pack8(acc[ai][bj][m][0], acc[ai][bj][m][1]); }
        } else {
            const int col0 = wc * 32 + 8 * fq;
#pragma unroll
            for (int ai = 0; ai < 2; ++ai)
#pragma unroll
                for (int m = 0; m < 4; ++m) { bf16_t* rp = O + (size_t)(row0 + ai * 128 + m * 16) * 256 + col0;
                    f32x4 a = acc[ai][0][m][0], b = acc[ai][0][m][1];
                    if (wc < 2) {
#pragma unroll
                        for (int i = 0; i < 4; ++i) { a[i] = ftanh(a[i]); b[i] = ftanh(b[i]); } }
                    *(u32x4*)(rp) = pack8(a, b);
                    a = acc[ai][1][m][0]; b = acc[ai][1][m][1];
#pragma unroll
                    for (int i = 0; i < 4; ++i) { a[i] = fsigmoid(a[i]); b[i] = fsigmoid(b[i]); }
                    *(u32x4*)(rp + 128) = pack8(a, b); }
        }
    }
};
struct EpiLoraUp {
    static constexpr bool PERM = true;
    unsigned char* wsb; const float* w0; const float* a0; int grp0; size_t goff;
    __device__ __forceinline__ void operator()(const AccT& acc, const Unit& u, int wr, int wc, int fr, int fq) const {
        const int grp = (u.pn >> 2) + grp0, colt = (u.pn & 3) * 256;
        const int row0 = u.pm * 256 + wr * 64 + fr, col0 = colt + wc * 32 + 8 * fq;
        size_t ooff = goff; if (grp == 0) ooff = A_E; if (grp == 1) ooff = A_AA;
        bf16_t* O = (bf16_t*)(wsb + ooff); const float* bias = grp == 0 ? w0 : a0;
#pragma unroll
        for (int ai = 0; ai < 2; ++ai)
#pragma unroll
            for (int m = 0; m < 4; ++m) { bf16_t* rp = O + (size_t)(row0 + ai * 128 + m * 16) * D + col0;
#pragma unroll
                for (int bj = 0; bj < 2; ++bj) { f32x4 a = acc[ai][bj][m][0], b = acc[ai][bj][m][1];
                    if (grp < 2) { const float sc = grp == 0 ? 0.6065306597126334f : 1.0f;
                        const f32x4 b0 = *(const f32x4*)(bias + col0 + bj * 128), b1 = *(const f32x4*)(bias + col0 + bj * 128 + 4);
                        a = a + b0; b = b + b1;
#pragma unroll
                        for (int i = 0; i < 4; ++i) { a[i] = sc * fsigmoid(a[i]); b[i] = sc * fsigmoid(b[i]); } }
                    *(u32x4*)(rp + bj * 128) = pack8(a, b); }
                asm volatile("" ::: "memory"); }
    }
};
struct EpiQlat {
    static constexpr bool PERM = true;
    bf16_t* O; const float* slotsH; float* slotsQ;
    __device__ __forceinline__ void operator()(const AccT& acc, const Unit& u, int wr, int wc, int fr, int fq) const {
        const int row0 = u.pm * 256 + wr * 64 + fr, col0 = u.pn * 256 + wc * 32 + 8 * fq;
#pragma unroll
        for (int ai = 0; ai < 2; ++ai)
#pragma unroll
            for (int m = 0; m < 4; ++m) { const int row = row0 + ai * 128 + m * 16; const float rs = rstd_slots16(slotsH, row); float ss = 0.f;
#pragma unroll
                for (int bj = 0; bj < 2; ++bj) { const f32x4 a = acc[ai][bj][m][0] * rs, b = acc[ai][bj][m][1] * rs;
                    ss += (a[0] * a[0] + a[1] * a[1]) + (a[2] * a[2] + a[3] * a[3]) + (b[0] * b[0] + b[1] * b[1]) + (b[2] * b[2] + b[3] * b[3]);
                    *(u32x4*)(O + (size_t)row * 512 + col0 + bj * 128) = pack8(a, b); }
                ss += __shfl_xor(ss, 16); ss += __shfl_xor(ss, 32);
                if (fq == 0) slotsQ[(size_t)row * 8 + u.pn * 4 + wc] = ss; }
    }
};
struct EpiQ {
    static constexpr bool PERM = true;
    bf16_t* qn; bf16_t* qr; const float* slotsQ; const float* cosT; const float* sinT;
    __device__ __forceinline__ void operator()(const AccT& acc, const Unit& u, int wr, int wc, int fr, int fq) const {
        const int row0 = u.pm * 256 + wr * 64 + fr;
#pragma unroll
        for (int ai = 0; ai < 2; ++ai)
#pragma unroll
            for (int m = 0; m < 4; ++m) { const int row = row0 + ai * 128 + m * 16;
                const f32x4 s0 = *(const f32x4*)(slotsQ + (size_t)row * 8), s1 = *(const f32x4*)(slotsQ + (size_t)row * 8 + 4);
                const float rs = __builtin_amdgcn_rsqf((sum4(s0) + sum4(s1)) * (1.0f / 512.0f) + RMS_EPS) * QSCALE;
                if (u.pn < 4) {
#pragma unroll
                    for (int bj = 0; bj < 2; ++bj) *(u32x4*)(qn + (size_t)row * D + u.pn * 256 + bj * 128 + wc * 32 + fq * 8) = pack8(acc[ai][bj][m][0] * rs, acc[ai][bj][m][1] * rs);
                } else {
                    const int head = 4 * (u.pn - 4) + wc; f32x4 o1[2], o2[2];
#pragma unroll
                    for (int n = 0; n < 2; ++n) { const f32x4 c = *(const f32x4*)(cosT + (size_t)row * 32 + fq * 8 + n * 4), s = *(const f32x4*)(sinT + (size_t)row * 32 + fq * 8 + n * 4);
                        const f32x4 x1 = acc[ai][0][m][n] * rs, x2 = acc[ai][1][m][n] * rs; o1[n] = x1 * c - x2 * s; o2[n] = x2 * c + x1 * s; }
                    *(u32x4*)(qr + (size_t)row * 512 + head * 64 + fq * 8) = pack8(o1[0], o1[1]);
                    *(u32x4*)(qr + (size_t)row * 512 + head * 64 + 32 + fq * 8) = pack8(o2[0], o2[1]);
                } }
    }
};
struct EpiKnope {
    static constexpr bool PERM = true;
    bf16_t* O; const float* slotsC;
    __device__ __forceinline__ void operator()(const AccT& acc, const Unit& u, int wr, int wc, int fr, int fq) const {
        const int row0 = u.pm * 256 + wr * 64 + fr, col0 = u.pn * 256 + wc * 32 + 8 * fq;
#pragma unroll
        for (int ai = 0; ai < 2; ++ai)
#pragma unroll
            for (int m = 0; m < 4; ++m) { const int row = row0 + ai * 128 + m * 16; const f32x4 s = *(const f32x4*)(slotsC + (size_t)row * 4);
                const float rs = __builtin_amdgcn_rsqf(sum4(s) * (1.0f / 256.0f) + RMS_EPS);
#pragma unroll
                for (int bj = 0; bj < 2; ++bj) *(u32x4*)(O + (size_t)row * D + col0 + bj * 128) = pack8(acc[ai][bj][m][0] * rs, acc[ai][bj][m][1] * rs); }
    }
};
struct EpiVt {
    static constexpr bool PERM = true;
    bf16_t* O; const float* slotsC;
    __device__ __forceinline__ void operator()(const AccT& acc, const Unit& u, int wr, int wc, int fr, int fq) const {
        const int row0 = u.pm * 256 + wr * 64 + fr, col0 = u.pn * 256 + wc * 32 + 8 * fq;
        f32x4 rs[2][2];
#pragma unroll
        for (int bj = 0; bj < 2; ++bj)
#pragma unroll
            for (int n = 0; n < 2; ++n)
#pragma unroll
                for (int i = 0; i < 4; ++i) { const f32x4 s = *(const f32x4*)(slotsC + (size_t)(col0 + bj * 128 + n * 4 + i) * 4); rs[bj][n][i] = __builtin_amdgcn_rsqf(sum4(s) * (1.0f / 256.0f) + RMS_EPS); }
#pragma unroll
        for (int ai = 0; ai < 2; ++ai)
#pragma unroll
            for (int m = 0; m < 4; ++m) { const int row = row0 + ai * 128 + m * 16;
#pragma unroll
                for (int bj = 0; bj < 2; ++bj) *(u32x4*)(O + (size_t)row * T + col0 + bj * 128) = pack8(acc[ai][bj][m][0] * rs[bj][0], acc[ai][bj][m][1] * rs[bj][1]); }
    }
};

struct Args { const float* in[33]; const int* pos; float* out; unsigned char* ws; int ph_lo, ph_hi; };

struct Ctx { LAS unsigned char* lds; int vcu, G, wave; };

__device__ __forceinline__ void tr_item(const float* W, int ldw, int k0, int n0, const float* s1, const float* s2, int ks0, bf16_t* Bt, int ldb, int nd0, int kd0, LAS float* scr, int lane) {
    f32x4 v[8];
#pragma unroll
    for (int i = 0; i < 8; ++i) v[i] = *(const f32x4*)(W + (size_t)(k0 + 8 * i + (lane >> 3)) * ldw + n0 + 4 * (lane & 7));
#pragma unroll
    for (int i = 0; i < 8; ++i) { const int kk = 8 * i + (lane >> 3);
        float sc = s1 ? s1[ks0 + kk] : 1.0f; if (s2) sc -= s2[ks0 + kk];
        LAS float* d = scr + kk * 33 + 4 * (lane & 7);
        d[0] = sc * v[i][0]; d[1] = sc * v[i][1]; d[2] = sc * v[i][2]; d[3] = sc * v[i][3]; }
    asm volatile("s_waitcnt lgkmcnt(0)" ::: "memory");
    const int c = lane & 7;
#pragma unroll
    for (int j = 0; j < 4; ++j) { const int n = (lane >> 3) + 8 * j; const LAS float* s = scr + (8 * c) * 33 + n;
        u32x4 o; o.x = cvt_pk_bf16(s[0 * 33], s[1 * 33]); o.y = cvt_pk_bf16(s[2 * 33], s[3 * 33]); o.z = cvt_pk_bf16(s[4 * 33], s[5 * 33]); o.w = cvt_pk_bf16(s[6 * 33], s[7 * 33]);
        *(u32x4*)(Bt + (size_t)(nd0 + n) * ldb + kd0 + 8 * c) = o; }
    asm volatile("s_waitcnt lgkmcnt(0)" ::: "memory");
}
__device__ __forceinline__ void zero_item(bf16_t* Bt, int ldb, int nd0, int kd0, int lane) {
    const int c = lane & 7;
#pragma unroll
    for (int j = 0; j < 4; ++j) { const int n = (lane >> 3) + 8 * j; *(u32x4*)(Bt + (size_t)(nd0 + n) * ldb + kd0 + 8 * c) = (u32x4){0u, 0u, 0u, 0u}; }
}

__device__ __forceinline__ void p0_prologue(const Ctx& F, const Args& a) {
    unsigned char* ws = a.ws;
    const int tid = fresh_tid(F.wave), lane = tid & 63, wave = __builtin_amdgcn_readfirstlane(tid >> 6);
    LAS float* scr = (LAS float*)(F.lds + wave * 16384);
    const int gw = F.vcu * 8 + wave, NGW = F.G * 8;
    const float* norm_g = a.in[2];
    constexpr int I_UG = 16 * 176, I_UGX = 16 * 16, I_DN = 44 * 32, I_SQ = 16 * 32, I_LD = 32 * 8, I_LU = 4 * 96, I_KN = 4 * 32, I_DQ = 16 * 16, I_UQ = 8 * 48;
    constexpr int NITEMS = 4 * I_UG + I_UGX + 4 * I_DN + 4 * I_SQ + I_LD + I_LU + 2 * I_KN + I_DQ + I_UQ + I_SQ;
    for (int it = gw; it < NITEMS; it += NGW) {
        int r = it;
        if (r < 4 * I_UG) { const int q = r / I_UG; r -= q * I_UG; const int l = q >> 1, s = q & 1; const int kb = r / 176, nb = r % 176, pn = nb >> 3, jb = nb & 7;
            const float* src = (jb < 4 ? a.in[3] : a.in[4]) + (size_t)q * D * FF;
            tr_item(src, FF, 64 * kb, 128 * pn + 32 * (jb & 3), norm_g + (l * 3 + (s ? 2 : 0)) * D, nullptr, 64 * kb, (bf16_t*)(ws + W_UG) + (size_t)q * 6144 * D, D, 32 * nb, 64 * kb, scr, lane); continue; }
        r -= 4 * I_UG;
        if (r < I_UGX) { const int kb = r / 16, nb = r % 16; bf16_t* Bt = (bf16_t*)(ws + W_UG) + (size_t)2 * 6144 * D;
            int sc = -1; if (nb < 8) sc = 32 * nb; else if (nb == 8) sc = 256; else if (nb == 12) sc = 288;
            if (sc >= 0) tr_item(a.in[25], 320, 64 * kb, sc, a.in[24], nullptr, 64 * kb, Bt, D, 5632 + 32 * nb, 64 * kb, scr, lane); else zero_item(Bt, D, 5632 + 32 * nb, 64 * kb, lane); continue; }
        r -= I_UGX;
        if (r < 4 * I_DN) { const int q = r / I_DN; r -= q * I_DN; const int kb = r / 32, nb = r % 32;
            tr_item(a.in[5] + (size_t)q * FF * D, D, 64 * kb, 32 * nb, nullptr, nullptr, 0, (bf16_t*)(ws + W_DN) + (size_t)q * D * FF, FF, 32 * nb, 64 * kb, scr, lane); continue; }
        r -= 4 * I_DN;
        if (r < 4 * I_SQ) { const int q = r / I_SQ; r -= q * I_SQ; const int kb = r / 32, nb = r % 32;
            if (q == 0) { tr_item(a.in[7], D, 64 * kb, 32 * nb, nullptr, nullptr, 0, (bf16_t*)(ws + W_RL), 2048, 32 * nb, 64 * kb, scr, lane); zero_item((bf16_t*)(ws + W_RL), 2048, 32 * nb, 1024 + 64 * kb, lane); }
            else tr_item(a.in[7 + q], D, 64 * kb, 32 * nb, nullptr, nullptr, 0, (bf16_t*)(ws + W_R + (size_t)q * 2 * MiB), D, 32 * nb, 64 * kb, scr, lane);
            continue; }
        r -= 4 * I_SQ;
        if (r < I_LD) { const int kb = r / 8, nb = r % 8; const int kk0 = 64 * (kb & 15); const bool second = kb >= 16;
            const float* src; int ldw, nc, mi; if (nb < 2) { src = a.in[12]; ldw = 64; nc = 32 * nb; mi = 1; } else if (nb < 4) { src = a.in[15]; ldw = 64; nc = 32 * (nb - 2); mi = 4; } else { src = a.in[17]; ldw = 128; nc = 32 * (nb - 4); mi = 5; }
            tr_item(src, ldw, kk0, nc, second ? a.in[6] + mi * D : nullptr, second ? a.in[6] : nullptr, kk0, (bf16_t*)(ws + W_RL), 2048, 1024 + 32 * nb, 64 * kb, scr, lane); continue; }
        r -= I_LD;
        if (r < I_LU) { const int kb = r / 96, nb = r % 96; const int grp = nb / 32, nc = 32 * (nb % 32); bf16_t* Bt = (bf16_t*)(ws + W_LU);
            if (grp == 0) { if (kb == 0) tr_item(a.in[13], D, 0, nc, nullptr, nullptr, 0, Bt, 256, 32 * nb, 0, scr, lane); else zero_item(Bt, 256, 32 * nb, 64 * kb, lane); }
            else if (grp == 1) { if (kb == 1) tr_item(a.in[16], D, 0, nc, nullptr, nullptr, 0, Bt, 256, 32 * nb, 64, scr, lane); else zero_item(Bt, 256, 32 * nb, 64 * kb, lane); }
            else { if (kb >= 2) tr_item(a.in[18], D, 64 * (kb - 2), nc, nullptr, nullptr, 0, Bt, 256, 32 * nb, 64 * kb, scr, lane); else zero_item(Bt, 256, 32 * nb, 64 * kb, lane); }
            continue; }
        r -= I_LU;
        if (r < 2 * I_KN) { const int q = r / I_KN; r -= q * I_KN; const int kb = r / 32, nb = r % 32;
            const int n0 = 32 * nb, sc = (n0 >> 7) * 256 + (n0 & 127) + q * 128;
            tr_item(a.in[27], 2048, 64 * kb, sc, a.in[26], nullptr, 64 * kb, (bf16_t*)(ws + (q ? W_VT : W_KN)), 256, n0, 64 * kb, scr, lane); continue; }
        r -= 2 * I_KN;
        if (r < I_DQ) { const int kb = r / 16, nb = r % 16;
            tr_item(a.in[28], 512, 64 * kb, 32 * nb, norm_g + (1 * 3 + 1) * D, nullptr, 64 * kb, (bf16_t*)(ws + W_DQ), D, 32 * nb, 64 * kb, scr, lane); continue; }
        r -= I_DQ;
        if (r < I_UQ) { const int kb = r / 48, nb = r % 48; int sc;
            if (nb < 32) { const int n0 = 32 * nb; sc = (n0 >> 7) * 192 + (n0 & 127); }
            else { const int t2 = (nb - 32) >> 3, jj = (nb - 32) & 7, half = jj >> 2, hh = jj & 3; sc = (4 * t2 + hh) * 192 + 128 + 32 * half; }
            tr_item(a.in[30], 1536, 64 * kb, sc, a.in[29], nullptr, 64 * kb, (bf16_t*)(ws + W_UQ), 512, 32 * nb, 64 * kb, scr, lane); continue; }
        r -= I_UQ;
        { const int kb = r / 32, nb = r % 32; tr_item(a.in[31], D, 64 * kb, 32 * nb, nullptr, nullptr, 0, (bf16_t*)(ws + W_MO), D, 32 * nb, 64 * kb, scr, lane); }
    }
    const float* x = a.in[0]; bf16_t* hb = (bf16_t*)(ws + A_HB); float* slotsH = (float*)(ws + WS_SLOTH);
    for (int m = gw; m < T; m += NGW) {
        const f32x4* xr = (const f32x4*)(x + (size_t)m * D) + lane; float ss = 0.f;
#pragma unroll
        for (int j = 0; j < 4; ++j) { const f32x4 v = xr[64 * j]; ss += (v[0] * v[0] + v[1] * v[1]) + (v[2] * v[2] + v[3] * v[3]);
            u32x2 w; w.x = cvt_pk_bf16(v[0], v[1]); w.y = cvt_pk_bf16(v[2], v[3]); *((u32x2*)(hb + (size_t)m * D) + lane + 64 * j) = w; }
        ss = wave_sum(ss);
        if (lane < 16) slotsH[(size_t)m * 16 + lane] = lane == 0 ? ss : 0.f;
    }
    float* cosT = (float*)(ws + A_COS); float* sinT = (float*)(ws + A_SIN);
    for (int i = (F.vcu * 512 + tid); i < T * 32; i += F.G * 512) {
        const int tok = i >> 5, j = i & 31;
        const float inv = exp2f(-(float)j * (13.287712379549449f / 32.0f));
        const float ang = (float)a.pos[tok] * inv;
        const double rev = (double)ang * 0.15915494309189535; const float fr = (float)(rev - floor(rev));
        cosT[i] = __builtin_amdgcn_cosf(fr); sinT[i] = __builtin_amdgcn_sinf(fr);
    }
}

__device__ __forceinline__ void p_premix(const Ctx& F, const Args& a) {
    const float* h = a.out; const float* g = a.in[2] + 1 * D; const float* mix = a.in[6];
    bf16_t* X1 = (bf16_t*)(a.ws + A_X1); bf16_t* XK = (bf16_t*)(a.ws + A_XK); bf16_t* XV = (bf16_t*)(a.ws + A_XV);
    const int tid = fresh_tid(F.wave), lane = tid & 63, wave = __builtin_amdgcn_readfirstlane(tid >> 6);
    const int gw = F.vcu * 8 + wave, NGW = F.G * 8;
    for (int ch = gw; ch < T / 16; ch += NGW) {
        const int t0 = ch * 16;
        f32x4 prev[4], gv[4];
#pragma unroll
        for (int j = 0; j < 4; ++j) gv[j] = *((const f32x4*)g + lane + 64 * j);
        if ((t0 & (SEQ - 1)) == 0) {
#pragma unroll
            for (int j = 0; j < 4; ++j) prev[j] = (f32x4){0.f, 0.f, 0.f, 0.f};
        } else {
            float ss = 0.f;
#pragma unroll
            for (int j = 0; j < 4; ++j) { prev[j] = *((const f32x4*)(h + (size_t)(t0 - 1) * D) + lane + 64 * j); ss += (prev[j][0] * prev[j][0] + prev[j][1] * prev[j][1]) + (prev[j][2] * prev[j][2] + prev[j][3] * prev[j][3]); }
            const float rs = __builtin_amdgcn_rsqf(wave_sum(ss) * (1.0f / 1024.0f) + RMS_EPS);
#pragma unroll
            for (int j = 0; j < 4; ++j) prev[j] = prev[j] * rs * gv[j];
        }
        for (int t = t0; t < t0 + 16; ++t) {
            f32x4 cur[4]; float ss = 0.f;
#pragma unroll
            for (int j = 0; j < 4; ++j) { cur[j] = *((const f32x4*)(h + (size_t)t * D) + lane + 64 * j); ss += (cur[j][0] * cur[j][0] + cur[j][1] * cur[j][1]) + (cur[j][2] * cur[j][2] + cur[j][3] * cur[j][3]); }
            const float rs = __builtin_amdgcn_rsqf(wave_sum(ss) * (1.0f / 1024.0f) + RMS_EPS);
#pragma unroll
            for (int j = 0; j < 4; ++j) {
                const f32x4 hn = cur[j] * rs * gv[j]; const f32x4 xx = prev[j] - hn; prev[j] = hn;
                const f32x4 mr = *((const f32x4*)(mix + 0 * D) + lane + 64 * j), mk = *((const f32x4*)(mix + 2 * D) + lane + 64 * j), mv = *((const f32x4*)(mix + 3 * D) + lane + 64 * j);
                const f32x4 xr = hn + xx * mr, xk = hn + xx * mk, xv = hn + xx * mv;
                u32x2 w;
                w.x = cvt_pk_bf16(xr[0], xr[1]); w.y = cvt_pk_bf16(xr[2], xr[3]); *((u32x2*)(X1 + (size_t)t * 2048) + lane + 64 * j) = w;
                w.x = cvt_pk_bf16(xx[0], xx[1]); w.y = cvt_pk_bf16(xx[2], xx[3]); *((u32x2*)(X1 + (size_t)t * 2048 + 1024) + lane + 64 * j) = w;
                w.x = cvt_pk_bf16(xk[0], xk[1]); w.y = cvt_pk_bf16(xk[2], xk[3]); *((u32x2*)(XK + (size_t)t * D) + lane + 64 * j) = w;
                w.x = cvt_pk_bf16(xv[0], xv[1]); w.y = cvt_pk_bf16(xv[2], xv[3]); *((u32x2*)(XV + (size_t)t * D) + lane + 64 * j) = w;
            }
        }
    }
}

constexpr int TC = 32;
__device__ __forceinline__ void p_scan(const Ctx& F, const Args& a) {
    const bf16_t* Rb = (const bf16_t*)(a.ws + A_R); const bf16_t* Kb = (const bf16_t*)(a.ws + A_KK); const bf16_t* Vb = (const bf16_t*)(a.ws + A_VV);
    const bf16_t* Eb = (const bf16_t*)(a.ws + A_E); const bf16_t* Ab = (const bf16_t*)(a.ws + A_AA); bf16_t* Gb = (bf16_t*)(a.ws + A_G);
    const float* k_k = a.in[19]; const float* k_a = a.in[20]; const float* r_k = a.in[21]; const float* gn_w = a.in[22]; const float* gn_b = a.in[23];
    LAS float* sR = (LAS float*)(F.lds); LAS float* sW = sR + TC * 64; LAS float* sK = sW + TC * 64; LAS float* sV = sK + TC * 64;
    LAS float* sKK = sV + TC * 64; LAS float* sKA = sKK + TC * 64; LAS float* sY = sKA + TC * 64; LAS float* sBo = sY + TC * 64;
    const int tid = fresh_tid(F.wave), lane = tid & 63, wave = __builtin_amdgcn_readfirstlane(tid >> 6);
    const int irow = wave * 8 + (lane >> 3), kseg = (lane & 7) * 8;
    const int ptt = tid >> 4, pc = (tid & 15) * 4;
    for (int unit0 = F.vcu; unit0 < 2 * NB * 16; unit0 += F.G) {
        const int unit = unit0 & 127; const bool shadow = unit0 >= 128;
        const int b = unit >> 4, hd = unit & 15; const int cbase = hd * 64;
        float S[8];
#pragma unroll
        for (int j = 0; j < 8; ++j) S[j] = 0.f;
        const f32x4 kkv = *(const f32x4*)(k_k + cbase + pc), kav = *(const f32x4*)(k_a + cbase + pc), rkv = *(const f32x4*)(r_k + cbase + pc);
        const f32x4 gw = *(const f32x4*)(gn_w + cbase + pc), gb = *(const f32x4*)(gn_b + cbase + pc);
        for (int c0 = 0; c0 < SEQ; c0 += TC) {
            const size_t gidx = (size_t)(b * SEQ + c0 + ptt) * D + cbase + pc;
            {
                const f32x4 r = unpack4(*(const u32x2*)(Rb + gidx)), k = unpack4(*(const u32x2*)(Kb + gidx)), v = unpack4(*(const u32x2*)(Vb + gidx));
                const f32x4 e = unpack4(*(const u32x2*)(Eb + gidx)), aa = unpack4(*(const u32x2*)(Ab + gidx));
                f32x4 kk = k * kkv; float ss = (kk[0] * kk[0] + kk[1] * kk[1]) + (kk[2] * kk[2] + kk[3] * kk[3]); ss = red16(ss);
                kk = kk * __builtin_amdgcn_rsqf(fmaxf(ss, 1e-24f));
                const f32x4 kp = k * (1.0f + (aa - 1.0f) * kav);
                const f32x4 rk = r * kp * rkv; const float bo = red16((rk[0] + rk[1]) + (rk[2] + rk[3]));
                f32x4 w;
#pragma unroll
                for (int i = 0; i < 4; ++i) w[i] = __builtin_amdgcn_exp2f(-e[i] * LOG2E);
                const int o = ptt * 64 + pc;
                *(LAS f32x4*)(sR + o) = r; *(LAS f32x4*)(sW + o) = w; *(LAS f32x4*)(sK + o) = kp; *(LAS f32x4*)(sV + o) = v; *(LAS f32x4*)(sKK + o) = kk; *(LAS f32x4*)(sKA + o) = kk * aa;
                if ((tid & 15) == 0) sBo[ptt] = bo;
            }
            __syncthreads();
#pragma unroll 2
            for (int t = 0; t < TC; ++t) {
                const int o = t * 64 + kseg;
                const f32x4 kk0 = *(const LAS f32x4*)(sKK + o), kk1 = *(const LAS f32x4*)(sKK + o + 4);
                const f32x4 w0 = *(const LAS f32x4*)(sW + o), w1 = *(const LAS f32x4*)(sW + o + 4);
                const f32x4 ka0 = *(const LAS f32x4*)(sKA + o), ka1 = *(const LAS f32x4*)(sKA + o + 4);
                const f32x4 kp0 = *(const LAS f32x4*)(sK + o), kp1 = *(const LAS f32x4*)(sK + o + 4);
                const f32x4 r0 = *(const LAS f32x4*)(sR + o), r1 = *(const LAS f32x4*)(sR + o + 4);
                const float vv = sV[t * 64 + irow];
                float sa = ((S[0] * kk0[0] + S[1] * kk0[1]) + (S[2] * kk0[2] + S[3] * kk0[3])) + ((S[4] * kk1[0] + S[5] * kk1[1]) + (S[6] * kk1[2] + S[7] * kk1[3]));
                sa = red8(sa);
#pragma unroll
                for (int j = 0; j < 4; ++j) { S[j] = S[j] * w0[j] + (vv * kp0[j] - sa * ka0[j]); S[4 + j] = S[4 + j] * w1[j] + (vv * kp1[j] - sa * ka1[j]); }
                float y = ((S[0] * r0[0] + S[1] * r0[1]) + (S[2] * r0[2] + S[3] * r0[3])) + ((S[4] * r1[0] + S[5] * r1[1]) + (S[6] * r1[2] + S[7] * r1[3]));
                y = red8(y);
                if ((lane & 7) == 0) sY[t * 64 + irow] = y;
            }
            __syncthreads();
            {
                const int o = ptt * 64 + pc;
                const f32x4 y = *(const LAS f32x4*)(sY + o), v = *(const LAS f32x4*)(sV + o);
                const float mu = red16((y[0] + y[1]) + (y[2] + y[3])) * (1.0f / 64.0f);
                const f32x4 d = y - mu; const float var = red16((d[0] * d[0] + d[1] * d[1]) + (d[2] * d[2] + d[3] * d[3])) * (1.0f / 64.0f);
                const float rs = __builtin_amdgcn_rsqf(var + GN_EPS); const float bo = sBo[ptt];
                const f32x4 gg = unpack4(*(const u32x2*)(Gb + gidx));
                const f32x4 ov = (d * rs * gw + gb + v * bo) * gg;
                u32x2 w; w.x = cvt_pk_bf16(ov[0], ov[1]); w.y = cvt_pk_bf16(ov[2], ov[3]); if (!shadow) *(u32x2*)(Gb + gidx) = w;
            }
            __syncthreads();
        }
    }
}


__device__ __forceinline__ void p_scan2(const Ctx& F, const Args& a) {
    const bf16_t* Rb = (const bf16_t*)(a.ws + A_R); const bf16_t* Kb = (const bf16_t*)(a.ws + A_KK); const bf16_t* Vb = (const bf16_t*)(a.ws + A_VV);
    const bf16_t* Eb = (const bf16_t*)(a.ws + A_E); const bf16_t* Ab = (const bf16_t*)(a.ws + A_AA); bf16_t* Yb = (bf16_t*)(a.ws + A_G); float* Bon = (float*)(a.ws + A_BON);
    const float* k_k = a.in[19]; const float* k_a = a.in[20]; const float* r_k = a.in[21];
    LAS float* sR = (LAS float*)(F.lds); LAS float* sW = sR + TC * 64; LAS float* sK = sW + TC * 64; LAS float* sV = sK + TC * 64;
    LAS float* sKK = sV + TC * 64; LAS float* sKA = sKK + TC * 64; LAS float* sY = sKA + TC * 64;
    const int tid = fresh_tid(F.wave), lane = tid & 63, wave = __builtin_amdgcn_readfirstlane(tid >> 6);
    const int lrow = wave * 8 + (lane >> 3), kseg = (lane & 7) * 8;
    const int ptt = tid >> 4, pc = (tid & 15) * 4;
    for (int unit = F.vcu; unit < 2 * NB * 16; unit += F.G) {
        const int bh = unit >> 1, half = unit & 1, b = bh >> 4, hd = bh & 15, cbase = hd * 64;
        f32x4 S0 = (f32x4){0.f, 0.f, 0.f, 0.f}, S1 = (f32x4){0.f, 0.f, 0.f, 0.f};
        const f32x4 kkv = *(const f32x4*)(k_k + cbase + pc), kav = *(const f32x4*)(k_a + cbase + pc), rkv = *(const f32x4*)(r_k + cbase + pc);
        size_t gidx = (size_t)(b * SEQ + ptt) * D + cbase + pc;
        u32x2 qr = *(const u32x2*)(Rb + gidx), qk = *(const u32x2*)(Kb + gidx), qv = *(const u32x2*)(Vb + gidx), qe = *(const u32x2*)(Eb + gidx), qa = *(const u32x2*)(Ab + gidx);
        for (int c0 = 0; c0 < SEQ; c0 += TC) {
            {
                const f32x4 r = unpack4(qr), k = unpack4(qk), v = unpack4(qv), e = unpack4(qe), aa = unpack4(qa);
                f32x4 kk = k * kkv; float ss = (kk[0] * kk[0] + kk[1] * kk[1]) + (kk[2] * kk[2] + kk[3] * kk[3]); ss = red16(ss);
                kk = kk * __builtin_amdgcn_rsqf(fmaxf(ss, 1e-24f));
                const f32x4 kp = k * (1.0f + (aa - 1.0f) * kav);
                const f32x4 rk = r * kp * rkv; const float bo = red16((rk[0] + rk[1]) + (rk[2] + rk[3]));
                f32x4 w;
#pragma unroll
                for (int i = 0; i < 4; ++i) w[i] = __builtin_amdgcn_exp2f(-e[i] * LOG2E);
                const int o = ptt * 64 + pc;
                *(LAS f32x4*)(sR + o) = r; *(LAS f32x4*)(sW + o) = w; *(LAS f32x4*)(sK + o) = kp; *(LAS f32x4*)(sV + o) = v; *(LAS f32x4*)(sKK + o) = kk; *(LAS f32x4*)(sKA + o) = kk * aa;
                if (half == 0 && (tid & 15) == 0) Bon[(size_t)(b * SEQ + c0 + ptt) * 16 + hd] = bo;
            }
            __syncthreads();
            if (c0 + TC < SEQ) { gidx += (size_t)TC * D;
                qr = *(const u32x2*)(Rb + gidx); qk = *(const u32x2*)(Kb + gidx); qv = *(const u32x2*)(Vb + gidx); qe = *(const u32x2*)(Eb + gidx); qa = *(const u32x2*)(Ab + gidx); }
            if (wave < 4) {
#define SCAN_LD(P, tt) { const int o_ = (tt) * 64 + kseg; \
                kk0##P = *(const LAS f32x4*)(sKK + o_); kk1##P = *(const LAS f32x4*)(sKK + o_ + 4); w0##P = *(const LAS f32x4*)(sW + o_); w1##P = *(const LAS f32x4*)(sW + o_ + 4); \
                ka0##P = *(const LAS f32x4*)(sKA + o_); ka1##P = *(const LAS f32x4*)(sKA + o_ + 4); kp0##P = *(const LAS f32x4*)(sK + o_); kp1##P = *(const LAS f32x4*)(sK + o_ + 4); \
                r0##P = *(const LAS f32x4*)(sR + o_); r1##P = *(const LAS f32x4*)(sR + o_ + 4); vv##P = sV[(tt) * 64 + half * 32 + lrow]; }
#define SCAN_STEP(P, tt) { f32x4 p4 = S0 * kk0##P; p4 = S1 * kk1##P + p4; const float sa = red8((p4[0] + p4[1]) + (p4[2] + p4[3])); \
                S0 = S0 * w0##P + (kp0##P * vv##P - ka0##P * sa); S1 = S1 * w1##P + (kp1##P * vv##P - ka1##P * sa); \
                f32x4 y4 = S0 * r0##P; y4 = S1 * r1##P + y4; sY[(tt) * 256 + tid] = (y4[0] + y4[1]) + (y4[2] + y4[3]); }
                f32x4 kk0A, kk1A, w0A, w1A, ka0A, ka1A, kp0A, kp1A, r0A, r1A; float vvA;
                f32x4 kk0B, kk1B, w0B, w1B, ka0B, ka1B, kp0B, kp1B, r0B, r1B; float vvB;
                SCAN_LD(A, 0)
#pragma unroll 2
                for (int t = 0; t < TC; t += 2) {
                    SCAN_LD(B, t + 1)
                    SCAN_STEP(A, t)
                    SCAN_LD(A, (t + 2 < TC) ? t + 2 : t)
                    SCAN_STEP(B, t + 1)
                }
#undef SCAN_LD
#undef SCAN_STEP
            }
            __syncthreads();
            {
                const int tok = tid >> 4, r2 = (tid & 15) * 2;
                const LAS f32x4* q = (const LAS f32x4*)(sY + tok * 256 + r2 * 8);
                const f32x4 s0 = q[0] + q[1], s1 = q[2] + q[3];
                *(unsigned*)(Yb + (size_t)(b * SEQ + c0 + tok) * D + cbase + half * 32 + r2) = cvt_pk_bf16((s0[0] + s0[1]) + (s0[2] + s0[3]), (s1[0] + s1[1]) + (s1[2] + s1[3]));
            }
        }
        __syncthreads();
    }
}
__device__ __forceinline__ void p_post(const Ctx& F, const Args& a) {
    bf16_t* Yb = (bf16_t*)(a.ws + A_G); const bf16_t* Vb = (const bf16_t*)(a.ws + A_VV); const bf16_t* Gg = (const bf16_t*)(a.ws + A_E); const float* Bon = (const float*)(a.ws + A_BON);
    const float* gn_w = a.in[22]; const float* gn_b = a.in[23];
    const int tid = fresh_tid(F.wave), grp = tid >> 4, gl = tid & 15;
    for (int item = F.vcu * 32 + grp; item < T * 16; item += F.G * 32) {
        const int tok = item >> 4, hd = item & 15; const size_t idx = (size_t)tok * D + hd * 64 + 4 * gl;
        const f32x4 y = unpack4(*(const u32x2*)(Yb + idx)), v = unpack4(*(const u32x2*)(Vb + idx)), g = unpack4(*(const u32x2*)(Gg + idx));
        const float bo = Bon[(size_t)tok * 16 + hd];
        const f32x4 gw = *(const f32x4*)(gn_w + hd * 64 + 4 * gl), gb = *(const f32x4*)(gn_b + hd * 64 + 4 * gl);
        const float mu = red16((y[0] + y[1]) + (y[2] + y[3])) * (1.0f / 64.0f);
        const f32x4 d = y - mu; const float var = red16((d[0] * d[0] + d[1] * d[1]) + (d[2] * d[2] + d[3] * d[3])) * (1.0f / 64.0f);
        const float rs = __builtin_amdgcn_rsqf(var + GN_EPS);
        const f32x4 ov = (d * rs * gw + gb + v * bo) * g;
        u32x2 w; w.x = cvt_pk_bf16(ov[0], ov[1]); w.y = cvt_pk_bf16(ov[2], ov[3]); *(u32x2*)(Yb + idx) = w;
    }
}

constexpr int KROW = 400, VROW = 144, KBUF = 64 * KROW, VBUF = 128 * VROW, ABUF = KBUF + VBUF;
__device__ __forceinline__ void attn_unit(LAS unsigned char* lds, const bf16_t* qn, const bf16_t* qr, const bf16_t* kn, const bf16_t* kr, const bf16_t* vt, bf16_t* o_out, int b, int h, int qb, int wave_s) {
    const int tid = fresh_tid(wave_s), lane = tid & 63, wid = __builtin_amdgcn_readfirstlane(tid >> 6), r32 = lane & 31, hi = lane >> 5;
    const int tok0 = b * SEQ, q0 = qb * 256 + wid * 32;
    bf16x8 qf[12];
    { const size_t tq = (size_t)(tok0 + q0 + r32);
#pragma unroll
      for (int d = 0; d < 8; ++d) qf[d] = *(const bf16x8*)(qn + tq * D + h * 128 + d * 16 + hi * 8);
#pragma unroll
      for (int d = 0; d < 4; ++d) qf[8 + d] = *(const bf16x8*)(qr + tq * 512 + h * 64 + d * 16 + hi * 8); }
    const int NT = (qb + 1) * 4;
    const int kkey0 = tid >> 4, kch0 = tid & 15;
    const int rkey = tid >> 3, rch = tid & 7;
    const int vrow0 = tid >> 3, vch = tid & 7;
    const bf16_t* gk0 = kn + (size_t)(tok0 + kkey0) * D + h * 128 + kch0 * 8;
    const bf16_t* gk1 = gk0 + (size_t)32 * D;
    const bf16_t* gr = kr + (size_t)(tok0 + rkey) * 64 + rch * 8;
    const bf16_t* gv0 = vt + (size_t)(h * 128 + vrow0) * T + tok0 + vch * 8;
    const bf16_t* gv1 = gv0 + (size_t)64 * T;
    const int lk0 = kkey0 * KROW + kch0 * 16, lk1 = lk0 + 32 * KROW, lr = rkey * KROW + 256 + rch * 16, lv0 = KBUF + vrow0 * VROW + vch * 16, lv1 = lv0 + 64 * VROW;
    const int pr = (r32 & 0x13) | ((r32 & 4) << 1) | ((r32 & 8) >> 1);
    const int kfo = pr * KROW + hi * 16, vfo = KBUF + r32 * VROW + hi * 16;
    u32x4 ld0, ld1, ld2, ld3, ld4;
    ld0 = *(const u32x4*)gk0; ld1 = *(const u32x4*)gk1; ld2 = *(const u32x4*)gr; ld3 = *(const u32x4*)gv0; ld4 = *(const u32x4*)gv1;
    __syncthreads();
    *(LAS u32x4*)(lds + lk0) = ld0; *(LAS u32x4*)(lds + lk1) = ld1; *(LAS u32x4*)(lds + lr) = ld2; *(LAS u32x4*)(lds + lv0) = ld3; *(LAS u32x4*)(lds + lv1) = ld4;
    __syncthreads();
    float mrun = -1e30f, lrun = 0.f;
    f32x16 o[4];
#pragma unroll
    for (int d = 0; d < 4; ++d) o[d] = f32x16{};
    for (int t = 0; t < NT; ++t) {
        const int cb = (t & 1) * ABUF, nb = ((t + 1) & 1) * ABUF;
        const bool more = (t + 1 < NT);
        if (more) { const size_t ko = (size_t)(t + 1) * 64 * D, ro = (size_t)(t + 1) * 64 * 64, vo = (size_t)(t + 1) * 64;
            ld0 = *(const u32x4*)(gk0 + ko); ld1 = *(const u32x4*)(gk1 + ko); ld2 = *(const u32x4*)(gr + ro); ld3 = *(const u32x4*)(gv0 + vo); ld4 = *(const u32x4*)(gv1 + vo); }
        if (64 * t <= q0 + 31) {
            f32x16 s0 = f32x16{}, s1 = f32x16{};
            __builtin_amdgcn_s_setprio(1);
#pragma unroll
            for (int d = 0; d < 12; ++d) {
                const bf16x8 k0 = *(const LAS bf16x8*)(lds + cb + kfo + d * 32), k1 = *(const LAS bf16x8*)(lds + cb + kfo + 32 * KROW + d * 32);
                s0 = __builtin_amdgcn_mfma_f32_32x32x16_bf16(k0, qf[d], s0, 0, 0, 0);
                s1 = __builtin_amdgcn_mfma_f32_32x32x16_bf16(k1, qf[d], s1, 0, 0, 0);
            }
            __builtin_amdgcn_s_setprio(0);
            if (64 * t + 63 > q0) {
                const int qi = q0 + r32, kb0 = 64 * t + 8 * hi;
#pragma unroll
                for (int r = 0; r < 16; ++r) { const int key = kb0 + 16 * (r >> 3) + (r & 7); if (key > qi) s0[r] = -1e30f; if (key + 32 > qi) s1[r] = -1e30f; }
            }
            float mx = fmaxf(fmaxf(s0[0], s1[0]), s0[1]);
#pragma unroll
            for (int r = 1; r < 16; ++r) mx = fmaxf(fmaxf(mx, s1[r]), (r < 15) ? s0[r + 1] : s1[r]);
            { auto rr = __builtin_amdgcn_permlane32_swap(__float_as_uint(mx), __float_as_uint(mx), false, false); mx = fmaxf(__uint_as_float(rr[0]), __uint_as_float(rr[1])); }
            if (__any(mx - mrun > 8.0f)) {
                const float mnew = fmaxf(mrun, mx); const float alpha = __builtin_amdgcn_exp2f(mrun - mnew); mrun = mnew; lrun *= alpha;
#pragma unroll
                for (int d = 0; d < 4; ++d) o[d] = o[d] * alpha;
            }
            float ps = 0.f;
#pragma unroll
            for (int r = 0; r < 16; ++r) { s0[r] = __builtin_amdgcn_exp2f(s0[r] - mrun); s1[r] = __builtin_amdgcn_exp2f(s1[r] - mrun); ps += s0[r] + s1[r]; }
            lrun += ps;
            bf16x8 pf[4];
            { u32x4 w;
              w.x = cvt_pk_bf16(s0[0], s0[1]); w.y = cvt_pk_bf16(s0[2], s0[3]); w.z = cvt_pk_bf16(s0[4], s0[5]); w.w = cvt_pk_bf16(s0[6], s0[7]); pf[0] = __builtin_bit_cast(bf16x8, w);
              w.x = cvt_pk_bf16(s0[8], s0[9]); w.y = cvt_pk_bf16(s0[10], s0[11]); w.z = cvt_pk_bf16(s0[12], s0[13]); w.w = cvt_pk_bf16(s0[14], s0[15]); pf[1] = __builtin_bit_cast(bf16x8, w);
              w.x = cvt_pk_bf16(s1[0], s1[1]); w.y = cvt_pk_bf16(s1[2], s1[3]); w.z = cvt_pk_bf16(s1[4], s1[5]); w.w = cvt_pk_bf16(s1[6], s1[7]); pf[2] = __builtin_bit_cast(bf16x8, w);
              w.x = cvt_pk_bf16(s1[8], s1[9]); w.y = cvt_pk_bf16(s1[10], s1[11]); w.z = cvt_pk_bf16(s1[12], s1[13]); w.w = cvt_pk_bf16(s1[14], s1[15]); pf[3] = __builtin_bit_cast(bf16x8, w); }
            __builtin_amdgcn_s_setprio(1);
#pragma unroll
            for (int d = 0; d < 4; ++d)
#pragma unroll
                for (int ks = 0; ks < 4; ++ks) {
                    const bf16x8 vf = *(const LAS bf16x8*)(lds + cb + vfo + d * 32 * VROW + ks * 32);
                    o[d] = __builtin_amdgcn_mfma_f32_32x32x16_bf16(vf, pf[ks], o[d], 0, 0, 0);
                }
            __builtin_amdgcn_s_setprio(0);
        }
        if (more) { *(LAS u32x4*)(lds + nb + lk0) = ld0; *(LAS u32x4*)(lds + nb + lk1) = ld1; *(LAS u32x4*)(lds + nb + lr) = ld2; *(LAS u32x4*)(lds + nb + lv0) = ld3; *(LAS u32x4*)(lds + nb + lv1) = ld4; }
        __syncthreads();
    }
    { auto rr = __builtin_amdgcn_permlane32_swap(__float_as_uint(lrun), __float_as_uint(lrun), false, false); lrun = __uint_as_float(rr[0]) + __uint_as_float(rr[1]); }
    const float rl = __builtin_amdgcn_rcpf(lrun);
    bf16_t* op = o_out + (size_t)(tok0 + q0 + r32) * D + h * 128 + 4 * hi;
#pragma unroll
    for (int d = 0; d < 4; ++d)
#pragma unroll
        for (int r4 = 0; r4 < 4; ++r4) { u32x2 w; w.x = cvt_pk_bf16(o[d][4 * r4] * rl, o[d][4 * r4 + 1] * rl); w.y = cvt_pk_bf16(o[d][4 * r4 + 2] * rl, o[d][4 * r4 + 3] * rl);
            *(u32x2*)(op + 32 * d + 8 * r4) = w; }
}
__device__ __forceinline__ void p_attn(const Ctx& F, const Args& a) {
    const bf16_t* qn = (const bf16_t*)(a.ws + A_QN); const bf16_t* qr = (const bf16_t*)(a.ws + A_QR);
    const bf16_t* kn = (const bf16_t*)(a.ws + A_KN); const bf16_t* kr = (const bf16_t*)(a.ws + A_KR); const bf16_t* vt = (const bf16_t*)(a.ws + A_VT);
    bf16_t* oo = (bf16_t*)(a.ws + A_QN);
    for (int p = F.vcu; p < 512; p += F.G) {
        const int bh = p >> 3, s = p & 7;
        attn_unit(F.lds, qn, qr, kn, kr, vt, oo, bh >> 3, bh & 7, 15 - s, F.wave);
        attn_unit(F.lds, qn, qr, kn, kr, vt, oo, bh >> 3, bh & 7, s, F.wave);
    }
}

__device__ __forceinline__ void p_final(const Ctx& F, const Args& a) {
    float* h = a.out; const float* g = a.in[32];
    const int tid = fresh_tid(F.wave), lane = tid & 63, wave = __builtin_amdgcn_readfirstlane(tid >> 6);
    const int gw = F.vcu * 8 + wave, NGW = F.G * 8;
    f32x4 gv[4];
#pragma unroll
    for (int j = 0; j < 4; ++j) gv[j] = *((const f32x4*)g + lane + 64 * j);
    for (int m = gw; m < T; m += NGW) {
        f32x4 v[4]; float ss = 0.f;
#pragma unroll
        for (int j = 0; j < 4; ++j) { v[j] = *((const f32x4*)(h + (size_t)m * D) + lane + 64 * j); ss += (v[j][0] * v[j][0] + v[j][1] * v[j][1]) + (v[j][2] * v[j][2] + v[j][3] * v[j][3]); }
        const float rs = __builtin_amdgcn_rsqf(wave_sum(ss) * (1.0f / 1024.0f) + RMS_EPS);
#pragma unroll
        for (int j = 0; j < 4; ++j) *((f32x4*)(h + (size_t)m * D) + lane + 64 * j) = v[j] * rs * gv[j];
    }
}

#define XB_XCNT(j)  (256  + 64 * (j))
#define XB_XSUB(j)  (1280 + 64 * (j))
#define XB_XGEN(j)  (2304 + 64 * (j))
#define XB_TOP      3328
#define XB_TOPGEN   3392
__device__ __forceinline__ unsigned xb_ld(unsigned* p)              { return __hip_atomic_load(p, __ATOMIC_RELAXED, __HIP_MEMORY_SCOPE_AGENT); }
__device__ __forceinline__ unsigned xb_add(unsigned* p, unsigned v) { return __hip_atomic_fetch_add(p, v, __ATOMIC_RELAXED, __HIP_MEMORY_SCOPE_AGENT); }
__device__ __forceinline__ void my_grid_sync(unsigned* bar, unsigned G, int wave_s, unsigned x, volatile LAS unsigned* st) {
    asm volatile("s_waitcnt vmcnt(0) lgkmcnt(0)" ::: "memory");
    __syncthreads();
    if (fresh_tid(wave_s) == 0) {
        unsigned nloc = st[0], nx = st[1];
        if (nloc == 0u) {
            for (;;) { unsigned sum = 0u, cnt = 0u, mine = 0u;
#pragma unroll
                for (unsigned j = 0; j < 16; ++j) { const unsigned c = xb_ld(&bar[XB_XCNT(j)]); sum += c; cnt += (c > 0u) ? 1u : 0u; mine = (j == x) ? c : mine; }
                if (sum == G) { nloc = mine; nx = cnt; break; }
                __builtin_amdgcn_s_sleep(1); }
            st[0] = nloc; st[1] = nx;
        }
        const unsigned old = xb_add(&bar[XB_XSUB(x)], 1u);
        const unsigned gen = old / nloc;
        if (old + 1u == (gen + 1u) * nloc) {
            __builtin_amdgcn_fence(__ATOMIC_RELEASE, "agent");
            asm volatile("s_waitcnt vmcnt(0)" ::: "memory");
            const unsigned og = xb_add(&bar[XB_TOP], 1u);
            const unsigned tg = og / nx;
            if (og + 1u == (tg + 1u) * nx) xb_add(&bar[XB_TOPGEN], 1u);
            else while (xb_ld(&bar[XB_TOPGEN]) == tg) __builtin_amdgcn_s_sleep(1);
            __builtin_amdgcn_fence(__ATOMIC_ACQUIRE, "agent");
            xb_add(&bar[XB_XGEN(x)], 1u);
            asm volatile("s_waitcnt vmcnt(0)" ::: "memory");
        } else {
            while (xb_ld(&bar[XB_XGEN(x)]) == gen) __builtin_amdgcn_s_sleep(1);
            __builtin_amdgcn_fence(__ATOMIC_ACQUIRE, "agent");
            asm volatile("s_waitcnt vmcnt(0)" ::: "memory");
        }
    }
    __syncthreads();
}
#define GSYNC() do { my_grid_sync(bar_words + 64 * bar_idx, (unsigned)F.G, F.wave); ++bar_idx; } while (0)
#define RUN_GEMM(EPI_T, epi, Aptr, lda_, Bptr, ldb_, M_, N_, K_) do { pg8::Gemm g_{(const bf16_t*)(Aptr), (lda_), (const bf16_t*)(Bptr), (ldb_), (M_), (N_), (K_)}; \
    pg8::StaticOrder S_; S_.init((M_), (N_), F.G, (int)blockIdx.x); pg8::gemm_phase<EPI_T, pg8::StaticOrder>(F.lds, g_, S_, (epi), F.wave); } while (0)

__global__ void __launch_bounds__(512, 2) fwd_mega(Args a) {
    extern __shared__ __attribute__((aligned(16))) unsigned char lds_raw[];
    cg::grid_group grid = cg::this_grid();
    Ctx F; F.lds = (LAS unsigned char*)lds_raw; F.wave = __builtin_amdgcn_readfirstlane((int)threadIdx.x >> 6);
    F.G = gridDim.x; { const int bx = blockIdx.x; F.vcu = (F.G % 8 == 0) ? (bx % 8) * (F.G / 8) + bx / 8 : bx; }
    unsigned char* ws = a.ws;
    float* slotsH = (float*)(ws + WS_SLOTH); float* slotsC = (float*)(ws + WS_SLOTC); float* slotsQ = (float*)(ws + WS_SLOTQ);
    bf16_t* HB = (bf16_t*)(ws + A_HB); bf16_t* MID = (bf16_t*)(ws + A_MID);
    const float* cosT = (const float*)(ws + A_COS); const float* sinT = (const float*)(ws + A_SIN);
    bf16_t* WUG = (bf16_t*)(ws + W_UG); bf16_t* WDN = (bf16_t*)(ws + W_DN);

    unsigned* bar_words = (unsigned*)ws;
    if (a.ph_hi > 1000) grid.sync();
    const unsigned xcc = (unsigned)__builtin_amdgcn_s_getreg((3 << 11) | 20) & 0xFu;
    volatile LAS unsigned* xst = (volatile LAS unsigned*)(F.lds + 131072 + 64);
    if (fresh_tid(F.wave) == 0) { xst[0] = 0u; xst[1] = 0u; (void)xb_add(&bar_words[XB_XCNT(xcc)], 1u); }
    __syncthreads();
    if (a.ph_lo <= 0 && 0 < a.ph_hi) {
    p0_prologue(F, a);
    }
    if (a.ph_lo <= 0 && 1 < a.ph_hi) my_grid_sync(bar_words, (unsigned)F.G, F.wave, xcc, xst);
    if (a.ph_lo <= 1 && 1 < a.ph_hi) {
    { EpiSwiglu E{MID, slotsH, nullptr, nullptr, nullptr, nullptr, nullptr}; RUN_GEMM(EpiSwiglu, E, HB, D, WUG, D, T, 5632, D); }
    }
    if (a.ph_lo <= 1 && 2 < a.ph_hi) my_grid_sync(bar_words, (unsigned)F.G, F.wave, xcc, xst);
    if (a.ph_lo <= 2 && 2 < a.ph_hi) {
    { EpiResid E{a.in[0], a.out, nullptr, nullptr, 0.5f}; RUN_GEMM(EpiResid, E, MID, FF, WDN, FF, T, D, FF); }
    }
    if (a.ph_lo <= 2 && 3 < a.ph_hi) my_grid_sync(bar_words, (unsigned)F.G, F.wave, xcc, xst);
    if (a.ph_lo <= 3 && 3 < a.ph_hi) {
    p_premix(F, a);
    }
    if (a.ph_lo <= 3 && 4 < a.ph_hi) my_grid_sync(bar_words, (unsigned)F.G, F.wave, xcc, xst);
    if (a.ph_lo <= 4 && 4 < a.ph_hi) {
    { EpiRL E{(bf16_t*)(ws + A_R), (bf16_t*)(ws + A_LM)}; pg8::Gemm g_{(const bf16_t*)(ws + A_X1), 2048, (const bf16_t*)(ws + W_RL), 2048, T, 1280, 2048}; pg8::OrderRL S_{(int)blockIdx.x};
      pg8::gemm_phase<EpiRL, pg8::OrderRL>(F.lds, g_, S_, E, F.wave); }
    }
    if (a.ph_lo <= 4 && 5 < a.ph_hi) my_grid_sync(bar_words, (unsigned)F.G, F.wave, xcc, xst);
    if (a.ph_lo <= 5 && 5 < a.ph_hi) {
    { EpiBf16 E{(bf16_t*)(ws + A_KK), D}; RUN_GEMM(EpiBf16, E, ws + A_XK, D, ws + W_K, D, T, D, D); }
    { EpiBf16 E{(bf16_t*)(ws + A_VV), D}; RUN_GEMM(EpiBf16, E, ws + A_XV, D, ws + W_V, D, T, D, D); }
    }
    if (a.ph_lo <= 5 && 6 < a.ph_hi) my_grid_sync(bar_words, (unsigned)F.G, F.wave, xcc, xst);
    if (a.ph_lo <= 6 && 6 < a.ph_hi) {
    { EpiLoraUp E{ws, a.in[11], a.in[14], 0, A_G}; RUN_GEMM(EpiLoraUp, E, ws + A_LM, 256, ws + W_LU, 256, T, 2048, 256); }
    }
    if (a.ph_lo <= 6 && 7 < a.ph_hi) my_grid_sync(bar_words, (unsigned)F.G, F.wave, xcc, xst);
    if (a.ph_lo <= 7 && 7 < a.ph_hi) {
    p_scan2(F, a);
    }
    if (a.ph_lo <= 7 && 8 < a.ph_hi) my_grid_sync(bar_words, (unsigned)F.G, F.wave, xcc, xst);
    if (a.ph_lo <= 8 && 8 < a.ph_hi) {
    { EpiLoraUp E{ws, a.in[11], a.in[14], 2, A_E}; RUN_GEMM(EpiLoraUp, E, ws + A_LM, 256, ws + W_LU + (size_t)2048 * 256 * 2, 256, T, 1024, 256); }
    }
    if (a.ph_lo <= 8 && 9 < a.ph_hi) my_grid_sync(bar_words, (unsigned)F.G, F.wave, xcc, xst);
    if (a.ph_lo <= 9 && 9 < a.ph_hi) {
    p_post(F, a);
    }
    if (a.ph_lo <= 9 && 10 < a.ph_hi) my_grid_sync(bar_words, (unsigned)F.G, F.wave, xcc, xst);
    if (a.ph_lo <= 10 && 10 < a.ph_hi) {
    { EpiResid E{a.out, a.out, HB, slotsH, 1.0f}; RUN_GEMM(EpiResid, E, ws + A_G, D, ws + W_O, D, T, D, D); }
    }
    if (a.ph_lo <= 10 && 11 < a.ph_hi) my_grid_sync(bar_words, (unsigned)F.G, F.wave, xcc, xst);
    if (a.ph_lo <= 11 && 11 < a.ph_hi) {
    { EpiSwiglu E{MID, slotsH, nullptr, nullptr, nullptr, nullptr, nullptr}; RUN_GEMM(EpiSwiglu, E, HB, D, WUG + (size_t)1 * 6144 * D, D, T, 5632, D); }
    }
    if (a.ph_lo <= 11 && 12 < a.ph_hi) my_grid_sync(bar_words, (unsigned)F.G, F.wave, xcc, xst);
    if (a.ph_lo <= 12 && 12 < a.ph_hi) {
    { EpiResid E{a.out, a.out, HB, slotsH, 0.5f}; RUN_GEMM(EpiResid, E, MID, FF, WDN + (size_t)1 * D * FF, FF, T, D, FF); }
    }
    if (a.ph_lo <= 12 && 13 < a.ph_hi) my_grid_sync(bar_words, (unsigned)F.G, F.wave, xcc, xst);
    if (a.ph_lo <= 13 && 13 < a.ph_hi) {
    { EpiSwiglu E{MID, slotsH, (bf16_t*)(ws + A_C), slotsC, (bf16_t*)(ws + A_KR), cosT, sinT}; RUN_GEMM(EpiSwiglu, E, HB, D, WUG + (size_t)2 * 6144 * D, D, T, 6144, D); }
    }
    if (a.ph_lo <= 13 && 14 < a.ph_hi) my_grid_sync(bar_words, (unsigned)F.G, F.wave, xcc, xst);
    if (a.ph_lo <= 14 && 14 < a.ph_hi) {
    { EpiResid E{a.out, a.out, HB, slotsH, 0.5f}; RUN_GEMM(EpiResid, E, MID, FF, WDN + (size_t)2 * D * FF, FF, T, D, FF); }
    { EpiKnope E{(bf16_t*)(ws + A_KN), slotsC}; RUN_GEMM(EpiKnope, E, ws + A_C, 256, ws + W_KN, 256, T, D, 256); }
    { EpiVt E{(bf16_t*)(ws + A_VT), slotsC}; RUN_GEMM(EpiVt, E, ws + W_VT, 256, ws + A_C, 256, D, T, 256); }
    }
    if (a.ph_lo <= 14 && 15 < a.ph_hi) my_grid_sync(bar_words, (unsigned)F.G, F.wave, xcc, xst);
    if (a.ph_lo <= 15 && 15 < a.ph_hi) {
    { EpiQlat E{(bf16_t*)(ws + A_QLAT), slotsH, slotsQ}; RUN_GEMM(EpiQlat, E, HB, D, ws + W_DQ, D, T, 512, D); }
    }
    if (a.ph_lo <= 15 && 16 < a.ph_hi) my_grid_sync(bar_words, (unsigned)F.G, F.wave, xcc, xst);
    if (a.ph_lo <= 16 && 16 < a.ph_hi) {
    { EpiQ E{(bf16_t*)(ws + A_QN), (bf16_t*)(ws + A_QR), slotsQ, cosT, sinT}; RUN_GEMM(EpiQ, E, ws + A_QLAT, 512, ws + W_UQ, 512, T, 1536, 512); }
    }
    if (a.ph_lo <= 16 && 17 < a.ph_hi) my_grid_sync(bar_words, (unsigned)F.G, F.wave, xcc, xst);
    if (a.ph_lo <= 17 && 17 < a.ph_hi) {
    p_attn(F, a);
    }
    if (a.ph_lo <= 17 && 18 < a.ph_hi) my_grid_sync(bar_words, (unsigned)F.G, F.wave, xcc, xst);
    if (a.ph_lo <= 18 && 18 < a.ph_hi) {
    { EpiResid E{a.out, a.out, HB, slotsH, 1.0f}; RUN_GEMM(EpiResid, E, ws + A_QN, D, ws + W_MO, D, T, D, D); }
    }
    if (a.ph_lo <= 18 && 19 < a.ph_hi) my_grid_sync(bar_words, (unsigned)F.G, F.wave, xcc, xst);
    if (a.ph_lo <= 19 && 19 < a.ph_hi) {
    { EpiSwiglu E{MID, slotsH, nullptr, nullptr, nullptr, nullptr, nullptr}; RUN_GEMM(EpiSwiglu, E, HB, D, WUG + (size_t)3 * 6144 * D, D, T, 5632, D); }
    }
    if (a.ph_lo <= 19 && 20 < a.ph_hi) my_grid_sync(bar_words, (unsigned)F.G, F.wave, xcc, xst);
    if (a.ph_lo <= 20 && 20 < a.ph_hi) {
    { EpiResid E{a.out, a.out, nullptr, nullptr, 0.5f}; RUN_GEMM(EpiResid, E, MID, FF, WDN + (size_t)3 * D * FF, FF, T, D, FF); }
    }
    if (a.ph_lo <= 20 && 21 < a.ph_hi) my_grid_sync(bar_words, (unsigned)F.G, F.wave, xcc, xst);
    if (a.ph_lo <= 21 && 21 < a.ph_hi) {
    p_final(F, a);
    }
}

extern "C" void kernel_launch(void* const* d_in, const int* in_sizes, int n_in, void* d_out, int out_size, void* d_ws, size_t ws_size, hipStream_t stream) {
    static int grid = 0;
    if (grid == 0) {
        if (n_in != 33 || out_size != T * D || ws_size < WS_NEED) { fprintf(stderr, "kernel_launch: unexpected shapes: n_in %d out %d ws %zu (need %zu)\n", n_in, out_size, ws_size, (size_t)WS_NEED); grid = -1; return; }
        int dev = 0, cus = 0, per_cu = 0;
        (void)hipGetDevice(&dev); (void)hipDeviceGetAttribute(&cus, hipDeviceAttributeMultiprocessorCount, dev);
        (void)hipFuncSetAttribute((const void*)fwd_mega, hipFuncAttributeMaxDynamicSharedMemorySize, LDS_BYTES);
        (void)hipOccupancyMaxActiveBlocksPerMultiprocessor(&per_cu, (const void*)fwd_mega, 512, LDS_BYTES);
        (void)hipGetLastError();
        grid = cus > 0 ? cus : 256;
        if (grid > 256) grid = 256;
    }
    if (grid < 0) return;
    (void)hipMemsetAsync(d_ws, 0, 65536, stream);
    Args a{};
    for (int i = 0; i < 33; ++i) a.in[i] = (const float*)d_in[i];
    a.pos = (const int*)d_in[1]; a.out = (float*)d_out; a.ws = (unsigned char*)d_ws;
    hipError_t e = hipSuccess;
#if N_LAUNCHES == 1
    a.ph_lo = 0; a.ph_hi = NPHASES;
    { void* args[] = {&a}; e = hipLaunchCooperativeKernel((void*)fwd_mega, dim3(grid), dim3(512), args, LDS_BYTES, stream); }
#else
    for (int p = 0; p < NPHASES; ++p) { a.ph_lo = p; a.ph_hi = p + 1; hipLaunchKernelGGL(fwd_mega, dim3(grid), dim3(512), LDS_BYTES, stream, a); }
    e = hipPeekAtLastError();
#endif
    if (e != hipSuccess) fprintf(stderr, "cooperative launch failed: %s (grid %d)\n", hipGetErrorString(e), grid);
}
```

```cpp
#include <hip/hip_runtime.h>
#include <hip/hip_cooperative_groups.h>
#include <cstdio>
#include <cstdint>
namespace cg = cooperative_groups;

#define LAS __attribute__((address_space(3)))
typedef unsigned short bf16_t;
typedef short bf16x8 __attribute__((ext_vector_type(8)));
typedef float f32x4 __attribute__((ext_vector_type(4)));
typedef float f32x16 __attribute__((ext_vector_type(16)));
typedef unsigned u32x4 __attribute__((ext_vector_type(4)));
typedef unsigned u32x2 __attribute__((ext_vector_type(2)));
typedef float f32x2 __attribute__((ext_vector_type(2)));

constexpr int T = 32768, D = 1024, FF = 2816, SEQ = 4096, NB = 8;
constexpr float RMS_EPS = 1e-6f, GN_EPS = 64e-5f;
constexpr float LOG2E = 1.4426950408889634f;
constexpr float QSCALE = 0.07216878364870322f * 1.4426950408889634f;

constexpr size_t MiB = 1u << 20;
constexpr size_t WS_SLOTH = MiB / 2;
constexpr size_t WS_SLOTC = WS_SLOTH + 2 * MiB;
constexpr size_t WS_SLOTQ = WS_SLOTC + MiB / 2;
constexpr size_t WS_W = 4 * MiB;
constexpr size_t W_UG = WS_W;
constexpr size_t W_DN = W_UG + 48 * MiB;
constexpr size_t W_R = W_DN + 22 * MiB;
constexpr size_t W_K = W_R + 2 * MiB;
constexpr size_t W_V = W_K + 2 * MiB;
constexpr size_t W_O = W_V + 2 * MiB;
constexpr size_t W_LD = W_O + 2 * MiB;
constexpr size_t W_LU = W_LD + 1 * MiB;
constexpr size_t W_KN = W_LU + 2 * MiB;
constexpr size_t W_VT = W_KN + MiB / 2;
constexpr size_t W_DQ = W_VT + MiB / 2;
constexpr size_t W_UQ = W_DQ + 1 * MiB;
constexpr size_t W_MO = W_UQ + 2 * MiB;
constexpr size_t W_END = W_MO + 2 * MiB;
constexpr size_t WS_A = 92 * MiB;
static_assert(W_END <= WS_A, "weights region");
constexpr size_t A_HB = WS_A + 0;
constexpr size_t A_MID = WS_A + 64 * MiB;
constexpr size_t A_C = WS_A + 240 * MiB;
constexpr size_t A_KR = WS_A + 256 * MiB;
constexpr size_t A_KN = WS_A + 260 * MiB;
constexpr size_t A_VT = WS_A + 324 * MiB;
constexpr size_t A_QLAT = A_MID;
constexpr size_t A_QN = A_MID + 32 * MiB;
constexpr size_t A_QR = A_MID + 96 * MiB;
constexpr size_t A_X1 = WS_A + 0;
constexpr size_t A_XK = WS_A + 128 * MiB;
constexpr size_t A_XV = WS_A + 192 * MiB;
constexpr size_t A_R = WS_A + 256 * MiB;
constexpr size_t A_LM = WS_A + 320 * MiB;
constexpr size_t A_KK = WS_A + 0;
constexpr size_t A_VV = WS_A + 64 * MiB;
constexpr size_t A_E = WS_A + 128 * MiB;
constexpr size_t A_AA = WS_A + 192 * MiB;
constexpr size_t A_G = WS_A + 336 * MiB;
constexpr size_t A_BON = WS_A + 400 * MiB;
constexpr size_t A_COS = WS_A + 404 * MiB;
constexpr size_t A_SIN = WS_A + 408 * MiB;
constexpr size_t W_RL = WS_A + 412 * MiB;
constexpr size_t WS_NEED = 512 * MiB;

constexpr int LDS_BYTES = 147456;
constexpr int NPHASES = 22;
#ifndef N_LAUNCHES
#define N_LAUNCHES 1
#endif

__device__ __forceinline__ unsigned cvt_pk_bf16(float lo, float hi) { unsigned r; asm volatile("v_cvt_pk_bf16_f32 %0, %1, %2" : "=v"(r) : "v"(lo), "v"(hi)); return r; }
__device__ __forceinline__ float fsigmoid(float x) { return __builtin_amdgcn_rcpf(1.0f + __builtin_amdgcn_exp2f(-x * LOG2E)); }
__device__ __forceinline__ float ftanh(float x) { return 1.0f - 2.0f * __builtin_amdgcn_rcpf(1.0f + __builtin_amdgcn_exp2f(2.0f * LOG2E * x)); }
__device__ __forceinline__ float wave_sum(float v) {
#pragma unroll
    for (int o = 1; o < 64; o <<= 1) v += __shfl_xor(v, o);
    return v;
}
template <int CTRL> __device__ __forceinline__ float dpp_mov(float x) { return __builtin_bit_cast(float, __builtin_amdgcn_update_dpp(0, __builtin_bit_cast(int, x), CTRL, 0xf, 0xf, true)); }
__device__ __forceinline__ float red8(float x) { x += dpp_mov<0xB1>(x); x += dpp_mov<0x4E>(x); x += dpp_mov<0x141>(x); return x; }
__device__ __forceinline__ float red16(float x) { x = red8(x); x += dpp_mov<0x140>(x); return x; }
__device__ __forceinline__ float sum4(f32x4 v) { return (v[0] + v[1]) + (v[2] + v[3]); }
__device__ __forceinline__ float rstd_slots16(const float* s, int row) {
    const f32x4* p = (const f32x4*)(s + (size_t)row * 16);
    const f32x4 a = p[0], b = p[1], c = p[2], d = p[3];
    return __builtin_amdgcn_rsqf((sum4(a) + sum4(b) + sum4(c) + sum4(d)) * (1.0f / 1024.0f) + RMS_EPS);
}
__device__ __forceinline__ f32x4 unpack4(u32x2 p) { f32x4 r; r[0] = __uint_as_float(p.x << 16); r[1] = __uint_as_float(p.x & 0xffff0000u); r[2] = __uint_as_float(p.y << 16); r[3] = __uint_as_float(p.y & 0xffff0000u); return r; }

__device__ __forceinline__ int fresh_tid(int wave_s) { int l; asm volatile("v_mbcnt_lo_u32_b32 %0, -1, 0\n\tv_mbcnt_hi_u32_b32 %0, -1, %0" : "=v"(l)); return wave_s * 64 + l; }

namespace pg8 {
constexpr int BM = 256, BK = 64, HALF = 128, HTB = HALF * BK * 2, STAGE_BYTES = 8 * HTB, NXCD = 8, WGM = 8;
__device__ __forceinline__ int lds_byte(int r, int c) { const int st = (r >> 4) * 2 + (c >> 5), rr = r & 15, cc = c & 31, ob = rr * 64 + cc * 2; return st * 1024 + (ob ^ (((ob >> 9) & 1) << 5)); }
__device__ __forceinline__ void stage_rc(int b, int& R, int& C) { const int st = b / 1024, sb = b % 1024, swz = sb ^ (((sb >> 9) & 1) << 5); R = (st >> 1) * 16 + swz / 64; C = (st & 1) * 32 + (swz % 64) / 2; }
__device__ __forceinline__ int perm32(int rho) { const int n = rho >> 4, i = rho & 15; return 8 * (i >> 2) + 4 * n + (i & 3); }
struct Unit { int pm, pn; };
struct Gemm { const bf16_t* A; int lda; const bf16_t* Bt; int ldb; int M, N, K; };
struct StaticOrder {
    int nM, nN, nwg, G, c;
    __device__ void init(int M, int N, int G_, int c_) { nM = M / BM; nN = N / BM; nwg = nM * nN; G = G_; c = c_; }
    __device__ bool next(int i, Unit& u) const {
        const long L = (long)i * G + c; if (L >= nwg) return false;
        int wgid = (int)L; { const int q = nwg / NXCD, r = nwg % NXCD, xcd = wgid % NXCD, off = wgid / NXCD; wgid = (xcd < r ? xcd * (q + 1) : r * (q + 1) + (xcd - r) * q) + off; }
        const int nig = WGM * nN, gid = wgid / nig, fm = gid * WGM, gsz = (nM - fm) < WGM ? (nM - fm) : WGM;
        u.pm = fm + ((wgid % nig) % gsz); u.pn = (wgid % nig) / gsz; return true;
    }
    __device__ __forceinline__ int unit_nt(const Unit&, int nt) const { return nt; }
};
struct OrderRL {
    int c;
    __device__ bool next(int i, Unit& u) const {
        int idx;
        if (c < 128) { if (i == 0) { u.pm = c; u.pn = 4; return true; } if (i > 1) return false; idx = c; }
        else { if (i > 2) return false; idx = 128 + 3 * (c - 128) + i; }
        u.pm = idx >> 2; u.pn = idx & 3; return true;
    }
    __device__ __forceinline__ int unit_nt(const Unit& u, int nt) const { return u.pn < 4 ? nt / 2 : nt; }
};

template <class Epi, class Sched>
__device__ __forceinline__ void gemm_phase(LAS unsigned char* lds, const Gemm g, const Sched& S, const Epi& E, int wave_s) {
    const int tid = fresh_tid(wave_s), wid = __builtin_amdgcn_readfirstlane(tid >> 6), lane = tid & 63, wr = wid >> 2, wc = wid & 3, fr = lane & 15, fq = lane >> 4;
    const int K = g.K, nt_full = K / BK;
    unsigned voffA[2], voffB[2];
#pragma unroll
    for (int i = 0; i < 2; ++i) { int R, C; stage_rc(tid * 16 + i * 8192, R, C); const int Rb = Epi::PERM ? ((R & ~31) + perm32(R & 31)) : R;
        voffA[i] = (unsigned)(R * g.lda + C) * 2u; voffB[i] = (unsigned)(Rb * g.ldb + C) * 2u; }
    const size_t kstep = (size_t)(BK * 2);
    const size_t hstepA = (size_t)HALF * g.lda * 2, hstepB = (size_t)HALF * g.ldb * 2;
    const size_t tstepA = 2 * hstepA, tstepB = 2 * hstepB;
    const unsigned ldsw = (unsigned)wid * 1024u;
    const int aoff = lds_byte(wr * 64 + fr, fq * 8), boff = lds_byte(wc * 32 + fr, fq * 8);
#define PG8_SA(b, h) (((b) * 2 + (h)) * HTB)
#define PG8_SB(b, h) ((4 + (b) * 2 + (h)) * HTB)
#define PG8_STAGE(bufoff, gbase, voff) do { _Pragma("unroll") for (int _i = 0; _i < 2; ++_i) \
        __builtin_amdgcn_global_load_lds((const unsigned*)((const char*)(gbase) + (voff)[_i]), (LAS unsigned*)(lds + (bufoff) + ldsw + _i * 8192), 16, 0, 0); } while (0)
#define PG8_LDA(dst, b, h) do { _Pragma("unroll") for (int m = 0; m < 4; ++m) _Pragma("unroll") for (int k = 0; k < 2; ++k) dst[m][k] = *(const LAS bf16x8*)(lds + PG8_SA(b, h) + aoff + m * 2048 + k * 1024); } while (0)
#define PG8_LDB(dst, b, h) do { _Pragma("unroll") for (int n = 0; n < 2; ++n) _Pragma("unroll") for (int k = 0; k < 2; ++k) dst[n][k] = *(const LAS bf16x8*)(lds + PG8_SB(b, h) + boff + n * 2048 + k * 1024); } while (0)
#define PG8_MMA(ai, bj, At, Bt) do { __builtin_amdgcn_s_setprio(1); _Pragma("unroll") for (int m = 0; m < 4; ++m) _Pragma("unroll") for (int n = 0; n < 2; ++n) _Pragma("unroll") for (int k = 0; k < 2; ++k) \
        acc[ai][bj][m][n] = __builtin_amdgcn_mfma_f32_16x16x32_bf16(Bt[n][k], At[m][k], acc[ai][bj][m][n], 0, 0, 0); __builtin_amdgcn_s_setprio(0); } while (0)
#define PG8_WAIT_V(n) asm volatile("s_waitcnt vmcnt(" #n ")" ::: "memory")
#define PG8_WAIT_L(n) asm volatile("s_waitcnt lgkmcnt(" #n ")" ::: "memory")
#define PG8_BAR __builtin_amdgcn_s_barrier()
#define PG8_SCHED __builtin_amdgcn_sched_barrier(0)
    Unit cur, nxt; int ui = 0;
    if (!S.next(0, cur)) return;
    f32x4 acc[2][2][4][2];
#pragma unroll
    for (int a = 0; a < 2; ++a)
#pragma unroll
        for (int b = 0; b < 2; ++b)
#pragma unroll
            for (int m = 0; m < 4; ++m)
#pragma unroll
                for (int n = 0; n < 2; ++n) acc[a][b][m][n] = (f32x4){0.f, 0.f, 0.f, 0.f};
    bf16x8 At[4][2], B0[2][2], B1[2][2];
    const char* cA = (const char*)g.A + (size_t)cur.pm * tstepA; const char* cB = (const char*)g.Bt + (size_t)cur.pn * tstepB;
    PG8_STAGE(PG8_SB(0, 0), cB, voffB); PG8_STAGE(PG8_SB(0, 1), cB + hstepB, voffB); PG8_STAGE(PG8_SA(0, 0), cA, voffA); PG8_STAGE(PG8_SA(0, 1), cA + hstepA, voffA);
    if (wr == 1) PG8_BAR;
    PG8_WAIT_V(2); PG8_BAR;
    PG8_STAGE(PG8_SB(1, 0), cB + kstep, voffB); PG8_STAGE(PG8_SA(1, 0), cA + kstep, voffA); PG8_STAGE(PG8_SB(1, 1), cB + hstepB + kstep, voffB);
    PG8_WAIT_V(6); PG8_BAR;
    for (;;) {
        const bool has_next = S.next(ui + 1, nxt);
        const char* nA = has_next ? (const char*)g.A + (size_t)nxt.pm * tstepA : cA; const char* nB = has_next ? (const char*)g.Bt + (size_t)nxt.pn * tstepB : cB;
        const int nt = S.unit_nt(cur, nt_full);
        for (int t = 0; t < nt; t += 2) {
            const bool last = (t == nt - 2);
            const char* a1 = cA + (size_t)(t + 1) * kstep;
            const char* a2 = last ? nA : cA + (size_t)(t + 2) * kstep; const char* b2 = last ? nB : cB + (size_t)(t + 2) * kstep;
            const char* a3 = a2 + kstep; const char* b3 = b2 + kstep;
            PG8_LDB(B0, 0, 0); PG8_LDB(B1, 0, 1); PG8_SCHED; PG8_LDA(At, 0, 0); PG8_STAGE(PG8_SA(1, 1), a1 + hstepA, voffA);
            PG8_WAIT_V(8); PG8_WAIT_L(0); PG8_BAR; PG8_MMA(0, 0, At, B0); PG8_MMA(0, 1, At, B1); PG8_BAR; PG8_SCHED;
            PG8_LDA(At, 0, 1); PG8_STAGE(PG8_SB(0, 0), b2, voffB); PG8_STAGE(PG8_SB(0, 1), b2 + hstepB, voffB); PG8_STAGE(PG8_SA(0, 0), a2, voffA);
            PG8_WAIT_V(8); PG8_WAIT_L(0); PG8_BAR; PG8_MMA(1, 0, At, B0); PG8_MMA(1, 1, At, B1); PG8_BAR; PG8_SCHED;
            PG8_LDB(B0, 1, 0); PG8_LDB(B1, 1, 1); PG8_SCHED; PG8_LDA(At, 1, 0); PG8_STAGE(PG8_SA(0, 1), a2 + hstepA, voffA);
            PG8_WAIT_V(8); PG8_WAIT_L(0); PG8_BAR; PG8_MMA(0, 0, At, B0); PG8_MMA(0, 1, At, B1); PG8_BAR; PG8_SCHED;
            PG8_LDA(At, 1, 1); PG8_STAGE(PG8_SB(1, 0), b3, voffB); PG8_STAGE(PG8_SB(1, 1), b3 + hstepB, voffB); PG8_STAGE(PG8_SA(1, 0), a3, voffA);
            PG8_WAIT_V(8); PG8_WAIT_L(0); PG8_BAR; PG8_MMA(1, 0, At, B0); PG8_MMA(1, 1, At, B1); PG8_BAR; PG8_SCHED;
        }
        if (wr == 0) PG8_BAR;
        E(acc, cur, wr, wc, fr, fq);
        if (!has_next) break;
#pragma unroll
        for (int a = 0; a < 2; ++a)
#pragma unroll
            for (int b = 0; b < 2; ++b)
#pragma unroll
                for (int m = 0; m < 4; ++m)
#pragma unroll
                    for (int n = 0; n < 2; ++n) acc[a][b][m][n] = (f32x4){0.f, 0.f, 0.f, 0.f};
        cur = nxt; cA = nA; cB = nB; ++ui;
        if (wr == 1) PG8_BAR;
    }
    PG8_WAIT_V(0);
    PG8_BAR;
#undef PG8_SA
#undef PG8_SB
#undef PG8_STAGE
#undef PG8_LDA
#undef PG8_LDB
#undef PG8_MMA
#undef PG8_WAIT_V
#undef PG8_WAIT_L
#undef PG8_BAR
#undef PG8_SCHED
}
}
using pg8::Unit;
typedef f32x4 AccT[2][2][4][2];

__device__ __forceinline__ u32x4 pack8(f32x4 a, f32x4 b) { u32x4 w; w.x = cvt_pk_bf16(a[0], a[1]); w.y = cvt_pk_bf16(a[2], a[3]); w.z = cvt_pk_bf16(b[0], b[1]); w.w = cvt_pk_bf16(b[2], b[3]); return w; }

struct EpiSwiglu {
    static constexpr bool PERM = true;
    bf16_t* mid; const float* slotsH; bf16_t* cbuf; float* slotsC; bf16_t* krope; const float* cosT; const float* sinT;
    __device__ __forceinline__ void operator()(const AccT& acc, const Unit& u, int wr, int wc, int fr, int fq) const {
        const int row0 = u.pm * 256 + wr * 64 + fr;
        if (u.pn < 22) {
#pragma unroll
            for (int ai = 0; ai < 2; ++ai)
#pragma unroll
                for (int m = 0; m < 4; ++m) {
                    const int row = row0 + ai * 128 + m * 16; const float rs = rstd_slots16(slotsH, row);
                    f32x4 o[2];
#pragma unroll
                    for (int n = 0; n < 2; ++n)
#pragma unroll
                        for (int i = 0; i < 4; ++i) { const float gt = acc[ai][0][m][n][i] * rs, up = acc[ai][1][m][n][i] * rs; o[n][i] = gt * fsigmoid(gt) * up; }
                    *(u32x4*)(mid + (size_t)row * FF + u.pn * 128 + wc * 32 + fq * 8) = pack8(o[0], o[1]);
                }
        } else if (u.pn == 22) {
#pragma unroll
            for (int ai = 0; ai < 2; ++ai)
#pragma unroll
                for (int m = 0; m < 4; ++m) {
                    const int row = row0 + ai * 128 + m * 16; const float rs = rstd_slots16(slotsH, row);
                    float ss = 0.f;
#pragma unroll
                    for (int bj = 0; bj < 2; ++bj) { const f32x4 a = acc[ai][bj][m][0] * rs, b = acc[ai][bj][m][1] * rs;
                        ss += (a[0] * a[0] + a[1] * a[1]) + (a[2] * a[2] + a[3] * a[3]) + (b[0] * b[0] + b[1] * b[1]) + (b[2] * b[2] + b[3] * b[3]);
                        *(u32x4*)(cbuf + (size_t)row * 256 + bj * 128 + wc * 32 + fq * 8) = pack8(a, b); }
                    ss += __shfl_xor(ss, 16); ss += __shfl_xor(ss, 32);
                    if (fq == 0) slotsC[(size_t)row * 4 + wc] = ss;
                }
        } else if (wc == 0) {
#pragma unroll
            for (int ai = 0; ai < 2; ++ai)
#pragma unroll
                for (int m = 0; m < 4; ++m) {
                    const int row = row0 + ai * 128 + m * 16; const float rs = rstd_slots16(slotsH, row);
                    f32x4 o1[2], o2[2];
#pragma unroll
                    for (int n = 0; n < 2; ++n) { const f32x4 c = *(const f32x4*)(cosT + (size_t)row * 32 + fq * 8 + n * 4), s = *(const f32x4*)(sinT + (size_t)row * 32 + fq * 8 + n * 4);
                        const f32x4 x1 = acc[ai][0][m][n] * rs, x2 = acc[ai][1][m][n] * rs; o1[n] = x1 * c - x2 * s; o2[n] = x2 * c + x1 * s; }
                    *(u32x4*)(krope + (size_t)row * 64 + fq * 8) = pack8(o1[0], o1[1]);
                    *(u32x4*)(krope + (size_t)row * 64 + 32 + fq * 8) = pack8(o2[0], o2[1]);
                }
        }
    }
};
struct EpiResid {
    static constexpr bool PERM = false;
    const float* hin; float* hout; bf16_t* hb; float* slots; float alpha;
    __device__ __forceinline__ void operator()(const AccT& acc, const Unit& u, int wr, int wc, int fr, int fq) const {
        const int row0 = u.pm * 256 + wr * 64 + fr, col0 = u.pn * 256 + wc * 32 + 4 * fq;
#pragma unroll
        for (int ai = 0; ai < 2; ++ai)
#pragma unroll
            for (int m = 0; m < 4; ++m) {
                const int row = row0 + ai * 128 + m * 16; const size_t off = (size_t)row * D + col0; float ss = 0.f;
#pragma unroll
                for (int bj = 0; bj < 2; ++bj)
#pragma unroll
                    for (int n = 0; n < 2; ++n) { const size_t o2 = off + bj * 128 + n * 16; const f32x4 b = *(const f32x4*)(hin + o2); const f32x4 o = b + acc[ai][bj][m][n] * alpha;
                        *(f32x4*)(hout + o2) = o; ss += (o[0] * o[0] + o[1] * o[1]) + (o[2] * o[2] + o[3] * o[3]);
                        if (hb) { u32x2 w; w.x = cvt_pk_bf16(o[0], o[1]); w.y = cvt_pk_bf16(o[2], o[3]); *(u32x2*)(hb + o2) = w; } }
                if (slots) { ss += __shfl_xor(ss, 16); ss += __shfl_xor(ss, 32); if (fq == 0) slots[(size_t)row * 16 + u.pn * 4 + wc] = ss; }
                if (m & 1) asm volatile("" ::: "memory");
            }
    }
};
struct EpiBf16 {
    static constexpr bool PERM = true;
    bf16_t* O; int ldc;
    __device__ __forceinline__ void operator()(const AccT& acc, const Unit& u, int wr, int wc, int fr, int fq) const {
        const int row0 = u.pm * 256 + wr * 64 + fr, col0 = u.pn * 256 + wc * 32 + 8 * fq;
#pragma unroll
        for (int ai = 0; ai < 2; ++ai)
#pragma unroll
            for (int m = 0; m < 4; ++m) { bf16_t* rp = O + (size_t)(row0 + ai * 128 + m * 16) * ldc + col0;
#pragma unroll
                for (int bj = 0; bj < 2; ++bj) *(u32x4*)(rp + bj * 128) = pack8(acc[ai][bj][m][0], acc[ai][bj][m][1]); }
    }
};
struct EpiLoraDown {
    static constexpr bool PERM = true;
    bf16_t* O;
    __device__ __forceinline__ void operator()(const AccT& acc, const Unit& u, int wr, int wc, int fr, int fq) const {
        const int row0 = u.pm * 256 + wr * 64 + fr, col0 = wc * 32 + 8 * fq;
#pragma unroll
        for (int ai = 0; ai < 2; ++ai)
#pragma unroll
            for (int m = 0; m < 4; ++m) { bf16_t* rp = O + (size_t)(row0 + ai * 128 + m * 16) * 256 + col0;
                f32x4 a = acc[ai][0][m][0], b = acc[ai][0][m][1];
                if (wc < 2) {
#pragma unroll
                    for (int i = 0; i < 4; ++i) { a[i] = ftanh(a[i]); b[i] = ftanh(b[i]); } }
                *(u32x4*)(rp) = pack8(a, b);
                a = acc[ai][1][m][0]; b = acc[ai][1][m][1];
#pragma unroll
                for (int i = 0; i < 4; ++i) { a[i] = fsigmoid(a[i]); b[i] = fsigmoid(b[i]); }
                *(u32x4*)(rp + 128) = pack8(a, b); }
    }
};
struct EpiRL {
    static constexpr bool PERM = true;
    bf16_t* R; bf16_t* O;
    __device__ __forceinline__ void operator()(const AccT& acc, const Unit& u, int wr, int wc, int fr, int fq) const {
        const int row0 = u.pm * 256 + wr * 64 + fr;
        if (u.pn < 4) {
            const int col0 = u.pn * 256 + wc * 32 + 8 * fq;
#pragma unroll
            for (int ai = 0; ai < 2; ++ai)
#pragma unroll
                for (int m = 0; m < 4; ++m) { bf16_t* rp = R + (size_t)(row0 + ai * 128 + m * 16) * D + col0;
#pragma unroll
                    for (int bj = 0; bj < 2; ++bj) *(u32x4*)(rp + bj * 128) = pack8(acc[ai][bj][m][0], acc[ai][bj][m][1]); }
        } else {
            const int col0 = wc * 32 + 8 * fq;
#pragma unroll
            for (int ai = 0; ai < 2; ++ai)
#pragma unroll
                for (int m = 0; m < 4; ++m) { bf16_t* rp = O + (size_t)(row0 + ai * 128 + m * 16) * 256 + col0;
                    f32x4 a = acc[ai][0][m][0], b = acc[ai][0][m][1];
                    if (wc < 2) {
#pragma unroll
                        for (int i = 0; i < 4; ++i) { a[i] = ftanh(a[i]); b[i] = ftanh(b[i]); } }
                    *(u32x4*)(rp) = pack8(a, b);
                    a = acc[ai][1][m][0]; b = acc[ai][1][m][1];
#pragma unroll
                    for (int i = 0; i < 4; ++i) { a[i] = fsigmoid(a[i]); b[i] = fsigmoid(b[i]); }
                    *(u32x4*)(rp + 128) = pack8(a, b); }
        }
    }
};
struct EpiLoraUp {
    static constexpr bool PERM = true;
    unsigned char* wsb; const float* w0; const float* a0; int grp0; size_t goff;
    __device__ __forceinline__ void operator()(const AccT& acc, const Unit& u, int wr, int wc, int fr, int fq) const {
        const int grp = (u.pn >> 2) + grp0, colt = (u.pn & 3) * 256;
        const int row0 = u.pm * 256 + wr * 64 + fr, col0 = colt + wc * 32 + 8 * fq;
        size_t ooff = goff; if (grp == 0) ooff = A_E; if (grp == 1) ooff = A_AA;
        bf16_t* O = (bf16_t*)(wsb + ooff); const float* bias = grp == 0 ? w0 : a0;
#pragma unroll
        for (int ai = 0; ai < 2; ++ai)
#pragma unroll
            for (int m = 0; m < 4; ++m) { bf16_t* rp = O + (size_t)(row0 + ai * 128 + m * 16) * D + col0;
#pragma unroll
                for (int bj = 0; bj < 2; ++bj) { f32x4 a = acc[ai][bj][m][0], b = acc[ai][bj][m][1];
                    if (grp < 2) { const float sc = grp == 0 ? 0.6065306597126334f : 1.0f;
                        const f32x4 b0 = *(const f32x4*)(bias + col0 + bj * 128), b1 = *(const f32x4*)(bias + col0 + bj * 128 + 4);
                        a = a + b0; b = b + b1;
#pragma unroll
                        for (int i = 0; i < 4; ++i) { a[i] = sc * fsigmoid(a[i]); b[i] = sc * fsigmoid(b[i]); } }
                    *(u32x4*)(rp + bj * 128) = pack8(a, b); }
                asm volatile("" ::: "memory"); }
    }
};
struct EpiQlat {
    static constexpr bool PERM = true;
    bf16_t* O; const float* slotsH; float* slotsQ;
    __device__ __forceinline__ void operator()(const AccT& acc, const Unit& u, int wr, int wc, int fr, int fq) const {
        const int row0 = u.pm * 256 + wr * 64 + fr, col0 = u.pn * 256 + wc * 32 + 8 * fq;
#pragma unroll
        for (int ai = 0; ai < 2; ++ai)
#pragma unroll
            for (int m = 0; m < 4; ++m) { const int row = row0 + ai * 128 + m * 16; const float rs = rstd_slots16(slotsH, row); float ss = 0.f;
#pragma unroll
                for (int bj = 0; bj < 2; ++bj) { const f32x4 a = acc[ai][bj][m][0] * rs, b = acc[ai][bj][m][1] * rs;
                    ss += (a[0] * a[0] + a[1] * a[1]) + (a[2] * a[2] + a[3] * a[3]) + (b[0] * b[0] + b[1] * b[1]) + (b[2] * b[2] + b[3] * b[3]);
                    *(u32x4*)(O + (size_t)row * 512 + col0 + bj * 128) = pack8(a, b); }
                ss += __shfl_xor(ss, 16); ss += __shfl_xor(ss, 32);
                if (fq == 0) slotsQ[(size_t)row * 8 + u.pn * 4 + wc] = ss; }
    }
};
struct EpiQ {
    static constexpr bool PERM = true;
    bf16_t* qn; bf16_t* qr; const float* slotsQ; const float* cosT; const float* sinT;
    __device__ __forceinline__ void operator()(const AccT& acc, const Unit& u, int wr, int wc, int fr, int fq) const {
        const int row0 = u.pm * 256 + wr * 64 + fr;
#pragma unroll
        for (int ai = 0; ai < 2; ++ai)
#pragma unroll
            for (int m = 0; m < 4; ++m) { const int row = row0 + ai * 128 + m * 16;
                const f32x4 s0 = *(const f32x4*)(slotsQ + (size_t)row * 8), s1 = *(const f32x4*)(slotsQ + (size_t)row * 8 + 4);
                const float rs = __builtin_amdgcn_rsqf((sum4(s0) + sum4(s1)) * (1.0f / 512.0f) + RMS_EPS) * QSCALE;
                if (u.pn < 4) {
#pragma unroll
                    for (int bj = 0; bj < 2; ++bj) *(u32x4*)(qn + (size_t)row * D + u.pn * 256 + bj * 128 + wc * 32 + fq * 8) = pack8(acc[ai][bj][m][0] * rs, acc[ai][bj][m][1] * rs);
                } else {
                    const int head = 4 * (u.pn - 4) + wc; f32x4 o1[2], o2[2];
#pragma unroll
                    for (int n = 0; n < 2; ++n) { const f32x4 c = *(const f32x4*)(cosT + (size_t)row * 32 + fq * 8 + n * 4), s = *(const f32x4*)(sinT + (size_t)row * 32 + fq * 8 + n * 4);
                        const f32x4 x1 = acc[ai][0][m][n] * rs, x2 = acc[ai][1][m][n] * rs; o1[n] = x1 * c - x2 * s; o2[n] = x2 * c + x1 * s; }
                    *(u32x4*)(qr + (size_t)row * 512 + head * 64 + fq * 8) = pack8(o1[0], o1[1]);
                    *(u32x4*)(qr + (size_t)row * 512 + head * 64 + 32 + fq * 8) = pack8(o2[0], o2[1]);
                } }
    }
};
struct EpiKnope {
    static constexpr bool PERM = true;
    bf16_t* O; const float* slotsC;
    __device__ __forceinline__ void operator()(const AccT& acc, const Unit& u, int wr, int wc, int fr, int fq) const {
        const int row0 = u.pm * 256 + wr * 64 + fr, col0 = u.pn * 256 + wc * 32 + 8 * fq;
#pragma unroll
        for (int ai = 0; ai < 2; ++ai)
#pragma unroll
            for (int m = 0; m < 4; ++m) { const int row = row0 + ai * 128 + m * 16; const f32x4 s = *(const f32x4*)(slotsC + (size_t)row * 4);
                const float rs = __builtin_amdgcn_rsqf(sum4(s) * (1.0f / 256.0f) + RMS_EPS);
#pragma unroll
                for (int bj = 0; bj < 2; ++bj) *(u32x4*)(O + (size_t)row * D + col0 + bj * 128) = pack8(acc[ai][bj][m][0] * rs, acc[ai][bj][m][1] * rs); }
    }
};
struct EpiVt {
    static constexpr bool PERM = true;
    bf16_t* O; const float* slotsC;
    __device__ __forceinline__ void operator()(const AccT& acc, const Unit& u, int wr, int wc, int fr, int fq) const {
        const int row0 = u.pm * 256 + wr * 64 + fr, col0 = u.pn * 256 + wc * 32 + 8 * fq;
        f32x4 rs[2][2];
#pragma unroll
        for (int bj = 0; bj < 2; ++bj)
#pragma unroll
            for (int n = 0; n < 2; ++n)
#pragma unroll
                for (int i = 0; i < 4; ++i) { const f32x4 s = *(const f32x4*)(slotsC + (size_t)(col0 + bj * 128 + n * 4 + i) * 4); rs[bj][n][i] = __builtin_amdgcn_rsqf(sum4(s) * (1.0f / 256.0f) + RMS_EPS); }
#pragma unroll
        for (int ai = 0; ai < 2; ++ai)
#pragma unroll
            for (int m = 0; m < 4; ++m) { const int row = row0 + ai * 128 + m * 16;
#pragma unroll
                for (int bj = 0; bj < 2; ++bj) *(u32x4*)(O + (size_t)row * T + col0 + bj * 128) = pack8(acc[ai][bj][m][0] * rs[bj][0], acc[ai][bj][m][1] * rs[bj][1]); }
    }
};

struct Args { const float* in[33]; const int* pos; float* out; unsigned char* ws; int ph_lo, ph_hi; };

struct Ctx { LAS unsigned char* lds; int vcu, G, wave; };

__device__ __forceinline__ void tr_item(const float* W, int ldw, int k0, int n0, const float* s1, const float* s2, int ks0, bf16_t* Bt, int ldb, int nd0, int kd0, LAS float* scr, int lane) {
    f32x4 v[8];
#pragma unroll
    for (int i = 0; i < 8; ++i) v[i] = *(const f32x4*)(W + (size_t)(k0 + 8 * i + (lane >> 3)) * ldw + n0 + 4 * (lane & 7));
#pragma unroll
    for (int i = 0; i < 8; ++i) { const int kk = 8 * i + (lane >> 3);
        float sc = s1 ? s1[ks0 + kk] : 1.0f; if (s2) sc -= s2[ks0 + kk];
        LAS float* d = scr + kk * 33 + 4 * (lane & 7);
        d[0] = sc * v[i][0]; d[1] = sc * v[i][1]; d[2] = sc * v[i][2]; d[3] = sc * v[i][3]; }
    asm volatile("s_waitcnt lgkmcnt(0)" ::: "memory");
    const int c = lane & 7;
#pragma unroll
    for (int j = 0; j < 4; ++j) { const int n = (lane >> 3) + 8 * j; const LAS float* s = scr + (8 * c) * 33 + n;
        u32x4 o; o.x = cvt_pk_bf16(s[0 * 33], s[1 * 33]); o.y = cvt_pk_bf16(s[2 * 33], s[3 * 33]); o.z = cvt_pk_bf16(s[4 * 33], s[5 * 33]); o.w = cvt_pk_bf16(s[6 * 33], s[7 * 33]);
        *(u32x4*)(Bt + (size_t)(nd0 + n) * ldb + kd0 + 8 * c) = o; }
    asm volatile("s_waitcnt lgkmcnt(0)" ::: "memory");
}
__device__ __forceinline__ void zero_item(bf16_t* Bt, int ldb, int nd0, int kd0, int lane) {
    const int c = lane & 7;
#pragma unroll
    for (int j = 0; j < 4; ++j) { const int n = (lane >> 3) + 8 * j; *(u32x4*)(Bt + (size_t)(nd0 + n) * ldb + kd0 + 8 * c) = (u32x4){0u, 0u, 0u, 0u}; }
}

constexpr int I_UG = 16 * 176, I_UGX = 16 * 16, I_DN = 44 * 32, I_SQ = 16 * 32, I_LD = 32 * 8, I_LU = 4 * 96, I_KN = 4 * 32, I_DQ = 16 * 16, I_UQ = 8 * 48;
constexpr int NITEMS = 4 * I_UG + I_UGX + 4 * I_DN + 4 * I_SQ + I_LD + I_LU + 2 * I_KN + I_DQ + I_UQ + I_SQ;
__device__ __forceinline__ void p0_item(const Args& a, int it, int mode, LAS float* scr, int lane) {
    unsigned char* ws = a.ws; const float* norm_g = a.in[2];
    int r = it;
        if (r < 4 * I_UG) { const int q = r / I_UG; r -= q * I_UG; if ((q >= 1) != (mode == 1)) return; const int l = q >> 1, s = q & 1; const int kb = r / 176, nb = r % 176, pn = nb >> 3, jb = nb & 7;
            const float* src = (jb < 4 ? a.in[3] : a.in[4]) + (size_t)q * D * FF;
            tr_item(src, FF, 64 * kb, 128 * pn + 32 * (jb & 3), norm_g + (l * 3 + (s ? 2 : 0)) * D, nullptr, 64 * kb, (bf16_t*)(ws + W_UG) + (size_t)q * 6144 * D, D, 32 * nb, 64 * kb, scr, lane); return; }
        r -= 4 * I_UG;
        if (r < I_UGX) { if (mode != 1) return; const int kb = r / 16, nb = r % 16; bf16_t* Bt = (bf16_t*)(ws + W_UG) + (size_t)2 * 6144 * D;
            int sc = -1; if (nb < 8) sc = 32 * nb; else if (nb == 8) sc = 256; else if (nb == 12) sc = 288;
            if (sc >= 0) tr_item(a.in[25], 320, 64 * kb, sc, a.in[24], nullptr, 64 * kb, Bt, D, 5632 + 32 * nb, 64 * kb, scr, lane); else zero_item(Bt, D, 5632 + 32 * nb, 64 * kb, lane); return; }
        r -= I_UGX;
        if (r < 4 * I_DN) { const int q = r / I_DN; r -= q * I_DN; if ((q >= 1) != (mode == 1)) return; const int kb = r / 32, nb = r % 32;
            tr_item(a.in[5] + (size_t)q * FF * D, D, 64 * kb, 32 * nb, nullptr, nullptr, 0, (bf16_t*)(ws + W_DN) + (size_t)q * D * FF, FF, 32 * nb, 64 * kb, scr, lane); return; }
        r -= 4 * I_DN;
        if (r < 4 * I_SQ) { const int q = r / I_SQ; r -= q * I_SQ; if ((q == 3) != (mode == 1)) return; const int kb = r / 32, nb = r % 32;
            if (q == 0) { tr_item(a.in[7], D, 64 * kb, 32 * nb, nullptr, nullptr, 0, (bf16_t*)(ws + W_RL), 2048, 32 * nb, 64 * kb, scr, lane); zero_item((bf16_t*)(ws + W_RL), 2048, 32 * nb, 1024 + 64 * kb, lane); }
            else tr_item(a.in[7 + q], D, 64 * kb, 32 * nb, nullptr, nullptr, 0, (bf16_t*)(ws + W_R + (size_t)q * 2 * MiB), D, 32 * nb, 64 * kb, scr, lane);
            return; }
        r -= 4 * I_SQ;
        if (r < I_LD) { if (mode != 0) return; const int kb = r / 8, nb = r % 8; const int kk0 = 64 * (kb & 15); const bool second = kb >= 16;
            const float* src; int ldw, nc, mi; if (nb < 2) { src = a.in[12]; ldw = 64; nc = 32 * nb; mi = 1; } else if (nb < 4) { src = a.in[15]; ldw = 64; nc = 32 * (nb - 2); mi = 4; } else { src = a.in[17]; ldw = 128; nc = 32 * (nb - 4); mi = 5; }
            tr_item(src, ldw, kk0, nc, second ? a.in[6] + mi * D : nullptr, second ? a.in[6] : nullptr, kk0, (bf16_t*)(ws + W_RL), 2048, 1024 + 32 * nb, 64 * kb, scr, lane); return; }
        r -= I_LD;
        if (r < I_LU) { if (mode != 0) return; const int kb = r / 96, nb = r % 96; const int grp = nb / 32, nc = 32 * (nb % 32); bf16_t* Bt = (bf16_t*)(ws + W_LU);
            if (grp == 0) { if (kb == 0) tr_item(a.in[13], D, 0, nc, nullptr, nullptr, 0, Bt, 256, 32 * nb, 0, scr, lane); else zero_item(Bt, 256, 32 * nb, 64 * kb, lane); }
            else if (grp == 1) { if (kb == 1) tr_item(a.in[16], D, 0, nc, nullptr, nullptr, 0, Bt, 256, 32 * nb, 64, scr, lane); else zero_item(Bt, 256, 32 * nb, 64 * kb, lane); }
            else { if (kb >= 2) tr_item(a.in[18], D, 64 * (kb - 2), nc, nullptr, nullptr, 0, Bt, 256, 32 * nb, 64 * kb, scr, lane); else zero_item(Bt, 256, 32 * nb, 64 * kb, lane); }
            return; }
        r -= I_LU;
        if (r < 2 * I_KN) { if (mode != 1) return; const int q = r / I_KN; r -= q * I_KN; const int kb = r / 32, nb = r % 32;
            const int n0 = 32 * nb, sc = (n0 >> 7) * 256 + (n0 & 127) + q * 128;
            tr_item(a.in[27], 2048, 64 * kb, sc, a.in[26], nullptr, 64 * kb, (bf16_t*)(ws + (q ? W_VT : W_KN)), 256, n0, 64 * kb, scr, lane); return; }
        r -= 2 * I_KN;
        if (r < I_DQ) { if (mode != 1) return; const int kb = r / 16, nb = r % 16;
            tr_item(a.in[28], 512, 64 * kb, 32 * nb, norm_g + (1 * 3 + 1) * D, nullptr, 64 * kb, (bf16_t*)(ws + W_DQ), D, 32 * nb, 64 * kb, scr, lane); return; }
        r -= I_DQ;
        if (r < I_UQ) { if (mode != 1) return; const int kb = r / 48, nb = r % 48; int sc;
            if (nb < 32) { const int n0 = 32 * nb; sc = (n0 >> 7) * 192 + (n0 & 127); }
            else { const int t2 = (nb - 32) >> 3, jj = (nb - 32) & 7, half = jj >> 2, hh = jj & 3; sc = (4 * t2 + hh) * 192 + 128 + 32 * half; }
            tr_item(a.in[30], 1536, 64 * kb, sc, a.in[29], nullptr, 64 * kb, (bf16_t*)(ws + W_UQ), 512, 32 * nb, 64 * kb, scr, lane); return; }
        r -= I_UQ;
        { if (mode != 1) return; const int kb = r / 32, nb = r % 32; tr_item(a.in[31], D, 64 * kb, 32 * nb, nullptr, nullptr, 0, (bf16_t*)(ws + W_MO), D, 32 * nb, 64 * kb, scr, lane); }
}
__device__ __forceinline__ void p0_prologue(const Ctx& F, const Args& a) {
    unsigned char* ws = a.ws;
    const int tid = fresh_tid(F.wave), lane = tid & 63, wave = __builtin_amdgcn_readfirstlane(tid >> 6);
    LAS float* scr = (LAS float*)(F.lds + wave * 16384);
    const int gw = F.vcu * 8 + wave, NGW = F.G * 8;
    const float* norm_g = a.in[2];
    for (int it = gw; it < NITEMS; it += NGW) p0_item(a, it, 0, scr, lane);
    const float* x = a.in[0]; bf16_t* hb = (bf16_t*)(ws + A_HB); float* slotsH = (float*)(ws + WS_SLOTH);
    for (int m = gw; m < T; m += NGW) {
        const f32x4* xr = (const f32x4*)(x + (size_t)m * D) + lane; float ss = 0.f;
#pragma unroll
        for (int j = 0; j < 4; ++j) { const f32x4 v = xr[64 * j]; ss += (v[0] * v[0] + v[1] * v[1]) + (v[2] * v[2] + v[3] * v[3]);
            u32x2 w; w.x = cvt_pk_bf16(v[0], v[1]); w.y = cvt_pk_bf16(v[2], v[3]); *((u32x2*)(hb + (size_t)m * D) + lane + 64 * j) = w; }
        ss = wave_sum(ss);
        if (lane < 16) slotsH[(size_t)m * 16 + lane] = lane == 0 ? ss : 0.f;
    }
    float* cosT = (float*)(ws + A_COS); float* sinT = (float*)(ws + A_SIN);
    for (int i = (F.vcu * 512 + tid); i < T * 32; i += F.G * 512) {
        const int tok = i >> 5, j = i & 31;
        const float inv = exp2f(-(float)j * (13.287712379549449f / 32.0f));
        const float ang = (float)a.pos[tok] * inv;
        const double rev = (double)ang * 0.15915494309189535; const float fr = (float)(rev - floor(rev));
        cosT[i] = __builtin_amdgcn_cosf(fr); sinT[i] = __builtin_amdgcn_sinf(fr);
    }
}

__device__ __forceinline__ void p_premix(const Ctx& F, const Args& a) {
    const float* h = a.out; const float* g = a.in[2] + 1 * D; const float* mix = a.in[6];
    bf16_t* X1 = (bf16_t*)(a.ws + A_X1); bf16_t* XK = (bf16_t*)(a.ws + A_XK); bf16_t* XV = (bf16_t*)(a.ws + A_XV);
    const int tid = fresh_tid(F.wave), lane = tid & 63, wave = __builtin_amdgcn_readfirstlane(tid >> 6);
    const int gw = F.vcu * 8 + wave, NGW = F.G * 8;
    for (int ch = gw; ch < T / 16; ch += NGW) {
        const int t0 = ch * 16;
        f32x4 prev[4], gv[4];
#pragma unroll
        for (int j = 0; j < 4; ++j) gv[j] = *((const f32x4*)g + lane + 64 * j);
        if ((t0 & (SEQ - 1)) == 0) {
#pragma unroll
            for (int j = 0; j < 4; ++j) prev[j] = (f32x4){0.f, 0.f, 0.f, 0.f};
        } else {
            float ss = 0.f;
#pragma unroll
            for (int j = 0; j < 4; ++j) { prev[j] = *((const f32x4*)(h + (size_t)(t0 - 1) * D) + lane + 64 * j); ss += (prev[j][0] * prev[j][0] + prev[j][1] * prev[j][1]) + (prev[j][2] * prev[j][2] + prev[j][3] * prev[j][3]); }
            const float rs = __builtin_amdgcn_rsqf(wave_sum(ss) * (1.0f / 1024.0f) + RMS_EPS);
#pragma unroll
            for (int j = 0; j < 4; ++j) prev[j] = prev[j] * rs * gv[j];
        }
        for (int t = t0; t < t0 + 16; ++t) {
            f32x4 cur[4]; float ss = 0.f;
#pragma unroll
            for (int j = 0; j < 4; ++j) { cur[j] = *((const f32x4*)(h + (size_t)t * D) + lane + 64 * j); ss += (cur[j][0] * cur[j][0] + cur[j][1] * cur[j][1]) + (cur[j][2] * cur[j][2] + cur[j][3] * cur[j][3]); }
            const float rs = __builtin_amdgcn_rsqf(wave_sum(ss) * (1.0f / 1024.0f) + RMS_EPS);
#pragma unroll
            for (int j = 0; j < 4; ++j) {
                const f32x4 hn = cur[j] * rs * gv[j]; const f32x4 xx = prev[j] - hn; prev[j] = hn;
                const f32x4 mr = *((const f32x4*)(mix + 0 * D) + lane + 64 * j), mk = *((const f32x4*)(mix + 2 * D) + lane + 64 * j), mv = *((const f32x4*)(mix + 3 * D) + lane + 64 * j);
                const f32x4 xr = hn + xx * mr, xk = hn + xx * mk, xv = hn + xx * mv;
                u32x2 w;
                w.x = cvt_pk_bf16(xr[0], xr[1]); w.y = cvt_pk_bf16(xr[2], xr[3]); *((u32x2*)(X1 + (size_t)t * 2048) + lane + 64 * j) = w;
                w.x = cvt_pk_bf16(xx[0], xx[1]); w.y = cvt_pk_bf16(xx[2], xx[3]); *((u32x2*)(X1 + (size_t)t * 2048 + 1024) + lane + 64 * j) = w;
                w.x = cvt_pk_bf16(xk[0], xk[1]); w.y = cvt_pk_bf16(xk[2], xk[3]); *((u32x2*)(XK + (size_t)t * D) + lane + 64 * j) = w;
                w.x = cvt_pk_bf16(xv[0], xv[1]); w.y = cvt_pk_bf16(xv[2], xv[3]); *((u32x2*)(XV + (size_t)t * D) + lane + 64 * j) = w;
            }
        }
    }
}

constexpr int TC = 32;
__device__ __forceinline__ void p_scan(const Ctx& F, const Args& a) {
    const bf16_t* Rb = (const bf16_t*)(a.ws + A_R); const bf16_t* Kb = (const bf16_t*)(a.ws + A_KK); const bf16_t* Vb = (const bf16_t*)(a.ws + A_VV);
    const bf16_t* Eb = (const bf16_t*)(a.ws + A_E); const bf16_t* Ab = (const bf16_t*)(a.ws + A_AA); bf16_t* Gb = (bf16_t*)(a.ws + A_G);
    const float* k_k = a.in[19]; const float* k_a = a.in[20]; const float* r_k = a.in[21]; const float* gn_w = a.in[22]; const float* gn_b = a.in[23];
    LAS float* sR = (LAS float*)(F.lds); LAS float* sW = sR + TC * 64; LAS float* sK = sW + TC * 64; LAS float* sV = sK + TC * 64;
    LAS float* sKK = sV + TC * 64; LAS float* sKA = sKK + TC * 64; LAS float* sY = sKA + TC * 64; LAS float* sBo = sY + TC * 64;
    const int tid = fresh_tid(F.wave), lane = tid & 63, wave = __builtin_amdgcn_readfirstlane(tid >> 6);
    const int irow = wave * 8 + (lane >> 3), kseg = (lane & 7) * 8;
    const int ptt = tid >> 4, pc = (tid & 15) * 4;
    for (int unit0 = F.vcu; unit0 < 2 * NB * 16; unit0 += F.G) {
        const int unit = unit0 & 127; const bool shadow = unit0 >= 128;
        const int b = unit >> 4, hd = unit & 15; const int cbase = hd * 64;
        float S[8];
#pragma unroll
        for (int j = 0; j < 8; ++j) S[j] = 0.f;
        const f32x4 kkv = *(const f32x4*)(k_k + cbase + pc), kav = *(const f32x4*)(k_a + cbase + pc), rkv = *(const f32x4*)(r_k + cbase + pc);
        const f32x4 gw = *(const f32x4*)(gn_w + cbase + pc), gb = *(const f32x4*)(gn_b + cbase + pc);
        for (int c0 = 0; c0 < SEQ; c0 += TC) {
            const size_t gidx = (size_t)(b * SEQ + c0 + ptt) * D + cbase + pc;
            {
                const f32x4 r = unpack4(*(const u32x2*)(Rb + gidx)), k = unpack4(*(const u32x2*)(Kb + gidx)), v = unpack4(*(const u32x2*)(Vb + gidx));
                const f32x4 e = unpack4(*(const u32x2*)(Eb + gidx)), aa = unpack4(*(const u32x2*)(Ab + gidx));
                f32x4 kk = k * kkv; float ss = (kk[0] * kk[0] + kk[1] * kk[1]) + (kk[2] * kk[2] + kk[3] * kk[3]); ss = red16(ss);
                kk = kk * __builtin_amdgcn_rsqf(fmaxf(ss, 1e-24f));
                const f32x4 kp = k * (1.0f + (aa - 1.0f) * kav);
                const f32x4 rk = r * kp * rkv; const float bo = red16((rk[0] + rk[1]) + (rk[2] + rk[3]));
                f32x4 w;
#pragma unroll
                for (int i = 0; i < 4; ++i) w[i] = __builtin_amdgcn_exp2f(-e[i] * LOG2E);
                const int o = ptt * 64 + pc;
                *(LAS f32x4*)(sR + o) = r; *(LAS f32x4*)(sW + o) = w; *(LAS f32x4*)(sK + o) = kp; *(LAS f32x4*)(sV + o) = v; *(LAS f32x4*)(sKK + o) = kk; *(LAS f32x4*)(sKA + o) = kk * aa;
                if ((tid & 15) == 0) sBo[ptt] = bo;
            }
            __syncthreads();
#pragma unroll 2
            for (int t = 0; t < TC; ++t) {
                const int o = t * 64 + kseg;
                const f32x4 kk0 = *(const LAS f32x4*)(sKK + o), kk1 = *(const LAS f32x4*)(sKK + o + 4);
                const f32x4 w0 = *(const LAS f32x4*)(sW + o), w1 = *(const LAS f32x4*)(sW + o + 4);
                const f32x4 ka0 = *(const LAS f32x4*)(sKA + o), ka1 = *(const LAS f32x4*)(sKA + o + 4);
                const f32x4 kp0 = *(const LAS f32x4*)(sK + o), kp1 = *(const LAS f32x4*)(sK + o + 4);
                const f32x4 r0 = *(const LAS f32x4*)(sR + o), r1 = *(const LAS f32x4*)(sR + o + 4);
                const float vv = sV[t * 64 + irow];
                float sa = ((S[0] * kk0[0] + S[1] * kk0[1]) + (S[2] * kk0[2] + S[3] * kk0[3])) + ((S[4] * kk1[0] + S[5] * kk1[1]) + (S[6] * kk1[2] + S[7] * kk1[3]));
                sa = red8(sa);
#pragma unroll
                for (int j = 0; j < 4; ++j) { S[j] = S[j] * w0[j] + (vv * kp0[j] - sa * ka0[j]); S[4 + j] = S[4 + j] * w1[j] + (vv * kp1[j] - sa * ka1[j]); }
                float y = ((S[0] * r0[0] + S[1] * r0[1]) + (S[2] * r0[2] + S[3] * r0[3])) + ((S[4] * r1[0] + S[5] * r1[1]) + (S[6] * r1[2] + S[7] * r1[3]));
                y = red8(y);
                if ((lane & 7) == 0) sY[t * 64 + irow] = y;
            }
            __syncthreads();
            {
                const int o = ptt * 64 + pc;
                const f32x4 y = *(const LAS f32x4*)(sY + o), v = *(const LAS f32x4*)(sV + o);
                const float mu = red16((y[0] + y[1]) + (y[2] + y[3])) * (1.0f / 64.0f);
                const f32x4 d = y - mu; const float var = red16((d[0] * d[0] + d[1] * d[1]) + (d[2] * d[2] + d[3] * d[3])) * (1.0f / 64.0f);
                const float rs = __builtin_amdgcn_rsqf(var + GN_EPS); const float bo = sBo[ptt];
                const f32x4 gg = unpack4(*(const u32x2*)(Gb + gidx));
                const f32x4 ov = (d * rs * gw + gb + v * bo) * gg;
                u32x2 w; w.x = cvt_pk_bf16(ov[0], ov[1]); w.y = cvt_pk_bf16(ov[2], ov[3]); if (!shadow) *(u32x2*)(Gb + gidx) = w;
            }
            __syncthreads();
        }
    }
}


__device__ __forceinline__ void p_scan2(const Ctx& F, const Args& a) {
    const bf16_t* Rb = (const bf16_t*)(a.ws + A_R); const bf16_t* Kb = (const bf16_t*)(a.ws + A_KK); const bf16_t* Vb = (const bf16_t*)(a.ws + A_VV);
    const bf16_t* Eb = (const bf16_t*)(a.ws + A_E); const bf16_t* Ab = (const bf16_t*)(a.ws + A_AA); bf16_t* Yb = (bf16_t*)(a.ws + A_G); float* Bon = (float*)(a.ws + A_BON);
    const float* k_k = a.in[19]; const float* k_a = a.in[20]; const float* r_k = a.in[21];
    LAS float* sR = (LAS float*)(F.lds); LAS float* sW = sR + TC * 64; LAS float* sK = sW + TC * 64; LAS float* sV = sK + TC * 64;
    LAS float* sKK = sV + TC * 64; LAS float* sKA = sKK + TC * 64; LAS float* sY = sKA + TC * 64;
    const int tid = fresh_tid(F.wave), lane = tid & 63, wave = __builtin_amdgcn_readfirstlane(tid >> 6);
    const int lrow = wave * 8 + (lane >> 3), kseg = (lane & 7) * 8;
    const int ptt = tid >> 4, pc = (tid & 15) * 4;
    for (int unit = F.vcu; unit < 2 * NB * 16; unit += F.G) {
        const int bh = unit >> 1, half = unit & 1, b = bh >> 4, hd = bh & 15, cbase = hd * 64;
        f32x4 S0 = (f32x4){0.f, 0.f, 0.f, 0.f}, S1 = (f32x4){0.f, 0.f, 0.f, 0.f};
        int hit = F.vcu * 4 + (wave & 3); LAS float* hscr = (LAS float*)(F.lds + 81920 + (wave & 3) * 8704);
        const f32x4 kkv = *(const f32x4*)(k_k + cbase + pc), kav = *(const f32x4*)(k_a + cbase + pc), rkv = *(const f32x4*)(r_k + cbase + pc);
        size_t gidx = (size_t)(b * SEQ + ptt) * D + cbase + pc;
        u32x2 qr = *(const u32x2*)(Rb + gidx), qk = *(const u32x2*)(Kb + gidx), qv = *(const u32x2*)(Vb + gidx), qe = *(const u32x2*)(Eb + gidx), qa = *(const u32x2*)(Ab + gidx);
        for (int c0 = 0; c0 < SEQ; c0 += TC) {
            {
                const f32x4 r = unpack4(qr), k = unpack4(qk), v = unpack4(qv), e = unpack4(qe), aa = unpack4(qa);
                f32x4 kk = k * kkv; float ss = (kk[0] * kk[0] + kk[1] * kk[1]) + (kk[2] * kk[2] + kk[3] * kk[3]); ss = red16(ss);
                kk = kk * __builtin_amdgcn_rsqf(fmaxf(ss, 1e-24f));
                const f32x4 kp = k * (1.0f + (aa - 1.0f) * kav);
                const f32x4 rk = r * kp * rkv; const float bo = red16((rk[0] + rk[1]) + (rk[2] + rk[3]));
                f32x4 w;
#pragma unroll
                for (int i = 0; i < 4; ++i) w[i] = __builtin_amdgcn_exp2f(-e[i] * LOG2E);
                const int o = ptt * 64 + pc;
                *(LAS f32x4*)(sR + o) = r; *(LAS f32x4*)(sW + o) = w; *(LAS f32x4*)(sK + o) = kp; *(LAS f32x4*)(sV + o) = v; *(LAS f32x4*)(sKK + o) = kk; *(LAS f32x4*)(sKA + o) = kk * aa;
                if (half == 0 && (tid & 15) == 0) Bon[(size_t)(b * SEQ + c0 + ptt) * 16 + hd] = bo;
            }
            __syncthreads();
            if (c0 + TC < SEQ) { gidx += (size_t)TC * D;
                qr = *(const u32x2*)(Rb + gidx); qk = *(const u32x2*)(Kb + gidx); qv = *(const u32x2*)(Vb + gidx); qe = *(const u32x2*)(Eb + gidx); qa = *(const u32x2*)(Ab + gidx); }
            if (wave >= 4) {
                if (hit < NITEMS) { p0_item(a, hit, 1, hscr, lane); hit += 1024; }
            }
            if (wave < 4) {
#define SCAN_LD(P, tt) { const int o_ = (tt) * 64 + kseg; \
                kk0##P = *(const LAS f32x4*)(sKK + o_); kk1##P = *(const LAS f32x4*)(sKK + o_ + 4); w0##P = *(const LAS f32x4*)(sW + o_); w1##P = *(const LAS f32x4*)(sW + o_ + 4); \
                ka0##P = *(const LAS f32x4*)(sKA + o_); ka1##P = *(const LAS f32x4*)(sKA + o_ + 4); kp0##P = *(const LAS f32x4*)(sK + o_); kp1##P = *(const LAS f32x4*)(sK + o_ + 4); \
                r0##P = *(const LAS f32x4*)(sR + o_); r1##P = *(const LAS f32x4*)(sR + o_ + 4); vv##P = sV[(tt) * 64 + half * 32 + lrow]; }
#define SCAN_STEP(P, tt) { f32x4 p4 = S0 * kk0##P; p4 = S1 * kk1##P + p4; const float sa = red8((p4[0] + p4[1]) + (p4[2] + p4[3])); \
                S0 = S0 * w0##P + (kp0##P * vv##P - ka0##P * sa); S1 = S1 * w1##P + (kp1##P * vv##P - ka1##P * sa); \
                f32x4 y4 = S0 * r0##P; y4 = S1 * r1##P + y4; sY[(tt) * 256 + tid] = (y4[0] + y4[1]) + (y4[2] + y4[3]); }
                f32x4 kk0A, kk1A, w0A, w1A, ka0A, ka1A, kp0A, kp1A, r0A, r1A; float vvA;
                f32x4 kk0B, kk1B, w0B, w1B, ka0B, ka1B, kp0B, kp1B, r0B, r1B; float vvB;
                SCAN_LD(A, 0)
#pragma unroll 2
                for (int t = 0; t < TC; t += 2) {
                    SCAN_LD(B, t + 1)
                    SCAN_STEP(A, t)
                    SCAN_LD(A, (t + 2 < TC) ? t + 2 : t)
                    SCAN_STEP(B, t + 1)
                }
#undef SCAN_LD
#undef SCAN_STEP
            }
            __syncthreads();
            {
                const int tok = tid >> 4, r2 = (tid & 15) * 2;
                const LAS f32x4* q = (const LAS f32x4*)(sY + tok * 256 + r2 * 8);
                const f32x4 s0 = q[0] + q[1], s1 = q[2] + q[3];
                *(unsigned*)(Yb + (size_t)(b * SEQ + c0 + tok) * D + cbase + half * 32 + r2) = cvt_pk_bf16((s0[0] + s0[1]) + (s0[2] + s0[3]), (s1[0] + s1[1]) + (s1[2] + s1[3]));
            }
        }
        if (wave >= 4) { while (hit < NITEMS) { p0_item(a, hit, 1, hscr, lane); hit += 1024; } }
        __syncthreads();
    }
}
__device__ __forceinline__ void p_post(const Ctx& F, const Args& a) {
    bf16_t* Yb = (bf16_t*)(a.ws + A_G); const bf16_t* Vb = (const bf16_t*)(a.ws + A_VV); const bf16_t* Gg = (const bf16_t*)(a.ws + A_E); const float* Bon = (const float*)(a.ws + A_BON);
    const float* gn_w = a.in[22]; const float* gn_b = a.in[23];
    const int tid = fresh_tid(F.wave), grp = tid >> 4, gl = tid & 15;
    for (int item = F.vcu * 32 + grp; item < T * 16; item += F.G * 32) {
        const int tok = item >> 4, hd = item & 15; const size_t idx = (size_t)tok * D + hd * 64 + 4 * gl;
        const f32x4 y = unpack4(*(const u32x2*)(Yb + idx)), v = unpack4(*(const u32x2*)(Vb + idx)), g = unpack4(*(const u32x2*)(Gg + idx));
        const float bo = Bon[(size_t)tok * 16 + hd];
        const f32x4 gw = *(const f32x4*)(gn_w + hd * 64 + 4 * gl), gb = *(const f32x4*)(gn_b + hd * 64 + 4 * gl);
        const float mu = red16((y[0] + y[1]) + (y[2] + y[3])) * (1.0f / 64.0f);
        const f32x4 d = y - mu; const float var = red16((d[0] * d[0] + d[1] * d[1]) + (d[2] * d[2] + d[3] * d[3])) * (1.0f / 64.0f);
        const float rs = __builtin_amdgcn_rsqf(var + GN_EPS);
        const f32x4 ov = (d * rs * gw + gb + v * bo) * g;
        u32x2 w; w.x = cvt_pk_bf16(ov[0], ov[1]); w.y = cvt_pk_bf16(ov[2], ov[3]); *(u32x2*)(Yb + idx) = w;
    }
}

constexpr int KROW = 400, VROW = 144, KBUF = 64 * KROW, VBUF = 128 * VROW, ABUF = KBUF + VBUF;
__device__ __forceinline__ void attn_unit(LAS unsigned char* lds, const bf16_t* qn, const bf16_t* qr, const bf16_t* kn, const bf16_t* kr, const bf16_t* vt, bf16_t* o_out, int b, int h, int qb, int wave_s) {
    const int tid = fresh_tid(wave_s), lane = tid & 63, wid = __builtin_amdgcn_readfirstlane(tid >> 6), r32 = lane & 31, hi = lane >> 5;
    const int tok0 = b * SEQ, q0 = qb * 256 + wid * 32;
    bf16x8 qf[12];
    { const size_t tq = (size_t)(tok0 + q0 + r32);
#pragma unroll
      for (int d = 0; d < 8; ++d) qf[d] = *(const bf16x8*)(qn + tq * D + h * 128 + d * 16 + hi * 8);
#pragma unroll
      for (int d = 0; d < 4; ++d) qf[8 + d] = *(const bf16x8*)(qr + tq * 512 + h * 64 + d * 16 + hi * 8); }
    const int NT = (qb + 1) * 4;
    const int kkey0 = tid >> 4, kch0 = tid & 15;
    const int rkey = tid >> 3, rch = tid & 7;
    const int vrow0 = tid >> 3, vch = tid & 7;
    const bf16_t* gk0 = kn + (size_t)(tok0 + kkey0) * D + h * 128 + kch0 * 8;
    const bf16_t* gk1 = gk0 + (size_t)32 * D;
    const bf16_t* gr = kr + (size_t)(tok0 + rkey) * 64 + rch * 8;
    const bf16_t* gv0 = vt + (size_t)(h * 128 + vrow0) * T + tok0 + vch * 8;
    const bf16_t* gv1 = gv0 + (size_t)64 * T;
    const int lk0 = kkey0 * KROW + kch0 * 16, lk1 = lk0 + 32 * KROW, lr = rkey * KROW + 256 + rch * 16, lv0 = KBUF + vrow0 * VROW + vch * 16, lv1 = lv0 + 64 * VROW;
    const int pr = (r32 & 0x13) | ((r32 & 4) << 1) | ((r32 & 8) >> 1);
    const int kfo = pr * KROW + hi * 16, vfo = KBUF + r32 * VROW + hi * 16;
    u32x4 ld0, ld1, ld2, ld3, ld4;
    ld0 = *(const u32x4*)gk0; ld1 = *(const u32x4*)gk1; ld2 = *(const u32x4*)gr; ld3 = *(const u32x4*)gv0; ld4 = *(const u32x4*)gv1;
    __syncthreads();
    *(LAS u32x4*)(lds + lk0) = ld0; *(LAS u32x4*)(lds + lk1) = ld1; *(LAS u32x4*)(lds + lr) = ld2; *(LAS u32x4*)(lds + lv0) = ld3; *(LAS u32x4*)(lds + lv1) = ld4;
    __syncthreads();
    float mrun = -1e30f, lrun = 0.f;
    f32x16 o[4];
#pragma unroll
    for (int d = 0; d < 4; ++d) o[d] = f32x16{};
    for (int t = 0; t < NT; ++t) {
        const int cb = (t & 1) * ABUF, nb = ((t + 1) & 1) * ABUF;
        const bool more = (t + 1 < NT);
        if (more) { const size_t ko = (size_t)(t + 1) * 64 * D, ro = (size_t)(t + 1) * 64 * 64, vo = (size_t)(t + 1) * 64;
            ld0 = *(const u32x4*)(gk0 + ko); ld1 = *(const u32x4*)(gk1 + ko); ld2 = *(const u32x4*)(gr + ro); ld3 = *(const u32x4*)(gv0 + vo); ld4 = *(const u32x4*)(gv1 + vo); }
        if (64 * t <= q0 + 31) {
            f32x16 s0 = f32x16{}, s1 = f32x16{};
            __builtin_amdgcn_s_setprio(1);
#pragma unroll
            for (int d = 0; d < 12; ++d) {
                const bf16x8 k0 = *(const LAS bf16x8*)(lds + cb + kfo + d * 32), k1 = *(const LAS bf16x8*)(lds + cb + kfo + 32 * KROW + d * 32);
                s0 = __builtin_amdgcn_mfma_f32_32x32x16_bf16(k0, qf[d], s0, 0, 0, 0);
                s1 = __builtin_amdgcn_mfma_f32_32x32x16_bf16(k1, qf[d], s1, 0, 0, 0);
            }
            __builtin_amdgcn_s_setprio(0);
            if (64 * t + 63 > q0) {
                const int qi = q0 + r32, kb0 = 64 * t + 8 * hi;
#pragma unroll
                for (int r = 0; r < 16; ++r) { const int key = kb0 + 16 * (r >> 3) + (r & 7); if (key > qi) s0[r] = -1e30f; if (key + 32 > qi) s1[r] = -1e30f; }
            }
            float mx = fmaxf(fmaxf(s0[0], s1[0]), s0[1]);
#pragma unroll
            for (int r = 1; r < 16; ++r) mx = fmaxf(fmaxf(mx, s1[r]), (r < 15) ? s0[r + 1] : s1[r]);
            { auto rr = __builtin_amdgcn_permlane32_swap(__float_as_uint(mx), __float_as_uint(mx), false, false); mx = fmaxf(__uint_as_float(rr[0]), __uint_as_float(rr[1])); }
            if (__any(mx - mrun > 8.0f)) {
                const float mnew = fmaxf(mrun, mx); const float alpha = __builtin_amdgcn_exp2f(mrun - mnew); mrun = mnew; lrun *= alpha;
#pragma unroll
                for (int d = 0; d < 4; ++d) o[d] = o[d] * alpha;
            }
            float ps = 0.f;
#pragma unroll
            for (int r = 0; r < 16; ++r) { s0[r] = __builtin_amdgcn_exp2f(s0[r] - mrun); s1[r] = __builtin_amdgcn_exp2f(s1[r] - mrun); ps += s0[r] + s1[r]; }
            lrun += ps;
            bf16x8 pf[4];
            { u32x4 w;
              w.x = cvt_pk_bf16(s0[0], s0[1]); w.y = cvt_pk_bf16(s0[2], s0[3]); w.z = cvt_pk_bf16(s0[4], s0[5]); w.w = cvt_pk_bf16(s0[6], s0[7]); pf[0] = __builtin_bit_cast(bf16x8, w);
              w.x = cvt_pk_bf16(s0[8], s0[9]); w.y = cvt_pk_bf16(s0[10], s0[11]); w.z = cvt_pk_bf16(s0[12], s0[13]); w.w = cvt_pk_bf16(s0[14], s0[15]); pf[1] = __builtin_bit_cast(bf16x8, w);
              w.x = cvt_pk_bf16(s1[0], s1[1]); w.y = cvt_pk_bf16(s1[2], s1[3]); w.z = cvt_pk_bf16(s1[4], s1[5]); w.w = cvt_pk_bf16(s1[6], s1[7]); pf[2] = __builtin_bit_cast(bf16x8, w);
              w.x = cvt_pk_bf16(s1[8], s1[9]); w.y = cvt_pk_bf16(s1[10], s1[11]); w.z = cvt_pk_bf16(s1[12], s1[13]); w.w = cvt_pk_bf16(s1[14], s1[15]); pf[3] = __builtin_bit_cast(bf16x8, w); }
            __builtin_amdgcn_s_setprio(1);
#pragma unroll
            for (int d = 0; d < 4; ++d)
#pragma unroll
                for (int ks = 0; ks < 4; ++ks) {
                    const bf16x8 vf = *(const LAS bf16x8*)(lds + cb + vfo + d * 32 * VROW + ks * 32);
                    o[d] = __builtin_amdgcn_mfma_f32_32x32x16_bf16(vf, pf[ks], o[d], 0, 0, 0);
                }
            __builtin_amdgcn_s_setprio(0);
        }
        if (more) { *(LAS u32x4*)(lds + nb + lk0) = ld0; *(LAS u32x4*)(lds + nb + lk1) = ld1; *(LAS u32x4*)(lds + nb + lr) = ld2; *(LAS u32x4*)(lds + nb + lv0) = ld3; *(LAS u32x4*)(lds + nb + lv1) = ld4; }
        __syncthreads();
    }
    { auto rr = __builtin_amdgcn_permlane32_swap(__float_as_uint(lrun), __float_as_uint(lrun), false, false); lrun = __uint_as_float(rr[0]) + __uint_as_float(rr[1]); }
    const float rl = __builtin_amdgcn_rcpf(lrun);
    bf16_t* op = o_out + (size_t)(tok0 + q0 + r32) * D + h * 128 + 4 * hi;
#pragma unroll
    for (int d = 0; d < 4; ++d)
#pragma unroll
        for (int r4 = 0; r4 < 4; ++r4) { u32x2 w; w.x = cvt_pk_bf16(o[d][4 * r4] * rl, o[d][4 * r4 + 1] * rl); w.y = cvt_pk_bf16(o[d][4 * r4 + 2] * rl, o[d][4 * r4 + 3] * rl);
            *(u32x2*)(op + 32 * d + 8 * r4) = w; }
}
__device__ __forceinline__ void p_attn(const Ctx& F, const Args& a) {
    const bf16_t* qn = (const bf16_t*)(a.ws + A_QN); const bf16_t* qr = (const bf16_t*)(a.ws + A_QR);
    const bf16_t* kn = (const bf16_t*)(a.ws + A_KN); const bf16_t* kr = (const bf16_t*)(a.ws + A_KR); const bf16_t* vt = (const bf16_t*)(a.ws + A_VT);
    bf16_t* oo = (bf16_t*)(a.ws + A_QN);
    for (int p = F.vcu; p < 512; p += F.G) {
        const int bh = p >> 3, s = p & 7;
        attn_unit(F.lds, qn, qr, kn, kr, vt, oo, bh >> 3, bh & 7, 15 - s, F.wave);
        attn_unit(F.lds, qn, qr, kn, kr, vt, oo, bh >> 3, bh & 7, s, F.wave);
    }
}

__device__ __forceinline__ void p_final(const Ctx& F, const Args& a) {
    float* h = a.out; const float* g = a.in[32];
    const int tid = fresh_tid(F.wave), lane = tid & 63, wave = __builtin_amdgcn_readfirstlane(tid >> 6);
    const int gw = F.vcu * 8 + wave, NGW = F.G * 8;
    f32x4 gv[4];
#pragma unroll
    for (int j = 0; j < 4; ++j) gv[j] = *((const f32x4*)g + lane + 64 * j);
    for (int m = gw; m < T; m += NGW) {
        f32x4 v[4]; float ss = 0.f;
#pragma unroll
        for (int j = 0; j < 4; ++j) { v[j] = *((const f32x4*)(h + (size_t)m * D) + lane + 64 * j); ss += (v[j][0] * v[j][0] + v[j][1] * v[j][1]) + (v[j][2] * v[j][2] + v[j][3] * v[j][3]); }
        const float rs = __builtin_amdgcn_rsqf(wave_sum(ss) * (1.0f / 1024.0f) + RMS_EPS);
#pragma unroll
        for (int j = 0; j < 4; ++j) *((f32x4*)(h + (size_t)m * D) + lane + 64 * j) = v[j] * rs * gv[j];
    }
}

#define XB_XCNT(j)  (256  + 64 * (j))
#define XB_XSUB(j)  (1280 + 64 * (j))
#define XB_XGEN(j)  (2304 + 64 * (j))
#define XB_TOP      3328
#define XB_TOPGEN   3392
__device__ __forceinline__ unsigned xb_ld(unsigned* p)              { return __hip_atomic_load(p, __ATOMIC_RELAXED, __HIP_MEMORY_SCOPE_AGENT); }
__device__ __forceinline__ unsigned xb_add(unsigned* p, unsigned v) { return __hip_atomic_fetch_add(p, v, __ATOMIC_RELAXED, __HIP_MEMORY_SCOPE_AGENT); }
__device__ __forceinline__ void my_grid_sync(unsigned* bar, unsigned G, int wave_s, unsigned x, volatile LAS unsigned* st) {
    asm volatile("s_waitcnt vmcnt(0) lgkmcnt(0)" ::: "memory");
    __syncthreads();
    if (fresh_tid(wave_s) == 0) {
        unsigned nloc = st[0], nx = st[1];
        if (nloc == 0u) {
            for (;;) { unsigned sum = 0u, cnt = 0u, mine = 0u;
#pragma unroll
                for (unsigned j = 0; j < 16; ++j) { const unsigned c = xb_ld(&bar[XB_XCNT(j)]); sum += c; cnt += (c > 0u) ? 1u : 0u; mine = (j == x) ? c : mine; }
                if (sum == G) { nloc = mine; nx = cnt; break; }
                __builtin_amdgcn_s_sleep(1); }
            st[0] = nloc; st[1] = nx;
        }
        const unsigned old = xb_add(&bar[XB_XSUB(x)], 1u);
        const unsigned gen = old / nloc;
        if (old + 1u == (gen + 1u) * nloc) {
            __builtin_amdgcn_fence(__ATOMIC_RELEASE, "agent");
            asm volatile("s_waitcnt vmcnt(0)" ::: "memory");
            const unsigned og = xb_add(&bar[XB_TOP], 1u);
            const unsigned tg = og / nx;
            if (og + 1u == (tg + 1u) * nx) xb_add(&bar[XB_TOPGEN], 1u);
            else while (xb_ld(&bar[XB_TOPGEN]) == tg) __builtin_amdgcn_s_sleep(1);
            __builtin_amdgcn_fence(__ATOMIC_ACQUIRE, "agent");
            xb_add(&bar[XB_XGEN(x)], 1u);
            asm volatile("s_waitcnt vmcnt(0)" ::: "memory");
        } else {
            while (xb_ld(&bar[XB_XGEN(x)]) == gen) __builtin_amdgcn_s_sleep(1);
            __builtin_amdgcn_fence(__ATOMIC_ACQUIRE, "agent");
            asm volatile("s_waitcnt vmcnt(0)" ::: "memory");
        }
    }
    __syncthreads();
}
#define GSYNC() do { my_grid_sync(bar_words + 64 * bar_idx, (unsigned)F.G, F.wave); ++bar_idx; } while (0)
#define RUN_GEMM(EPI_T, epi, Aptr, lda_, Bptr, ldb_, M_, N_, K_) do { pg8::Gemm g_{(const bf16_t*)(Aptr), (lda_), (const bf16_t*)(Bptr), (ldb_), (M_), (N_), (K_)}; \
    pg8::StaticOrder S_; S_.init((M_), (N_), F.G, (int)blockIdx.x); pg8::gemm_phase<EPI_T, pg8::StaticOrder>(F.lds, g_, S_, (epi), F.wave); } while (0)

__global__ void __launch_bounds__(512, 2) fwd_mega(Args a) {
    extern __shared__ __attribute__((aligned(16))) unsigned char lds_raw[];
    cg::grid_group grid = cg::this_grid();
    Ctx F; F.lds = (LAS unsigned char*)lds_raw; F.wave = __builtin_amdgcn_readfirstlane((int)threadIdx.x >> 6);
    F.G = gridDim.x; { const int bx = blockIdx.x; F.vcu = (F.G % 8 == 0) ? (bx % 8) * (F.G / 8) + bx / 8 : bx; }
    unsigned char* ws = a.ws;
    float* slotsH = (float*)(ws + WS_SLOTH); float* slotsC = (float*)(ws + WS_SLOTC); float* slotsQ = (float*)(ws + WS_SLOTQ);
    bf16_t* HB = (bf16_t*)(ws + A_HB); bf16_t* MID = (bf16_t*)(ws + A_MID);
    const float* cosT = (const float*)(ws + A_COS); const float* sinT = (const float*)(ws + A_SIN);
    bf16_t* WUG = (bf16_t*)(ws + W_UG); bf16_t* WDN = (bf16_t*)(ws + W_DN);

    unsigned* bar_words = (unsigned*)ws;
    if (a.ph_hi > 1000) grid.sync();
    const unsigned xcc = (unsigned)__builtin_amdgcn_s_getreg((3 << 11) | 20) & 0xFu;
    volatile LAS unsigned* xst = (volatile LAS unsigned*)(F.lds + 131072 + 64);
    if (fresh_tid(F.wave) == 0) { xst[0] = 0u; xst[1] = 0u; (void)xb_add(&bar_words[XB_XCNT(xcc)], 1u); }
    __syncthreads();
    if (a.ph_lo <= 0 && 0 < a.ph_hi) {
    p0_prologue(F, a);
    }
    if (a.ph_lo <= 0 && 1 < a.ph_hi) my_grid_sync(bar_words, (unsigned)F.G, F.wave, xcc, xst);
    if (a.ph_lo <= 1 && 1 < a.ph_hi) {
    { EpiSwiglu E{MID, slotsH, nullptr, nullptr, nullptr, nullptr, nullptr}; RUN_GEMM(EpiSwiglu, E, HB, D, WUG, D, T, 5632, D); }
    }
    if (a.ph_lo <= 1 && 2 < a.ph_hi) my_grid_sync(bar_words, (unsigned)F.G, F.wave, xcc, xst);
    if (a.ph_lo <= 2 && 2 < a.ph_hi) {
    { EpiResid E{a.in[0], a.out, nullptr, nullptr, 0.5f}; RUN_GEMM(EpiResid, E, MID, FF, WDN, FF, T, D, FF); }
    }
    if (a.ph_lo <= 2 && 3 < a.ph_hi) my_grid_sync(bar_words, (unsigned)F.G, F.wave, xcc, xst);
    if (a.ph_lo <= 3 && 3 < a.ph_hi) {
    p_premix(F, a);
    }
    if (a.ph_lo <= 3 && 4 < a.ph_hi) my_grid_sync(bar_words, (unsigned)F.G, F.wave, xcc, xst);
    if (a.ph_lo <= 4 && 4 < a.ph_hi) {
    { EpiRL E{(bf16_t*)(ws + A_R), (bf16_t*)(ws + A_LM)}; pg8::Gemm g_{(const bf16_t*)(ws + A_X1), 2048, (const bf16_t*)(ws + W_RL), 2048, T, 1280, 2048}; pg8::OrderRL S_{(int)blockIdx.x};
      pg8::gemm_phase<EpiRL, pg8::OrderRL>(F.lds, g_, S_, E, F.wave); }
    }
    if (a.ph_lo <= 4 && 5 < a.ph_hi) my_grid_sync(bar_words, (unsigned)F.G, F.wave, xcc, xst);
    if (a.ph_lo <= 5 && 5 < a.ph_hi) {
    { EpiBf16 E{(bf16_t*)(ws + A_KK), D}; RUN_GEMM(EpiBf16, E, ws + A_XK, D, ws + W_K, D, T, D, D); }
    { EpiBf16 E{(bf16_t*)(ws + A_VV), D}; RUN_GEMM(EpiBf16, E, ws + A_XV, D, ws + W_V, D, T, D, D); }
    }
    if (a.ph_lo <= 5 && 6 < a.ph_hi) my_grid_sync(bar_words, (unsigned)F.G, F.wave, xcc, xst);
    if (a.ph_lo <= 6 && 6 < a.ph_hi) {
    { EpiLoraUp E{ws, a.in[11], a.in[14], 0, A_G}; RUN_GEMM(EpiLoraUp, E, ws + A_LM, 256, ws + W_LU, 256, T, 2048, 256); }
    }
    if (a.ph_lo <= 6 && 7 < a.ph_hi) my_grid_sync(bar_words, (unsigned)F.G, F.wave, xcc, xst);
    if (a.ph_lo <= 7 && 7 < a.ph_hi) {
    p_scan2(F, a);
    }
    if (a.ph_lo <= 7 && 8 < a.ph_hi) my_grid_sync(bar_words, (unsigned)F.G, F.wave, xcc, xst);
    if (a.ph_lo <= 8 && 8 < a.ph_hi) {
    { EpiLoraUp E{ws, a.in[11], a.in[14], 2, A_E}; RUN_GEMM(EpiLoraUp, E, ws + A_LM, 256, ws + W_LU + (size_t)2048 * 256 * 2, 256, T, 1024, 256); }
    }
    if (a.ph_lo <= 8 && 9 < a.ph_hi) my_grid_sync(bar_words, (unsigned)F.G, F.wave, xcc, xst);
    if (a.ph_lo <= 9 && 9 < a.ph_hi) {
    p_post(F, a);
    }
    if (a.ph_lo <= 9 && 10 < a.ph_hi) my_grid_sync(bar_words, (unsigned)F.G, F.wave, xcc, xst);
    if (a.ph_lo <= 10 && 10 < a.ph_hi) {
    { EpiResid E{a.out, a.out, HB, slotsH, 1.0f}; RUN_GEMM(EpiResid, E, ws + A_G, D, ws + W_O, D, T, D, D); }
    }
    if (a.ph_lo <= 10 && 11 < a.ph_hi) my_grid_sync(bar_words, (unsigned)F.G, F.wave, xcc, xst);
    if (a.ph_lo <= 11 && 11 < a.ph_hi) {
    { EpiSwiglu E{MID, slotsH, nullptr, nullptr, nullptr, nullptr, nullptr}; RUN_GEMM(EpiSwiglu, E, HB, D, WUG + (size_t)1 * 6144 * D, D, T, 5632, D); }
    }
    if (a.ph_lo <= 11 && 12 < a.ph_hi) my_grid_sync(bar_words, (unsigned)F.G, F.wave, xcc, xst);
    if (a.ph_lo <= 12 && 12 < a.ph_hi) {
    { EpiResid E{a.out, a.out, HB, slotsH, 0.5f}; RUN_GEMM(EpiResid, E, MID, FF, WDN + (size_t)1 * D * FF, FF, T, D, FF); }
    }
    if (a.ph_lo <= 12 && 13 < a.ph_hi) my_grid_sync(bar_words, (unsigned)F.G, F.wave, xcc, xst);
    if (a.ph_lo <= 13 && 13 < a.ph_hi) {
    { EpiSwiglu E{MID, slotsH, (bf16_t*)(ws + A_C), slotsC, (bf16_t*)(ws + A_KR), cosT, sinT}; RUN_GEMM(EpiSwiglu, E, HB, D, WUG + (size_t)2 * 6144 * D, D, T, 6144, D); }
    }
    if (a.ph_lo <= 13 && 14 < a.ph_hi) my_grid_sync(bar_words, (unsigned)F.G, F.wave, xcc, xst);
    if (a.ph_lo <= 14 && 14 < a.ph_hi) {
    { EpiResid E{a.out, a.out, HB, slotsH, 0.5f}; RUN_GEMM(EpiResid, E, MID, FF, WDN + (size_t)2 * D * FF, FF, T, D, FF); }
    { EpiKnope E{(bf16_t*)(ws + A_KN), slotsC}; RUN_GEMM(EpiKnope, E, ws + A_C, 256, ws + W_KN, 256, T, D, 256); }
    { EpiVt E{(bf16_t*)(ws + A_VT), slotsC}; RUN_GEMM(EpiVt, E, ws + W_VT, 256, ws + A_C, 256, D, T, 256); }
    }
    if (a.ph_lo <= 14 && 15 < a.ph_hi) my_grid_sync(bar_words, (unsigned)F.G, F.wave, xcc, xst);
    if (a.ph_lo <= 15 && 15 < a.ph_hi) {
    { EpiQlat E{(bf16_t*)(ws + A_QLAT), slotsH, slotsQ}; RUN_GEMM(EpiQlat, E, HB, D, ws + W_DQ, D, T, 512, D); }
    }
    if (a.ph_lo <= 15 && 16 < a.ph_hi) my_grid_sync(bar_words, (unsigned)F.G, F.wave, xcc, xst);
    if (a.ph_lo <= 16 && 16 < a.ph_hi) {
    { EpiQ E{(bf16_t*)(ws + A_QN), (bf16_t*)(ws + A_QR), slotsQ, cosT, sinT}; RUN_GEMM(EpiQ, E, ws + A_QLAT, 512, ws + W_UQ, 512, T, 1536, 512); }
    }
    if (a.ph_lo <= 16 && 17 < a.ph_hi) my_grid_sync(bar_words, (unsigned)F.G, F.wave, xcc, xst);
    if (a.ph_lo <= 17 && 17 < a.ph_hi) {
    p_attn(F, a);
    }
    if (a.ph_lo <= 17 && 18 < a.ph_hi) my_grid_sync(bar_words, (unsigned)F.G, F.wave, xcc, xst);
    if (a.ph_lo <= 18 && 18 < a.ph_hi) {
    { EpiResid E{a.out, a.out, HB, slotsH, 1.0f}; RUN_GEMM(EpiResid, E, ws + A_QN, D, ws + W_MO, D, T, D, D); }
    }
    if (a.ph_lo <= 18 && 19 < a.ph_hi) my_grid_sync(bar_words, (unsigned)F.G, F.wave, xcc, xst);
    if (a.ph_lo <= 19 && 19 < a.ph_hi) {
    { EpiSwiglu E{MID, slotsH, nullptr, nullptr, nullptr, nullptr, nullptr}; RUN_GEMM(EpiSwiglu, E, HB, D, WUG + (size_t)3 * 6144 * D, D, T, 5632, D); }
    }
    if (a.ph_lo <= 19 && 20 < a.ph_hi) my_grid_sync(bar_words, (unsigned)F.G, F.wave, xcc, xst);
    if (a.ph_lo <= 20 && 20 < a.ph_hi) {
    { EpiResid E{a.out, a.out, nullptr, nullptr, 0.5f}; RUN_GEMM(EpiResid, E, MID, FF, WDN + (size_t)3 * D * FF, FF, T, D, FF); }
    }
    if (a.ph_lo <= 20 && 21 < a.ph_hi) my_grid_sync(bar_words, (unsigned)F.G, F.wave, xcc, xst);
    if (a.ph_lo <= 21 && 21 < a.ph_hi) {
    p_final(F, a);
    }
}

extern "C" void kernel_launch(void* const* d_in, const int* in_sizes, int n_in, void* d_out, int out_size, void* d_ws, size_t ws_size, hipStream_t stream) {
    static int grid = 0;
    if (grid == 0) {
        if (n_in != 33 || out_size != T * D || ws_size < WS_NEED) { fprintf(stderr, "kernel_launch: unexpected shapes: n_in %d out %d ws %zu (need %zu)\n", n_in, out_size, ws_size, (size_t)WS_NEED); grid = -1; return; }
        int dev = 0, cus = 0, per_cu = 0;
        (void)hipGetDevice(&dev); (void)hipDeviceGetAttribute(&cus, hipDeviceAttributeMultiprocessorCount, dev);
        (void)hipFuncSetAttribute((const void*)fwd_mega, hipFuncAttributeMaxDynamicSharedMemorySize, LDS_BYTES);
        (void)hipOccupancyMaxActiveBlocksPerMultiprocessor(&per_cu, (const void*)fwd_mega, 512, LDS_BYTES);
        (void)hipGetLastError();
        grid = cus > 0 ? cus : 256;
        if (grid > 256) grid = 256;
    }
    if (grid < 0) return;
    (void)hipMemsetAsync(d_ws, 0, 65536, stream);
    Args a{};
    for (int i = 0; i < 33; ++i) a.in[i] = (const float*)d_in[i];
    a.pos = (const int*)d_in[1]; a.out = (float*)d_out; a.ws = (unsigned char*)d_ws;
    hipError_t e = hipSuccess;
#if N_LAUNCHES == 1
    a.ph_lo = 0; a.ph_hi = NPHASES;
    { void* args[] = {&a}; e = hipLaunchCooperativeKernel((void*)fwd_mega, dim3(grid), dim3(512), args, LDS_BYTES, stream); }
#else
    for (int p = 0; p < NPHASES; ++p) { a.ph_lo = p; a.ph_hi = p + 1; hipLaunchKernelGGL(fwd_mega, dim3(grid), dim3(512), LDS_BYTES, stream, a); }
    e = hipPeekAtLastError();
#endif
    if (e != hipSuccess) fprintf(stderr, "cooperative launch failed: %s (grid %d)\n", hipGetErrorString(e), grid);
}
```

```cpp
#include <hip/hip_runtime.h>
#include <hip/hip_cooperative_groups.h>
#include <cstdio>
#include <cstdint>
namespace cg = cooperative_groups;

#define LAS __attribute__((address_space(3)))
typedef unsigned short bf16_t;
typedef short bf16x8 __attribute__((ext_vector_type(8)));
typedef float f32x4 __attribute__((ext_vector_type(4)));
typedef float f32x16 __attribute__((ext_vector_type(16)));
typedef unsigned u32x4 __attribute__((ext_vector_type(4)));
typedef unsigned u32x2 __attribute__((ext_vector_type(2)));
typedef float f32x2 __attribute__((ext_vector_type(2)));

constexpr int T = 32768, D = 1024, FF = 2816, SEQ = 4096, NB = 8;
constexpr float RMS_EPS = 1e-6f, GN_EPS = 64e-5f;
constexpr float LOG2E = 1.4426950408889634f;
constexpr float QSCALE = 0.07216878364870322f * 1.4426950408889634f;

constexpr size_t MiB = 1u << 20;
constexpr size_t WS_SLOTH = MiB / 2;
constexpr size_t WS_SLOTC = WS_SLOTH + 2 * MiB;
constexpr size_t WS_SLOTQ = WS_SLOTC + MiB / 2;
constexpr size_t WS_W = 4 * MiB;
constexpr size_t W_UG = WS_W;
constexpr size_t W_DN = W_UG + 48 * MiB;
constexpr size_t W_R = W_DN + 22 * MiB;
constexpr size_t W_K = W_R + 2 * MiB;
constexpr size_t W_V = W_K + 2 * MiB;
constexpr size_t W_O = W_V + 2 * MiB;
constexpr size_t W_LD = W_O + 2 * MiB;
constexpr size_t W_LU = W_LD + 1 * MiB;
constexpr size_t W_KN = W_LU + 2 * MiB;
constexpr size_t W_VT = W_KN + MiB / 2;
constexpr size_t W_DQ = W_VT + MiB / 2;
constexpr size_t W_UQ = W_DQ + 1 * MiB;
constexpr size_t W_MO = W_UQ + 2 * MiB;
constexpr size_t W_END = W_MO + 2 * MiB;
constexpr size_t WS_A = 92 * MiB;
static_assert(W_END <= WS_A, "weights region");
constexpr size_t A_HB = WS_A + 0;
constexpr size_t A_MID = WS_A + 64 * MiB;
constexpr size_t A_C = WS_A + 240 * MiB;
constexpr size_t A_KR = WS_A + 256 * MiB;
constexpr size_t A_KN = WS_A + 260 * MiB;
constexpr size_t A_VT = WS_A + 324 * MiB;
constexpr size_t A_QLAT = A_MID;
constexpr size_t A_QN = A_MID + 32 * MiB;
constexpr size_t A_QR = A_MID + 96 * MiB;
constexpr size_t A_X1 = WS_A + 0;
constexpr size_t A_XK = WS_A + 128 * MiB;
constexpr size_t A_XV = WS_A + 192 * MiB;
constexpr size_t A_R = WS_A + 256 * MiB;
constexpr size_t A_LM = WS_A + 320 * MiB;
constexpr size_t A_KK = WS_A + 0;
constexpr size_t A_VV = WS_A + 64 * MiB;
constexpr size_t A_E = WS_A + 128 * MiB;
constexpr size_t A_AA = WS_A + 192 * MiB;
constexpr size_t A_G = WS_A + 336 * MiB;
constexpr size_t A_BON = WS_A + 400 * MiB;
constexpr size_t A_COS = WS_A + 404 * MiB;
constexpr size_t A_SIN = WS_A + 408 * MiB;
constexpr size_t W_RL = WS_A + 412 * MiB;
constexpr size_t WS_NEED = 512 * MiB;

constexpr int LDS_BYTES = 147456;
constexpr int NPHASES = 21;
#ifndef N_LAUNCHES
#define N_LAUNCHES 1
#endif

__device__ __forceinline__ unsigned cvt_pk_bf16(float lo, float hi) { unsigned r; asm volatile("v_cvt_pk_bf16_f32 %0, %1, %2" : "=v"(r) : "v"(lo), "v"(hi)); return r; }
__device__ __forceinline__ float fsigmoid(float x) { return __builtin_amdgcn_rcpf(1.0f + __builtin_amdgcn_exp2f(-x * LOG2E)); }
__device__ __forceinline__ float ftanh(float x) { return 1.0f - 2.0f * __builtin_amdgcn_rcpf(1.0f + __builtin_amdgcn_exp2f(2.0f * LOG2E * x)); }
__device__ __forceinline__ float wave_sum(float v) {
#pragma unroll
    for (int o = 1; o < 64; o <<= 1) v += __shfl_xor(v, o);
    return v;
}
template <int CTRL> __device__ __forceinline__ float dpp_mov(float x) { return __builtin_bit_cast(float, __builtin_amdgcn_update_dpp(0, __builtin_bit_cast(int, x), CTRL, 0xf, 0xf, true)); }
__device__ __forceinline__ float red8(float x) { x += dpp_mov<0xB1>(x); x += dpp_mov<0x4E>(x); x += dpp_mov<0x141>(x); return x; }
__device__ __forceinline__ float red16(float x) { x = red8(x); x += dpp_mov<0x140>(x); return x; }
__device__ __forceinline__ float sum4(f32x4 v) { return (v[0] + v[1]) + (v[2] + v[3]); }
__device__ __forceinline__ float rstd_slots16(const float* s, int row) {
    const f32x4* p = (const f32x4*)(s + (size_t)row * 16);
    const f32x4 a = p[0], b = p[1], c = p[2], d = p[3];
    return __builtin_amdgcn_rsqf((sum4(a) + sum4(b) + sum4(c) + sum4(d)) * (1.0f / 1024.0f) + RMS_EPS);
}
__device__ __forceinline__ f32x4 unpack4(u32x2 p) { f32x4 r; r[0] = __uint_as_float(p.x << 16); r[1] = __uint_as_float(p.x & 0xffff0000u); r[2] = __uint_as_float(p.y << 16); r[3] = __uint_as_float(p.y & 0xffff0000u); return r; }

__device__ __forceinline__ int fresh_tid(int wave_s) { int l; asm volatile("v_mbcnt_lo_u32_b32 %0, -1, 0\n\tv_mbcnt_hi_u32_b32 %0, -1, %0" : "=v"(l)); return wave_s * 64 + l; }

namespace pg8 {
constexpr int BM = 256, BK = 64, HALF = 128, HTB = HALF * BK * 2, STAGE_BYTES = 8 * HTB, NXCD = 8, WGM = 8;
__device__ __forceinline__ int lds_byte(int r, int c) { const int st = (r >> 4) * 2 + (c >> 5), rr = r & 15, cc = c & 31, ob = rr * 64 + cc * 2; return st * 1024 + (ob ^ (((ob >> 9) & 1) << 5)); }
__device__ __forceinline__ void stage_rc(int b, int& R, int& C) { const int st = b / 1024, sb = b % 1024, swz = sb ^ (((sb >> 9) & 1) << 5); R = (st >> 1) * 16 + swz / 64; C = (st & 1) * 32 + (swz % 64) / 2; }
__device__ __forceinline__ int perm32(int rho) { const int n = rho >> 4, i = rho & 15; return 8 * (i >> 2) + 4 * n + (i & 3); }
struct Unit { int pm, pn; };
struct Gemm { const bf16_t* A; int lda; const bf16_t* Bt; int ldb; int M, N, K; };
struct StaticOrder {
    int nM, nN, nwg, G, c;
    __device__ void init(int M, int N, int G_, int c_) { nM = M / BM; nN = N / BM; nwg = nM * nN; G = G_; c = c_; }
    __device__ bool next(int i, Unit& u) const {
        const long L = (long)i * G + c; if (L >= nwg) return false;
        int wgid = (int)L; { const int q = nwg / NXCD, r = nwg % NXCD, xcd = wgid % NXCD, off = wgid / NXCD; wgid = (xcd < r ? xcd * (q + 1) : r * (q + 1) + (xcd - r) * q) + off; }
        const int nig = WGM * nN, gid = wgid / nig, fm = gid * WGM, gsz = (nM - fm) < WGM ? (nM - fm) : WGM;
        u.pm = fm + ((wgid % nig) % gsz); u.pn = (wgid % nig) / gsz; return true;
    }
    __device__ __forceinline__ int unit_nt(const Unit&, int nt) const { return nt; }
};
struct OrderRL {
    int c;
    __device__ bool next(int i, Unit& u) const {
        int idx;
        if (c < 128) { if (i == 0) { u.pm = c; u.pn = 4; return true; } if (i > 1) return false; idx = c; }
        else { if (i > 2) return false; idx = 128 + 3 * (c - 128) + i; }
        u.pm = idx >> 2; u.pn = idx & 3; return true;
    }
    __device__ __forceinline__ int unit_nt(const Unit& u, int nt) const { return u.pn < 4 ? nt / 2 : nt; }
};

template <class Epi, class Sched>
__device__ __forceinline__ void gemm_phase(LAS unsigned char* lds, const Gemm g, const Sched& S, const Epi& E, int wave_s) {
    const int tid = fresh_tid(wave_s), wid = __builtin_amdgcn_readfirstlane(tid >> 6), lane = tid & 63, wr = wid >> 2, wc = wid & 3, fr = lane & 15, fq = lane >> 4;
    const int K = g.K, nt_full = K / BK;
    unsigned voffA[2], voffB[2];
#pragma unroll
    for (int i = 0; i < 2; ++i) { int R, C; stage_rc(tid * 16 + i * 8192, R, C); const int Rb = Epi::PERM ? ((R & ~31) + perm32(R & 31)) : R;
        voffA[i] = (unsigned)(R * g.lda + C) * 2u; voffB[i] = (unsigned)(Rb * g.ldb + C) * 2u; }
    const size_t kstep = (size_t)(BK * 2);
    const size_t hstepA = (size_t)HALF * g.lda * 2, hstepB = (size_t)HALF * g.ldb * 2;
    const size_t tstepA = 2 * hstepA, tstepB = 2 * hstepB;
    const unsigned ldsw = (unsigned)wid * 1024u;
    const int aoff = lds_byte(wr * 64 + fr, fq * 8), boff = lds_byte(wc * 32 + fr, fq * 8);
#define PG8_SA(b, h) (((b) * 2 + (h)) * HTB)
#define PG8_SB(b, h) ((4 + (b) * 2 + (h)) * HTB)
#define PG8_STAGE(bufoff, gbase, voff) do { _Pragma("unroll") for (int _i = 0; _i < 2; ++_i) \
        __builtin_amdgcn_global_load_lds((const unsigned*)((const char*)(gbase) + (voff)[_i]), (LAS unsigned*)(lds + (bufoff) + ldsw + _i * 8192), 16, 0, 0); } while (0)
#define PG8_LDA(dst, b, h) do { _Pragma("unroll") for (int m = 0; m < 4; ++m) _Pragma("unroll") for (int k = 0; k < 2; ++k) dst[m][k] = *(const LAS bf16x8*)(lds + PG8_SA(b, h) + aoff + m * 2048 + k * 1024); } while (0)
#define PG8_LDB(dst, b, h) do { _Pragma("unroll") for (int n = 0; n < 2; ++n) _Pragma("unroll") for (int k = 0; k < 2; ++k) dst[n][k] = *(const LAS bf16x8*)(lds + PG8_SB(b, h) + boff + n * 2048 + k * 1024); } while (0)
#define PG8_MMA(ai, bj, At, Bt) do { __builtin_amdgcn_s_setprio(1); _Pragma("unroll") for (int m = 0; m < 4; ++m) _Pragma("unroll") for (int n = 0; n < 2; ++n) _Pragma("unroll") for (int k = 0; k < 2; ++k) \
        acc[ai][bj][m][n] = __builtin_amdgcn_mfma_f32_16x16x32_bf16(Bt[n][k], At[m][k], acc[ai][bj][m][n], 0, 0, 0); __builtin_amdgcn_s_setprio(0); } while (0)
#define PG8_WAIT_V(n) asm volatile("s_waitcnt vmcnt(" #n ")" ::: "memory")
#define PG8_WAIT_L(n) asm volatile("s_waitcnt lgkmcnt(" #n ")" ::: "memory")
#define PG8_BAR __builtin_amdgcn_s_barrier()
#define PG8_SCHED __builtin_amdgcn_sched_barrier(0)
    Unit cur, nxt; int ui = 0;
    if (!S.next(0, cur)) return;
    f32x4 acc[2][2][4][2];
#pragma unroll
    for (int a = 0; a < 2; ++a)
#pragma unroll
        for (int b = 0; b < 2; ++b)
#pragma unroll
            for (int m = 0; m < 4; ++m)
#pragma unroll
                for (int n = 0; n < 2; ++n) acc[a][b][m][n] = (f32x4){0.f, 0.f, 0.f, 0.f};
    bf16x8 At[4][2], B0[2][2], B1[2][2];
    const char* cA = (const char*)g.A + (size_t)cur.pm * tstepA; const char* cB = (const char*)g.Bt + (size_t)cur.pn * tstepB;
    PG8_STAGE(PG8_SB(0, 0), cB, voffB); PG8_STAGE(PG8_SB(0, 1), cB + hstepB, voffB); PG8_STAGE(PG8_SA(0, 0), cA, voffA); PG8_STAGE(PG8_SA(0, 1), cA + hstepA, voffA);
    if (wr == 1) PG8_BAR;
    PG8_WAIT_V(2); PG8_BAR;
    PG8_STAGE(PG8_SB(1, 0), cB + kstep, voffB); PG8_STAGE(PG8_SA(1, 0), cA + kstep, voffA); PG8_STAGE(PG8_SB(1, 1), cB + hstepB + kstep, voffB);
    PG8_WAIT_V(6); PG8_BAR;
    for (;;) {
        const bool has_next = S.next(ui + 1, nxt);
        const char* nA = has_next ? (const char*)g.A + (size_t)nxt.pm * tstepA : cA; const char* nB = has_next ? (const char*)g.Bt + (size_t)nxt.pn * tstepB : cB;
        const int nt = S.unit_nt(cur, nt_full);
        for (int t = 0; t < nt; t += 2) {
            const bool last = (t == nt - 2);
            const char* a1 = cA + (size_t)(t + 1) * kstep;
            const char* a2 = last ? nA : cA + (size_t)(t + 2) * kstep; const char* b2 = last ? nB : cB + (size_t)(t + 2) * kstep;
            const char* a3 = a2 + kstep; const char* b3 = b2 + kstep;
            PG8_LDB(B0, 0, 0); PG8_LDB(B1, 0, 1); PG8_SCHED; PG8_LDA(At, 0, 0); PG8_STAGE(PG8_SA(1, 1), a1 + hstepA, voffA);
            PG8_WAIT_V(8); PG8_WAIT_L(0); PG8_BAR; PG8_MMA(0, 0, At, B0); PG8_MMA(0, 1, At, B1); PG8_BAR; PG8_SCHED;
            PG8_LDA(At, 0, 1); PG8_STAGE(PG8_SB(0, 0), b2, voffB); PG8_STAGE(PG8_SB(0, 1), b2 + hstepB, voffB); PG8_STAGE(PG8_SA(0, 0), a2, voffA);
            PG8_WAIT_V(8); PG8_WAIT_L(0); PG8_BAR; PG8_MMA(1, 0, At, B0); PG8_MMA(1, 1, At, B1); PG8_BAR; PG8_SCHED;
            PG8_LDB(B0, 1, 0); PG8_LDB(B1, 1, 1); PG8_SCHED; PG8_LDA(At, 1, 0); PG8_STAGE(PG8_SA(0, 1), a2 + hstepA, voffA);
            PG8_WAIT_V(8); PG8_WAIT_L(0); PG8_BAR; PG8_MMA(0, 0, At, B0); PG8_MMA(0, 1, At, B1); PG8_BAR; PG8_SCHED;
            PG8_LDA(At, 1, 1); PG8_STAGE(PG8_SB(1, 0), b3, voffB); PG8_STAGE(PG8_SB(1, 1), b3 + hstepB, voffB); PG8_STAGE(PG8_SA(1, 0), a3, voffA);
            PG8_WAIT_V(8); PG8_WAIT_L(0); PG8_BAR; PG8_MMA(1, 0, At, B0); PG8_MMA(1, 1, At, B1); PG8_BAR; PG8_SCHED;
        }
        if (wr == 0) PG8_BAR;
        E(acc, cur, wr, wc, fr, fq);
        if (!has_next) break;
#pragma unroll
        for (int a = 0; a < 2; ++a)
#pragma unroll
            for (int b = 0; b < 2; ++b)
#pragma unroll
                for (int m = 0; m < 4; ++m)
#pragma unroll
                    for (int n = 0; n < 2; ++n) acc[a][b][m][n] = (f32x4){0.f, 0.f, 0.f, 0.f};
        cur = nxt; cA = nA; cB = nB; ++ui;
        if (wr == 1) PG8_BAR;
    }
    PG8_WAIT_V(0);
    PG8_BAR;
#undef PG8_SA
#undef PG8_SB
#undef PG8_STAGE
#undef PG8_LDA
#undef PG8_LDB
#undef PG8_MMA
#undef PG8_WAIT_V
#undef PG8_WAIT_L
#undef PG8_BAR
#undef PG8_SCHED
}
}
using pg8::Unit;
typedef f32x4 AccT[2][2][4][2];

__device__ __forceinline__ u32x4 pack8(f32x4 a, f32x4 b) { u32x4 w; w.x = cvt_pk_bf16(a[0], a[1]); w.y = cvt_pk_bf16(a[2], a[3]); w.z = cvt_pk_bf16(b[0], b[1]); w.w = cvt_pk_bf16(b[2], b[3]); return w; }

struct EpiSwiglu {
    static constexpr bool PERM = true;
    bf16_t* mid; const float* slotsH; bf16_t* cbuf; float* slotsC; bf16_t* krope; const float* cosT; const float* sinT;
    __device__ __forceinline__ void operator()(const AccT& acc, const Unit& u, int wr, int wc, int fr, int fq) const {
        const int row0 = u.pm * 256 + wr * 64 + fr;
        if (u.pn < 22) {
#pragma unroll
            for (int ai = 0; ai < 2; ++ai)
#pragma unroll
                for (int m = 0; m < 4; ++m) {
                    const int row = row0 + ai * 128 + m * 16; const float rs = rstd_slots16(slotsH, row);
                    f32x4 o[2];
#pragma unroll
                    for (int n = 0; n < 2; ++n)
#pragma unroll
                        for (int i = 0; i < 4; ++i) { const float gt = acc[ai][0][m][n][i] * rs, up = acc[ai][1][m][n][i] * rs; o[n][i] = gt * fsigmoid(gt) * up; }
                    *(u32x4*)(mid + (size_t)row * FF + u.pn * 128 + wc * 32 + fq * 8) = pack8(o[0], o[1]);
                }
        } else if (u.pn == 22) {
#pragma unroll
            for (int ai = 0; ai < 2; ++ai)
#pragma unroll
                for (int m = 0; m < 4; ++m) {
                    const int row = row0 + ai * 128 + m * 16; const float rs = rstd_slots16(slotsH, row);
                    float ss = 0.f;
#pragma unroll
                    for (int bj = 0; bj < 2; ++bj) { const f32x4 a = acc[ai][bj][m][0] * rs, b = acc[ai][bj][m][1] * rs;
                        ss += (a[0] * a[0] + a[1] * a[1]) + (a[2] * a[2] + a[3] * a[3]) + (b[0] * b[0] + b[1] * b[1]) + (b[2] * b[2] + b[3] * b[3]);
                        *(u32x4*)(cbuf + (size_t)row * 256 + bj * 128 + wc * 32 + fq * 8) = pack8(a, b); }
                    ss += __shfl_xor(ss, 16); ss += __shfl_xor(ss, 32);
                    if (fq == 0) slotsC[(size_t)row * 4 + wc] = ss;
                }
        } else if (wc == 0) {
#pragma unroll
            for (int ai = 0; ai < 2; ++ai)
#pragma unroll
                for (int m = 0; m < 4; ++m) {
                    const int row = row0 + ai * 128 + m * 16; const float rs = rstd_slots16(slotsH, row);
                    f32x4 o1[2], o2[2];
#pragma unroll
                    for (int n = 0; n < 2; ++n) { const f32x4 c = *(const f32x4*)(cosT + (size_t)row * 32 + fq * 8 + n * 4), s = *(const f32x4*)(sinT + (size_t)row * 32 + fq * 8 + n * 4);
                        const f32x4 x1 = acc[ai][0][m][n] * rs, x2 = acc[ai][1][m][n] * rs; o1[n] = x1 * c - x2 * s; o2[n] = x2 * c + x1 * s; }
                    *(u32x4*)(krope + (size_t)row * 64 + fq * 8) = pack8(o1[0], o1[1]);
                    *(u32x4*)(krope + (size_t)row * 64 + 32 + fq * 8) = pack8(o2[0], o2[1]);
                }
        }
    }
};
struct EpiResid {
    static constexpr bool PERM = false;
    const float* hin; float* hout; bf16_t* hb; float* slots; float alpha;
    __device__ __forceinline__ void operator()(const AccT& acc, const Unit& u, int wr, int wc, int fr, int fq) const {
        const int row0 = u.pm * 256 + wr * 64 + fr, col0 = u.pn * 256 + wc * 32 + 4 * fq;
#pragma unroll
        for (int ai = 0; ai < 2; ++ai)
#pragma unroll
            for (int m = 0; m < 4; ++m) {
                const int row = row0 + ai * 128 + m * 16; const size_t off = (size_t)row * D + col0; float ss = 0.f;
#pragma unroll
                for (int bj = 0; bj < 2; ++bj)
#pragma unroll
                    for (int n = 0; n < 2; ++n) { const size_t o2 = off + bj * 128 + n * 16; const f32x4 b = *(const f32x4*)(hin + o2); const f32x4 o = b + acc[ai][bj][m][n] * alpha;
                        *(f32x4*)(hout + o2) = o; ss += (o[0] * o[0] + o[1] * o[1]) + (o[2] * o[2] + o[3] * o[3]);
                        if (hb) { u32x2 w; w.x = cvt_pk_bf16(o[0], o[1]); w.y = cvt_pk_bf16(o[2], o[3]); *(u32x2*)(hb + o2) = w; } }
                if (slots) { ss += __shfl_xor(ss, 16); ss += __shfl_xor(ss, 32); if (fq == 0) slots[(size_t)row * 16 + u.pn * 4 + wc] = ss; }
                if (m & 1) asm volatile("" ::: "memory");
            }
    }
};
struct EpiBf16 {
    static constexpr bool PERM = true;
    bf16_t* O; int ldc;
    __device__ __forceinline__ void operator()(const AccT& acc, const Unit& u, int wr, int wc, int fr, int fq) const {
        const int row0 = u.pm * 256 + wr * 64 + fr, col0 = u.pn * 256 + wc * 32 + 8 * fq;
#pragma unroll
        for (int ai = 0; ai < 2; ++ai)
#pragma unroll
            for (int m = 0; m < 4; ++m) { bf16_t* rp = O + (size_t)(row0 + ai * 128 + m * 16) * ldc + col0;
#pragma unroll
                for (int bj = 0; bj < 2; ++bj) *(u32x4*)(rp + bj * 128) = pack8(acc[ai][bj][m][0], acc[ai][bj][m][1]); }
    }
};
struct EpiLoraDown {
    static constexpr bool PERM = true;
    bf16_t* O;
    __device__ __forceinline__ void operator()(const AccT& acc, const Unit& u, int wr, int wc, int fr, int fq) const {
        const int row0 = u.pm * 256 + wr * 64 + fr, col0 = wc * 32 + 8 * fq;
#pragma unroll
        for (int ai = 0; ai < 2; ++ai)
#pragma unroll
            for (int m = 0; m < 4; ++m) { bf16_t* rp = O + (size_t)(row0 + ai * 128 + m * 16) * 256 + col0;
                f32x4 a = acc[ai][0][m][0], b = acc[ai][0][m][1];
                if (wc < 2) {
#pragma unroll
                    for (int i = 0; i < 4; ++i) { a[i] = ftanh(a[i]); b[i] = ftanh(b[i]); } }
                *(u32x4*)(rp) = pack8(a, b);
                a = acc[ai][1][m][0]; b = acc[ai][1][m][1];
#pragma unroll
                for (int i = 0; i < 4; ++i) { a[i] = fsigmoid(a[i]); b[i] = fsigmoid(b[i]); }
                *(u32x4*)(rp + 128) = pack8(a, b); }
    }
};
struct EpiRL {
    static constexpr bool PERM = true;
    bf16_t* R; bf16_t* O;
    __device__ __forceinline__ void operator()(const AccT& acc, const Unit& u, int wr, int wc, int fr, int fq) const {
        const int row0 = u.pm * 256 + wr * 64 + fr;
        if (u.pn < 4) {
            const int col0 = u.pn * 256 + wc * 32 + 8 * fq;
#pragma unroll
            for (int ai = 0; ai < 2; ++ai)
#pragma unroll
                for (int m = 0; m < 4; ++m) { bf16_t* rp = R + (size_t)(row0 + ai * 128 + m * 16) * D + col0;
#pragma unroll
                    for (int bj = 0; bj < 2; ++bj) *(u32x4*)(rp + bj * 128) = pack8(acc[ai][bj][m][0], acc[ai][bj][m][1]); }
        } else {
            const int col0 = wc * 32 + 8 * fq;
#pragma unroll
            for (int ai = 0; ai < 2; ++ai)
#pragma unroll
                for (int m = 0; m < 4; ++m) { bf16_t* rp = O + (size_t)(row0 + ai * 128 + m * 16) * 256 + col0;
                    f32x4 a = acc[ai][0][m][0], b = acc[ai][0][m][1];
                    if (wc < 2) {
#pragma unroll
                        for (int i = 0; i < 4; ++i) { a[i] = ftanh(a[i]); b[i] = ftanh(b[i]); } }
                    *(u32x4*)(rp) = pack8(a, b);
                    a = acc[ai][1][m][0]; b = acc[ai][1][m][1];
#pragma unroll
                    for (int i = 0; i < 4; ++i) { a[i] = fsigmoid(a[i]); b[i] = fsigmoid(b[i]); }
                    *(u32x4*)(rp + 128) = pack8(a, b); }
        }
    }
};
struct EpiLoraUp {
    static constexpr bool PERM = true;
    unsigned char* wsb; const float* w0; const float* a0; int grp0; size_t goff;
    __device__ __forceinline__ void operator()(const AccT& acc, const Unit& u, int wr, int wc, int fr, int fq) const {
        const int grp = (u.pn >> 2) + grp0, colt = (u.pn & 3) * 256;
        const int row0 = u.pm * 256 + wr * 64 + fr, col0 = colt + wc * 32 + 8 * fq;
        size_t ooff = goff; if (grp == 0) ooff = A_E; if (grp == 1) ooff = A_AA;
        bf16_t* O = (bf16_t*)(wsb + ooff); const float* bias = grp == 0 ? w0 : a0;
#pragma unroll
        for (int ai = 0; ai < 2; ++ai)
#pragma unroll
            for (int m = 0; m < 4; ++m) { bf16_t* rp = O + (size_t)(row0 + ai * 128 + m * 16) * D + col0;
#pragma unroll
                for (int bj = 0; bj < 2; ++bj) { f32x4 a = acc[ai][bj][m][0], b = acc[ai][bj][m][1];
                    if (grp < 2) { const float sc = grp == 0 ? 0.6065306597126334f : 1.0f;
                        const f32x4 b0 = *(const f32x4*)(bias + col0 + bj * 128), b1 = *(const f32x4*)(bias + col0 + bj * 128 + 4);
                        a = a + b0; b = b + b1;
#pragma unroll
                        for (int i = 0; i < 4; ++i) { a[i] = sc * fsigmoid(a[i]); b[i] = sc * fsigmoid(b[i]); } }
                    *(u32x4*)(rp + bj * 128) = pack8(a, b); }
                asm volatile("" ::: "memory"); }
    }
};
struct EpiQlat {
    static constexpr bool PERM = true;
    bf16_t* O; const float* slotsH; float* slotsQ;
    __device__ __forceinline__ void operator()(const AccT& acc, const Unit& u, int wr, int wc, int fr, int fq) const {
        const int row0 = u.pm * 256 + wr * 64 + fr, col0 = u.pn * 256 + wc * 32 + 8 * fq;
#pragma unroll
        for (int ai = 0; ai < 2; ++ai)
#pragma unroll
            for (int m = 0; m < 4; ++m) { const int row = row0 + ai * 128 + m * 16; const float rs = rstd_slots16(slotsH, row); float ss = 0.f;
#pragma unroll
                for (int bj = 0; bj < 2; ++bj) { const f32x4 a = acc[ai][bj][m][0] * rs, b = acc[ai][bj][m][1] * rs;
                    ss += (a[0] * a[0] + a[1] * a[1]) + (a[2] * a[2] + a[3] * a[3]) + (b[0] * b[0] + b[1] * b[1]) + (b[2] * b[2] + b[3] * b[3]);
                    *(u32x4*)(O + (size_t)row * 512 + col0 + bj * 128) = pack8(a, b); }
                ss += __shfl_xor(ss, 16); ss += __shfl_xor(ss, 32);
                if (fq == 0) slotsQ[(size_t)row * 8 + u.pn * 4 + wc] = ss; }
    }
};
struct EpiQ {
    static constexpr bool PERM = true;
    bf16_t* qn; bf16_t* qr; const float* slotsQ; const float* cosT; const float* sinT;
    __device__ __forceinline__ void operator()(const AccT& acc, const Unit& u, int wr, int wc, int fr, int fq) const {
        const int row0 = u.pm * 256 + wr * 64 + fr;
#pragma unroll
        for (int ai = 0; ai < 2; ++ai)
#pragma unroll
            for (int m = 0; m < 4; ++m) { const int row = row0 + ai * 128 + m * 16;
                const f32x4 s0 = *(const f32x4*)(slotsQ + (size_t)row * 8), s1 = *(const f32x4*)(slotsQ + (size_t)row * 8 + 4);
                const float rs = __builtin_amdgcn_rsqf((sum4(s0) + sum4(s1)) * (1.0f / 512.0f) + RMS_EPS) * QSCALE;
                if (u.pn < 4) {
#pragma unroll
                    for (int bj = 0; bj < 2; ++bj) *(u32x4*)(qn + (size_t)row * D + u.pn * 256 + bj * 128 + wc * 32 + fq * 8) = pack8(acc[ai][bj][m][0] * rs, acc[ai][bj][m][1] * rs);
                } else {
                    const int head = 4 * (u.pn - 4) + wc; f32x4 o1[2], o2[2];
#pragma unroll
                    for (int n = 0; n < 2; ++n) { const f32x4 c = *(const f32x4*)(cosT + (size_t)row * 32 + fq * 8 + n * 4), s = *(const f32x4*)(sinT + (size_t)row * 32 + fq * 8 + n * 4);
                        const f32x4 x1 = acc[ai][0][m][n] * rs, x2 = acc[ai][1][m][n] * rs; o1[n] = x1 * c - x2 * s; o2[n] = x2 * c + x1 * s; }
                    *(u32x4*)(qr + (size_t)row * 512 + head * 64 + fq * 8) = pack8(o1[0], o1[1]);
                    *(u32x4*)(qr + (size_t)row * 512 + head * 64 + 32 + fq * 8) = pack8(o2[0], o2[1]);
                } }
    }
};
struct EpiKnope {
    static constexpr bool PERM = true;
    bf16_t* O; const float* slotsC;
    __device__ __forceinline__ void operator()(const AccT& acc, const Unit& u, int wr, int wc, int fr, int fq) const {
        const int row0 = u.pm * 256 + wr * 64 + fr, col0 = u.pn * 256 + wc * 32 + 8 * fq;
#pragma unroll
        for (int ai = 0; ai < 2; ++ai)
#pragma unroll
            for (int m = 0; m < 4; ++m) { const int row = row0 + ai * 128 + m * 16; const f32x4 s = *(const f32x4*)(slotsC + (size_t)row * 4);
                const float rs = __builtin_amdgcn_rsqf(sum4(s) * (1.0f / 256.0f) + RMS_EPS);
#pragma unroll
                for (int bj = 0; bj < 2; ++bj) *(u32x4*)(O + (size_t)row * D + col0 + bj * 128) = pack8(acc[ai][bj][m][0] * rs, acc[ai][bj][m][1] * rs); }
    }
};
struct EpiVt {
    static constexpr bool PERM = true;
    bf16_t* O; const float* slotsC;
    __device__ __forceinline__ void operator()(const AccT& acc, const Unit& u, int wr, int wc, int fr, int fq) const {
        const int row0 = u.pm * 256 + wr * 64 + fr, col0 = u.pn * 256 + wc * 32 + 8 * fq;
        f32x4 rs[2][2];
#pragma unroll
        for (int bj = 0; bj < 2; ++bj)
#pragma unroll
            for (int n = 0; n < 2; ++n)
#pragma unroll
                for (int i = 0; i < 4; ++i) { const f32x4 s = *(const f32x4*)(slotsC + (size_t)(col0 + bj * 128 + n * 4 + i) * 4); rs[bj][n][i] = __builtin_amdgcn_rsqf(sum4(s) * (1.0f / 256.0f) + RMS_EPS); }
#pragma unroll
        for (int ai = 0; ai < 2; ++ai)
#pragma unroll
            for (int m = 0; m < 4; ++m) { const int row = row0 + ai * 128 + m * 16;
#pragma unroll
                for (int bj = 0; bj < 2; ++bj) *(u32x4*)(O + (size_t)row * T + col0 + bj * 128) = pack8(acc[ai][bj][m][0] * rs[bj][0], acc[ai][bj][m][1] * rs[bj][1]); }
    }
};

struct Args { const float* in[33]; const int* pos; float* out; unsigned char* ws; int ph_lo, ph_hi; };

struct Ctx { LAS unsigned char* lds; int vcu, G, wave; };

__device__ __forceinline__ void tr_item(const float* W, int ldw, int k0, int n0, const float* s1, const float* s2, int ks0, bf16_t* Bt, int ldb, int nd0, int kd0, LAS float* scr, int lane) {
    f32x4 v[8];
#pragma unroll
    for (int i = 0; i < 8; ++i) v[i] = *(const f32x4*)(W + (size_t)(k0 + 8 * i + (lane >> 3)) * ldw + n0 + 4 * (lane & 7));
#pragma unroll
    for (int i = 0; i < 8; ++i) { const int kk = 8 * i + (lane >> 3);
        float sc = s1 ? s1[ks0 + kk] : 1.0f; if (s2) sc -= s2[ks0 + kk];
        LAS float* d = scr + kk * 33 + 4 * (lane & 7);
        d[0] = sc * v[i][0]; d[1] = sc * v[i][1]; d[2] = sc * v[i][2]; d[3] = sc * v[i][3]; }
    asm volatile("s_waitcnt lgkmcnt(0)" ::: "memory");
    const int c = lane & 7;
#pragma unroll
    for (int j = 0; j < 4; ++j) { const int n = (lane >> 3) + 8 * j; const LAS float* s = scr + (8 * c) * 33 + n;
        u32x4 o; o.x = cvt_pk_bf16(s[0 * 33], s[1 * 33]); o.y = cvt_pk_bf16(s[2 * 33], s[3 * 33]); o.z = cvt_pk_bf16(s[4 * 33], s[5 * 33]); o.w = cvt_pk_bf16(s[6 * 33], s[7 * 33]);
        *(u32x4*)(Bt + (size_t)(nd0 + n) * ldb + kd0 + 8 * c) = o; }
    asm volatile("s_waitcnt lgkmcnt(0)" ::: "memory");
}
__device__ __forceinline__ void zero_item(bf16_t* Bt, int ldb, int nd0, int kd0, int lane) {
    const int c = lane & 7;
#pragma unroll
    for (int j = 0; j < 4; ++j) { const int n = (lane >> 3) + 8 * j; *(u32x4*)(Bt + (size_t)(nd0 + n) * ldb + kd0 + 8 * c) = (u32x4){0u, 0u, 0u, 0u}; }
}

constexpr int I_UG = 16 * 176, I_UGX = 16 * 16, I_DN = 44 * 32, I_SQ = 16 * 32, I_LD = 32 * 8, I_LU = 4 * 96, I_KN = 4 * 32, I_DQ = 16 * 16, I_UQ = 8 * 48;
constexpr int NITEMS = 4 * I_UG + I_UGX + 4 * I_DN + 4 * I_SQ + I_LD + I_LU + 2 * I_KN + I_DQ + I_UQ + I_SQ;
__device__ __forceinline__ void p0_item(const Args& a, int it, int mode, LAS float* scr, int lane) {
    unsigned char* ws = a.ws; const float* norm_g = a.in[2];
    int r = it;
        if (r < 4 * I_UG) { const int q = r / I_UG; r -= q * I_UG; if ((q >= 1) != (mode == 1)) return; const int l = q >> 1, s = q & 1; const int kb = r / 176, nb = r % 176, pn = nb >> 3, jb = nb & 7;
            const float* src = (jb < 4 ? a.in[3] : a.in[4]) + (size_t)q * D * FF;
            tr_item(src, FF, 64 * kb, 128 * pn + 32 * (jb & 3), norm_g + (l * 3 + (s ? 2 : 0)) * D, nullptr, 64 * kb, (bf16_t*)(ws + W_UG) + (size_t)q * 6144 * D, D, 32 * nb, 64 * kb, scr, lane); return; }
        r -= 4 * I_UG;
        if (r < I_UGX) { if (mode != 1) return; const int kb = r / 16, nb = r % 16; bf16_t* Bt = (bf16_t*)(ws + W_UG) + (size_t)2 * 6144 * D;
            int sc = -1; if (nb < 8) sc = 32 * nb; else if (nb == 8) sc = 256; else if (nb == 12) sc = 288;
            if (sc >= 0) tr_item(a.in[25], 320, 64 * kb, sc, a.in[24], nullptr, 64 * kb, Bt, D, 5632 + 32 * nb, 64 * kb, scr, lane); else zero_item(Bt, D, 5632 + 32 * nb, 64 * kb, lane); return; }
        r -= I_UGX;
        if (r < 4 * I_DN) { const int q = r / I_DN; r -= q * I_DN; if ((q >= 1) != (mode == 1)) return; const int kb = r / 32, nb = r % 32;
            tr_item(a.in[5] + (size_t)q * FF * D, D, 64 * kb, 32 * nb, nullptr, nullptr, 0, (bf16_t*)(ws + W_DN) + (size_t)q * D * FF, FF, 32 * nb, 64 * kb, scr, lane); return; }
        r -= 4 * I_DN;
        if (r < 4 * I_SQ) { const int q = r / I_SQ; r -= q * I_SQ; if ((q == 3) != (mode == 1)) return; const int kb = r / 32, nb = r % 32;
            if (q == 0) { tr_item(a.in[7], D, 64 * kb, 32 * nb, nullptr, nullptr, 0, (bf16_t*)(ws + W_RL), 2048, 32 * nb, 64 * kb, scr, lane); zero_item((bf16_t*)(ws + W_RL), 2048, 32 * nb, 1024 + 64 * kb, lane); }
            else tr_item(a.in[7 + q], D, 64 * kb, 32 * nb, nullptr, nullptr, 0, (bf16_t*)(ws + W_R + (size_t)q * 2 * MiB), D, 32 * nb, 64 * kb, scr, lane);
            return; }
        r -= 4 * I_SQ;
        if (r < I_LD) { if (mode != 0) return; const int kb = r / 8, nb = r % 8; const int kk0 = 64 * (kb & 15); const bool second = kb >= 16;
            const float* src; int ldw, nc, mi; if (nb < 2) { src = a.in[12]; ldw = 64; nc = 32 * nb; mi = 1; } else if (nb < 4) { src = a.in[15]; ldw = 64; nc = 32 * (nb - 2); mi = 4; } else { src = a.in[17]; ldw = 128; nc = 32 * (nb - 4); mi = 5; }
            tr_item(src, ldw, kk0, nc, second ? a.in[6] + mi * D : nullptr, second ? a.in[6] : nullptr, kk0, (bf16_t*)(ws + W_RL), 2048, 1024 + 32 * nb, 64 * kb, scr, lane); return; }
        r -= I_LD;
        if (r < I_LU) { if (mode != 0) return; const int kb = r / 96, nb = r % 96; const int grp = nb / 32, nc = 32 * (nb % 32); bf16_t* Bt = (bf16_t*)(ws + W_LU);
            if (grp == 0) { if (kb == 0) tr_item(a.in[13], D, 0, nc, nullptr, nullptr, 0, Bt, 256, 32 * nb, 0, scr, lane); else zero_item(Bt, 256, 32 * nb, 64 * kb, lane); }
            else if (grp == 1) { if (kb == 1) tr_item(a.in[16], D, 0, nc, nullptr, nullptr, 0, Bt, 256, 32 * nb, 64, scr, lane); else zero_item(Bt, 256, 32 * nb, 64 * kb, lane); }
            else { if (kb >= 2) tr_item(a.in[18], D, 64 * (kb - 2), nc, nullptr, nullptr, 0, Bt, 256, 32 * nb, 64 * kb, scr, lane); else zero_item(Bt, 256, 32 * nb, 64 * kb, lane); }
            return; }
        r -= I_LU;
        if (r < 2 * I_KN) { if (mode != 1) return; const int q = r / I_KN; r -= q * I_KN; const int kb = r / 32, nb = r % 32;
            const int n0 = 32 * nb, sc = (n0 >> 7) * 256 + (n0 & 127) + q * 128;
            tr_item(a.in[27], 2048, 64 * kb, sc, a.in[26], nullptr, 64 * kb, (bf16_t*)(ws + (q ? W_VT : W_KN)), 256, n0, 64 * kb, scr, lane); return; }
        r -= 2 * I_KN;
        if (r < I_DQ) { if (mode != 1) return; const int kb = r / 16, nb = r % 16;
            tr_item(a.in[28], 512, 64 * kb, 32 * nb, norm_g + (1 * 3 + 1) * D, nullptr, 64 * kb, (bf16_t*)(ws + W_DQ), D, 32 * nb, 64 * kb, scr, lane); return; }
        r -= I_DQ;
        if (r < I_UQ) { if (mode != 1) return; const int kb = r / 48, nb = r % 48; int sc;
            if (nb < 32) { const int n0 = 32 * nb; sc = (n0 >> 7) * 192 + (n0 & 127); }
            else { const int t2 = (nb - 32) >> 3, jj = (nb - 32) & 7, half = jj >> 2, hh = jj & 3; sc = (4 * t2 + hh) * 192 + 128 + 32 * half; }
            tr_item(a.in[30], 1536, 64 * kb, sc, a.in[29], nullptr, 64 * kb, (bf16_t*)(ws + W_UQ), 512, 32 * nb, 64 * kb, scr, lane); return; }
        r -= I_UQ;
        { if (mode != 1) return; const int kb = r / 32, nb = r % 32; tr_item(a.in[31], D, 64 * kb, 32 * nb, nullptr, nullptr, 0, (bf16_t*)(ws + W_MO), D, 32 * nb, 64 * kb, scr, lane); }
}
__device__ __forceinline__ void p0_prologue(const Ctx& F, const Args& a) {
    unsigned char* ws = a.ws;
    const int tid = fresh_tid(F.wave), lane = tid & 63, wave = __builtin_amdgcn_readfirstlane(tid >> 6);
    LAS float* scr = (LAS float*)(F.lds + wave * 16384);
    const int gw = F.vcu * 8 + wave, NGW = F.G * 8;
    const float* norm_g = a.in[2];
    for (int it = gw; it < NITEMS; it += NGW) p0_item(a, it, 0, scr, lane);
    const float* x = a.in[0]; bf16_t* hb = (bf16_t*)(ws + A_HB); float* slotsH = (float*)(ws + WS_SLOTH);
    for (int m = gw; m < T; m += NGW) {
        const f32x4* xr = (const f32x4*)(x + (size_t)m * D) + lane; float ss = 0.f;
#pragma unroll
        for (int j = 0; j < 4; ++j) { const f32x4 v = xr[64 * j]; ss += (v[0] * v[0] + v[1] * v[1]) + (v[2] * v[2] + v[3] * v[3]);
            u32x2 w; w.x = cvt_pk_bf16(v[0], v[1]); w.y = cvt_pk_bf16(v[2], v[3]); *((u32x2*)(hb + (size_t)m * D) + lane + 64 * j) = w; }
        ss = wave_sum(ss);
        if (lane < 16) slotsH[(size_t)m * 16 + lane] = lane == 0 ? ss : 0.f;
    }
    float* cosT = (float*)(ws + A_COS); float* sinT = (float*)(ws + A_SIN);
    for (int i = (F.vcu * 512 + tid); i < T * 32; i += F.G * 512) {
        const int tok = i >> 5, j = i & 31;
        const float inv = exp2f(-(float)j * (13.287712379549449f / 32.0f));
        const float ang = (float)a.pos[tok] * inv;
        const double rev = (double)ang * 0.15915494309189535; const float fr = (float)(rev - floor(rev));
        cosT[i] = __builtin_amdgcn_cosf(fr); sinT[i] = __builtin_amdgcn_sinf(fr);
    }
}

__device__ __forceinline__ void p_premix(const Ctx& F, const Args& a) {
    const float* h = a.out; const float* g = a.in[2] + 1 * D; const float* mix = a.in[6];
    bf16_t* X1 = (bf16_t*)(a.ws + A_X1); bf16_t* XK = (bf16_t*)(a.ws + A_XK); bf16_t* XV = (bf16_t*)(a.ws + A_XV);
    const int tid = fresh_tid(F.wave), lane = tid & 63, wave = __builtin_amdgcn_readfirstlane(tid >> 6);
    const int gw = F.vcu * 8 + wave, NGW = F.G * 8;
    for (int ch = gw; ch < T / 16; ch += NGW) {
        const int t0 = ch * 16;
        f32x4 prev[4], gv[4];
#pragma unroll
        for (int j = 0; j < 4; ++j) gv[j] = *((const f32x4*)g + lane + 64 * j);
        if ((t0 & (SEQ - 1)) == 0) {
#pragma unroll
            for (int j = 0; j < 4; ++j) prev[j] = (f32x4){0.f, 0.f, 0.f, 0.f};
        } else {
            float ss = 0.f;
#pragma unroll
            for (int j = 0; j < 4; ++j) { prev[j] = *((const f32x4*)(h + (size_t)(t0 - 1) * D) + lane + 64 * j); ss += (prev[j][0] * prev[j][0] + prev[j][1] * prev[j][1]) + (prev[j][2] * prev[j][2] + prev[j][3] * prev[j][3]); }
            const float rs = __builtin_amdgcn_rsqf(wave_sum(ss) * (1.0f / 1024.0f) + RMS_EPS);
#pragma unroll
            for (int j = 0; j < 4; ++j) prev[j] = prev[j] * rs * gv[j];
        }
        for (int t = t0; t < t0 + 16; ++t) {
            f32x4 cur[4]; float ss = 0.f;
#pragma unroll
            for (int j = 0; j < 4; ++j) { cur[j] = *((const f32x4*)(h + (size_t)t * D) + lane + 64 * j); ss += (cur[j][0] * cur[j][0] + cur[j][1] * cur[j][1]) + (cur[j][2] * cur[j][2] + cur[j][3] * cur[j][3]); }
            const float rs = __builtin_amdgcn_rsqf(wave_sum(ss) * (1.0f / 1024.0f) + RMS_EPS);
#pragma unroll
            for (int j = 0; j < 4; ++j) {
                const f32x4 hn = cur[j] * rs * gv[j]; const f32x4 xx = prev[j] - hn; prev[j] = hn;
                const f32x4 mr = *((const f32x4*)(mix + 0 * D) + lane + 64 * j), mk = *((const f32x4*)(mix + 2 * D) + lane + 64 * j), mv = *((const f32x4*)(mix + 3 * D) + lane + 64 * j);
                const f32x4 xr = hn + xx * mr, xk = hn + xx * mk, xv = hn + xx * mv;
                u32x2 w;
                w.x = cvt_pk_bf16(xr[0], xr[1]); w.y = cvt_pk_bf16(xr[2], xr[3]); *((u32x2*)(X1 + (size_t)t * 2048) + lane + 64 * j) = w;
                w.x = cvt_pk_bf16(xx[0], xx[1]); w.y = cvt_pk_bf16(xx[2], xx[3]); *((u32x2*)(X1 + (size_t)t * 2048 + 1024) + lane + 64 * j) = w;
                w.x = cvt_pk_bf16(xk[0], xk[1]); w.y = cvt_pk_bf16(xk[2], xk[3]); *((u32x2*)(XK + (size_t)t * D) + lane + 64 * j) = w;
                w.x = cvt_pk_bf16(xv[0], xv[1]); w.y = cvt_pk_bf16(xv[2], xv[3]); *((u32x2*)(XV + (size_t)t * D) + lane + 64 * j) = w;
            }
        }
    }
}

constexpr int TC = 32;
__device__ __forceinline__ void p_scan(const Ctx& F, const Args& a) {
    const bf16_t* Rb = (const bf16_t*)(a.ws + A_R); const bf16_t* Kb = (const bf16_t*)(a.ws + A_KK); const bf16_t* Vb = (const bf16_t*)(a.ws + A_VV);
    const bf16_t* Eb = (const bf16_t*)(a.ws + A_E); const bf16_t* Ab = (const bf16_t*)(a.ws + A_AA); bf16_t* Gb = (bf16_t*)(a.ws + A_G);
    const float* k_k = a.in[19]; const float* k_a = a.in[20]; const float* r_k = a.in[21]; const float* gn_w = a.in[22]; const float* gn_b = a.in[23];
    LAS float* sR = (LAS float*)(F.lds); LAS float* sW = sR + TC * 64; LAS float* sK = sW + TC * 64; LAS float* sV = sK + TC * 64;
    LAS float* sKK = sV + TC * 64; LAS float* sKA = sKK + TC * 64; LAS float* sY = sKA + TC * 64; LAS float* sBo = sY + TC * 64;
    const int tid = fresh_tid(F.wave), lane = tid & 63, wave = __builtin_amdgcn_readfirstlane(tid >> 6);
    const int irow = wave * 8 + (lane >> 3), kseg = (lane & 7) * 8;
    const int ptt = tid >> 4, pc = (tid & 15) * 4;
    for (int unit0 = F.vcu; unit0 < 2 * NB * 16; unit0 += F.G) {
        const int unit = unit0 & 127; const bool shadow = unit0 >= 128;
        const int b = unit >> 4, hd = unit & 15; const int cbase = hd * 64;
        float S[8];
#pragma unroll
        for (int j = 0; j < 8; ++j) S[j] = 0.f;
        const f32x4 kkv = *(const f32x4*)(k_k + cbase + pc), kav = *(const f32x4*)(k_a + cbase + pc), rkv = *(const f32x4*)(r_k + cbase + pc);
        const f32x4 gw = *(const f32x4*)(gn_w + cbase + pc), gb = *(const f32x4*)(gn_b + cbase + pc);
        for (int c0 = 0; c0 < SEQ; c0 += TC) {
            const size_t gidx = (size_t)(b * SEQ + c0 + ptt) * D + cbase + pc;
            {
                const f32x4 r = unpack4(*(const u32x2*)(Rb + gidx)), k = unpack4(*(const u32x2*)(Kb + gidx)), v = unpack4(*(const u32x2*)(Vb + gidx));
                const f32x4 e = unpack4(*(const u32x2*)(Eb + gidx)), aa = unpack4(*(const u32x2*)(Ab + gidx));
                f32x4 kk = k * kkv; float ss = (kk[0] * kk[0] + kk[1] * kk[1]) + (kk[2] * kk[2] + kk[3] * kk[3]); ss = red16(ss);
                kk = kk * __builtin_amdgcn_rsqf(fmaxf(ss, 1e-24f));
                const f32x4 kp = k * (1.0f + (aa - 1.0f) * kav);
                const f32x4 rk = r * kp * rkv; const float bo = red16((rk[0] + rk[1]) + (rk[2] + rk[3]));
                f32x4 w;
#pragma unroll
                for (int i = 0; i < 4; ++i) w[i] = __builtin_amdgcn_exp2f(-e[i] * LOG2E);
                const int o = ptt * 64 + pc;
                *(LAS f32x4*)(sR + o) = r; *(LAS f32x4*)(sW + o) = w; *(LAS f32x4*)(sK + o) = kp; *(LAS f32x4*)(sV + o) = v; *(LAS f32x4*)(sKK + o) = kk; *(LAS f32x4*)(sKA + o) = kk * aa;
                if ((tid & 15) == 0) sBo[ptt] = bo;
            }
            __syncthreads();
#pragma unroll 2
            for (int t = 0; t < TC; ++t) {
                const int o = t * 64 + kseg;
                const f32x4 kk0 = *(const LAS f32x4*)(sKK + o), kk1 = *(const LAS f32x4*)(sKK + o + 4);
                const f32x4 w0 = *(const LAS f32x4*)(sW + o), w1 = *(const LAS f32x4*)(sW + o + 4);
                const f32x4 ka0 = *(const LAS f32x4*)(sKA + o), ka1 = *(const LAS f32x4*)(sKA + o + 4);
                const f32x4 kp0 = *(const LAS f32x4*)(sK + o), kp1 = *(const LAS f32x4*)(sK + o + 4);
                const f32x4 r0 = *(const LAS f32x4*)(sR + o), r1 = *(const LAS f32x4*)(sR + o + 4);
                const float vv = sV[t * 64 + irow];
                float sa = ((S[0] * kk0[0] + S[1] * kk0[1]) + (S[2] * kk0[2] + S[3] * kk0[3])) + ((S[4] * kk1[0] + S[5] * kk1[1]) + (S[6] * kk1[2] + S[7] * kk1[3]));
                sa = red8(sa);
#pragma unroll
                for (int j = 0; j < 4; ++j) { S[j] = S[j] * w0[j] + (vv * kp0[j] - sa * ka0[j]); S[4 + j] = S[4 + j] * w1[j] + (vv * kp1[j] - sa * ka1[j]); }
                float y = ((S[0] * r0[0] + S[1] * r0[1]) + (S[2] * r0[2] + S[3] * r0[3])) + ((S[4] * r1[0] + S[5] * r1[1]) + (S[6] * r1[2] + S[7] * r1[3]));
                y = red8(y);
                if ((lane & 7) == 0) sY[t * 64 + irow] = y;
            }
            __syncthreads();
            {
                const int o = ptt * 64 + pc;
                const f32x4 y = *(const LAS f32x4*)(sY + o), v = *(const LAS f32x4*)(sV + o);
                const float mu = red16((y[0] + y[1]) + (y[2] + y[3])) * (1.0f / 64.0f);
                const f32x4 d = y - mu; const float var = red16((d[0] * d[0] + d[1] * d[1]) + (d[2] * d[2] + d[3] * d[3])) * (1.0f / 64.0f);
                const float rs = __builtin_amdgcn_rsqf(var + GN_EPS); const float bo = sBo[ptt];
                const f32x4 gg = unpack4(*(const u32x2*)(Gb + gidx));
                const f32x4 ov = (d * rs * gw + gb + v * bo) * gg;
                u32x2 w; w.x = cvt_pk_bf16(ov[0], ov[1]); w.y = cvt_pk_bf16(ov[2], ov[3]); if (!shadow) *(u32x2*)(Gb + gidx) = w;
            }
            __syncthreads();
        }
    }
}


__device__ __forceinline__ void p_scan2(const Ctx& F, const Args& a) {
    const bf16_t* Rb = (const bf16_t*)(a.ws + A_R); const bf16_t* Kb = (const bf16_t*)(a.ws + A_KK); const bf16_t* Vb = (const bf16_t*)(a.ws + A_VV);
    const bf16_t* Eb = (const bf16_t*)(a.ws + A_E); const bf16_t* Ab = (const bf16_t*)(a.ws + A_AA); bf16_t* Yb = (bf16_t*)(a.ws + A_G); float* Bon = (float*)(a.ws + A_BON);
    const float* k_k = a.in[19]; const float* k_a = a.in[20]; const float* r_k = a.in[21];
    LAS float* sR = (LAS float*)(F.lds); LAS float* sW = sR + TC * 64; LAS float* sK = sW + TC * 64; LAS float* sV = sK + TC * 64;
    LAS float* sKK = sV + TC * 64; LAS float* sKA = sKK + TC * 64; LAS float* sY = sKA + TC * 64;
    const int tid = fresh_tid(F.wave), lane = tid & 63, wave = __builtin_amdgcn_readfirstlane(tid >> 6);
    const int lrow = wave * 8 + (lane >> 3), kseg = (lane & 7) * 8;
    const int ptt = tid >> 4, pc = (tid & 15) * 4;
    for (int unit = F.vcu; unit < 2 * NB * 16; unit += F.G) {
        const int bh = unit >> 1, half = unit & 1, b = bh >> 4, hd = bh & 15, cbase = hd * 64;
        f32x4 S0 = (f32x4){0.f, 0.f, 0.f, 0.f}, S1 = (f32x4){0.f, 0.f, 0.f, 0.f};
        int hit = F.vcu * 4 + (wave & 3); LAS float* hscr = (LAS float*)(F.lds + 81920 + (wave & 3) * 8704);
        const f32x4 kkv = *(const f32x4*)(k_k + cbase + pc), kav = *(const f32x4*)(k_a + cbase + pc), rkv = *(const f32x4*)(r_k + cbase + pc);
        size_t gidx = (size_t)(b * SEQ + ptt) * D + cbase + pc;
        u32x2 qr = *(const u32x2*)(Rb + gidx), qk = *(const u32x2*)(Kb + gidx), qv = *(const u32x2*)(Vb + gidx), qe = *(const u32x2*)(Eb + gidx), qa = *(const u32x2*)(Ab + gidx);
        for (int c0 = 0; c0 < SEQ; c0 += TC) {
            {
                const f32x4 r = unpack4(qr), k = unpack4(qk), v = unpack4(qv), e = unpack4(qe), aa = unpack4(qa);
                f32x4 kk = k * kkv; float ss = (kk[0] * kk[0] + kk[1] * kk[1]) + (kk[2] * kk[2] + kk[3] * kk[3]); ss = red16(ss);
                kk = kk * __builtin_amdgcn_rsqf(fmaxf(ss, 1e-24f));
                const f32x4 kp = k * (1.0f + (aa - 1.0f) * kav);
                const f32x4 rk = r * kp * rkv; const float bo = red16((rk[0] + rk[1]) + (rk[2] + rk[3]));
                f32x4 w;
#pragma unroll
                for (int i = 0; i < 4; ++i) w[i] = __builtin_amdgcn_exp2f(-e[i] * LOG2E);
                const int o = ptt * 64 + pc;
                *(LAS f32x4*)(sR + o) = r; *(LAS f32x4*)(sW + o) = w; *(LAS f32x4*)(sK + o) = kp; *(LAS f32x4*)(sV + o) = v; *(LAS f32x4*)(sKK + o) = kk; *(LAS f32x4*)(sKA + o) = kk * aa;
                if (half == 0 && (tid & 15) == 0) Bon[(size_t)(b * SEQ + c0 + ptt) * 16 + hd] = bo;
            }
            __syncthreads();
            if (c0 + TC < SEQ) { gidx += (size_t)TC * D;
                qr = *(const u32x2*)(Rb + gidx); qk = *(const u32x2*)(Kb + gidx); qv = *(const u32x2*)(Vb + gidx); qe = *(const u32x2*)(Eb + gidx); qa = *(const u32x2*)(Ab + gidx); }
            if (wave >= 4) {
                if (hit < NITEMS) { p0_item(a, hit, 1, hscr, lane); hit += 1024; }
            }
            if (wave < 4) {
#define SCAN_LD(P, tt) { const int o_ = (tt) * 64 + kseg; \
                kk0##P = *(const LAS f32x4*)(sKK + o_); kk1##P = *(const LAS f32x4*)(sKK + o_ + 4); w0##P = *(const LAS f32x4*)(sW + o_); w1##P = *(const LAS f32x4*)(sW + o_ + 4); \
                ka0##P = *(const LAS f32x4*)(sKA + o_); ka1##P = *(const LAS f32x4*)(sKA + o_ + 4); kp0##P = *(const LAS f32x4*)(sK + o_); kp1##P = *(const LAS f32x4*)(sK + o_ + 4); \
                r0##P = *(const LAS f32x4*)(sR + o_); r1##P = *(const LAS f32x4*)(sR + o_ + 4); vv##P = sV[(tt) * 64 + half * 32 + lrow]; }
#define SCAN_STEP(P, tt) { f32x4 p4 = S0 * kk0##P; p4 = S1 * kk1##P + p4; const float sa = red8((p4[0] + p4[1]) + (p4[2] + p4[3])); \
                S0 = S0 * w0##P + (kp0##P * vv##P - ka0##P * sa); S1 = S1 * w1##P + (kp1##P * vv##P - ka1##P * sa); \
                f32x4 y4 = S0 * r0##P; y4 = S1 * r1##P + y4; sY[(tt) * 256 + tid] = (y4[0] + y4[1]) + (y4[2] + y4[3]); }
                f32x4 kk0A, kk1A, w0A, w1A, ka0A, ka1A, kp0A, kp1A, r0A, r1A; float vvA;
                f32x4 kk0B, kk1B, w0B, w1B, ka0B, ka1B, kp0B, kp1B, r0B, r1B; float vvB;
                SCAN_LD(A, 0)
#pragma unroll 2
                for (int t = 0; t < TC; t += 2) {
                    SCAN_LD(B, t + 1)
                    SCAN_STEP(A, t)
                    SCAN_LD(A, (t + 2 < TC) ? t + 2 : t)
                    SCAN_STEP(B, t + 1)
                }
#undef SCAN_LD
#undef SCAN_STEP
            }
            __syncthreads();
            {
                const int tok = tid >> 4, r2 = (tid & 15) * 2;
                const LAS f32x4* q = (const LAS f32x4*)(sY + tok * 256 + r2 * 8);
                const f32x4 s0 = q[0] + q[1], s1 = q[2] + q[3];
                *(unsigned*)(Yb + (size_t)(b * SEQ + c0 + tok) * D + cbase + half * 32 + r2) = cvt_pk_bf16((s0[0] + s0[1]) + (s0[2] + s0[3]), (s1[0] + s1[1]) + (s1[2] + s1[3]));
            }
        }
        if (wave >= 4) { while (hit < NITEMS) { p0_item(a, hit, 1, hscr, lane); hit += 1024; } }
        __syncthreads();
    }
}
__device__ __forceinline__ void p_post(const Ctx& F, const Args& a) {
    bf16_t* Yb = (bf16_t*)(a.ws + A_G); const bf16_t* Vb = (const bf16_t*)(a.ws + A_VV); const bf16_t* Gg = (const bf16_t*)(a.ws + A_E); const float* Bon = (const float*)(a.ws + A_BON);
    const float* gn_w = a.in[22]; const float* gn_b = a.in[23];
    const int tid = fresh_tid(F.wave), grp = tid >> 4, gl = tid & 15;
    for (int item = F.vcu * 32 + grp; item < T * 16; item += F.G * 32) {
        const int tok = item >> 4, hd = item & 15; const size_t idx = (size_t)tok * D + hd * 64 + 4 * gl;
        const f32x4 y = unpack4(*(const u32x2*)(Yb + idx)), v = unpack4(*(const u32x2*)(Vb + idx)), g = unpack4(*(const u32x2*)(Gg + idx));
        const float bo = Bon[(size_t)tok * 16 + hd];
        const f32x4 gw = *(const f32x4*)(gn_w + hd * 64 + 4 * gl), gb = *(const f32x4*)(gn_b + hd * 64 + 4 * gl);
        const float mu = red16((y[0] + y[1]) + (y[2] + y[3])) * (1.0f / 64.0f);
        const f32x4 d = y - mu; const float var = red16((d[0] * d[0] + d[1] * d[1]) + (d[2] * d[2] + d[3] * d[3])) * (1.0f / 64.0f);
        const float rs = __builtin_amdgcn_rsqf(var + GN_EPS);
        const f32x4 ov = (d * rs * gw + gb + v * bo) * g;
        u32x2 w; w.x = cvt_pk_bf16(ov[0], ov[1]); w.y = cvt_pk_bf16(ov[2], ov[3]); *(u32x2*)(Yb + idx) = w;
    }
}

constexpr int KROW = 400, VROW = 144, KBUF = 64 * KROW, VBUF = 128 * VROW, ABUF = KBUF + VBUF;
__device__ __forceinline__ void attn_unit(LAS unsigned char* lds, const bf16_t* qn, const bf16_t* qr, const bf16_t* kn, const bf16_t* kr, const bf16_t* vt, bf16_t* o_out, int b, int h, int qb, int wave_s) {
    const int tid = fresh_tid(wave_s), lane = tid & 63, wid = __builtin_amdgcn_readfirstlane(tid >> 6), r32 = lane & 31, hi = lane >> 5;
    const int tok0 = b * SEQ, q0 = qb * 256 + wid * 32;
    bf16x8 qf[12];
    { const size_t tq = (size_t)(tok0 + q0 + r32);
#pragma unroll
      for (int d = 0; d < 8; ++d) qf[d] = *(const bf16x8*)(qn + tq * D + h * 128 + d * 16 + hi * 8);
#pragma unroll
      for (int d = 0; d < 4; ++d) qf[8 + d] = *(const bf16x8*)(qr + tq * 512 + h * 64 + d * 16 + hi * 8); }
    const int NT = (qb + 1) * 4;
    const int kkey0 = tid >> 4, kch0 = tid & 15;
    const int rkey = tid >> 3, rch = tid & 7;
    const int vrow0 = tid >> 3, vch = tid & 7;
    const bf16_t* gk0 = kn + (size_t)(tok0 + kkey0) * D + h * 128 + kch0 * 8;
    const bf16_t* gk1 = gk0 + (size_t)32 * D;
    const bf16_t* gr = kr + (size_t)(tok0 + rkey) * 64 + rch * 8;
    const bf16_t* gv0 = vt + (size_t)(h * 128 + vrow0) * T + tok0 + vch * 8;
    const bf16_t* gv1 = gv0 + (size_t)64 * T;
    const int lk0 = kkey0 * KROW + kch0 * 16, lk1 = lk0 + 32 * KROW, lr = rkey * KROW + 256 + rch * 16, lv0 = KBUF + vrow0 * VROW + vch * 16, lv1 = lv0 + 64 * VROW;
    const int pr = (r32 & 0x13) | ((r32 & 4) << 1) | ((r32 & 8) >> 1);
    const int kfo = pr * KROW + hi * 16, vfo = KBUF + r32 * VROW + hi * 16;
    u32x4 ld0, ld1, ld2, ld3, ld4;
    ld0 = *(const u32x4*)gk0; ld1 = *(const u32x4*)gk1; ld2 = *(const u32x4*)gr; ld3 = *(const u32x4*)gv0; ld4 = *(const u32x4*)gv1;
    __syncthreads();
    *(LAS u32x4*)(lds + lk0) = ld0; *(LAS u32x4*)(lds + lk1) = ld1; *(LAS u32x4*)(lds + lr) = ld2; *(LAS u32x4*)(lds + lv0) = ld3; *(LAS u32x4*)(lds + lv1) = ld4;
    __syncthreads();
    float mrun = -1e30f, lrun = 0.f;
    f32x16 o[4];
#pragma unroll
    for (int d = 0; d < 4; ++d) o[d] = f32x16{};
    for (int t = 0; t < NT; ++t) {
        const int cb = (t & 1) * ABUF, nb = ((t + 1) & 1) * ABUF;
        const bool more = (t + 1 < NT);
        if (more) { const size_t ko = (size_t)(t + 1) * 64 * D, ro = (size_t)(t + 1) * 64 * 64, vo = (size_t)(t + 1) * 64;
            ld0 = *(const u32x4*)(gk0 + ko); ld1 = *(const u32x4*)(gk1 + ko); ld2 = *(const u32x4*)(gr + ro); ld3 = *(const u32x4*)(gv0 + vo); ld4 = *(const u32x4*)(gv1 + vo); }
        if (64 * t <= q0 + 31) {
            f32x16 s0 = f32x16{}, s1 = f32x16{};
            __builtin_amdgcn_s_setprio(1);
#pragma unroll
            for (int d = 0; d < 12; ++d) {
                const bf16x8 k0 = *(const LAS bf16x8*)(lds + cb + kfo + d * 32), k1 = *(const LAS bf16x8*)(lds + cb + kfo + 32 * KROW + d * 32);
                s0 = __builtin_amdgcn_mfma_f32_32x32x16_bf16(k0, qf[d], s0, 0, 0, 0);
                s1 = __builtin_amdgcn_mfma_f32_32x32x16_bf16(k1, qf[d], s1, 0, 0, 0);
            }
            __builtin_amdgcn_s_setprio(0);
            if (64 * t + 63 > q0) {
                const int qi = q0 + r32, kb0 = 64 * t + 8 * hi;
#pragma unroll
                for (int r = 0; r < 16; ++r) { const int key = kb0 + 16 * (r >> 3) + (r & 7); if (key > qi) s0[r] = -1e30f; if (key + 32 > qi) s1[r] = -1e30f; }
            }
            float mx = fmaxf(fmaxf(s0[0], s1[0]), s0[1]);
#pragma unroll
            for (int r = 1; r < 16; ++r) mx = fmaxf(fmaxf(mx, s1[r]), (r < 15) ? s0[r + 1] : s1[r]);
            { auto rr = __builtin_amdgcn_permlane32_swap(__float_as_uint(mx), __float_as_uint(mx), false, false); mx = fmaxf(__uint_as_float(rr[0]), __uint_as_float(rr[1])); }
            if (__any(mx - mrun > 8.0f)) {
                const float mnew = fmaxf(mrun, mx); const float alpha = __builtin_amdgcn_exp2f(mrun - mnew); mrun = mnew; lrun *= alpha;
#pragma unroll
                for (int d = 0; d < 4; ++d) o[d] = o[d] * alpha;
            }
            float ps = 0.f;
#pragma unroll
            for (int r = 0; r < 16; ++r) { s0[r] = __builtin_amdgcn_exp2f(s0[r] - mrun); s1[r] = __builtin_amdgcn_exp2f(s1[r] - mrun); ps += s0[r] + s1[r]; }
            lrun += ps;
            bf16x8 pf[4];
            { u32x4 w;
              w.x = cvt_pk_bf16(s0[0], s0[1]); w.y = cvt_pk_bf16(s0[2], s0[3]); w.z = cvt_pk_bf16(s0[4], s0[5]); w.w = cvt_pk_bf16(s0[6], s0[7]); pf[0] = __builtin_bit_cast(bf16x8, w);
              w.x = cvt_pk_bf16(s0[8], s0[9]); w.y = cvt_pk_bf16(s0[10], s0[11]); w.z = cvt_pk_bf16(s0[12], s0[13]); w.w = cvt_pk_bf16(s0[14], s0[15]); pf[1] = __builtin_bit_cast(bf16x8, w);
              w.x = cvt_pk_bf16(s1[0], s1[1]); w.y = cvt_pk_bf16(s1[2], s1[3]); w.z = cvt_pk_bf16(s1[4], s1[5]); w.w = cvt_pk_bf16(s1[6], s1[7]); pf[2] = __builtin_bit_cast(bf16x8, w);
              w.x = cvt_pk_bf16(s1[8], s1[9]); w.y = cvt_pk_bf16(s1[10], s1[11]); w.z = cvt_pk_bf16(s1[12], s1[13]); w.w = cvt_pk_bf16(s1[14], s1[15]); pf[3] = __builtin_bit_cast(bf16x8, w); }
            __builtin_amdgcn_s_setprio(1);
#pragma unroll
            for (int d = 0; d < 4; ++d)
#pragma unroll
                for (int ks = 0; ks < 4; ++ks) {
                    const bf16x8 vf = *(const LAS bf16x8*)(lds + cb + vfo + d * 32 * VROW + ks * 32);
                    o[d] = __builtin_amdgcn_mfma_f32_32x32x16_bf16(vf, pf[ks], o[d], 0, 0, 0);
                }
            __builtin_amdgcn_s_setprio(0);
        }
        if (more) { *(LAS u32x4*)(lds + nb + lk0) = ld0; *(LAS u32x4*)(lds + nb + lk1) = ld1; *(LAS u32x4*)(lds + nb + lr) = ld2; *(LAS u32x4*)(lds + nb + lv0) = ld3; *(LAS u32x4*)(lds + nb + lv1) = ld4; }
        __syncthreads();
    }
    { auto rr = __builtin_amdgcn_permlane32_swap(__float_as_uint(lrun), __float_as_uint(lrun), false, false); lrun = __uint_as_float(rr[0]) + __uint_as_float(rr[1]); }
    const float rl = __builtin_amdgcn_rcpf(lrun);
    bf16_t* op = o_out + (size_t)(tok0 + q0 + r32) * D + h * 128 + 4 * hi;
#pragma unroll
    for (int d = 0; d < 4; ++d)
#pragma unroll
        for (int r4 = 0; r4 < 4; ++r4) { u32x2 w; w.x = cvt_pk_bf16(o[d][4 * r4] * rl, o[d][4 * r4 + 1] * rl); w.y = cvt_pk_bf16(o[d][4 * r4 + 2] * rl, o[d][4 * r4 + 3] * rl);
            *(u32x2*)(op + 32 * d + 8 * r4) = w; }
}
__device__ __forceinline__ void p_attn(const Ctx& F, const Args& a) {
    const bf16_t* qn = (const bf16_t*)(a.ws + A_QN); const bf16_t* qr = (const bf16_t*)(a.ws + A_QR);
    const bf16_t* kn = (const bf16_t*)(a.ws + A_KN); const bf16_t* kr = (const bf16_t*)(a.ws + A_KR); const bf16_t* vt = (const bf16_t*)(a.ws + A_VT);
    bf16_t* oo = (bf16_t*)(a.ws + A_QN);
    for (int p = F.vcu; p < 512; p += F.G) {
        const int bh = p >> 3, s = p & 7;
        attn_unit(F.lds, qn, qr, kn, kr, vt, oo, bh >> 3, bh & 7, 15 - s, F.wave);
        attn_unit(F.lds, qn, qr, kn, kr, vt, oo, bh >> 3, bh & 7, s, F.wave);
    }
}

__device__ __forceinline__ void p_final(const Ctx& F, const Args& a) {
    float* h = a.out; const float* g = a.in[32];
    const int tid = fresh_tid(F.wave), lane = tid & 63, wave = __builtin_amdgcn_readfirstlane(tid >> 6);
    const int gw = F.vcu * 8 + wave, NGW = F.G * 8;
    f32x4 gv[4];
#pragma unroll
    for (int j = 0; j < 4; ++j) gv[j] = *((const f32x4*)g + lane + 64 * j);
    for (int m = gw; m < T; m += NGW) {
        f32x4 v[4]; float ss = 0.f;
#pragma unroll
        for (int j = 0; j < 4; ++j) { v[j] = *((const f32x4*)(h + (size_t)m * D) + lane + 64 * j); ss += (v[j][0] * v[j][0] + v[j][1] * v[j][1]) + (v[j][2] * v[j][2] + v[j][3] * v[j][3]); }
        const float rs = __builtin_amdgcn_rsqf(wave_sum(ss) * (1.0f / 1024.0f) + RMS_EPS);
#pragma unroll
        for (int j = 0; j < 4; ++j) *((f32x4*)(h + (size_t)m * D) + lane + 64 * j) = v[j] * rs * gv[j];
    }
}

#define XB_XCNT(j)  (256  + 64 * (j))
#define XB_XSUB(j)  (1280 + 64 * (j))
#define XB_XGEN(j)  (2304 + 64 * (j))
#define XB_TOP      3328
#define XB_TOPGEN   3392
__device__ __forceinline__ unsigned xb_ld(unsigned* p)              { return __hip_atomic_load(p, __ATOMIC_RELAXED, __HIP_MEMORY_SCOPE_AGENT); }
__device__ __forceinline__ unsigned xb_add(unsigned* p, unsigned v) { return __hip_atomic_fetch_add(p, v, __ATOMIC_RELAXED, __HIP_MEMORY_SCOPE_AGENT); }
__device__ __forceinline__ void my_grid_sync(unsigned* bar, unsigned G, int wave_s, unsigned x, volatile LAS unsigned* st) {
    asm volatile("s_waitcnt vmcnt(0) lgkmcnt(0)" ::: "memory");
    __syncthreads();
    if (fresh_tid(wave_s) == 0) {
        unsigned nloc = st[0], nx = st[1];
        if (nloc == 0u) {
            for (;;) { unsigned sum = 0u, cnt = 0u, mine = 0u;
#pragma unroll
                for (unsigned j = 0; j < 16; ++j) { const unsigned c = xb_ld(&bar[XB_XCNT(j)]); sum += c; cnt += (c > 0u) ? 1u : 0u; mine = (j == x) ? c : mine; }
                if (sum == G) { nloc = mine; nx = cnt; break; }
                __builtin_amdgcn_s_sleep(1); }
            st[0] = nloc; st[1] = nx;
        }
        const unsigned old = xb_add(&bar[XB_XSUB(x)], 1u);
        const unsigned gen = old / nloc;
        if (old + 1u == (gen + 1u) * nloc) {
            __builtin_amdgcn_fence(__ATOMIC_RELEASE, "agent");
            asm volatile("s_waitcnt vmcnt(0)" ::: "memory");
            const unsigned og = xb_add(&bar[XB_TOP], 1u);
            const unsigned tg = og / nx;
            if (og + 1u == (tg + 1u) * nx) xb_add(&bar[XB_TOPGEN], 1u);
            else while (xb_ld(&bar[XB_TOPGEN]) == tg) __builtin_amdgcn_s_sleep(1);
            __builtin_amdgcn_fence(__ATOMIC_ACQUIRE, "agent");
            xb_add(&bar[XB_XGEN(x)], 1u);
            asm volatile("s_waitcnt vmcnt(0)" ::: "memory");
        } else {
            while (xb_ld(&bar[XB_XGEN(x)]) == gen) __builtin_amdgcn_s_sleep(1);
            __builtin_amdgcn_fence(__ATOMIC_ACQUIRE, "agent");
            asm volatile("s_waitcnt vmcnt(0)" ::: "memory");
        }
    }
    __syncthreads();
}
#define GSYNC() do { my_grid_sync(bar_words + 64 * bar_idx, (unsigned)F.G, F.wave); ++bar_idx; } while (0)
#define RUN_GEMM(EPI_T, epi, Aptr, lda_, Bptr, ldb_, M_, N_, K_) do { pg8::Gemm g_{(const bf16_t*)(Aptr), (lda_), (const bf16_t*)(Bptr), (ldb_), (M_), (N_), (K_)}; \
    pg8::StaticOrder S_; S_.init((M_), (N_), F.G, (int)blockIdx.x); pg8::gemm_phase<EPI_T, pg8::StaticOrder>(F.lds, g_, S_, (epi), F.wave); } while (0)

__global__ void __launch_bounds__(512, 2) fwd_mega(Args a) {
    extern __shared__ __attribute__((aligned(16))) unsigned char lds_raw[];
    cg::grid_group grid = cg::this_grid();
    Ctx F; F.lds = (LAS unsigned char*)lds_raw; F.wave = __builtin_amdgcn_readfirstlane((int)threadIdx.x >> 6);
    F.G = gridDim.x; { const int bx = blockIdx.x; F.vcu = (F.G % 8 == 0) ? (bx % 8) * (F.G / 8) + bx / 8 : bx; }
    unsigned char* ws = a.ws;
    float* slotsH = (float*)(ws + WS_SLOTH); float* slotsC = (float*)(ws + WS_SLOTC); float* slotsQ = (float*)(ws + WS_SLOTQ);
    bf16_t* HB = (bf16_t*)(ws + A_HB); bf16_t* MID = (bf16_t*)(ws + A_MID);
    const float* cosT = (const float*)(ws + A_COS); const float* sinT = (const float*)(ws + A_SIN);
    bf16_t* WUG = (bf16_t*)(ws + W_UG); bf16_t* WDN = (bf16_t*)(ws + W_DN);

    unsigned* bar_words = (unsigned*)ws;
    if (a.ph_hi > 1000) grid.sync();
    const unsigned xcc = (unsigned)__builtin_amdgcn_s_getreg((3 << 11) | 20) & 0xFu;
    volatile LAS unsigned* xst = (volatile LAS unsigned*)(F.lds + 131072 + 64);
    if (fresh_tid(F.wave) == 0) { xst[0] = 0u; xst[1] = 0u; (void)xb_add(&bar_words[XB_XCNT(xcc)], 1u); }
    __syncthreads();
    if (a.ph_lo <= 0 && 0 < a.ph_hi) {
    p0_prologue(F, a);
    }
    if (a.ph_lo <= 0 && 1 < a.ph_hi) my_grid_sync(bar_words, (unsigned)F.G, F.wave, xcc, xst);
    if (a.ph_lo <= 1 && 1 < a.ph_hi) {
    { EpiSwiglu E{MID, slotsH, nullptr, nullptr, nullptr, nullptr, nullptr}; RUN_GEMM(EpiSwiglu, E, HB, D, WUG, D, T, 5632, D); }
    }
    if (a.ph_lo <= 1 && 2 < a.ph_hi) my_grid_sync(bar_words, (unsigned)F.G, F.wave, xcc, xst);
    if (a.ph_lo <= 2 && 2 < a.ph_hi) {
    { EpiResid E{a.in[0], a.out, nullptr, nullptr, 0.5f}; RUN_GEMM(EpiResid, E, MID, FF, WDN, FF, T, D, FF); }
    }
    if (a.ph_lo <= 2 && 3 < a.ph_hi) my_grid_sync(bar_words, (unsigned)F.G, F.wave, xcc, xst);
    if (a.ph_lo <= 3 && 3 < a.ph_hi) {
    p_premix(F, a);
    }
    if (a.ph_lo <= 3 && 4 < a.ph_hi) my_grid_sync(bar_words, (unsigned)F.G, F.wave, xcc, xst);
    if (a.ph_lo <= 4 && 4 < a.ph_hi) {
    { EpiRL E{(bf16_t*)(ws + A_R), (bf16_t*)(ws + A_LM)}; pg8::Gemm g_{(const bf16_t*)(ws + A_X1), 2048, (const bf16_t*)(ws + W_RL), 2048, T, 1280, 2048}; pg8::OrderRL S_{(int)blockIdx.x};
      pg8::gemm_phase<EpiRL, pg8::OrderRL>(F.lds, g_, S_, E, F.wave); }
    }
    if (a.ph_lo <= 4 && 5 < a.ph_hi) my_grid_sync(bar_words, (unsigned)F.G, F.wave, xcc, xst);
    if (a.ph_lo <= 5 && 5 < a.ph_hi) {
    { EpiBf16 E{(bf16_t*)(ws + A_KK), D}; RUN_GEMM(EpiBf16, E, ws + A_XK, D, ws + W_K, D, T, D, D); }
    { EpiBf16 E{(bf16_t*)(ws + A_VV), D}; RUN_GEMM(EpiBf16, E, ws + A_XV, D, ws + W_V, D, T, D, D); }
    { EpiLoraUp E{ws, a.in[11], a.in[14], 0, A_G}; RUN_GEMM(EpiLoraUp, E, ws + A_LM, 256, ws + W_LU, 256, T, 2048, 256); }
    }
    if (a.ph_lo <= 5 && 6 < a.ph_hi) my_grid_sync(bar_words, (unsigned)F.G, F.wave, xcc, xst);
    if (a.ph_lo <= 6 && 6 < a.ph_hi) {
    p_scan2(F, a);
    }
    if (a.ph_lo <= 6 && 7 < a.ph_hi) my_grid_sync(bar_words, (unsigned)F.G, F.wave, xcc, xst);
    if (a.ph_lo <= 7 && 7 < a.ph_hi) {
    { EpiLoraUp E{ws, a.in[11], a.in[14], 2, A_E}; RUN_GEMM(EpiLoraUp, E, ws + A_LM, 256, ws + W_LU + (size_t)2048 * 256 * 2, 256, T, 1024, 256); }
    }
    if (a.ph_lo <= 7 && 8 < a.ph_hi) my_grid_sync(bar_words, (unsigned)F.G, F.wave, xcc, xst);
    if (a.ph_lo <= 8 && 8 < a.ph_hi) {
    p_post(F, a);
    }
    if (a.ph_lo <= 8 && 9 < a.ph_hi) my_grid_sync(bar_words, (unsigned)F.G, F.wave, xcc, xst);
    if (a.ph_lo <= 9 && 9 < a.ph_hi) {
    { EpiResid E{a.out, a.out, HB, slotsH, 1.0f}; RUN_GEMM(EpiResid, E, ws + A_G, D, ws + W_O, D, T, D, D); }
    }
    if (a.ph_lo <= 9 && 10 < a.ph_hi) my_grid_sync(bar_words, (unsigned)F.G, F.wave, xcc, xst);
    if (a.ph_lo <= 10 && 10 < a.ph_hi) {
    { EpiSwiglu E{MID, slotsH, nullptr, nullptr, nullptr, nullptr, nullptr}; RUN_GEMM(EpiSwiglu, E, HB, D, WUG + (size_t)1 * 6144 * D, D, T, 5632, D); }
    }
    if (a.ph_lo <= 10 && 11 < a.ph_hi) my_grid_sync(bar_words, (unsigned)F.G, F.wave, xcc, xst);
    if (a.ph_lo <= 11 && 11 < a.ph_hi) {
    { EpiResid E{a.out, a.out, HB, slotsH, 0.5f}; RUN_GEMM(EpiResid, E, MID, FF, WDN + (size_t)1 * D * FF, FF, T, D, FF); }
    }
    if (a.ph_lo <= 11 && 12 < a.ph_hi) my_grid_sync(bar_words, (unsigned)F.G, F.wave, xcc, xst);
    if (a.ph_lo <= 12 && 12 < a.ph_hi) {
    { EpiSwiglu E{MID, slotsH, (bf16_t*)(ws + A_C), slotsC, (bf16_t*)(ws + A_KR), cosT, sinT}; RUN_GEMM(EpiSwiglu, E, HB, D, WUG + (size_t)2 * 6144 * D, D, T, 6144, D); }
    }
    if (a.ph_lo <= 12 && 13 < a.ph_hi) my_grid_sync(bar_words, (unsigned)F.G, F.wave, xcc, xst);
    if (a.ph_lo <= 13 && 13 < a.ph_hi) {
    { EpiResid E{a.out, a.out, HB, slotsH, 0.5f}; RUN_GEMM(EpiResid, E, MID, FF, WDN + (size_t)2 * D * FF, FF, T, D, FF); }
    { EpiKnope E{(bf16_t*)(ws + A_KN), slotsC}; RUN_GEMM(EpiKnope, E, ws + A_C, 256, ws + W_KN, 256, T, D, 256); }
    { EpiVt E{(bf16_t*)(ws + A_VT), slotsC}; RUN_GEMM(EpiVt, E, ws + W_VT, 256, ws + A_C, 256, D, T, 256); }
    }
    if (a.ph_lo <= 13 && 14 < a.ph_hi) my_grid_sync(bar_words, (unsigned)F.G, F.wave, xcc, xst);
    if (a.ph_lo <= 14 && 14 < a.ph_hi) {
    { EpiQlat E{(bf16_t*)(ws + A_QLAT), slotsH, slotsQ}; RUN_GEMM(EpiQlat, E, HB, D, ws + W_DQ, D, T, 512, D); }
    }
    if (a.ph_lo <= 14 && 15 < a.ph_hi) my_grid_sync(bar_words, (unsigned)F.G, F.wave, xcc, xst);
    if (a.ph_lo <= 15 && 15 < a.ph_hi) {
    { EpiQ E{(bf16_t*)(ws + A_QN), (bf16_t*)(ws + A_QR), slotsQ, cosT, sinT}; RUN_GEMM(EpiQ, E, ws + A_QLAT, 512, ws + W_UQ, 512, T, 1536, 512); }
    }
    if (a.ph_lo <= 15 && 16 < a.ph_hi) my_grid_sync(bar_words, (unsigned)F.G, F.wave, xcc, xst);
    if (a.ph_lo <= 16 && 16 < a.ph_hi) {
    p_attn(F, a);
    }
    if (a.ph_lo <= 16 && 17 < a.ph_hi) my_grid_sync(bar_words, (unsigned)F.G, F.wave, xcc, xst);
    if (a.ph_lo <= 17 && 17 < a.ph_hi) {
    { EpiResid E{a.out, a.out, HB, slotsH, 1.0f}; RUN_GEMM(EpiResid, E, ws + A_QN, D, ws + W_MO, D, T, D, D); }
    }
    if (a.ph_lo <= 17 && 18 < a.ph_hi) my_grid_sync(bar_words, (unsigned)F.G, F.wave, xcc, xst);
    if (a.ph_lo <= 18 && 18 < a.ph_hi) {
    { EpiSwiglu E{MID, slotsH, nullptr, nullptr, nullptr, nullptr, nullptr}; RUN_GEMM(EpiSwiglu, E, HB, D, WUG + (size_t)3 * 6144 * D, D, T, 5632, D); }
    }
    if (a.ph_lo <= 18 && 19 < a.ph_hi) my_grid_sync(bar_words, (unsigned)F.G, F.wave, xcc, xst);
    if (a.ph_lo <= 19 && 19 < a.ph_hi) {
    { EpiResid E{a.out, a.out, nullptr, nullptr, 0.5f}; RUN_GEMM(EpiResid, E, MID, FF, WDN + (size_t)3 * D * FF, FF, T, D, FF); }
    }
    if (a.ph_lo <= 19 && 20 < a.ph_hi) my_grid_sync(bar_words, (unsigned)F.G, F.wave, xcc, xst);
    if (a.ph_lo <= 20 && 20 < a.ph_hi) {
    p_final(F, a);
    }
}

extern "C" void kernel_launch(void* const* d_in, const int* in_sizes, int n_in, void* d_out, int out_size, void* d_ws, size_t ws_size, hipStream_t stream) {
    static int grid = 0;
    if (grid == 0) {
        if (n_in != 33 || out_size != T * D || ws_size < WS_NEED) { fprintf(stderr, "kernel_launch: unexpected shapes: n_in %d out %d ws %zu (need %zu)\n", n_in, out_size, ws_size, (size_t)WS_NEED); grid = -1; return; }
        int dev = 0, cus = 0, per_cu = 0;
        (void)hipGetDevice(&dev); (void)hipDeviceGetAttribute(&cus, hipDeviceAttributeMultiprocessorCount, dev);
        (void)hipFuncSetAttribute((const void*)fwd_mega, hipFuncAttributeMaxDynamicSharedMemorySize, LDS_BYTES);
        (void)hipOccupancyMaxActiveBlocksPerMultiprocessor(&per_cu, (const void*)fwd_mega, 512, LDS_BYTES);
        (void)hipGetLastError();
        grid = cus > 0 ? cus : 256;
        if (grid > 256) grid = 256;
    }
    if (grid < 0) return;
    (void)hipMemsetAsync(d_ws, 0, 16384, stream);
    Args a{};
    for (int i = 0; i < 33; ++i) a.in[i] = (const float*)d_in[i];
    a.pos = (const int*)d_in[1]; a.out = (float*)d_out; a.ws = (unsigned char*)d_ws;
    hipError_t e = hipSuccess;
#if N_LAUNCHES == 1
    a.ph_lo = 0; a.ph_hi = NPHASES;
    { void* args[] = {&a}; e = hipLaunchCooperativeKernel((void*)fwd_mega, dim3(grid), dim3(512), args, LDS_BYTES, stream); }
#else
    for (int p = 0; p < NPHASES; ++p) { a.ph_lo = p; a.ph_hi = p + 1; hipLaunchKernelGGL(fwd_mega, dim3(grid), dim3(512), LDS_BYTES, stream, a); }
    e = hipPeekAtLastError();
#endif
    if (e != hipSuccess) fprintf(stderr, "cooperative launch failed: %s (grid %d)\n", hipGetErrorString(e), grid);
}
```

```cpp
#include <hip/hip_runtime.h>
#include <hip/hip_cooperative_groups.h>
#include <cstdio>
#include <cstdint>
namespace cg = cooperative_groups;

#define LAS __attribute__((address_space(3)))
typedef unsigned short bf16_t;
typedef short bf16x8 __attribute__((ext_vector_type(8)));
typedef float f32x4 __attribute__((ext_vector_type(4)));
typedef float f32x16 __attribute__((ext_vector_type(16)));
typedef unsigned u32x4 __attribute__((ext_vector_type(4)));
typedef unsigned u32x2 __attribute__((ext_vector_type(2)));
typedef float f32x2 __attribute__((ext_vector_type(2)));

constexpr int T = 32768, D = 1024, FF = 2816, SEQ = 4096, NB = 8;
constexpr float RMS_EPS = 1e-6f, GN_EPS = 64e-5f;
constexpr float LOG2E = 1.4426950408889634f;
constexpr float QSCALE = 0.07216878364870322f * 1.4426950408889634f;

constexpr size_t MiB = 1u << 20;
constexpr size_t WS_SLOTH = MiB / 2;
constexpr size_t WS_SLOTC = WS_SLOTH + 2 * MiB;
constexpr size_t WS_SLOTQ = WS_SLOTC + MiB / 2;
constexpr size_t WS_W = 4 * MiB;
constexpr size_t W_UG = WS_W;
constexpr size_t W_DN = W_UG + 48 * MiB;
constexpr size_t W_R = W_DN + 22 * MiB;
constexpr size_t W_K = W_R + 2 * MiB;
constexpr size_t W_V = W_K + 2 * MiB;
constexpr size_t W_O = W_V + 2 * MiB;
constexpr size_t W_LD = W_O + 2 * MiB;
constexpr size_t W_LU = W_LD + 1 * MiB;
constexpr size_t W_KN = W_LU + 2 * MiB;
constexpr size_t W_VT = W_KN + MiB / 2;
constexpr size_t W_DQ = W_VT + MiB / 2;
constexpr size_t W_UQ = W_DQ + 1 * MiB;
constexpr size_t W_MO = W_UQ + 2 * MiB;
constexpr size_t W_END = W_MO + 2 * MiB;
constexpr size_t WS_A = 92 * MiB;
static_assert(W_END <= WS_A, "weights region");
constexpr size_t A_HB = WS_A + 0;
constexpr size_t A_MID = WS_A + 64 * MiB;
constexpr size_t A_C = WS_A + 240 * MiB;
constexpr size_t A_KR = WS_A + 256 * MiB;
constexpr size_t A_KN = WS_A + 260 * MiB;
constexpr size_t A_VT = WS_A + 324 * MiB;
constexpr size_t A_QLAT = A_MID;
constexpr size_t A_QN = A_MID + 32 * MiB;
constexpr size_t A_QR = A_MID + 96 * MiB;
constexpr size_t A_X1 = WS_A + 0;
constexpr size_t A_XK = WS_A + 128 * MiB;
constexpr size_t A_XV = WS_A + 192 * MiB;
constexpr size_t A_R = WS_A + 256 * MiB;
constexpr size_t A_LM = WS_A + 320 * MiB;
constexpr size_t A_KK = WS_A + 0;
constexpr size_t A_VV = WS_A + 64 * MiB;
constexpr size_t A_E = WS_A + 128 * MiB;
constexpr size_t A_AA = WS_A + 192 * MiB;
constexpr size_t A_G = WS_A + 336 * MiB;
constexpr size_t A_BON = WS_A + 400 * MiB;
constexpr size_t A_COS = WS_A + 404 * MiB;
constexpr size_t A_SIN = WS_A + 408 * MiB;
constexpr size_t W_RL = WS_A + 412 * MiB;
constexpr size_t WS_NEED = 512 * MiB;

constexpr int LDS_BYTES = 147456;
constexpr int NPHASES = 21;
#ifndef N_LAUNCHES
#define N_LAUNCHES 1
#endif

__device__ __forceinline__ unsigned cvt_pk_bf16(float lo, float hi) { unsigned r; asm volatile("v_cvt_pk_bf16_f32 %0, %1, %2" : "=v"(r) : "v"(lo), "v"(hi)); return r; }
__device__ __forceinline__ float fsigmoid(float x) { return __builtin_amdgcn_rcpf(1.0f + __builtin_amdgcn_exp2f(-x * LOG2E)); }
__device__ __forceinline__ float ftanh(float x) { return 1.0f - 2.0f * __builtin_amdgcn_rcpf(1.0f + __builtin_amdgcn_exp2f(2.0f * LOG2E * x)); }
__device__ __forceinline__ float wave_sum(float v) {
#pragma unroll
    for (int o = 1; o < 64; o <<= 1) v += __shfl_xor(v, o);
    return v;
}
template <int CTRL> __device__ __forceinline__ float dpp_mov(float x) { return __builtin_bit_cast(float, __builtin_amdgcn_update_dpp(0, __builtin_bit_cast(int, x), CTRL, 0xf, 0xf, true)); }
__device__ __forceinline__ float red8(float x) { x += dpp_mov<0xB1>(x); x += dpp_mov<0x4E>(x); x += dpp_mov<0x141>(x); return x; }
__device__ __forceinline__ float red16(float x) { x = red8(x); x += dpp_mov<0x140>(x); return x; }
__device__ __forceinline__ float sum4(f32x4 v) { return (v[0] + v[1]) + (v[2] + v[3]); }
__device__ __forceinline__ float rstd_slots16(const float* s, int row) {
    const f32x4* p = (const f32x4*)(s + (size_t)row * 16);
    const f32x4 a = p[0], b = p[1], c = p[2], d = p[3];
    return __builtin_amdgcn_rsqf((sum4(a) + sum4(b) + sum4(c) + sum4(d)) * (1.0f / 1024.0f) + RMS_EPS);
}
__device__ __forceinline__ f32x4 unpack4(u32x2 p) { f32x4 r; r[0] = __uint_as_float(p.x << 16); r[1] = __uint_as_float(p.x & 0xffff0000u); r[2] = __uint_as_float(p.y << 16); r[3] = __uint_as_float(p.y & 0xffff0000u); return r; }

__device__ __forceinline__ int fresh_tid(int wave_s) { int l; asm volatile("v_mbcnt_lo_u32_b32 %0, -1, 0\n\tv_mbcnt_hi_u32_b32 %0, -1, %0" : "=v"(l)); return wave_s * 64 + l; }

namespace pg8 {
constexpr int BM = 256, BK = 64, HALF = 128, HTB = HALF * BK * 2, STAGE_BYTES = 8 * HTB, NXCD = 8, WGM = 8;
__device__ __forceinline__ int lds_byte(int r, int c) { const int st = (r >> 4) * 2 + (c >> 5), rr = r & 15, cc = c & 31, ob = rr * 64 + cc * 2; return st * 1024 + (ob ^ (((ob >> 9) & 1) << 5)); }
__device__ __forceinline__ void stage_rc(int b, int& R, int& C) { const int st = b / 1024, sb = b % 1024, swz = sb ^ (((sb >> 9) & 1) << 5); R = (st >> 1) * 16 + swz / 64; C = (st & 1) * 32 + (swz % 64) / 2; }
__device__ __forceinline__ int perm32(int rho) { const int n = rho >> 4, i = rho & 15; return 8 * (i >> 2) + 4 * n + (i & 3); }
struct Unit { int pm, pn; };
struct Gemm { const bf16_t* A; int lda; const bf16_t* Bt; int ldb; int M, N, K; };
struct StaticOrder {
    int nM, nN, nwg, G, c;
    __device__ void init(int M, int N, int G_, int c_) { nM = M / BM; nN = N / BM; nwg = nM * nN; G = G_; c = c_; }
    __device__ bool next(int i, Unit& u) const {
        const long L = (long)i * G + c; if (L >= nwg) return false;
        int wgid = (int)L; { const int q = nwg / NXCD, r = nwg % NXCD, xcd = wgid % NXCD, off = wgid / NXCD; wgid = (xcd < r ? xcd * (q + 1) : r * (q + 1) + (xcd - r) * q) + off; }
        const int nig = WGM * nN, gid = wgid / nig, fm = gid * WGM, gsz = (nM - fm) < WGM ? (nM - fm) : WGM;
        u.pm = fm + ((wgid % nig) % gsz); u.pn = (wgid % nig) / gsz; return true;
    }
    __device__ __forceinline__ int unit_nt(const Unit&, int nt) const { return nt; }
};
struct OrderRL {
    int c;
    __device__ bool next(int i, Unit& u) const {
        int idx;
        if (c < 128) { if (i == 0) { u.pm = c; u.pn = 4; return true; } if (i > 1) return false; idx = c; }
        else { if (i > 2) return false; idx = 128 + 3 * (c - 128) + i; }
        u.pm = idx >> 2; u.pn = idx & 3; return true;
    }
    __device__ __forceinline__ int unit_nt(const Unit& u, int nt) const { return u.pn < 4 ? nt / 2 : nt; }
};

template <class Epi, class Sched>
__device__ __forceinline__ void gemm_phase(LAS unsigned char* lds, const Gemm g, const Sched& S, const Epi& E, int wave_s) {
    const int tid = fresh_tid(wave_s), wid = __builtin_amdgcn_readfirstlane(tid >> 6), lane = tid & 63, wr = wid >> 2, wc = wid & 3, fr = lane & 15, fq = lane >> 4;
    const int K = g.K, nt_full = K / BK;
    unsigned voffA[2], voffB[2];
#pragma unroll
    for (int i = 0; i < 2; ++i) { int R, C; stage_rc(tid * 16 + i * 8192, R, C); const int Rb = Epi::PERM ? ((R & ~31) + perm32(R & 31)) : R;
        voffA[i] = (unsigned)(R * g.lda + C) * 2u; voffB[i] = (unsigned)(Rb * g.ldb + C) * 2u; }
    const size_t kstep = (size_t)(BK * 2);
    const size_t hstepA = (size_t)HALF * g.lda * 2, hstepB = (size_t)HALF * g.ldb * 2;
    const size_t tstepA = 2 * hstepA, tstepB = 2 * hstepB;
    const unsigned ldsw = (unsigned)wid * 1024u;
    const int aoff = lds_byte(wr * 64 + fr, fq * 8), boff = lds_byte(wc * 32 + fr, fq * 8);
#define PG8_SA(b, h) (((b) * 2 + (h)) * HTB)
#define PG8_SB(b, h) ((4 + (b) * 2 + (h)) * HTB)
#define PG8_STAGE(bufoff, gbase, voff) do { _Pragma("unroll") for (int _i = 0; _i < 2; ++_i) \
        __builtin_amdgcn_global_load_lds((const unsigned*)((const char*)(gbase) + (voff)[_i]), (LAS unsigned*)(lds + (bufoff) + ldsw + _i * 8192), 16, 0, 0); } while (0)
#define PG8_LDA(dst, b, h) do { _Pragma("unroll") for (int m = 0; m < 4; ++m) _Pragma("unroll") for (int k = 0; k < 2; ++k) dst[m][k] = *(const LAS bf16x8*)(lds + PG8_SA(b, h) + aoff + m * 2048 + k * 1024); } while (0)
#define PG8_LDB(dst, b, h) do { _Pragma("unroll") for (int n = 0; n < 2; ++n) _Pragma("unroll") for (int k = 0; k < 2; ++k) dst[n][k] = *(const LAS bf16x8*)(lds + PG8_SB(b, h) + boff + n * 2048 + k * 1024); } while (0)
#define PG8_MMA(ai, bj, At, Bt) do { __builtin_amdgcn_s_setprio(1); _Pragma("unroll") for (int m = 0; m < 4; ++m) _Pragma("unroll") for (int n = 0; n < 2; ++n) _Pragma("unroll") for (int k = 0; k < 2; ++k) \
        acc[ai][bj][m][n] = __builtin_amdgcn_mfma_f32_16x16x32_bf16(Bt[n][k], At[m][k], acc[ai][bj][m][n], 0, 0, 0); __builtin_amdgcn_s_setprio(0); } while (0)
#define PG8_WAIT_V(n) asm volatile("s_waitcnt vmcnt(" #n ")" ::: "memory")
#define PG8_WAIT_L(n) asm volatile("s_waitcnt lgkmcnt(" #n ")" ::: "memory")
#define PG8_BAR __builtin_amdgcn_s_barrier()
#define PG8_SCHED __builtin_amdgcn_sched_barrier(0)
    Unit cur, nxt; int ui = 0;
    if (!S.next(0, cur)) return;
    f32x4 acc[2][2][4][2];
#pragma unroll
    for (int a = 0; a < 2; ++a)
#pragma unroll
        for (int b = 0; b < 2; ++b)
#pragma unroll
            for (int m = 0; m < 4; ++m)
#pragma unroll
                for (int n = 0; n < 2; ++n) acc[a][b][m][n] = (f32x4){0.f, 0.f, 0.f, 0.f};
    bf16x8 At[4][2], B0[2][2], B1[2][2];
    const char* cA = (const char*)g.A + (size_t)cur.pm * tstepA; const char* cB = (const char*)g.Bt + (size_t)cur.pn * tstepB;
    PG8_STAGE(PG8_SB(0, 0), cB, voffB); PG8_STAGE(PG8_SB(0, 1), cB + hstepB, voffB); PG8_STAGE(PG8_SA(0, 0), cA, voffA); PG8_STAGE(PG8_SA(0, 1), cA + hstepA, voffA);
    if (wr == 1) PG8_BAR;
    PG8_WAIT_V(2); PG8_BAR;
    PG8_STAGE(PG8_SB(1, 0), cB + kstep, voffB); PG8_STAGE(PG8_SA(1, 0), cA + kstep, voffA); PG8_STAGE(PG8_SB(1, 1), cB + hstepB + kstep, voffB);
    PG8_WAIT_V(6); PG8_BAR;
    for (;;) {
        const bool has_next = S.next(ui + 1, nxt);
        const char* nA = has_next ? (const char*)g.A + (size_t)nxt.pm * tstepA : cA; const char* nB = has_next ? (const char*)g.Bt + (size_t)nxt.pn * tstepB : cB;
        const int nt = S.unit_nt(cur, nt_full);
        for (int t = 0; t < nt; t += 2) {
            const bool last = (t == nt - 2);
            const char* a1 = cA + (size_t)(t + 1) * kstep;
            const char* a2 = last ? nA : cA + (size_t)(t + 2) * kstep; const char* b2 = last ? nB : cB + (size_t)(t + 2) * kstep;
            const char* a3 = a2 + kstep; const char* b3 = b2 + kstep;
            PG8_LDB(B0, 0, 0); PG8_LDB(B1, 0, 1); PG8_SCHED; PG8_LDA(At, 0, 0); PG8_STAGE(PG8_SA(1, 1), a1 + hstepA, voffA);
            PG8_WAIT_V(8); PG8_WAIT_L(0); PG8_BAR; PG8_MMA(0, 0, At, B0); PG8_MMA(0, 1, At, B1); PG8_BAR; PG8_SCHED;
            PG8_LDA(At, 0, 1); PG8_STAGE(PG8_SB(0, 0), b2, voffB); PG8_STAGE(PG8_SB(0, 1), b2 + hstepB, voffB); PG8_STAGE(PG8_SA(0, 0), a2, voffA);
            PG8_WAIT_V(8); PG8_WAIT_L(0); PG8_BAR; PG8_MMA(1, 0, At, B0); PG8_MMA(1, 1, At, B1); PG8_BAR; PG8_SCHED;
            PG8_LDB(B0, 1, 0); PG8_LDB(B1, 1, 1); PG8_SCHED; PG8_LDA(At, 1, 0); PG8_STAGE(PG8_SA(0, 1), a2 + hstepA, voffA);
            PG8_WAIT_V(8); PG8_WAIT_L(0); PG8_BAR; PG8_MMA(0, 0, At, B0); PG8_MMA(0, 1, At, B1); PG8_BAR; PG8_SCHED;
            PG8_LDA(At, 1, 1); PG8_STAGE(PG8_SB(1, 0), b3, voffB); PG8_STAGE(PG8_SB(1, 1), b3 + hstepB, voffB); PG8_STAGE(PG8_SA(1, 0), a3, voffA);
            PG8_WAIT_V(8); PG8_WAIT_L(0); PG8_BAR; PG8_MMA(1, 0, At, B0); PG8_MMA(1, 1, At, B1); PG8_BAR; PG8_SCHED;
        }
        if (wr == 0) PG8_BAR;
        E(acc, cur, wr, wc, fr, fq);
        if (!has_next) break;
#pragma unroll
        for (int a = 0; a < 2; ++a)
#pragma unroll
            for (int b = 0; b < 2; ++b)
#pragma unroll
                for (int m = 0; m < 4; ++m)
#pragma unroll
                    for (int n = 0; n < 2; ++n) acc[a][b][m][n] = (f32x4){0.f, 0.f, 0.f, 0.f};
        cur = nxt; cA = nA; cB = nB; ++ui;
        if (wr == 1) PG8_BAR;
    }
    PG8_WAIT_V(0);
    PG8_BAR;
#undef PG8_SA
#undef PG8_SB
#undef PG8_STAGE
#undef PG8_LDA
#undef PG8_LDB
#undef PG8_MMA
#undef PG8_WAIT_V
#undef PG8_WAIT_L
#undef PG8_BAR
#undef PG8_SCHED
}
}
using pg8::Unit;
typedef f32x4 AccT[2][2][4][2];

__device__ __forceinline__ u32x4 pack8(f32x4 a, f32x4 b) { u32x4 w; w.x = cvt_pk_bf16(a[0], a[1]); w.y = cvt_pk_bf16(a[2], a[3]); w.z = cvt_pk_bf16(b[0], b[1]); w.w = cvt_pk_bf16(b[2], b[3]); return w; }

struct EpiSwiglu {
    static constexpr bool PERM = true;
    bf16_t* mid; const float* slotsH; bf16_t* cbuf; float* slotsC; bf16_t* krope; const float* cosT; const float* sinT;
    __device__ __forceinline__ void operator()(const AccT& acc, const Unit& u, int wr, int wc, int fr, int fq) const {
        const int row0 = u.pm * 256 + wr * 64 + fr;
        if (u.pn < 22) {
#pragma unroll
            for (int ai = 0; ai < 2; ++ai)
#pragma unroll
                for (int m = 0; m < 4; ++m) {
                    const int row = row0 + ai * 128 + m * 16; const float rs = rstd_slots16(slotsH, row);
                    f32x4 o[2];
#pragma unroll
                    for (int n = 0; n < 2; ++n)
#pragma unroll
                        for (int i = 0; i < 4; ++i) { const float gt = acc[ai][0][m][n][i] * rs, up = acc[ai][1][m][n][i] * rs; o[n][i] = gt * fsigmoid(gt) * up; }
                    *(u32x4*)(mid + (size_t)row * FF + u.pn * 128 + wc * 32 + fq * 8) = pack8(o[0], o[1]);
                }
        } else if (u.pn == 22) {
#pragma unroll
            for (int ai = 0; ai < 2; ++ai)
#pragma unroll
                for (int m = 0; m < 4; ++m) {
                    const int row = row0 + ai * 128 + m * 16; const float rs = rstd_slots16(slotsH, row);
                    float ss = 0.f;
#pragma unroll
                    for (int bj = 0; bj < 2; ++bj) { const f32x4 a = acc[ai][bj][m][0] * rs, b = acc[ai][bj][m][1] * rs;
                        ss += (a[0] * a[0] + a[1] * a[1]) + (a[2] * a[2] + a[3] * a[3]) + (b[0] * b[0] + b[1] * b[1]) + (b[2] * b[2] + b[3] * b[3]);
                        *(u32x4*)(cbuf + (size_t)row * 256 + bj * 128 + wc * 32 + fq * 8) = pack8(a, b); }
                    ss += __shfl_xor(ss, 16); ss += __shfl_xor(ss, 32);
                    if (fq == 0) slotsC[(size_t)row * 4 + wc] = ss;
                }
        } else if (wc == 0) {
#pragma unroll
            for (int ai = 0; ai < 2; ++ai)
#pragma unroll
                for (int m = 0; m < 4; ++m) {
                    const int row = row0 + ai * 128 + m * 16; const float rs = rstd_slots16(slotsH, row);
                    f32x4 o1[2], o2[2];
#pragma unroll
                    for (int n = 0; n < 2; ++n) { const f32x4 c = *(const f32x4*)(cosT + (size_t)row * 32 + fq * 8 + n * 4), s = *(const f32x4*)(sinT + (size_t)row * 32 + fq * 8 + n * 4);
                        const f32x4 x1 = acc[ai][0][m][n] * rs, x2 = acc[ai][1][m][n] * rs; o1[n] = x1 * c - x2 * s; o2[n] = x2 * c + x1 * s; }
                    *(u32x4*)(krope + (size_t)row * 64 + fq * 8) = pack8(o1[0], o1[1]);
                    *(u32x4*)(krope + (size_t)row * 64 + 32 + fq * 8) = pack8(o2[0], o2[1]);
                }
        }
    }
};
struct EpiResid {
    static constexpr bool PERM = false;
    const float* hin; float* hout; bf16_t* hb; float* slots; float alpha;
    __device__ __forceinline__ void operator()(const AccT& acc, const Unit& u, int wr, int wc, int fr, int fq) const {
        const int row0 = u.pm * 256 + wr * 64 + fr, col0 = u.pn * 256 + wc * 32 + 4 * fq;
#pragma unroll
        for (int ai = 0; ai < 2; ++ai)
#pragma unroll
            for (int m = 0; m < 4; ++m) {
                const int row = row0 + ai * 128 + m * 16; const size_t off = (size_t)row * D + col0; float ss = 0.f;
#pragma unroll
                for (int bj = 0; bj < 2; ++bj)
#pragma unroll
                    for (int n = 0; n < 2; ++n) { const size_t o2 = off + bj * 128 + n * 16; const f32x4 b = *(const f32x4*)(hin + o2); const f32x4 o = b + acc[ai][bj][m][n] * alpha;
                        *(f32x4*)(hout + o2) = o; ss += (o[0] * o[0] + o[1] * o[1]) + (o[2] * o[2] + o[3] * o[3]);
                        if (hb) { u32x2 w; w.x = cvt_pk_bf16(o[0], o[1]); w.y = cvt_pk_bf16(o[2], o[3]); *(u32x2*)(hb + o2) = w; } }
                if (slots) { ss += __shfl_xor(ss, 16); ss += __shfl_xor(ss, 32); if (fq == 0) slots[(size_t)row * 16 + u.pn * 4 + wc] = ss; }
                if (m & 1) asm volatile("" ::: "memory");
            }
    }
};
struct EpiBf16 {
    static constexpr bool PERM = true;
    bf16_t* O; int ldc;
    __device__ __forceinline__ void operator()(const AccT& acc, const Unit& u, int wr, int wc, int fr, int fq) const {
        const int row0 = u.pm * 256 + wr * 64 + fr, col0 = u.pn * 256 + wc * 32 + 8 * fq;
#pragma unroll
        for (int ai = 0; ai < 2; ++ai)
#pragma unroll
            for (int m = 0; m < 4; ++m) { bf16_t* rp = O + (size_t)(row0 + ai * 128 + m * 16) * ldc + col0;
#pragma unroll
                for (int bj = 0; bj < 2; ++bj) *(u32x4*)(rp + bj * 128) = pack8(acc[ai][bj][m][0], acc[ai][bj][m][1]); }
    }
};
struct EpiLoraDown {
    static constexpr bool PERM = true;
    bf16_t* O;
    __device__ __forceinline__ void operator()(const AccT& acc, const Unit& u, int wr, int wc, int fr, int fq) const {
        const int row0 = u.pm * 256 + wr * 64 + fr, col0 = wc * 32 + 8 * fq;
#pragma unroll
        for (int ai = 0; ai < 2; ++ai)
#pragma unroll
            for (int m = 0; m < 4; ++m) { bf16_t* rp = O + (size_t)(row0 + ai * 128 + m * 16) * 256 + col0;
                f32x4 a = acc[ai][0][m][0], b = acc[ai][0][m][1];
                if (wc < 2) {
#pragma unroll
                    for (int i = 0; i < 4; ++i) { a[i] = ftanh(a[i]); b[i] = ftanh(b[i]); } }
                *(u32x4*)(rp) = pack8(a, b);
                a = acc[ai][1][m][0]; b = acc[ai][1][m][1];
#pragma unroll
                for (int i = 0; i < 4; ++i) { a[i] = fsigmoid(a[i]); b[i] = fsigmoid(b[i]); }
                *(u32x4*)(rp + 128) = pack8(a, b); }
    }
};
struct EpiRL {
    static constexpr bool PERM = true;
    bf16_t* R; bf16_t* O;
    __device__ __forceinline__ void operator()(const AccT& acc, const Unit& u, int wr, int wc, int fr, int fq) const {
        const int row0 = u.pm * 256 + wr * 64 + fr;
        if (u.pn < 4) {
            const int col0 = u.pn * 256 + wc * 32 + 8 * fq;
#pragma unroll
            for (int ai = 0; ai < 2; ++ai)
#pragma unroll
                for (int m = 0; m < 4; ++m) { bf16_t* rp = R + (size_t)(row0 + ai * 128 + m * 16) * D + col0;
#pragma unroll
                    for (int bj = 0; bj < 2; ++bj) *(u32x4*)(rp + bj * 128) = pack8(acc[ai][bj][m][0], acc[ai][bj][m][1]); }
        } else {
            const int col0 = wc * 32 + 8 * fq;
#pragma unroll
            for (int ai = 0; ai < 2; ++ai)
#pragma unroll
                for (int m = 0; m < 4; ++m) { bf16_t* rp = O + (size_t)(row0 + ai * 128 + m * 16) * 256 + col0;
                    f32x4 a = acc[ai][0][m][0], b = acc[ai][0][m][1];
                    if (wc < 2) {
#pragma unroll
                        for (int i = 0; i < 4; ++i) { a[i] = ftanh(a[i]); b[i] = ftanh(b[i]); } }
                    *(u32x4*)(rp) = pack8(a, b);
                    a = acc[ai][1][m][0]; b = acc[ai][1][m][1];
#pragma unroll
                    for (int i = 0; i < 4; ++i) { a[i] = fsigmoid(a[i]); b[i] = fsigmoid(b[i]); }
                    *(u32x4*)(rp + 128) = pack8(a, b); }
        }
    }
};
struct EpiLoraUp {
    static constexpr bool PERM = true;
    unsigned char* wsb; const float* w0; const float* a0; int grp0; size_t goff;
    __device__ __forceinline__ void operator()(const AccT& acc, const Unit& u, int wr, int wc, int fr, int fq) const {
        const int grp = (u.pn >> 2) + grp0, colt = (u.pn & 3) * 256;
        const int row0 = u.pm * 256 + wr * 64 + fr, col0 = colt + wc * 32 + 8 * fq;
        size_t ooff = goff; if (grp == 0) ooff = A_E; if (grp == 1) ooff = A_AA;
        bf16_t* O = (bf16_t*)(wsb + ooff); const float* bias = grp == 0 ? w0 : a0;
#pragma unroll
        for (int ai = 0; ai < 2; ++ai)
#pragma unroll
            for (int m = 0; m < 4; ++m) { bf16_t* rp = O + (size_t)(row0 + ai * 128 + m * 16) * D + col0;
#pragma unroll
                for (int bj = 0; bj < 2; ++bj) { f32x4 a = acc[ai][bj][m][0], b = acc[ai][bj][m][1];
                    if (grp < 2) { const float sc = grp == 0 ? 0.6065306597126334f : 1.0f;
                        const f32x4 b0 = *(const f32x4*)(bias + col0 + bj * 128), b1 = *(const f32x4*)(bias + col0 + bj * 128 + 4);
                        a = a + b0; b = b + b1;
#pragma unroll
                        for (int i = 0; i < 4; ++i) { a[i] = sc * fsigmoid(a[i]); b[i] = sc * fsigmoid(b[i]); } }
                    *(u32x4*)(rp + bj * 128) = pack8(a, b); }
                asm volatile("" ::: "memory"); }
    }
};
struct EpiQlat {
    static constexpr bool PERM = true;
    bf16_t* O; const float* slotsH; float* slotsQ;
    __device__ __forceinline__ void operator()(const AccT& acc, const Unit& u, int wr, int wc, int fr, int fq) const {
        const int row0 = u.pm * 256 + wr * 64 + fr, col0 = u.pn * 256 + wc * 32 + 8 * fq;
#pragma unroll
        for (int ai = 0; ai < 2; ++ai)
#pragma unroll
            for (int m = 0; m < 4; ++m) { const int row = row0 + ai * 128 + m * 16; const float rs = rstd_slots16(slotsH, row); float ss = 0.f;
#pragma unroll
                for (int bj = 0; bj < 2; ++bj) { const f32x4 a = acc[ai][bj][m][0] * rs, b = acc[ai][bj][m][1] * rs;
                    ss += (a[0] * a[0] + a[1] * a[1]) + (a[2] * a[2] + a[3] * a[3]) + (b[0] * b[0] + b[1] * b[1]) + (b[2] * b[2] + b[3] * b[3]);
                    *(u32x4*)(O + (size_t)row * 512 + col0 + bj * 128) = pack8(a, b); }
                ss += __shfl_xor(ss, 16); ss += __shfl_xor(ss, 32);
                if (fq == 0) slotsQ[(size_t)row * 8 + u.pn * 4 + wc] = ss; }
    }
};
struct EpiQ {
    static constexpr bool PERM = true;
    bf16_t* qn; bf16_t* qr; const float* slotsQ; const float* cosT; const float* sinT;
    __device__ __forceinline__ void operator()(const AccT& acc, const Unit& u, int wr, int wc, int fr, int fq) const {
        const int row0 = u.pm * 256 + wr * 64 + fr;
#pragma unroll
        for (int ai = 0; ai < 2; ++ai)
#pragma unroll
            for (int m = 0; m < 4; ++m) { const int row = row0 + ai * 128 + m * 16;
                const f32x4 s0 = *(const f32x4*)(slotsQ + (size_t)row * 8), s1 = *(const f32x4*)(slotsQ + (size_t)row * 8 + 4);
                const float rs = __builtin_amdgcn_rsqf((sum4(s0) + sum4(s1)) * (1.0f / 512.0f) + RMS_EPS) * QSCALE;
                if (u.pn < 4) {
#pragma unroll
                    for (int bj = 0; bj < 2; ++bj) *(u32x4*)(qn + (size_t)row * D + u.pn * 256 + bj * 128 + wc * 32 + fq * 8) = pack8(acc[ai][bj][m][0] * rs, acc[ai][bj][m][1] * rs);
                } else {
                    const int head = 4 * (u.pn - 4) + wc; f32x4 o1[2], o2[2];
#pragma unroll
                    for (int n = 0; n < 2; ++n) { const f32x4 c = *(const f32x4*)(cosT + (size_t)row * 32 + fq * 8 + n * 4), s = *(const f32x4*)(sinT + (size_t)row * 32 + fq * 8 + n * 4);
                        const f32x4 x1 = acc[ai][0][m][n] * rs, x2 = acc[ai][1][m][n] * rs; o1[n] = x1 * c - x2 * s; o2[n] = x2 * c + x1 * s; }
                    *(u32x4*)(qr + (size_t)row * 512 + head * 64 + fq * 8) = pack8(o1[0], o1[1]);
                    *(u32x4*)(qr + (size_t)row * 512 + head * 64 + 32 + fq * 8) = pack8(o2[0], o2[1]);
                } }
    }
};
struct EpiKnope {
    static constexpr bool PERM = true;
    bf16_t* O; const float* slotsC;
    __device__ __forceinline__ void operator()(const AccT& acc, const Unit& u, int wr, int wc, int fr, int fq) const {
        const int row0 = u.pm * 256 + wr * 64 + fr, col0 = u.pn * 256 + wc * 32 + 8 * fq;
#pragma unroll
        for (int ai = 0; ai < 2; ++ai)
#pragma unroll
            for (int m = 0; m < 4; ++m) { const int row = row0 + ai * 128 + m * 16; const f32x4 s = *(const f32x4*)(slotsC + (size_t)row * 4);
                const float rs = __builtin_amdgcn_rsqf(sum4(s) * (1.0f / 256.0f) + RMS_EPS);
#pragma unroll
                for (int bj = 0; bj < 2; ++bj) *(u32x4*)(O + (size_t)row * D + col0 + bj * 128) = pack8(acc[ai][bj][m][0] * rs, acc[ai][bj][m][1] * rs); }
    }
};
struct EpiVt {
    static constexpr bool PERM = true;
    bf16_t* O; const float* slotsC;
    __device__ __forceinline__ void operator()(const AccT& acc, const Unit& u, int wr, int wc, int fr, int fq) const {
        const int row0 = u.pm * 256 + wr * 64 + fr, col0 = u.pn * 256 + wc * 32 + 8 * fq;
        f32x4 rs[2][2];
#pragma unroll
        for (int bj = 0; bj < 2; ++bj)
#pragma unroll
            for (int n = 0; n < 2; ++n)
#pragma unroll
                for (int i = 0; i < 4; ++i) { const f32x4 s = *(const f32x4*)(slotsC + (size_t)(col0 + bj * 128 + n * 4 + i) * 4); rs[bj][n][i] = __builtin_amdgcn_rsqf(sum4(s) * (1.0f / 256.0f) + RMS_EPS); }
#pragma unroll
        for (int ai = 0; ai < 2; ++ai)
#pragma unroll
            for (int m = 0; m < 4; ++m) { const int row = row0 + ai * 128 + m * 16;
#pragma unroll
                for (int bj = 0; bj < 2; ++bj) *(u32x4*)(O + (size_t)row * T + col0 + bj * 128) = pack8(acc[ai][bj][m][0] * rs[bj][0], acc[ai][bj][m][1] * rs[bj][1]); }
    }
};

struct Args { const float* in[33]; const int* pos; float* out; unsigned char* ws; int ph_lo, ph_hi; };

struct Ctx { LAS unsigned char* lds; int vcu, G, wave; };

__device__ __forceinline__ void tr_item(const float* W, int ldw, int k0, int n0, const float* s1, const float* s2, int ks0, bf16_t* Bt, int ldb, int nd0, int kd0, LAS float* scr, int lane) {
    f32x4 v[8];
#pragma unroll
    for (int i = 0; i < 8; ++i) v[i] = *(const f32x4*)(W + (size_t)(k0 + 8 * i + (lane >> 3)) * ldw + n0 + 4 * (lane & 7));
#pragma unroll
    for (int i = 0; i < 8; ++i) { const int kk = 8 * i + (lane >> 3);
        float sc = s1 ? s1[ks0 + kk] : 1.0f; if (s2) sc -= s2[ks0 + kk];
        LAS float* d = scr + kk * 33 + 4 * (lane & 7);
        d[0] = sc * v[i][0]; d[1] = sc * v[i][1]; d[2] = sc * v[i][2]; d[3] = sc * v[i][3]; }
    asm volatile("s_waitcnt lgkmcnt(0)" ::: "memory");
    const int c = lane & 7;
#pragma unroll
    for (int j = 0; j < 4; ++j) { const int n = (lane >> 3) + 8 * j; const LAS float* s = scr + (8 * c) * 33 + n;
        u32x4 o; o.x = cvt_pk_bf16(s[0 * 33], s[1 * 33]); o.y = cvt_pk_bf16(s[2 * 33], s[3 * 33]); o.z = cvt_pk_bf16(s[4 * 33], s[5 * 33]); o.w = cvt_pk_bf16(s[6 * 33], s[7 * 33]);
        *(u32x4*)(Bt + (size_t)(nd0 + n) * ldb + kd0 + 8 * c) = o; }
    asm volatile("s_waitcnt lgkmcnt(0)" ::: "memory");
}
__device__ __forceinline__ void zero_item(bf16_t* Bt, int ldb, int nd0, int kd0, int lane) {
    const int c = lane & 7;
#pragma unroll
    for (int j = 0; j < 4; ++j) { const int n = (lane >> 3) + 8 * j; *(u32x4*)(Bt + (size_t)(nd0 + n) * ldb + kd0 + 8 * c) = (u32x4){0u, 0u, 0u, 0u}; }
}

constexpr int I_UG = 16 * 176, I_UGX = 16 * 16, I_DN = 44 * 32, I_SQ = 16 * 32, I_LD = 32 * 8, I_LU = 4 * 96, I_KN = 4 * 32, I_DQ = 16 * 16, I_UQ = 8 * 48;
constexpr int NITEMS = 4 * I_UG + I_UGX + 4 * I_DN + 4 * I_SQ + I_LD + I_LU + 2 * I_KN + I_DQ + I_UQ + I_SQ;
__device__ __forceinline__ void p0_item(const Args& a, int it, int mode, LAS float* scr, int lane) {
    unsigned char* ws = a.ws; const float* norm_g = a.in[2];
    int r = it;
        if (r < 4 * I_UG) { const int q = r / I_UG; r -= q * I_UG; if ((q >= 1) != (mode == 1)) return; const int l = q >> 1, s = q & 1; const int kb = r / 176, nb = r % 176, pn = nb >> 3, jb = nb & 7;
            const float* src = (jb < 4 ? a.in[3] : a.in[4]) + (size_t)q * D * FF;
            tr_item(src, FF, 64 * kb, 128 * pn + 32 * (jb & 3), norm_g + (l * 3 + (s ? 2 : 0)) * D, nullptr, 64 * kb, (bf16_t*)(ws + W_UG) + (size_t)q * 6144 * D, D, 32 * nb, 64 * kb, scr, lane); return; }
        r -= 4 * I_UG;
        if (r < I_UGX) { if (mode != 1) return; const int kb = r / 16, nb = r % 16; bf16_t* Bt = (bf16_t*)(ws + W_UG) + (size_t)2 * 6144 * D;
            int sc = -1; if (nb < 8) sc = 32 * nb; else if (nb == 8) sc = 256; else if (nb == 12) sc = 288;
            if (sc >= 0) tr_item(a.in[25], 320, 64 * kb, sc, a.in[24], nullptr, 64 * kb, Bt, D, 5632 + 32 * nb, 64 * kb, scr, lane); else zero_item(Bt, D, 5632 + 32 * nb, 64 * kb, lane); return; }
        r -= I_UGX;
        if (r < 4 * I_DN) { const int q = r / I_DN; r -= q * I_DN; if ((q >= 1) != (mode == 1)) return; const int kb = r / 32, nb = r % 32;
            tr_item(a.in[5] + (size_t)q * FF * D, D, 64 * kb, 32 * nb, nullptr, nullptr, 0, (bf16_t*)(ws + W_DN) + (size_t)q * D * FF, FF, 32 * nb, 64 * kb, scr, lane); return; }
        r -= 4 * I_DN;
        if (r < 4 * I_SQ) { const int q = r / I_SQ; r -= q * I_SQ; if ((q == 3) != (mode == 1)) return; const int kb = r / 32, nb = r % 32;
            if (q == 0) { tr_item(a.in[7], D, 64 * kb, 32 * nb, nullptr, nullptr, 0, (bf16_t*)(ws + W_RL), 2048, 32 * nb, 64 * kb, scr, lane); zero_item((bf16_t*)(ws + W_RL), 2048, 32 * nb, 1024 + 64 * kb, lane); }
            else tr_item(a.in[7 + q], D, 64 * kb, 32 * nb, nullptr, nullptr, 0, (bf16_t*)(ws + W_R + (size_t)q * 2 * MiB), D, 32 * nb, 64 * kb, scr, lane);
            return; }
        r -= 4 * I_SQ;
        if (r < I_LD) { if (mode != 0) return; const int kb = r / 8, nb = r % 8; const int kk0 = 64 * (kb & 15); const bool second = kb >= 16;
            const float* src; int ldw, nc, mi; if (nb < 2) { src = a.in[12]; ldw = 64; nc = 32 * nb; mi = 1; } else if (nb < 4) { src = a.in[15]; ldw = 64; nc = 32 * (nb - 2); mi = 4; } else { src = a.in[17]; ldw = 128; nc = 32 * (nb - 4); mi = 5; }
            tr_item(src, ldw, kk0, nc, second ? a.in[6] + mi * D : nullptr, second ? a.in[6] : nullptr, kk0, (bf16_t*)(ws + W_RL), 2048, 1024 + 32 * nb, 64 * kb, scr, lane); return; }
        r -= I_LD;
        if (r < I_LU) { if (mode != 0) return; const int kb = r / 96, nb = r % 96; const int grp = nb / 32, nc = 32 * (nb % 32); bf16_t* Bt = (bf16_t*)(ws + W_LU);
            if (grp == 0) { if (kb == 0) tr_item(a.in[13], D, 0, nc, nullptr, nullptr, 0, Bt, 256, 32 * nb, 0, scr, lane); else zero_item(Bt, 256, 32 * nb, 64 * kb, lane); }
            else if (grp == 1) { if (kb == 1) tr_item(a.in[16], D, 0, nc, nullptr, nullptr, 0, Bt, 256, 32 * nb, 64, scr, lane); else zero_item(Bt, 256, 32 * nb, 64 * kb, lane); }
            else { if (kb >= 2) tr_item(a.in[18], D, 64 * (kb - 2), nc, nullptr, nullptr, 0, Bt, 256, 32 * nb, 64 * kb, scr, lane); else zero_item(Bt, 256, 32 * nb, 64 * kb, lane); }
            return; }
        r -= I_LU;
        if (r < 2 * I_KN) { if (mode != 1) return; const int q = r / I_KN; r -= q * I_KN; const int kb = r / 32, nb = r % 32;
            const int n0 = 32 * nb, sc = (n0 >> 7) * 256 + (n0 & 127) + q * 128;
            tr_item(a.in[27], 2048, 64 * kb, sc, a.in[26], nullptr, 64 * kb, (bf16_t*)(ws + (q ? W_VT : W_KN)), 256, n0, 64 * kb, scr, lane); return; }
        r -= 2 * I_KN;
        if (r < I_DQ) { if (mode != 1) return; const int kb = r / 16, nb = r % 16;
            tr_item(a.in[28], 512, 64 * kb, 32 * nb, norm_g + (1 * 3 + 1) * D, nullptr, 64 * kb, (bf16_t*)(ws + W_DQ), D, 32 * nb, 64 * kb, scr, lane); return; }
        r -= I_DQ;
        if (r < I_UQ) { if (mode != 1) return; const int kb = r / 48, nb = r % 48; int sc;
            if (nb < 32) { const int n0 = 32 * nb; sc = (n0 >> 7) * 192 + (n0 & 127); }
            else { const int t2 = (nb - 32) >> 3, jj = (nb - 32) & 7, half = jj >> 2, hh = jj & 3; sc = (4 * t2 + hh) * 192 + 128 + 32 * half; }
            tr_item(a.in[30], 1536, 64 * kb, sc, a.in[29], nullptr, 64 * kb, (bf16_t*)(ws + W_UQ), 512, 32 * nb, 64 * kb, scr, lane); return; }
        r -= I_UQ;
        { if (mode != 1) return; const int kb = r / 32, nb = r % 32; tr_item(a.in[31], D, 64 * kb, 32 * nb, nullptr, nullptr, 0, (bf16_t*)(ws + W_MO), D, 32 * nb, 64 * kb, scr, lane); }
}
__device__ __forceinline__ void p0_prologue(const Ctx& F, const Args& a) {
    unsigned char* ws = a.ws;
    const int tid = fresh_tid(F.wave), lane = tid & 63, wave = __builtin_amdgcn_readfirstlane(tid >> 6);
    LAS float* scr = (LAS float*)(F.lds + wave * 16384);
    const int gw = F.vcu * 8 + wave, NGW = F.G * 8;
    const float* norm_g = a.in[2];
    for (int it = gw; it < NITEMS; it += NGW) p0_item(a, it, 0, scr, lane);
    const float* x = a.in[0]; bf16_t* hb = (bf16_t*)(ws + A_HB); float* slotsH = (float*)(ws + WS_SLOTH);
    for (int m = gw; m < T; m += NGW) {
        const f32x4* xr = (const f32x4*)(x + (size_t)m * D) + lane; float ss = 0.f;
#pragma unroll
        for (int j = 0; j < 4; ++j) { const f32x4 v = xr[64 * j]; ss += (v[0] * v[0] + v[1] * v[1]) + (v[2] * v[2] + v[3] * v[3]);
            u32x2 w; w.x = cvt_pk_bf16(v[0], v[1]); w.y = cvt_pk_bf16(v[2], v[3]); *((u32x2*)(hb + (size_t)m * D) + lane + 64 * j) = w; }
        ss = wave_sum(ss);
        if (lane < 16) slotsH[(size_t)m * 16 + lane] = lane == 0 ? ss : 0.f;
    }
    float* cosT = (float*)(ws + A_COS); float* sinT = (float*)(ws + A_SIN);
    for (int i = (F.vcu * 512 + tid); i < T * 32; i += F.G * 512) {
        const int tok = i >> 5, j = i & 31;
        const float inv = exp2f(-(float)j * (13.287712379549449f / 32.0f));
        const float ang = (float)a.pos[tok] * inv;
        const double rev = (double)ang * 0.15915494309189535; const float fr = (float)(rev - floor(rev));
        cosT[i] = __builtin_amdgcn_cosf(fr); sinT[i] = __builtin_amdgcn_sinf(fr);
    }
}

__device__ __forceinline__ void p_premix(const Ctx& F, const Args& a) {
    const float* h = a.out; const float* g = a.in[2] + 1 * D; const float* mix = a.in[6];
    bf16_t* X1 = (bf16_t*)(a.ws + A_X1); bf16_t* XK = (bf16_t*)(a.ws + A_XK); bf16_t* XV = (bf16_t*)(a.ws + A_XV);
    const int tid = fresh_tid(F.wave), lane = tid & 63, wave = __builtin_amdgcn_readfirstlane(tid >> 6);
    const int gw = F.vcu * 8 + wave, NGW = F.G * 8;
    for (int ch = gw; ch < T / 16; ch += NGW) {
        const int t0 = ch * 16;
        f32x4 prev[4], gv[4];
#pragma unroll
        for (int j = 0; j < 4; ++j) gv[j] = *((const f32x4*)g + lane + 64 * j);
        if ((t0 & (SEQ - 1)) == 0) {
#pragma unroll
            for (int j = 0; j < 4; ++j) prev[j] = (f32x4){0.f, 0.f, 0.f, 0.f};
        } else {
            float ss = 0.f;
#pragma unroll
            for (int j = 0; j < 4; ++j) { prev[j] = *((const f32x4*)(h + (size_t)(t0 - 1) * D) + lane + 64 * j); ss += (prev[j][0] * prev[j][0] + prev[j][1] * prev[j][1]) + (prev[j][2] * prev[j][2] + prev[j][3] * prev[j][3]); }
            const float rs = __builtin_amdgcn_rsqf(wave_sum(ss) * (1.0f / 1024.0f) + RMS_EPS);
#pragma unroll
            for (int j = 0; j < 4; ++j) prev[j] = prev[j] * rs * gv[j];
        }
        for (int t = t0; t < t0 + 16; ++t) {
            f32x4 cur[4]; float ss = 0.f;
#pragma unroll
            for (int j = 0; j < 4; ++j) { cur[j] = *((const f32x4*)(h + (size_t)t * D) + lane + 64 * j); ss += (cur[j][0] * cur[j][0] + cur[j][1] * cur[j][1]) + (cur[j][2] * cur[j][2] + cur[j][3] * cur[j][3]); }
            const float rs = __builtin_amdgcn_rsqf(wave_sum(ss) * (1.0f / 1024.0f) + RMS_EPS);
#pragma unroll
            for (int j = 0; j < 4; ++j) {
                const f32x4 hn = cur[j] * rs * gv[j]; const f32x4 xx = prev[j] - hn; prev[j] = hn;
                const f32x4 mr = *((const f32x4*)(mix + 0 * D) + lane + 64 * j), mk = *((const f32x4*)(mix + 2 * D) + lane + 64 * j), mv = *((const f32x4*)(mix + 3 * D) + lane + 64 * j);
                const f32x4 xr = hn + xx * mr, xk = hn + xx * mk, xv = hn + xx * mv;
                u32x2 w;
                w.x = cvt_pk_bf16(xr[0], xr[1]); w.y = cvt_pk_bf16(xr[2], xr[3]); *((u32x2*)(X1 + (size_t)t * 2048) + lane + 64 * j) = w;
                w.x = cvt_pk_bf16(xx[0], xx[1]); w.y = cvt_pk_bf16(xx[2], xx[3]); *((u32x2*)(X1 + (size_t)t * 2048 + 1024) + lane + 64 * j) = w;
                w.x = cvt_pk_bf16(xk[0], xk[1]); w.y = cvt_pk_bf16(xk[2], xk[3]); *((u32x2*)(XK + (size_t)t * D) + lane + 64 * j) = w;
                w.x = cvt_pk_bf16(xv[0], xv[1]); w.y = cvt_pk_bf16(xv[2], xv[3]); *((u32x2*)(XV + (size_t)t * D) + lane + 64 * j) = w;
            }
        }
    }
}

constexpr int TC = 32;
__device__ __forceinline__ void p_scan(const Ctx& F, const Args& a) {
    const bf16_t* Rb = (const bf16_t*)(a.ws + A_R); const bf16_t* Kb = (const bf16_t*)(a.ws + A_KK); const bf16_t* Vb = (const bf16_t*)(a.ws + A_VV);
    const bf16_t* Eb = (const bf16_t*)(a.ws + A_E); const bf16_t* Ab = (const bf16_t*)(a.ws + A_AA); bf16_t* Gb = (bf16_t*)(a.ws + A_G);
    const float* k_k = a.in[19]; const float* k_a = a.in[20]; const float* r_k = a.in[21]; const float* gn_w = a.in[22]; const float* gn_b = a.in[23];
    LAS float* sR = (LAS float*)(F.lds); LAS float* sW = sR + TC * 64; LAS float* sK = sW + TC * 64; LAS float* sV = sK + TC * 64;
    LAS float* sKK = sV + TC * 64; LAS float* sKA = sKK + TC * 64; LAS float* sY = sKA + TC * 64; LAS float* sBo = sY + TC * 64;
    const int tid = fresh_tid(F.wave), lane = tid & 63, wave = __builtin_amdgcn_readfirstlane(tid >> 6);
    const int irow = wave * 8 + (lane >> 3), kseg = (lane & 7) * 8;
    const int ptt = tid >> 4, pc = (tid & 15) * 4;
    for (int unit0 = F.vcu; unit0 < 2 * NB * 16; unit0 += F.G) {
        const int unit = unit0 & 127; const bool shadow = unit0 >= 128;
        const int b = unit >> 4, hd = unit & 15; const int cbase = hd * 64;
        float S[8];
#pragma unroll
        for (int j = 0; j < 8; ++j) S[j] = 0.f;
        const f32x4 kkv = *(const f32x4*)(k_k + cbase + pc), kav = *(const f32x4*)(k_a + cbase + pc), rkv = *(const f32x4*)(r_k + cbase + pc);
        const f32x4 gw = *(const f32x4*)(gn_w + cbase + pc), gb = *(const f32x4*)(gn_b + cbase + pc);
        for (int c0 = 0; c0 < SEQ; c0 += TC) {
            const size_t gidx = (size_t)(b * SEQ + c0 + ptt) * D + cbase + pc;
            {
                const f32x4 r = unpack4(*(const u32x2*)(Rb + gidx)), k = unpack4(*(const u32x2*)(Kb + gidx)), v = unpack4(*(const u32x2*)(Vb + gidx));
                const f32x4 e = unpack4(*(const u32x2*)(Eb + gidx)), aa = unpack4(*(const u32x2*)(Ab + gidx));
                f32x4 kk = k * kkv; float ss = (kk[0] * kk[0] + kk[1] * kk[1]) + (kk[2] * kk[2] + kk[3] * kk[3]); ss = red16(ss);
                kk = kk * __builtin_amdgcn_rsqf(fmaxf(ss, 1e-24f));
                const f32x4 kp = k * (1.0f + (aa - 1.0f) * kav);
                const f32x4 rk = r * kp * rkv; const float bo = red16((rk[0] + rk[1]) + (rk[2] + rk[3]));
                f32x4 w;
#pragma unroll
                for (int i = 0; i < 4; ++i) w[i] = __builtin_amdgcn_exp2f(-e[i] * LOG2E);
                const int o = ptt * 64 + pc;
                *(LAS f32x4*)(sR + o) = r; *(LAS f32x4*)(sW + o) = w; *(LAS f32x4*)(sK + o) = kp; *(LAS f32x4*)(sV + o) = v; *(LAS f32x4*)(sKK + o) = kk; *(LAS f32x4*)(sKA + o) = kk * aa;
                if ((tid & 15) == 0) sBo[ptt] = bo;
            }
            __syncthreads();
#pragma unroll 2
            for (int t = 0; t < TC; ++t) {
                const int o = t * 64 + kseg;
                const f32x4 kk0 = *(const LAS f32x4*)(sKK + o), kk1 = *(const LAS f32x4*)(sKK + o + 4);
                const f32x4 w0 = *(const LAS f32x4*)(sW + o), w1 = *(const LAS f32x4*)(sW + o + 4);
                const f32x4 ka0 = *(const LAS f32x4*)(sKA + o), ka1 = *(const LAS f32x4*)(sKA + o + 4);
                const f32x4 kp0 = *(const LAS f32x4*)(sK + o), kp1 = *(const LAS f32x4*)(sK + o + 4);
                const f32x4 r0 = *(const LAS f32x4*)(sR + o), r1 = *(const LAS f32x4*)(sR + o + 4);
                const float vv = sV[t * 64 + irow];
                float sa = ((S[0] * kk0[0] + S[1] * kk0[1]) + (S[2] * kk0[2] + S[3] * kk0[3])) + ((S[4] * kk1[0] + S[5] * kk1[1]) + (S[6] * kk1[2] + S[7] * kk1[3]));
                sa = red8(sa);
#pragma unroll
                for (int j = 0; j < 4; ++j) { S[j] = S[j] * w0[j] + (vv * kp0[j] - sa * ka0[j]); S[4 + j] = S[4 + j] * w1[j] + (vv * kp1[j] - sa * ka1[j]); }
                float y = ((S[0] * r0[0] + S[1] * r0[1]) + (S[2] * r0[2] + S[3] * r0[3])) + ((S[4] * r1[0] + S[5] * r1[1]) + (S[6] * r1[2] + S[7] * r1[3]));
                y = red8(y);
                if ((lane & 7) == 0) sY[t * 64 + irow] = y;
            }
            __syncthreads();
            {
                const int o = ptt * 64 + pc;
                const f32x4 y = *(const LAS f32x4*)(sY + o), v = *(const LAS f32x4*)(sV + o);
                const float mu = red16((y[0] + y[1]) + (y[2] + y[3])) * (1.0f / 64.0f);
                const f32x4 d = y - mu; const float var = red16((d[0] * d[0] + d[1] * d[1]) + (d[2] * d[2] + d[3] * d[3])) * (1.0f / 64.0f);
                const float rs = __builtin_amdgcn_rsqf(var + GN_EPS); const float bo = sBo[ptt];
                const f32x4 gg = unpack4(*(const u32x2*)(Gb + gidx));
                const f32x4 ov = (d * rs * gw + gb + v * bo) * gg;
                u32x2 w; w.x = cvt_pk_bf16(ov[0], ov[1]); w.y = cvt_pk_bf16(ov[2], ov[3]); if (!shadow) *(u32x2*)(Gb + gidx) = w;
            }
            __syncthreads();
        }
    }
}


__device__ __forceinline__ void p_scan2(const Ctx& F, const Args& a) {
    const bf16_t* Rb = (const bf16_t*)(a.ws + A_R); const bf16_t* Kb = (const bf16_t*)(a.ws + A_KK); const bf16_t* Vb = (const bf16_t*)(a.ws + A_VV);
    const bf16_t* Eb = (const bf16_t*)(a.ws + A_E); const bf16_t* Ab = (const bf16_t*)(a.ws + A_AA); bf16_t* Yb = (bf16_t*)(a.ws + A_G); float* Bon = (float*)(a.ws + A_BON);
    const float* k_k = a.in[19]; const float* k_a = a.in[20]; const float* r_k = a.in[21];
    LAS float* sR = (LAS float*)(F.lds); LAS float* sW = sR + TC * 64; LAS float* sK = sW + TC * 64; LAS float* sV = sK + TC * 64;
    LAS float* sKK = sV + TC * 64; LAS float* sKA = sKK + TC * 64; LAS float* sY = sKA + TC * 64;
    const int tid = fresh_tid(F.wave), lane = tid & 63, wave = __builtin_amdgcn_readfirstlane(tid >> 6);
    const int lrow = wave * 8 + (lane >> 3), kseg = (lane & 7) * 8;
    const int ptt = tid >> 4, pc = (tid & 15) * 4;
    for (int unit = F.vcu; unit < 2 * NB * 16; unit += F.G) {
        const int bh = unit >> 1, half = unit & 1, b = bh >> 4, hd = bh & 15, cbase = hd * 64;
        f32x4 S0 = (f32x4){0.f, 0.f, 0.f, 0.f}, S1 = (f32x4){0.f, 0.f, 0.f, 0.f};
        int hit = F.vcu * 4 + (wave & 3); LAS float* hscr = (LAS float*)(F.lds + 81920 + (wave & 3) * 8704);
        const f32x4 kkv = *(const f32x4*)(k_k + cbase + pc), kav = *(const f32x4*)(k_a + cbase + pc), rkv = *(const f32x4*)(r_k + cbase + pc);
        size_t gidx = (size_t)(b * SEQ + ptt) * D + cbase + pc;
        u32x2 qr = *(const u32x2*)(Rb + gidx), qk = *(const u32x2*)(Kb + gidx), qv = *(const u32x2*)(Vb + gidx), qe = *(const u32x2*)(Eb + gidx), qa = *(const u32x2*)(Ab + gidx);
        for (int c0 = 0; c0 < SEQ; c0 += TC) {
            {
                const f32x4 r = unpack4(qr), k = unpack4(qk), v = unpack4(qv), e = unpack4(qe), aa = unpack4(qa);
                f32x4 kk = k * kkv; float ss = (kk[0] * kk[0] + kk[1] * kk[1]) + (kk[2] * kk[2] + kk[3] * kk[3]); ss = red16(ss);
                kk = kk * __builtin_amdgcn_rsqf(fmaxf(ss, 1e-24f));
                const f32x4 kp = k * (1.0f + (aa - 1.0f) * kav);
                const f32x4 rk = r * kp * rkv; const float bo = red16((rk[0] + rk[1]) + (rk[2] + rk[3]));
                f32x4 w;
#pragma unroll
                for (int i = 0; i < 4; ++i) w[i] = __builtin_amdgcn_exp2f(-e[i] * LOG2E);
                const int o = ptt * 64 + pc;
                *(LAS f32x4*)(sR + o) = r; *(LAS f32x4*)(sW + o) = w; *(LAS f32x4*)(sK + o) = kp; *(LAS f32x4*)(sV + o) = v; *(LAS f32x4*)(sKK + o) = kk; *(LAS f32x4*)(sKA + o) = kk * aa;
                if (half == 0 && (tid & 15) == 0) Bon[(size_t)(b * SEQ + c0 + ptt) * 16 + hd] = bo;
            }
            __syncthreads();
            if (c0 + TC < SEQ) { gidx += (size_t)TC * D;
                qr = *(const u32x2*)(Rb + gidx); qk = *(const u32x2*)(Kb + gidx); qv = *(const u32x2*)(Vb + gidx); qe = *(const u32x2*)(Eb + gidx); qa = *(const u32x2*)(Ab + gidx); }
            if (wave >= 4) {
                if (hit < NITEMS) { p0_item(a, hit, 1, hscr, lane); hit += 1024; }
            }
            if (wave < 4) {
#define SCAN_LD(P, tt) { const int o_ = (tt) * 64 + kseg; \
                kk0##P = *(const LAS f32x4*)(sKK + o_); kk1##P = *(const LAS f32x4*)(sKK + o_ + 4); w0##P = *(const LAS f32x4*)(sW + o_); w1##P = *(const LAS f32x4*)(sW + o_ + 4); \
                ka0##P = *(const LAS f32x4*)(sKA + o_); ka1##P = *(const LAS f32x4*)(sKA + o_ + 4); kp0##P = *(const LAS f32x4*)(sK + o_); kp1##P = *(const LAS f32x4*)(sK + o_ + 4); \
                r0##P = *(const LAS f32x4*)(sR + o_); r1##P = *(const LAS f32x4*)(sR + o_ + 4); vv##P = sV[(tt) * 64 + half * 32 + lrow]; }
#define SCAN_STEP(P, tt) { f32x4 p4 = S0 * kk0##P; p4 = S1 * kk1##P + p4; const float sa = red8((p4[0] + p4[1]) + (p4[2] + p4[3])); \
                S0 = S0 * w0##P + (kp0##P * vv##P - ka0##P * sa); S1 = S1 * w1##P + (kp1##P * vv##P - ka1##P * sa); \
                f32x4 y4 = S0 * r0##P; y4 = S1 * r1##P + y4; sY[(tt) * 256 + tid] = (y4[0] + y4[1]) + (y4[2] + y4[3]); }
                f32x4 kk0A, kk1A, w0A, w1A, ka0A, ka1A, kp0A, kp1A, r0A, r1A; float vvA;
                f32x4 kk0B, kk1B, w0B, w1B, ka0B, ka1B, kp0B, kp1B, r0B, r1B; float vvB;
                SCAN_LD(A, 0)
#pragma unroll
                for (int t = 0; t < TC; t += 2) {
                    SCAN_LD(B, t + 1)
                    SCAN_STEP(A, t)
                    SCAN_LD(A, (t + 2 < TC) ? t + 2 : t)
                    SCAN_STEP(B, t + 1)
                }
#undef SCAN_LD
#undef SCAN_STEP
            }
            __syncthreads();
            {
                const int tok = tid >> 4, r2 = (tid & 15) * 2;
                const LAS f32x4* q = (const LAS f32x4*)(sY + tok * 256 + r2 * 8);
                const f32x4 s0 = q[0] + q[1], s1 = q[2] + q[3];
                *(unsigned*)(Yb + (size_t)(b * SEQ + c0 + tok) * D + cbase + half * 32 + r2) = cvt_pk_bf16((s0[0] + s0[1]) + (s0[2] + s0[3]), (s1[0] + s1[1]) + (s1[2] + s1[3]));
            }
        }
        if (wave >= 4) { while (hit < NITEMS) { p0_item(a, hit, 1, hscr, lane); hit += 1024; } }
        __syncthreads();
    }
}
__device__ __forceinline__ void p_post(const Ctx& F, const Args& a) {
    bf16_t* Yb = (bf16_t*)(a.ws + A_G); const bf16_t* Vb = (const bf16_t*)(a.ws + A_VV); const bf16_t* Gg = (const bf16_t*)(a.ws + A_E); const float* Bon = (const float*)(a.ws + A_BON);
    const float* gn_w = a.in[22]; const float* gn_b = a.in[23];
    const int tid = fresh_tid(F.wave), grp = tid >> 4, gl = tid & 15;
    for (int item = F.vcu * 32 + grp; item < T * 16; item += F.G * 32) {
        const int tok = item >> 4, hd = item & 15; const size_t idx = (size_t)tok * D + hd * 64 + 4 * gl;
        const f32x4 y = unpack4(*(const u32x2*)(Yb + idx)), v = unpack4(*(const u32x2*)(Vb + idx)), g = unpack4(*(const u32x2*)(Gg + idx));
        const float bo = Bon[(size_t)tok * 16 + hd];
        const f32x4 gw = *(const f32x4*)(gn_w + hd * 64 + 4 * gl), gb = *(const f32x4*)(gn_b + hd * 64 + 4 * gl);
        const float mu = red16((y[0] + y[1]) + (y[2] + y[3])) * (1.0f / 64.0f);
        const f32x4 d = y - mu; const float var = red16((d[0] * d[0] + d[1] * d[1]) + (d[2] * d[2] + d[3] * d[3])) * (1.0f / 64.0f);
        const float rs = __builtin_amdgcn_rsqf(var + GN_EPS);
        const f32x4 ov = (d * rs * gw + gb + v * bo) * g;
        u32x2 w; w.x = cvt_pk_bf16(ov[0], ov[1]); w.y = cvt_pk_bf16(ov[2], ov[3]); *(u32x2*)(Yb + idx) = w;
    }
}

constexpr int KROW = 400, VROW = 144, KBUF = 64 * KROW, VBUF = 128 * VROW, ABUF = KBUF + VBUF;
__device__ __forceinline__ void attn_unit(LAS unsigned char* lds, const bf16_t* qn, const bf16_t* qr, const bf16_t* kn, const bf16_t* kr, const bf16_t* vt, bf16_t* o_out, int b, int h, int qb, int wave_s) {
    const int tid = fresh_tid(wave_s), lane = tid & 63, wid = __builtin_amdgcn_readfirstlane(tid >> 6), r32 = lane & 31, hi = lane >> 5;
    const int tok0 = b * SEQ, q0 = qb * 256 + wid * 32;
    bf16x8 qf[12];
    { const size_t tq = (size_t)(tok0 + q0 + r32);
#pragma unroll
      for (int d = 0; d < 8; ++d) qf[d] = *(const bf16x8*)(qn + tq * D + h * 128 + d * 16 + hi * 8);
#pragma unroll
      for (int d = 0; d < 4; ++d) qf[8 + d] = *(const bf16x8*)(qr + tq * 512 + h * 64 + d * 16 + hi * 8); }
    const int NT = (qb + 1) * 4;
    const int kkey0 = tid >> 4, kch0 = tid & 15;
    const int rkey = tid >> 3, rch = tid & 7;
    const int vrow0 = tid >> 3, vch = tid & 7;
    const bf16_t* gk0 = kn + (size_t)(tok0 + kkey0) * D + h * 128 + kch0 * 8;
    const bf16_t* gk1 = gk0 + (size_t)32 * D;
    const bf16_t* gr = kr + (size_t)(tok0 + rkey) * 64 + rch * 8;
    const bf16_t* gv0 = vt + (size_t)(h * 128 + vrow0) * T + tok0 + vch * 8;
    const bf16_t* gv1 = gv0 + (size_t)64 * T;
    const int lk0 = kkey0 * KROW + kch0 * 16, lk1 = lk0 + 32 * KROW, lr = rkey * KROW + 256 + rch * 16, lv0 = KBUF + vrow0 * VROW + vch * 16, lv1 = lv0 + 64 * VROW;
    const int pr = (r32 & 0x13) | ((r32 & 4) << 1) | ((r32 & 8) >> 1);
    const int kfo = pr * KROW + hi * 16, vfo = KBUF + r32 * VROW + hi * 16;
    u32x4 ld0, ld1, ld2, ld3, ld4;
    ld0 = *(const u32x4*)gk0; ld1 = *(const u32x4*)gk1; ld2 = *(const u32x4*)gr; ld3 = *(const u32x4*)gv0; ld4 = *(const u32x4*)gv1;
    __syncthreads();
    *(LAS u32x4*)(lds + lk0) = ld0; *(LAS u32x4*)(lds + lk1) = ld1; *(LAS u32x4*)(lds + lr) = ld2; *(LAS u32x4*)(lds + lv0) = ld3; *(LAS u32x4*)(lds + lv1) = ld4;
    __syncthreads();
    float mrun = -1e30f, lrun = 0.f;
    f32x16 o[4];
#pragma unroll
    for (int d = 0; d < 4; ++d) o[d] = f32x16{};
    for (int t = 0; t < NT; ++t) {
        const int cb = (t & 1) * ABUF, nb = ((t + 1) & 1) * ABUF;
        const bool more = (t + 1 < NT);
        if (more) { const size_t ko = (size_t)(t + 1) * 64 * D, ro = (size_t)(t + 1) * 64 * 64, vo = (size_t)(t + 1) * 64;
            ld0 = *(const u32x4*)(gk0 + ko); ld1 = *(const u32x4*)(gk1 + ko); ld2 = *(const u32x4*)(gr + ro); ld3 = *(const u32x4*)(gv0 + vo); ld4 = *(const u32x4*)(gv1 + vo); }
        if (64 * t <= q0 + 31) {
            f32x16 s0 = f32x16{}, s1 = f32x16{};
            __builtin_amdgcn_s_setprio(1);
#pragma unroll
            for (int d = 0; d < 12; ++d) {
                const bf16x8 k0 = *(const LAS bf16x8*)(lds + cb + kfo + d * 32), k1 = *(const LAS bf16x8*)(lds + cb + kfo + 32 * KROW + d * 32);
                s0 = __builtin_amdgcn_mfma_f32_32x32x16_bf16(k0, qf[d], s0, 0, 0, 0);
                s1 = __builtin_amdgcn_mfma_f32_32x32x16_bf16(k1, qf[d], s1, 0, 0, 0);
            }
            __builtin_amdgcn_s_setprio(0);
            if (64 * t + 63 > q0) {
                const int qi = q0 + r32, kb0 = 64 * t + 8 * hi;
#pragma unroll
                for (int r = 0; r < 16; ++r) { const int key = kb0 + 16 * (r >> 3) + (r & 7); if (key > qi) s0[r] = -1e30f; if (key + 32 > qi) s1[r] = -1e30f; }
            }
            float mx = fmaxf(fmaxf(s0[0], s1[0]), s0[1]);
#pragma unroll
            for (int r = 1; r < 16; ++r) mx = fmaxf(fmaxf(mx, s1[r]), (r < 15) ? s0[r + 1] : s1[r]);
            { auto rr = __builtin_amdgcn_permlane32_swap(__float_as_uint(mx), __float_as_uint(mx), false, false); mx = fmaxf(__uint_as_float(rr[0]), __uint_as_float(rr[1])); }
            if (__any(mx - mrun > 8.0f)) {
                const float mnew = fmaxf(mrun, mx); const float alpha = __builtin_amdgcn_exp2f(mrun - mnew); mrun = mnew; lrun *= alpha;
#pragma unroll
                for (int d = 0; d < 4; ++d) o[d] = o[d] * alpha;
            }
            float ps = 0.f;
#pragma unroll
            for (int r = 0; r < 16; ++r) { s0[r] = __builtin_amdgcn_exp2f(s0[r] - mrun); s1[r] = __builtin_amdgcn_exp2f(s1[r] - mrun); ps += s0[r] + s1[r]; }
            lrun += ps;
            bf16x8 pf[4];
            { u32x4 w;
              w.x = cvt_pk_bf16(s0[0], s0[1]); w.y = cvt_pk_bf16(s0[2], s0[3]); w.z = cvt_pk_bf16(s0[4], s0[5]); w.w = cvt_pk_bf16(s0[6], s0[7]); pf[0] = __builtin_bit_cast(bf16x8, w);
              w.x = cvt_pk_bf16(s0[8], s0[9]); w.y = cvt_pk_bf16(s0[10], s0[11]); w.z = cvt_pk_bf16(s0[12], s0[13]); w.w = cvt_pk_bf16(s0[14], s0[15]); pf[1] = __builtin_bit_cast(bf16x8, w);
              w.x = cvt_pk_bf16(s1[0], s1[1]); w.y = cvt_pk_bf16(s1[2], s1[3]); w.z = cvt_pk_bf16(s1[4], s1[5]); w.w = cvt_pk_bf16(s1[6], s1[7]); pf[2] = __builtin_bit_cast(bf16x8, w);
              w.x = cvt_pk_bf16(s1[8], s1[9]); w.y = cvt_pk_bf16(s1[10], s1[11]); w.z = cvt_pk_bf16(s1[12], s1[13]); w.w = cvt_pk_bf16(s1[14], s1[15]); pf[3] = __builtin_bit_cast(bf16x8, w); }
            __builtin_amdgcn_s_setprio(1);
#pragma unroll
            for (int d = 0; d < 4; ++d)
#pragma unroll
                for (int ks = 0; ks < 4; ++ks) {
                    const bf16x8 vf = *(const LAS bf16x8*)(lds + cb + vfo + d * 32 * VROW + ks * 32);
                    o[d] = __builtin_amdgcn_mfma_f32_32x32x16_bf16(vf, pf[ks], o[d], 0, 0, 0);
                }
            __builtin_amdgcn_s_setprio(0);
        }
        if (more) { *(LAS u32x4*)(lds + nb + lk0) = ld0; *(LAS u32x4*)(lds + nb + lk1) = ld1; *(LAS u32x4*)(lds + nb + lr) = ld2; *(LAS u32x4*)(lds + nb + lv0) = ld3; *(LAS u32x4*)(lds + nb + lv1) = ld4; }
        __syncthreads();
    }
    { auto rr = __builtin_amdgcn_permlane32_swap(__float_as_uint(lrun), __float_as_uint(lrun), false, false); lrun = __uint_as_float(rr[0]) + __uint_as_float(rr[1]); }
    const float rl = __builtin_amdgcn_rcpf(lrun);
    bf16_t* op = o_out + (size_t)(tok0 + q0 + r32) * D + h * 128 + 4 * hi;
#pragma unroll
    for (int d = 0; d < 4; ++d)
#pragma unroll
        for (int r4 = 0; r4 < 4; ++r4) { u32x2 w; w.x = cvt_pk_bf16(o[d][4 * r4] * rl, o[d][4 * r4 + 1] * rl); w.y = cvt_pk_bf16(o[d][4 * r4 + 2] * rl, o[d][4 * r4 + 3] * rl);
            *(u32x2*)(op + 32 * d + 8 * r4) = w; }
}
__device__ __forceinline__ void p_attn(const Ctx& F, const Args& a) {
    const bf16_t* qn = (const bf16_t*)(a.ws + A_QN); const bf16_t* qr = (const bf16_t*)(a.ws + A_QR);
    const bf16_t* kn = (const bf16_t*)(a.ws + A_KN); const bf16_t* kr = (const bf16_t*)(a.ws + A_KR); const bf16_t* vt = (const bf16_t*)(a.ws + A_VT);
    bf16_t* oo = (bf16_t*)(a.ws + A_QN);
    for (int p = F.vcu; p < 512; p += F.G) {
        const int bh = p >> 3, s = p & 7;
        attn_unit(F.lds, qn, qr, kn, kr, vt, oo, bh >> 3, bh & 7, 15 - s, F.wave);
        attn_unit(F.lds, qn, qr, kn, kr, vt, oo, bh >> 3, bh & 7, s, F.wave);
    }
}

__device__ __forceinline__ void p_final(const Ctx& F, const Args& a) {
    float* h = a.out; const float* g = a.in[32];
    const int tid = fresh_tid(F.wave), lane = tid & 63, wave = __builtin_amdgcn_readfirstlane(tid >> 6);
    const int gw = F.vcu * 8 + wave, NGW = F.G * 8;
    f32x4 gv[4];
#pragma unroll
    for (int j = 0; j < 4; ++j) gv[j] = *((const f32x4*)g + lane + 64 * j);
    for (int m = gw; m < T; m += NGW) {
        f32x4 v[4]; float ss = 0.f;
#pragma unroll
        for (int j = 0; j < 4; ++j) { v[j] = *((const f32x4*)(h + (size_t)m * D) + lane + 64 * j); ss += (v[j][0] * v[j][0] + v[j][1] * v[j][1]) + (v[j][2] * v[j][2] + v[j][3] * v[j][3]); }
        const float rs = __builtin_amdgcn_rsqf(wave_sum(ss) * (1.0f / 1024.0f) + RMS_EPS);
#pragma unroll
        for (int j = 0; j < 4; ++j) *((f32x4*)(h + (size_t)m * D) + lane + 64 * j) = v[j] * rs * gv[j];
    }
}

#define XB_XCNT(j)  (256  + 64 * (j))
#define XB_XSUB(j)  (1280 + 64 * (j))
#define XB_XGEN(j)  (2304 + 64 * (j))
#define XB_TOP      3328
#define XB_TOPGEN   3392
__device__ __forceinline__ unsigned xb_ld(unsigned* p)              { return __hip_atomic_load(p, __ATOMIC_RELAXED, __HIP_MEMORY_SCOPE_AGENT); }
__device__ __forceinline__ unsigned xb_add(unsigned* p, unsigned v) { return __hip_atomic_fetch_add(p, v, __ATOMIC_RELAXED, __HIP_MEMORY_SCOPE_AGENT); }
__device__ __forceinline__ void my_grid_sync(unsigned* bar, unsigned G, int wave_s, unsigned x, volatile LAS unsigned* st) {
    asm volatile("s_waitcnt vmcnt(0) lgkmcnt(0)" ::: "memory");
    __syncthreads();
    if (fresh_tid(wave_s) == 0) {
        unsigned nloc = st[0], nx = st[1];
        if (nloc == 0u) {
            for (;;) { unsigned sum = 0u, cnt = 0u, mine = 0u;
#pragma unroll
                for (unsigned j = 0; j < 16; ++j) { const unsigned c = xb_ld(&bar[XB_XCNT(j)]); sum += c; cnt += (c > 0u) ? 1u : 0u; mine = (j == x) ? c : mine; }
                if (sum == G) { nloc = mine; nx = cnt; break; }
                __builtin_amdgcn_s_sleep(1); }
            st[0] = nloc; st[1] = nx;
        }
        const unsigned old = xb_add(&bar[XB_XSUB(x)], 1u);
        const unsigned gen = old / nloc;
        if (old + 1u == (gen + 1u) * nloc) {
            __builtin_amdgcn_fence(__ATOMIC_RELEASE, "agent");
            asm volatile("s_waitcnt vmcnt(0)" ::: "memory");
            const unsigned og = xb_add(&bar[XB_TOP], 1u);
            const unsigned tg = og / nx;
            if (og + 1u == (tg + 1u) * nx) xb_add(&bar[XB_TOPGEN], 1u);
            else while (xb_ld(&bar[XB_TOPGEN]) == tg) __builtin_amdgcn_s_sleep(1);
            __builtin_amdgcn_fence(__ATOMIC_ACQUIRE, "agent");
            xb_add(&bar[XB_XGEN(x)], 1u);
            asm volatile("s_waitcnt vmcnt(0)" ::: "memory");
        } else {
            while (xb_ld(&bar[XB_XGEN(x)]) == gen) __builtin_amdgcn_s_sleep(1);
            __builtin_amdgcn_fence(__ATOMIC_ACQUIRE, "agent");
            asm volatile("s_waitcnt vmcnt(0)" ::: "memory");
        }
    }
    __syncthreads();
}
#define GSYNC() do { my_grid_sync(bar_words + 64 * bar_idx, (unsigned)F.G, F.wave); ++bar_idx; } while (0)
#define RUN_GEMM(EPI_T, epi, Aptr, lda_, Bptr, ldb_, M_, N_, K_) do { pg8::Gemm g_{(const bf16_t*)(Aptr), (lda_), (const bf16_t*)(Bptr), (ldb_), (M_), (N_), (K_)}; \
    pg8::StaticOrder S_; S_.init((M_), (N_), F.G, (int)blockIdx.x); pg8::gemm_phase<EPI_T, pg8::StaticOrder>(F.lds, g_, S_, (epi), F.wave); } while (0)

__global__ void __launch_bounds__(512, 2) fwd_mega(Args a) {
    extern __shared__ __attribute__((aligned(16))) unsigned char lds_raw[];
    cg::grid_group grid = cg::this_grid();
    Ctx F; F.lds = (LAS unsigned char*)lds_raw; F.wave = __builtin_amdgcn_readfirstlane((int)threadIdx.x >> 6);
    F.G = gridDim.x; { const int bx = blockIdx.x; F.vcu = (F.G % 8 == 0) ? (bx % 8) * (F.G / 8) + bx / 8 : bx; }
    unsigned char* ws = a.ws;
    float* slotsH = (float*)(ws + WS_SLOTH); float* slotsC = (float*)(ws + WS_SLOTC); float* slotsQ = (float*)(ws + WS_SLOTQ);
    bf16_t* HB = (bf16_t*)(ws + A_HB); bf16_t* MID = (bf16_t*)(ws + A_MID);
    const float* cosT = (const float*)(ws + A_COS); const float* sinT = (const float*)(ws + A_SIN);
    bf16_t* WUG = (bf16_t*)(ws + W_UG); bf16_t* WDN = (bf16_t*)(ws + W_DN);

    unsigned* bar_words = (unsigned*)ws;
    if (a.ph_hi > 1000) grid.sync();
    const unsigned xcc = (unsigned)__builtin_amdgcn_s_getreg((3 << 11) | 20) & 0xFu;
    volatile LAS unsigned* xst = (volatile LAS unsigned*)(F.lds + 131072 + 64);
    if (fresh_tid(F.wave) == 0) { xst[0] = 0u; xst[1] = 0u; (void)xb_add(&bar_words[XB_XCNT(xcc)], 1u); }
    __syncthreads();
    if (a.ph_lo <= 0 && 0 < a.ph_hi) {
    p0_prologue(F, a);
    }
    if (a.ph_lo <= 0 && 1 < a.ph_hi) my_grid_sync(bar_words, (unsigned)F.G, F.wave, xcc, xst);
    if (a.ph_lo <= 1 && 1 < a.ph_hi) {
    { EpiSwiglu E{MID, slotsH, nullptr, nullptr, nullptr, nullptr, nullptr}; RUN_GEMM(EpiSwiglu, E, HB, D, WUG, D, T, 5632, D); }
    }
    if (a.ph_lo <= 1 && 2 < a.ph_hi) my_grid_sync(bar_words, (unsigned)F.G, F.wave, xcc, xst);
    if (a.ph_lo <= 2 && 2 < a.ph_hi) {
    { EpiResid E{a.in[0], a.out, nullptr, nullptr, 0.5f}; RUN_GEMM(EpiResid, E, MID, FF, WDN, FF, T, D, FF); }
    }
    if (a.ph_lo <= 2 && 3 < a.ph_hi) my_grid_sync(bar_words, (unsigned)F.G, F.wave, xcc, xst);
    if (a.ph_lo <= 3 && 3 < a.ph_hi) {
    p_premix(F, a);
    }
    if (a.ph_lo <= 3 && 4 < a.ph_hi) my_grid_sync(bar_words, (unsigned)F.G, F.wave, xcc, xst);
    if (a.ph_lo <= 4 && 4 < a.ph_hi) {
    { EpiRL E{(bf16_t*)(ws + A_R), (bf16_t*)(ws + A_LM)}; pg8::Gemm g_{(const bf16_t*)(ws + A_X1), 2048, (const bf16_t*)(ws + W_RL), 2048, T, 1280, 2048}; pg8::OrderRL S_{(int)blockIdx.x};
      pg8::gemm_phase<EpiRL, pg8::OrderRL>(F.lds, g_, S_, E, F.wave); }
    }
    if (a.ph_lo <= 4 && 5 < a.ph_hi) my_grid_sync(bar_words, (unsigned)F.G, F.wave, xcc, xst);
    if (a.ph_lo <= 5 && 5 < a.ph_hi) {
    { EpiBf16 E{(bf16_t*)(ws + A_KK), D}; RUN_GEMM(EpiBf16, E, ws + A_XK, D, ws + W_K, D, T, D, D); }
    { EpiBf16 E{(bf16_t*)(ws + A_VV), D}; RUN_GEMM(EpiBf16, E, ws + A_XV, D, ws + W_V, D, T, D, D); }
    { EpiLoraUp E{ws, a.in[11], a.in[14], 0, A_G}; RUN_GEMM(EpiLoraUp, E, ws + A_LM, 256, ws + W_LU, 256, T, 2048, 256); }
    }
    if (a.ph_lo <= 5 && 6 < a.ph_hi) my_grid_sync(bar_words, (unsigned)F.G, F.wave, xcc, xst);
    if (a.ph_lo <= 6 && 6 < a.ph_hi) {
    p_scan2(F, a);
    }
    if (a.ph_lo <= 6 && 7 < a.ph_hi) my_grid_sync(bar_words, (unsigned)F.G, F.wave, xcc, xst);
    if (a.ph_lo <= 7 && 7 < a.ph_hi) {
    { EpiLoraUp E{ws, a.in[11], a.in[14], 2, A_E}; RUN_GEMM(EpiLoraUp, E, ws + A_LM, 256, ws + W_LU + (size_t)2048 * 256 * 2, 256, T, 1024, 256); }
    }
    if (a.ph_lo <= 7 && 8 < a.ph_hi) my_grid_sync(bar_words, (unsigned)F.G, F.wave, xcc, xst);
    if (a.ph_lo <= 8 && 8 < a.ph_hi) {
    p_post(F, a);
    }
    if (a.ph_lo <= 8 && 9 < a.ph_hi) my_grid_sync(bar_words, (unsigned)F.G, F.wave, xcc, xst);
    if (a.ph_lo <= 9 && 9 < a.ph_hi) {
    { EpiResid E{a.out, a.out, HB, slotsH, 1.0f}; RUN_GEMM(EpiResid, E, ws + A_G, D, ws + W_O, D, T, D, D); }
    }
    if (a.ph_lo <= 9 && 10 < a.ph_hi) my_grid_sync(bar_words, (unsigned)F.G, F.wave, xcc, xst);
    if (a.ph_lo <= 10 && 10 < a.ph_hi) {
    { EpiSwiglu E{MID, slotsH, nullptr, nullptr, nullptr, nullptr, nullptr}; RUN_GEMM(EpiSwiglu, E, HB, D, WUG + (size_t)1 * 6144 * D, D, T, 5632, D); }
    }
    if (a.ph_lo <= 10 && 11 < a.ph_hi) my_grid_sync(bar_words, (unsigned)F.G, F.wave, xcc, xst);
    if (a.ph_lo <= 11 && 11 < a.ph_hi) {
    { EpiResid E{a.out, a.out, HB, slotsH, 0.5f}; RUN_GEMM(EpiResid, E, MID, FF, WDN + (size_t)1 * D * FF, FF, T, D, FF); }
    }
    if (a.ph_lo <= 11 && 12 < a.ph_hi) my_grid_sync(bar_words, (unsigned)F.G, F.wave, xcc, xst);
    if (a.ph_lo <= 12 && 12 < a.ph_hi) {
    { EpiSwiglu E{MID, slotsH, (bf16_t*)(ws + A_C), slotsC, (bf16_t*)(ws + A_KR), cosT, sinT}; RUN_GEMM(EpiSwiglu, E, HB, D, WUG + (size_t)2 * 6144 * D, D, T, 6144, D); }
    }
    if (a.ph_lo <= 12 && 13 < a.ph_hi) my_grid_sync(bar_words, (unsigned)F.G, F.wave, xcc, xst);
    if (a.ph_lo <= 13 && 13 < a.ph_hi) {
    { EpiResid E{a.out, a.out, HB, slotsH, 0.5f}; RUN_GEMM(EpiResid, E, MID, FF, WDN + (size_t)2 * D * FF, FF, T, D, FF); }
    { EpiKnope E{(bf16_t*)(ws + A_KN), slotsC}; RUN_GEMM(EpiKnope, E, ws + A_C, 256, ws + W_KN, 256, T, D, 256); }
    { EpiVt E{(bf16_t*)(ws + A_VT), slotsC}; RUN_GEMM(EpiVt, E, ws + W_VT, 256, ws + A_C, 256, D, T, 256); }
    }
    if (a.ph_lo <= 13 && 14 < a.ph_hi) my_grid_sync(bar_words, (unsigned)F.G, F.wave, xcc, xst);
    if (a.ph_lo <= 14 && 14 < a.ph_hi) {
    { EpiQlat E{(bf16_t*)(ws + A_QLAT), slotsH, slotsQ}; RUN_GEMM(EpiQlat, E, HB, D, ws + W_DQ, D, T, 512, D); }
    }
    if (a.ph_lo <= 14 && 15 < a.ph_hi) my_grid_sync(bar_words, (unsigned)F.G, F.wave, xcc, xst);
    if (a.ph_lo <= 15 && 15 < a.ph_hi) {
    { EpiQ E{(bf16_t*)(ws + A_QN), (bf16_t*)(ws + A_QR), slotsQ, cosT, sinT}; RUN_GEMM(EpiQ, E, ws + A_QLAT, 512, ws + W_UQ, 512, T, 1536, 512); }
    }
    if (a.ph_lo <= 15 && 16 < a.ph_hi) my_grid_sync(bar_words, (unsigned)F.G, F.wave, xcc, xst);
    if (a.ph_lo <= 16 && 16 < a.ph_hi) {
    p_attn(F, a);
    }
    if (a.ph_lo <= 16 && 17 < a.ph_hi) my_grid_sync(bar_words, (unsigned)F.G, F.wave, xcc, xst);
    if (a.ph_lo <= 17 && 17 < a.ph_hi) {
    { EpiResid E{a.out, a.out, HB, slotsH, 1.0f}; RUN_GEMM(EpiResid, E, ws + A_QN, D, ws + W_MO, D, T, D, D); }
    }
    if (a.ph_lo <= 17 && 18 < a.ph_hi) my_grid_sync(bar_words, (unsigned)F.G, F.wave, xcc, xst);
    if (a.ph_lo <= 18 && 18 < a.ph_hi) {
    { EpiSwiglu E{MID, slotsH, nullptr, nullptr, nullptr, nullptr, nullptr}; RUN_GEMM(EpiSwiglu, E, HB, D, WUG + (size_t)3 * 6144 * D, D, T, 5632, D); }
    }
    if (a.ph_lo <= 18 && 19 < a.ph_hi) my_grid_sync(bar_words, (unsigned)F.G, F.wave, xcc, xst);
    if (a.ph_lo <= 19 && 19 < a.ph_hi) {
    { EpiResid E{a.out, a.out, nullptr, nullptr, 0.5f}; RUN_GEMM(EpiResid, E, MID, FF, WDN + (size_t)3 * D * FF, FF, T, D, FF); }
    }
    if (a.ph_lo <= 19 && 20 < a.ph_hi) my_grid_sync(bar_words, (unsigned)F.G, F.wave, xcc, xst);
    if (a.ph_lo <= 20 && 20 < a.ph_hi) {
    p_final(F, a);
    }
}

extern "C" void kernel_launch(void* const* d_in, const int* in_sizes, int n_in, void* d_out, int out_size, void* d_ws, size_t ws_size, hipStream_t stream) {
    static int grid = 0;
    if (grid == 0) {
        if (n_in != 33 || out_size != T * D || ws_size < WS_NEED) { fprintf(stderr, "kernel_launch: unexpected shapes: n_in %d out %d ws %zu (need %zu)\n", n_in, out_size, ws_size, (size_t)WS_NEED); grid = -1; return; }
        int dev = 0, cus = 0, per_cu = 0;
        (void)hipGetDevice(&dev); (void)hipDeviceGetAttribute(&cus, hipDeviceAttributeMultiprocessorCount, dev);
        (void)hipFuncSetAttribute((const void*)fwd_mega, hipFuncAttributeMaxDynamicSharedMemorySize, LDS_BYTES);
        (void)hipOccupancyMaxActiveBlocksPerMultiprocessor(&per_cu, (const void*)fwd_mega, 512, LDS_BYTES);
        (void)hipGetLastError();
        grid = cus > 0 ? cus : 256;
        if (grid > 256) grid = 256;
    }
    if (grid < 0) return;
    (void)hipMemsetAsync(d_ws, 0, 16384, stream);
    Args a{};
    for (int i = 0; i < 33; ++i) a.in[i] = (const float*)d_in[i];
    a.pos = (const int*)d_in[1]; a.out = (float*)d_out; a.ws = (unsigned char*)d_ws;
    hipError_t e = hipSuccess;
#if N_LAUNCHES == 1
    a.ph_lo = 0; a.ph_hi = NPHASES;
    { void* args[] = {&a}; e = hipLaunchCooperativeKernel((void*)fwd_mega, dim3(grid), dim3(512), args, LDS_BYTES, stream); }
#else
    for (int p = 0; p < NPHASES; ++p) { a.ph_lo = p; a.ph_hi = p + 1; hipLaunchKernelGGL(fwd_mega, dim3(grid), dim3(512), LDS_BYTES, stream, a); }
    e = hipPeekAtLastError();
#endif
    if (e != hipSuccess) fprintf(stderr, "cooperative launch failed: %s (grid %d)\n", hipGetErrorString(e), grid);
}
```
